# Optimizing an MI355X kernel written in HIP

```python
import math
import jax, jax.numpy as jnp
from jax import lax
import numpy as np

D_MODEL = 1024
BATCH = 8
SEQ = 4096
DEPTH = 2

GRID_W = 64
CTX_LEN = 256

CONV_CH = 256
HY_CH = 256
RW_HEADS = 8
RW_HEAD_DIM = 64
RW_CH = RW_HEADS * RW_HEAD_DIM
MIX_W = CONV_CH + HY_CH + RW_CH
RW_DECAY_RANK = 64
RW_ICLR_RANK = 64
RW_GATE_RANK = 128
RW_COLS = 3 * RW_CH + 2 * RW_DECAY_RANK + 2 * RW_ICLR_RANK + RW_GATE_RANK
P_IN = 3 * CONV_CH + 3 * HY_CH + RW_COLS
RW_GN_EPS = 64e-5
HY_ORDER = 2
HY_EMB = 33
HY_BANDS = (HY_EMB - 1) // 2
HY_HID = 64
HY_TARGET = 1e-2
HY_FAST = 0.3
HY_SLOW = 1.5
N_EXPERTS = 64
TOP_K = 8
EXPERT_FF = 256
SHARED_FF = 256
ROUTED_SCALE = 2.5
EXPERT_BLOCK = 256
DN_ALPHA = (2 * DEPTH) ** 0.25
DN_BETA = (8 * DEPTH) ** -0.25
LN_EPS = 1e-5

kernel_name = 'hybrid_conv_hyena_rwkv7_moe_dit'

F32 = jnp.float32


def layer_norm(x, g, b):
    xf = x.astype(F32)
    mu = jnp.mean(xf, -1, keepdims=True)
    var = jnp.mean(jnp.square(xf - mu), -1, keepdims=True)
    return ((xf - mu) * lax.rsqrt(var + LN_EPS) * g + b).astype(x.dtype)


def rms_norm(y, g):
    yf = y.astype(F32)
    return (yf * lax.rsqrt(jnp.mean(yf * yf, -1, keepdims=True) + LN_EPS) * g).astype(y.dtype)


def dwconv3(u, w, axis=1):
    n = u.shape[axis]
    pad = [(0, 0)] * u.ndim
    pad[axis] = (1, 1)
    up = jnp.pad(u, pad)
    tap = lambda s: lax.slice_in_dim(up, s, s + n, axis=axis)
    return tap(0) * w[0] + tap(1) * w[1] + tap(2) * w[2]


def short_conv_mixer(u, conv_w, rows):
    b_gate, c_gate, xin = jnp.split(u, 3, axis=-1)
    z = c_gate * xin
    if rows is None:
        z = dwconv3(z, conv_w, axis=1)
    else:
        bsz, n, ch = z.shape
        z = dwconv3(z.reshape(bsz, rows, GRID_W, ch), conv_w, axis=1).reshape(bsz, n, ch)
    return b_gate * z


def hyena_filters(L, w1, b1, w2, b2, w3, b3, w_out, freq):
    w1, b1, w2, b2, w3, b3, w_out, freq = (a.astype(F32) for a in (w1, b1, w2, b2, w3, b3, w_out, freq))
    t = jnp.linspace(0.0, 1.0, L, dtype=F32)[:, None]
    pos = jnp.arange(L, dtype=F32)[:, None]
    bands = jnp.linspace(1e-4, HY_BANDS - 1, HY_BANDS, dtype=F32)[None, :]
    ang = (2.0 * math.pi / L) * pos * bands
    z = jnp.concatenate([t, jnp.cos(ang), -jnp.sin(ang)], axis=-1)
    h = jnp.sin(freq * (z @ w1 + b1))
    h = jnp.sin(freq * (h @ w2 + b2))
    h = jnp.sin(freq * (h @ w3 + b3))
    h = (h @ w_out).reshape(L, HY_ORDER, 2, HY_CH)
    deltas = jnp.abs(jnp.linspace(math.log(HY_TARGET) / HY_SLOW, math.log(HY_TARGET) / HY_FAST, HY_CH, dtype=F32))
    h = h * jnp.exp(-t * deltas)[:, None, None, :]
    k_two = jnp.concatenate([h[:, :, 0], jnp.zeros((1, HY_ORDER, HY_CH), F32), jnp.flip(h[1:, :, 1], axis=0)], axis=0)
    return jnp.fft.rfft(k_two, axis=0)


def fft_long_conv(u, kf, skip):
    L = u.shape[1]
    uf32 = u.astype(F32)
    uf = jnp.fft.rfft(uf32, n=2 * L, axis=1)
    y = jnp.fft.irfft(uf * kf[None], n=2 * L, axis=1)[:, :L]
    return y + uf32 * skip.astype(F32)


def hyena_mixer(u, sconv_w, sconv_b, kf, skip):
    u = dwconv3(u, sconv_w) + sconv_b
    v, x1, x2 = jnp.split(u, 3, axis=-1)
    z = fft_long_conv(v, kf[:, 0], skip[0]) * x1
    z = fft_long_conv(z, kf[:, 1], skip[1]) * x2
    return z.astype(u.dtype)


def _heads(t):
    return t.reshape(t.shape[:-1] + (RW_HEADS, RW_HEAD_DIM))


def rwkv_inputs(u, mu, w0, w_up, a0, a_up, k_k, k_a):
    bsz, n, _ = u.shape
    shift_w = jnp.stack([mu[0], 1.0 - mu[0] - mu[1], mu[1]])
    u = dwconv3(u, shift_w)
    r = u[..., :RW_CH]
    k = u[..., RW_CH:2 * RW_CH]
    v = u[..., 2 * RW_CH:3 * RW_CH]
    o = 3 * RW_CH
    wd = u[..., o:o + 2 * RW_DECAY_RANK].reshape(bsz, n, 2, RW_DECAY_RANK)
    o += 2 * RW_DECAY_RANK
    ad = u[..., o:o + 2 * RW_ICLR_RANK].reshape(bsz, n, 2, RW_ICLR_RANK)
    gd = u[..., o + 2 * RW_ICLR_RANK:]
    w_log = -jax.nn.softplus(-(w0 + jnp.einsum('bldr,drc->bldc', jnp.tanh(wd), w_up))) - 0.5
    decay = jnp.exp(-jnp.exp(w_log.astype(F32)))
    a = jax.nn.sigmoid(a0 + jnp.einsum('bldr,drc->bldc', ad, a_up))
    kd = k[:, :, None, :] * (1.0 + (a - 1.0) * k_a)
    kk = _heads(k * k_k).astype(F32)
    kk = kk * lax.rsqrt(jnp.maximum(jnp.sum(kk * kk, -1, keepdims=True), 1e-24))
    return (_heads(r), _heads(decay), _heads(kd), _heads(v), kk, _heads(a), gd)


def _wkv_step(S, inp):
    r, w, k, v, kk, a = inp
    sk = jnp.einsum('dbhvk,dbhk->dbhv', S, kk)
    S = S * w[..., None, :] - sk[..., None] * (kk * a)[..., None, :] + v[..., None] * k[..., None, :]
    y = jnp.einsum('dbhvk,dbhk->dbhv', S, r)
    return S, y


def wkv_bidir(s0, r, decay, kd, v, kk, a):
    def to_scan(t):
        t = jnp.stack([t[:, :, 0], jnp.flip(t[:, :, 1], axis=1)], axis=0).astype(F32)
        return jnp.moveaxis(t, 2, 0)
    dup = lambda t: jnp.stack([t, t], axis=2)
    xs = tuple(to_scan(t) for t in (dup(r), decay, kd, dup(v), dup(kk), a))
    S, ys = lax.scan(_wkv_step, s0, xs)
    y = ys[:, 0] + jnp.flip(ys[:, 1], axis=0)
    return S, jnp.moveaxis(y, 0, 1)


def rwkv_output(y, r, kd, v, gd, g_up, r_k, lnx_g, lnx_b):
    bsz, n = y.shape[:2]
    mu = jnp.mean(y, -1, keepdims=True)
    var = jnp.mean(jnp.square(y - mu), -1, keepdims=True)
    yn = ((y - mu) * lax.rsqrt(var + RW_GN_EPS)).reshape(bsz, n, RW_CH) * lnx_g + lnx_b
    s = jnp.einsum('blhn,bldhn,hn->blh', r.astype(F32), kd.astype(F32), r_k.astype(F32))
    bonus = (s[..., None] * v.astype(F32)).reshape(bsz, n, RW_CH)
    g = jax.nn.sigmoid(gd) @ g_up
    return ((yn + bonus) * g).astype(gd.dtype)


def token_mixer(hl, hc, lp, need_ctx):
    L_lat, L_ctx = hl.shape[1], hc.shape[1]
    rows = L_lat // GRID_W
    cut = [3 * CONV_CH, 3 * CONV_CH + 3 * HY_CH]
    pl_a, pl_h, pl_r = jnp.split(hl @ lp['w_in'], cut, axis=-1)
    pc_a, pc_h, pc_r = jnp.split(hc @ lp['w_in'], cut, axis=-1)
    rw_p = (lp['rw_mu'], lp['rw_w0'], lp['rw_w_up'], lp['rw_a0'], lp['rw_a_up'], lp['rw_k_k'], lp['rw_k_a'])
    rc = rwkv_inputs(pc_r, *rw_p)
    rl = rwkv_inputs(pl_r, *rw_p)
    s0 = jnp.zeros((2, hl.shape[0], RW_HEADS, RW_HEAD_DIM, RW_HEAD_DIM), F32)
    s_ctx, y_ctx = wkv_bidir(s0, *rc[:6])
    _, y_lat = wkv_bidir(s_ctx, *rl[:6])

    def merge(p_a, p_h, rw, y, grid_rows, L):
        ya = short_conv_mixer(p_a, lp['conv_a'], grid_rows)
        kf = hyena_filters(L, lp['hf_w1'], lp['hf_b1'], lp['hf_w2'], lp['hf_b2'],
                           lp['hf_w3'], lp['hf_b3'], lp['hf_wout'], lp['hf_freq'])
        yh = hyena_mixer(p_h, lp['hy_sconv_w'], lp['hy_sconv_b'], kf, lp['hf_skip'])
        r, _, kd, v, _, _, gd = rw
        yr = rwkv_output(y, r, kd, v, gd, lp['rw_g_up'], lp['rw_r_k'], lp['rw_lnx_g'], lp['rw_lnx_b'])
        g = lp['mix_norm_g']
        ycat = jnp.concatenate([rms_norm(ya, g[:CONV_CH]), rms_norm(yh, g[CONV_CH:]), yr], axis=-1)
        return ycat @ lp['w_out']

    out_l = merge(pl_a, pl_h, rl, y_lat, rows, L_lat)
    out_c = merge(pc_a, pc_h, rc, y_ctx, None, L_ctx) if need_ctx else None
    return out_l, out_c


def swiglu(t, wg, wu, wd):
    return (jax.nn.silu(t @ wg) * (t @ wu)) @ wd


def routed_experts(t, idx, gate, w_gate, w_up, w_down):
    n_tok, d = t.shape
    m = n_tok * TOP_K
    flat_e = idx.reshape(m)
    flat_tok = jnp.arange(m, dtype=jnp.int32) // TOP_K
    flat_gate = gate.reshape(m)
    order = jnp.argsort(flat_e)
    e_sorted = flat_e[order]
    counts = jnp.bincount(flat_e, length=N_EXPERTS)
    padded = (counts + EXPERT_BLOCK - 1) // EXPERT_BLOCK * EXPERT_BLOCK
    pad_end = jnp.cumsum(padded)
    pad_start = pad_end - padded
    cnt_start = jnp.cumsum(counts) - counts
    slot = pad_start[e_sorted] + jnp.arange(m, dtype=jnp.int32) - cnt_start[e_sorted]
    n_blocks = -(-(m + N_EXPERTS * (EXPERT_BLOCK - 1)) // EXPERT_BLOCK)
    cap = n_blocks * EXPERT_BLOCK
    slot_tok = jnp.full((cap,), n_tok, jnp.int32).at[slot].set(flat_tok[order])
    slot_gate = jnp.zeros((cap,), t.dtype).at[slot].set(flat_gate[order])
    block_e = jnp.minimum(jnp.searchsorted(pad_end, jnp.arange(n_blocks, dtype=jnp.int32) * EXPERT_BLOCK, side='right'), N_EXPERTS - 1)
    t_pad = jnp.concatenate([t, jnp.zeros((1, d), t.dtype)], axis=0)

    def block_step(acc, blk):
        tok, g, e = blk
        y = swiglu(t_pad[tok], w_gate[e], w_up[e], w_down[e]) * g[:, None]
        return acc.at[tok].add(y), None

    acc, _ = lax.scan(block_step, jnp.zeros((n_tok + 1, d), t.dtype),
                      (slot_tok.reshape(n_blocks, EXPERT_BLOCK), slot_gate.reshape(n_blocks, EXPERT_BLOCK), block_e))
    return acc[:n_tok]


def moe_ffn(t, w_router, e_bias, w_e_gate, w_e_up, w_e_down, w_s_gate, w_s_up, w_s_down):
    scores = jax.nn.sigmoid((t @ w_router).astype(F32))
    _, idx = lax.top_k(scores + e_bias.astype(F32), TOP_K)
    sel = jnp.take_along_axis(scores, idx, axis=-1)
    gate = (ROUTED_SCALE * sel / jnp.sum(sel, -1, keepdims=True)).astype(t.dtype)
    return routed_experts(t, idx, gate, w_e_gate, w_e_up, w_e_down) + swiglu(t, w_s_gate, w_s_up, w_s_down)


def setup_inputs(seed: int = 0) -> dict:
    key = jax.random.key(seed)
    ks = iter(jax.random.split(key, 64))
    D = D_MODEL

    def nrm(shape, std):
        return std * jax.random.normal(next(ks), shape, F32)

    x = nrm((BATCH, SEQ, D), 1.0)
    c = nrm((BATCH, D), 1.0)
    ctx = nrm((BATCH, CTX_LEN, D), 1.0)
    c_ctx = nrm((D,), 1.0)
    w_ada = nrm((DEPTH, D, 6 * D), D ** -0.5)
    b_ada = nrm((DEPTH, 6 * D), 0.02)
    w_in = nrm((DEPTH, D, P_IN), D ** -0.5)
    conv_a = nrm((DEPTH, 3, CONV_CH), 3 ** -0.5)
    hy_sconv_w = nrm((DEPTH, 3, 3 * HY_CH), 3 ** -0.5)
    hy_sconv_b = nrm((DEPTH, 3 * HY_CH), 0.02)
    hf_w1 = nrm((DEPTH, HY_EMB, HY_HID), HY_EMB ** -0.5)
    hf_b1 = nrm((DEPTH, HY_HID), 0.1)
    hf_w2 = nrm((DEPTH, HY_HID, HY_HID), HY_HID ** -0.5)
    hf_b2 = nrm((DEPTH, HY_HID), 0.1)
    hf_w3 = nrm((DEPTH, HY_HID, HY_HID), HY_HID ** -0.5)
    hf_b3 = nrm((DEPTH, HY_HID), 0.1)
    hf_wout = nrm((DEPTH, HY_HID, HY_ORDER * 2 * HY_CH), 0.02)
    hf_freq = 1.0 + nrm((DEPTH, HY_HID), 0.05)
    hf_skip = nrm((DEPTH, HY_ORDER, HY_CH), 1.0)
    rw_mu = jax.random.uniform(next(ks), (DEPTH, 2, RW_COLS), F32, 0.0, 0.4)
    ramp = jnp.linspace(0.0, 1.0, RW_CH, dtype=F32) ** 0.85
    rw_w0 = (-6.5 + 5.0 * ramp)[None, None, :] + nrm((DEPTH, 2, RW_CH), 0.1)
    rw_w_up = nrm((DEPTH, 2, RW_DECAY_RANK, RW_CH), 0.1 * RW_DECAY_RANK ** -0.5)
    rw_a0 = nrm((DEPTH, 2, RW_CH), 0.1)
    rw_a_up = nrm((DEPTH, 2, RW_ICLR_RANK, RW_CH), 0.5 * RW_ICLR_RANK ** -0.5)
    rw_g_up = nrm((DEPTH, RW_GATE_RANK, RW_CH), RW_GATE_RANK ** -0.5)
    rw_k_k = 0.85 + nrm((DEPTH, RW_CH), 0.02)
    rw_k_a = 1.0 + nrm((DEPTH, RW_CH), 0.02)
    rw_r_k = nrm((DEPTH, RW_HEADS, RW_HEAD_DIM), 0.1)
    rw_lnx_g = 1.0 + nrm((DEPTH, RW_CH), 0.02)
    rw_lnx_b = nrm((DEPTH, RW_CH), 0.02)
    mix_norm_g = 1.0 + nrm((DEPTH, CONV_CH + HY_CH), 0.02)
    w_out = nrm((DEPTH, MIX_W, D), DN_BETA * MIX_W ** -0.5)
    ln_g = 1.0 + nrm((DEPTH, 2, D), 0.02)
    ln_b = nrm((DEPTH, 2, D), 0.02)
    w_router = nrm((DEPTH, D, N_EXPERTS), D ** -0.5)
    e_bias = nrm((DEPTH, N_EXPERTS), 0.01)
    w_e_gate = nrm((DEPTH, N_EXPERTS, D, EXPERT_FF), D ** -0.5)
    w_e_up = nrm((DEPTH, N_EXPERTS, D, EXPERT_FF), D ** -0.5)
    w_e_down = nrm((DEPTH, N_EXPERTS, EXPERT_FF, D), DN_BETA * EXPERT_FF ** -0.5)
    w_s_gate = nrm((DEPTH, D, SHARED_FF), D ** -0.5)
    w_s_up = nrm((DEPTH, D, SHARED_FF), D ** -0.5)
    w_s_down = nrm((DEPTH, SHARED_FF, D), DN_BETA * SHARED_FF ** -0.5)
    return {'x': x, 'c': c, 'ctx': ctx, 'c_ctx': c_ctx, 'w_ada': w_ada, 'b_ada': b_ada, 'w_in': w_in,
            'conv_a': conv_a, 'hy_sconv_w': hy_sconv_w, 'hy_sconv_b': hy_sconv_b,
            'hf_w1': hf_w1, 'hf_b1': hf_b1, 'hf_w2': hf_w2, 'hf_b2': hf_b2, 'hf_w3': hf_w3, 'hf_b3': hf_b3,
            'hf_wout': hf_wout, 'hf_freq': hf_freq, 'hf_skip': hf_skip,
            'rw_mu': rw_mu, 'rw_w0': rw_w0, 'rw_w_up': rw_w_up, 'rw_a0': rw_a0, 'rw_a_up': rw_a_up,
            'rw_g_up': rw_g_up, 'rw_k_k': rw_k_k, 'rw_k_a': rw_k_a, 'rw_r_k': rw_r_k,
            'rw_lnx_g': rw_lnx_g, 'rw_lnx_b': rw_lnx_b, 'mix_norm_g': mix_norm_g, 'w_out': w_out,
            'ln_g': ln_g, 'ln_b': ln_b, 'w_router': w_router, 'e_bias': e_bias,
            'w_e_gate': w_e_gate, 'w_e_up': w_e_up, 'w_e_down': w_e_down,
            'w_s_gate': w_s_gate, 'w_s_up': w_s_up, 'w_s_down': w_s_down}


def reference(x, c, ctx, c_ctx, w_ada, b_ada, w_in, conv_a, hy_sconv_w, hy_sconv_b,
              hf_w1, hf_b1, hf_w2, hf_b2, hf_w3, hf_b3, hf_wout, hf_freq, hf_skip,
              rw_mu, rw_w0, rw_w_up, rw_a0, rw_a_up, rw_g_up, rw_k_k, rw_k_a, rw_r_k,
              rw_lnx_g, rw_lnx_b, mix_norm_g, w_out, ln_g, ln_b, w_router, e_bias,
              w_e_gate, w_e_up, w_e_down, w_s_gate, w_s_up, w_s_down):
    B, L, D = x.shape
    xc = ctx
    for l in range(DEPTH):
        last = l == DEPTH - 1
        lp = {'w_in': w_in[l], 'conv_a': conv_a[l], 'hy_sconv_w': hy_sconv_w[l], 'hy_sconv_b': hy_sconv_b[l],
              'hf_w1': hf_w1[l], 'hf_b1': hf_b1[l], 'hf_w2': hf_w2[l], 'hf_b2': hf_b2[l],
              'hf_w3': hf_w3[l], 'hf_b3': hf_b3[l], 'hf_wout': hf_wout[l], 'hf_freq': hf_freq[l],
              'hf_skip': hf_skip[l], 'rw_mu': rw_mu[l], 'rw_w0': rw_w0[l], 'rw_w_up': rw_w_up[l],
              'rw_a0': rw_a0[l], 'rw_a_up': rw_a_up[l], 'rw_g_up': rw_g_up[l], 'rw_k_k': rw_k_k[l],
              'rw_k_a': rw_k_a[l], 'rw_r_k': rw_r_k[l], 'rw_lnx_g': rw_lnx_g[l], 'rw_lnx_b': rw_lnx_b[l],
              'mix_norm_g': mix_norm_g[l], 'w_out': w_out[l]}
        mod_l = jax.nn.silu(c) @ w_ada[l] + b_ada[l]
        mod_c = jax.nn.silu(c_ctx) @ w_ada[l] + b_ada[l]
        sh1, sc1, g1, sh2, sc2, g2 = jnp.split(mod_l[:, None, :], 6, axis=-1)
        csh1, csc1, cg1, csh2, csc2, cg2 = jnp.split(mod_c, 6)
        hl = x * (1.0 + sc1) + sh1
        hc = xc * (1.0 + csc1) + csh1
        ol, oc = token_mixer(hl, hc, lp, not last)
        x = layer_norm(DN_ALPHA * x + g1 * ol, ln_g[l, 0], ln_b[l, 0])
        hl = (x * (1.0 + sc2) + sh2).reshape(B * L, D)
        moe_w = (w_router[l], e_bias[l], w_e_gate[l], w_e_up[l], w_e_down[l], w_s_gate[l], w_s_up[l], w_s_down[l])
        if last:
            fl = moe_ffn(hl, *moe_w)
        else:
            xc = layer_norm(DN_ALPHA * xc + cg1 * oc, ln_g[l, 0], ln_b[l, 0])
            hc = (xc * (1.0 + csc2) + csh2).reshape(-1, D)
            f_all = moe_ffn(jnp.concatenate([hl, hc], axis=0), *moe_w)
            fl = f_all[:B * L]
            xc = layer_norm(DN_ALPHA * xc + cg2 * f_all[B * L:].reshape(xc.shape), ln_g[l, 1], ln_b[l, 1])
        x = layer_norm(DN_ALPHA * x + g2 * fl.reshape(B, L, D), ln_g[l, 1], ln_b[l, 1])
    return x
```

```cpp
#ifdef EMU
#include "emu_hip.h"
#else
#include <hip/hip_runtime.h>
#include <hip/hip_cooperative_groups.h>
namespace cg = cooperative_groups;
#endif
#include <stdint.h>
#include <stddef.h>

#define DI __device__ __forceinline__

#ifdef CFG_SMALL
constexpr int D = 384, NB = 2, SEQ = 256, GRID_W = 16, CTXL = 256, CONV_CH = 128, HY_CH = 128, RW_H = 2;
#else
constexpr int D = 1024, NB = 8, SEQ = 4096, GRID_W = 64, CTXL = 256, CONV_CH = 256, HY_CH = 256, RW_H = 8;
#endif
constexpr int DEPTH = 2;
constexpr int HD = 64;
constexpr int RW_CH = RW_H * HD;
constexpr int MIX_W = CONV_CH + HY_CH + RW_CH;
constexpr int DRK = 64, IRK = 64, GRK = 128;
constexpr int RW_COLS = 3 * RW_CH + 2 * DRK + 2 * IRK + GRK;
constexpr int PA_W = 3 * CONV_CH, PH_W = 3 * HY_CH;
constexpr int P_IN = PA_W + PH_W + RW_COLS;
constexpr int HY_EMB = 33, HY_BANDS = 16, HY_HID = 64;
constexpr int NE = 64, TOPK = 8, FF = 256;
constexpr int TL = NB * SEQ, TC = NB * CTXL, T = TL + TC;
constexpr int FFTN = 2 * SEQ;
constexpr int ilog2c(int n) { return n <= 1 ? 0 : 1 + ilog2c(n / 2); }
constexpr int LOG2N = ilog2c(FFTN);
constexpr float LN_EPS = 1e-5f;
constexpr float RW_GN_EPS = 64e-5f;
constexpr float DN_ALPHA = 1.41421356237309515f;
constexpr float ROUTED_SCALE = 2.5f;
constexpr int NT = 512;
constexpr int SMEM_BYTES = 160 * 1024;
static_assert(MIX_W == D, "mix width");
static_assert(D % 128 == 0 && P_IN % 128 == 0 && PA_W % 128 == 0 && PH_W % 128 == 0, "tiles");
static_assert(SEQ % 256 == 0 && CTXL % 256 == 0, "row tiles");

typedef unsigned short u16;
typedef __attribute__((ext_vector_type(8))) short bf16x8;
typedef __attribute__((ext_vector_type(16))) float f32x16;
typedef __attribute__((ext_vector_type(4))) unsigned u32x4;
typedef __attribute__((ext_vector_type(2))) unsigned u32x2;
typedef __attribute__((ext_vector_type(4))) float f32x4;
struct cf { float x, y; };

struct Params {
  const float *x, *c, *ctx, *c_ctx, *w_ada, *b_ada, *w_in, *conv_a, *hy_sconv_w, *hy_sconv_b;
  const float *hf_w1, *hf_b1, *hf_w2, *hf_b2, *hf_w3, *hf_b3, *hf_wout, *hf_freq, *hf_skip;
  const float *rw_mu, *rw_w0, *rw_w_up, *rw_a0, *rw_a_up, *rw_g_up, *rw_k_k, *rw_k_a, *rw_r_k;
  const float *rw_lnx_g, *rw_lnx_b, *mix_norm_g, *w_out, *ln_g, *ln_b, *w_router, *e_bias;
  const float *w_e_gate, *w_e_up, *w_e_down, *w_s_gate, *w_s_up, *w_s_down;
  float* out;
  float* mod;
  float* h3lat;
  float* h3ctx;
  cf* tw;
  int* cnt;
  float* sbonus;
  cf* spec;
  u16* HL;
  u16* PA;
  u16* PHlat;
  u16* PHctx;
  u16* PR;
  u16* SIsh_lat;
  u16* SIsh_ctx;
  u16* SIdir_lat;
  u16* SIdir_ctx;
  u16* ya;
  u16* yhlat;
  u16* yhctx;
  u16* gbuf;
  u16* ybuf;
  u16* ycat;
  float* XA;
  float* acc;
  int* etok;
  float* egate;
};

#ifdef EMU
DI int TIDX() { return threadIdx.x; }
DI int BIDX() { return blockIdx.x; }
#else
DI int TIDX() { int t = threadIdx.x; asm volatile("" : "+v"(t)); return t; }
DI int BIDX() { int b = blockIdx.x; asm volatile("" : "+s"(b)); return b; }
#endif

DI u16 f2bf(float x) {
  unsigned u = __builtin_bit_cast(unsigned, x);
  u += 0x7fffu + ((u >> 16) & 1u);
  return (u16)(u >> 16);
}
DI float bf2f(u16 h) { return __builtin_bit_cast(float, ((unsigned)h) << 16); }
DI u16 f2h(float x) { return __builtin_bit_cast(u16, (_Float16)x); }
DI float h2f(u16 h) { return (float)__builtin_bit_cast(_Float16, h); }
DI float sigmoidf_(float x) { return 1.0f / (1.0f + expf(-x)); }
DI float siluf_(float x) { return x / (1.0f + expf(-x)); }
DI float softplusf_(float x) { return x > 20.f ? x : log1pf(expf(x)); }

DI float wave_sum(float v) {
#pragma unroll
  for (int m = 1; m < 64; m <<= 1) v += __shfl_xor(v, m);
  return v;
}
DI int crow(int reg, int h) { return (reg & 3) + 8 * (reg >> 2) + 4 * h; }
#define MFMA32(a, b, c) __builtin_amdgcn_mfma_f32_32x32x16_bf16((a), (b), (c), 0, 0, 0)

DI int modrow(int r) { return r < TL ? r / SEQ : NB; }
DI const float* modp(const Params& p, int l, int r) { return p.mod + ((size_t)l * (NB + 1) + modrow(r)) * (6 * D); }

constexpr int LDT = 40;
template <class Epi>
DI void gemm_tile_256x128(const u16* __restrict__ A, int lda, const float* __restrict__ B, int ldb, int K, int m0, int n0,
                          char* smem, Epi epi) {
  const int tid = TIDX(), lane = tid & 63, wave = tid >> 6;
  const int wm = wave >> 1, wn = wave & 1;
  u16* As = (u16*)smem;
  u16* Bs = (u16*)(smem + 2 * 256 * LDT * 2);
  f32x16 acc[2][2];
#pragma unroll
  for (int i = 0; i < 2; ++i)
#pragma unroll
    for (int j = 0; j < 2; ++j)
#pragma unroll
      for (int r = 0; r < 16; ++r) acc[i][j][r] = 0.f;
  const int arow = tid >> 2, akq = tid & 3;
  const int bn = tid & 127, bkq = tid >> 7;
  u32x4 ra[2];
  float rb[8];
  auto gload = [&](int k0) {
#pragma unroll
    for (int i = 0; i < 2; ++i) ra[i] = *(const u32x4*)(A + (size_t)(m0 + arow + 128 * i) * lda + k0 + akq * 8);
#pragma unroll
    for (int j = 0; j < 8; ++j) rb[j] = B[(size_t)(k0 + bkq * 8 + j) * ldb + n0 + bn];
  };
  auto lstore = [&](int buf) {
#pragma unroll
    for (int i = 0; i < 2; ++i) *(u32x4*)(As + ((size_t)buf * 256 + arow + 128 * i) * LDT + akq * 8) = ra[i];
    u32x4 pb;
    pb[0] = f2bf(rb[0]) | ((unsigned)f2bf(rb[1]) << 16);
    pb[1] = f2bf(rb[2]) | ((unsigned)f2bf(rb[3]) << 16);
    pb[2] = f2bf(rb[4]) | ((unsigned)f2bf(rb[5]) << 16);
    pb[3] = f2bf(rb[6]) | ((unsigned)f2bf(rb[7]) << 16);
    *(u32x4*)(Bs + ((size_t)buf * 128 + bn) * LDT + bkq * 8) = pb;
  };
  gload(0);
  lstore(0);
  __syncthreads();
  const int nk = K / 32;
  for (int kt = 0; kt < nk; ++kt) {
    const int cur = kt & 1;
    if (kt + 1 < nk) gload((kt + 1) * 32);
#pragma unroll
    for (int ks = 0; ks < 2; ++ks) {
      bf16x8 af[2], bfr[2];
#pragma unroll
      for (int i = 0; i < 2; ++i)
        af[i] = *(const bf16x8*)(As + ((size_t)cur * 256 + wm * 64 + i * 32 + (lane & 31)) * LDT + ks * 16 + (lane >> 5) * 8);
#pragma unroll
      for (int j = 0; j < 2; ++j)
        bfr[j] = *(const bf16x8*)(Bs + ((size_t)cur * 128 + wn * 64 + j * 32 + (lane & 31)) * LDT + ks * 16 + (lane >> 5) * 8);
#pragma unroll
      for (int i = 0; i < 2; ++i)
#pragma unroll
        for (int j = 0; j < 2; ++j) acc[i][j] = MFMA32(af[i], bfr[j], acc[i][j]);
    }
    if (kt + 1 < nk) lstore(cur ^ 1);
    __syncthreads();
  }
#pragma unroll
  for (int i = 0; i < 2; ++i)
#pragma unroll
    for (int j = 0; j < 2; ++j)
#pragma unroll
      for (int r = 0; r < 16; ++r)
        epi(m0 + wm * 64 + i * 32 + crow(r, lane >> 5), n0 + wn * 64 + j * 32 + (lane & 31), acc[i][j][r]);
}

DI void ph_prologue(const Params& p, char* smem) {
  const int tid = TIDX();
  constexpr int NCH = 6 * D / 128;
  constexpr int ITEMS_MOD = DEPTH * NCH;
  constexpr int ITEMS_H3 = DEPTH * (SEQ / 64 + CTXL / 64);
  constexpr int ITEMS = ITEMS_MOD + ITEMS_H3 + 1;
  for (int item = BIDX(); item < ITEMS; item += gridDim.x) {
    if (item < ITEMS_MOD) {
      const int l = item / NCH, ch = item % NCH;
      float* sv = (float*)smem;
      float* red = sv + (NB + 1) * D;
      for (int i = tid; i < (NB + 1) * D; i += NT) {
        int row = i / D, e = i % D;
        float v = row < NB ? p.c[row * D + e] : p.c_ctx[e];
        sv[i] = siluf_(v);
      }
      __syncthreads();
      const int col = ch * 128 + (tid & 127), kg = tid >> 7;
      float a[NB + 1];
#pragma unroll
      for (int r = 0; r < NB + 1; ++r) a[r] = 0.f;
      const float* W = p.w_ada + (size_t)l * D * 6 * D;
      for (int k = kg * (D / 4); k < (kg + 1) * (D / 4); ++k) {
        float w = W[(size_t)k * 6 * D + col];
#pragma unroll
        for (int r = 0; r < NB + 1; ++r) a[r] += sv[r * D + k] * w;
      }
#pragma unroll
      for (int r = 0; r < NB + 1; ++r) red[(kg * (NB + 1) + r) * 128 + (tid & 127)] = a[r];
      __syncthreads();
      for (int i = tid; i < (NB + 1) * 128; i += NT) {
        int r = i / 128, cc = i % 128;
        float s = 0.f;
        for (int g = 0; g < 4; ++g) s += red[(g * (NB + 1) + r) * 128 + cc];
        int cg_ = ch * 128 + cc;
        p.mod[((size_t)l * (NB + 1) + r) * 6 * D + cg_] = s + p.b_ada[(size_t)l * 6 * D + cg_];
      }
      __syncthreads();
    } else if (item < ITEMS_MOD + ITEMS_H3) {
      int it = item - ITEMS_MOD;
      constexpr int PER_L = SEQ / 64 + CTXL / 64;
      const int l = it / PER_L;
      int q = it % PER_L;
      const bool isctx = q >= SEQ / 64;
      const int L = isctx ? CTXL : SEQ;
      const int pos0 = (isctx ? q - SEQ / 64 : q) * 64;
      float* z = (float*)smem;
      float* ha = z + 64 * 36;
      float* hb = ha + 64 * 64;
      for (int i = tid; i < 64 * HY_EMB; i += NT) {
        int pp = i / HY_EMB, e = i % HY_EMB;
        int pos = pos0 + pp;
        float v;
        if (e == 0) v = (float)pos / (float)(L - 1);
        else {
          int bi = (e - 1) % HY_BANDS;
          float band = 1e-4f + ((float)(HY_BANDS - 1) - 1e-4f) * (float)bi / (float)(HY_BANDS - 1);
          float ang = (2.0f * 3.14159265358979323846f / (float)L) * (float)pos * band;
          v = (e - 1) < HY_BANDS ? cosf(ang) : -sinf(ang);
        }
        z[pp * 36 + e] = v;
      }
      __syncthreads();
      const int pp = tid >> 3, sub = tid & 7;
      const float* fr = p.hf_freq + l * HY_HID;
      {
        const float* w = p.hf_w1 + (size_t)l * HY_EMB * HY_HID;
        const float* b = p.hf_b1 + l * HY_HID;
        for (int uu = 0; uu < 8; ++uu) {
          int u = sub * 8 + uu;
          float s = b[u];
          for (int e = 0; e < HY_EMB; ++e) s += z[pp * 36 + e] * w[e * HY_HID + u];
          ha[pp * 64 + u] = sinf(fr[u] * s);
        }
      }
      __syncthreads();
      {
        const float* w = p.hf_w2 + (size_t)l * HY_HID * HY_HID;
        const float* b = p.hf_b2 + l * HY_HID;
        for (int uu = 0; uu < 8; ++uu) {
          int u = sub * 8 + uu;
          float s = b[u];
          for (int e = 0; e < HY_HID; ++e) s += ha[pp * 64 + e] * w[e * HY_HID + u];
          hb[pp * 64 + u] = sinf(fr[u] * s);
        }
      }
      __syncthreads();
      {
        const float* w = p.hf_w3 + (size_t)l * HY_HID * HY_HID;
        const float* b = p.hf_b3 + l * HY_HID;
        float* dst = isctx ? p.h3ctx + ((size_t)l * CTXL + pos0) * 64 : p.h3lat + ((size_t)l * SEQ + pos0) * 64;
        for (int uu = 0; uu < 8; ++uu) {
          int u = sub * 8 + uu;
          float s = b[u];
          for (int e = 0; e < HY_HID; ++e) s += hb[pp * 64 + e] * w[e * HY_HID + u];
          dst[pp * 64 + u] = sinf(fr[u] * s);
        }
      }
      __syncthreads();
    } else {
      for (int k = tid; k < FFTN / 2; k += NT) {
        double ang = -2.0 * 3.14159265358979323846 * (double)k / (double)FFTN;
        cf w; w.x = (float)cos(ang); w.y = (float)sin(ang);
        p.tw[k] = w;
      }
      for (int i = tid; i < DEPTH * NE; i += NT) p.cnt[i] = 0;
    }
  }
}

DI void ph_premod(const Params& p) {
  const int tid = TIDX();
  constexpr int ITEMS = T / 8;
  for (int item = BIDX(); item < ITEMS; item += gridDim.x) {
    for (int i = tid; i < 8 * D; i += NT) {
      int r = item * 8 + i / D, e = i % D;
      const float* m = modp(p, 0, r);
      float xv = r < TL ? p.x[(size_t)r * D + e] : p.ctx[(size_t)(r - TL) * D + e];
      p.HL[(size_t)r * D + e] = f2bf(xv * (1.f + m[D + e]) + m[e]);
    }
  }
}

template <int R, bool INV>
DI void fft_pass(cf* buf, const cf* tw, int m) {
  const int g = m >> (R - 1);
  constexpr int NQ = 1 << R;
  for (int w = TIDX(); w < (FFTN >> R); w += NT) {
    const int j = w % g, blk = w / g;
    const int base = blk * (g << R) + j;
    cf v[NQ];
#pragma unroll
    for (int q = 0; q < NQ; ++q) v[q] = buf[base + q * g];
    if (!INV) {
#pragma unroll
      for (int r = 0; r < R; ++r) {
        const int half = 1 << (R - 1 - r);
#pragma unroll
        for (int q = 0; q < NQ; ++q) {
          if ((q & half) == 0) {
            const int jj = (q & (half - 1)) * g + j;
            const cf W = tw[jj * ((FFTN / 2) / (half * g))];
            cf a = v[q], b = v[q + half];
            v[q].x = a.x + b.x; v[q].y = a.y + b.y;
            float dx = a.x - b.x, dy = a.y - b.y;
            v[q + half].x = dx * W.x - dy * W.y;
            v[q + half].y = dx * W.y + dy * W.x;
          }
        }
      }
    } else {
#pragma unroll
      for (int r = R - 1; r >= 0; --r) {
        const int half = 1 << (R - 1 - r);
#pragma unroll
        for (int q = 0; q < NQ; ++q) {
          if ((q & half) == 0) {
            const int jj = (q & (half - 1)) * g + j;
            const cf W = tw[jj * ((FFTN / 2) / (half * g))];
            cf a = v[q], b = v[q + half];
            float bx = b.x * W.x + b.y * W.y;
            float by = b.y * W.x - b.x * W.y;
            v[q].x = a.x + bx; v[q].y = a.y + by;
            v[q + half].x = a.x - bx; v[q + half].y = a.y - by;
          }
        }
      }
    }
#pragma unroll
    for (int q = 0; q < NQ; ++q) buf[base + q * g] = v[q];
  }
}
constexpr int FFT_R4 = LOG2N / 4, FFT_REM = LOG2N % 4;
DI void fft_fwd(cf* buf, const cf* tw) {
  int m = FFTN / 2;
#pragma unroll
  for (int i = 0; i < FFT_R4; ++i) { fft_pass<4, false>(buf, tw, m); __syncthreads(); m >>= 4; }
  if (FFT_REM == 3) { fft_pass<3, false>(buf, tw, m); __syncthreads(); }
  if (FFT_REM == 2) { fft_pass<2, false>(buf, tw, m); __syncthreads(); }
  if (FFT_REM == 1) { fft_pass<1, false>(buf, tw, m); __syncthreads(); }
}
DI void fft_inv(cf* buf, const cf* tw) {
  if (FFT_REM == 3) { fft_pass<3, true>(buf, tw, 4); __syncthreads(); }
  if (FFT_REM == 2) { fft_pass<2, true>(buf, tw, 2); __syncthreads(); }
  if (FFT_REM == 1) { fft_pass<1, true>(buf, tw, 1); __syncthreads(); }
  int m = (1 << FFT_REM) * 8;
#pragma unroll
  for (int i = 0; i < FFT_R4; ++i) { fft_pass<4, true>(buf, tw, m); __syncthreads(); m <<= 4; }
}

DI float hy_delta(int c) {
  const float lo = -4.605170185988091f / 1.5f, hi = -4.605170185988091f / 0.3f;
  return fabsf(lo + (hi - lo) * (float)c / (float)(HY_CH - 1));
}

DI void hy_spectrum_item(const Params& p, int l, int o, int c, char* smem) {
  const int tid = TIDX();
  cf* buf = (cf*)smem;
  cf* tw = buf + FFTN;
  float* wc = (float*)(tw + FFTN / 2);
  for (int i = tid; i < FFTN / 2; i += NT) tw[i] = p.tw[i];
  if (tid < 128) {
    int dir = tid >> 6, u = tid & 63;
    wc[tid] = p.hf_wout[((size_t)l * HY_HID + u) * (4 * HY_CH) + o * 2 * HY_CH + dir * HY_CH + c];
  }
  __syncthreads();
  const float dl = hy_delta(c);
  for (int t = tid; t < SEQ; t += NT) {
    const float* h = p.h3lat + ((size_t)l * SEQ + t) * 64;
    float sf = 0.f, sb = 0.f;
    for (int u = 0; u < 64; ++u) { float hv = h[u]; sf += hv * wc[u]; sb += hv * wc[64 + u]; }
    float dec = expf(-((float)t / (float)(SEQ - 1)) * dl);
    cf a; a.x = sf * dec; a.y = 0.f;
    buf[t] = a;
    if (t >= 1) { cf b; b.x = sb * dec; b.y = 0.f; buf[FFTN - t] = b; }
    if (t == 0) { cf zz; zz.x = 0.f; zz.y = 0.f; buf[SEQ] = zz; }
  }
  __syncthreads();
  fft_fwd(buf, tw);
  cf* dst = p.spec + ((size_t)o * HY_CH + c) * FFTN;
  const float sc = 1.0f / (float)FFTN;
  for (int i = tid; i < FFTN; i += NT) { cf v = buf[i]; v.x *= sc; v.y *= sc; dst[i] = v; }
  __syncthreads();
}

DI void ph_inproj(const Params& p, int l, char* smem) {
  constexpr int MT = T / 256, NTL = P_IN / 128;
  constexpr int GEMM_ITEMS = MT * NTL;
  constexpr int SPEC_ITEMS = 2 * HY_CH;
  const float* W = p.w_in + (size_t)l * D * P_IN;
  for (int item = BIDX(); item < GEMM_ITEMS + SPEC_ITEMS; item += gridDim.x) {
    if (item < GEMM_ITEMS) {
      const int mt = item / NTL, nt = item % NTL;
      gemm_tile_256x128(p.HL, D, W, P_IN, D, mt * 256, nt * 128, smem, [&](int r, int n, float v) {
        u16 hv = f2bf(v);
        if (n < PA_W) p.PA[(size_t)r * PA_W + n] = hv;
        else if (n < PA_W + PH_W) {
          int cc = n - PA_W;
          if (r < TL) { int b = r / SEQ, t = r % SEQ; p.PHlat[((size_t)b * PH_W + cc) * SEQ + t] = hv; }
          else { int rc = r - TL; int b = rc / CTXL, t = rc % CTXL; p.PHctx[((size_t)b * PH_W + cc) * CTXL + t] = hv; }
        } else p.PR[(size_t)r * RW_COLS + (n - PA_W - PH_W)] = hv;
      });
    } else {
      int it = item - GEMM_ITEMS;
      hy_spectrum_item(p, l, it / HY_CH, it % HY_CH, smem);
    }
  }
}

DI float hy_u(const u16* P, int t, int L, float w0, float w1, float w2, float bias) {
  float s = w1 * bf2f(P[t]) + bias;
  if (t >= 1) s += w0 * bf2f(P[t - 1]);
  if (t + 1 < L) s += w2 * bf2f(P[t + 1]);
  return s;
}

DI void hyena_lat_item(const Params& p, int l, int c, int pair, char* smem) {
  const int tid = TIDX();
  cf* buf = (cf*)smem;
  cf* tw = buf + FFTN;
  for (int i = tid; i < FFTN / 2; i += NT) tw[i] = p.tw[i];
  constexpr int NPT = (SEQ + NT - 1) / NT;
  const float* cw = p.hy_sconv_w + (size_t)l * 3 * PH_W;
  const float* cb = p.hy_sconv_b + (size_t)l * PH_W;
  const int b0 = pair * 2, b1 = pair * 2 + 1;
  float vr[NPT][2], z1[NPT][2];
  {
    const int col = c;
    const float w0 = cw[col], w1 = cw[PH_W + col], w2 = cw[2 * PH_W + col], bs = cb[col];
    const u16* P0 = p.PHlat + ((size_t)b0 * PH_W + col) * SEQ;
    const u16* P1 = p.PHlat + ((size_t)b1 * PH_W + col) * SEQ;
#pragma unroll
    for (int i = 0; i < NPT; ++i) {
      int t = tid + i * NT;
      if (t < SEQ) {
        vr[i][0] = hy_u(P0, t, SEQ, w0, w1, w2, bs);
        vr[i][1] = hy_u(P1, t, SEQ, w0, w1, w2, bs);
        cf a; a.x = vr[i][0]; a.y = vr[i][1];
        buf[t] = a;
        cf zz; zz.x = 0.f; zz.y = 0.f;
        buf[t + SEQ] = zz;
      }
    }
  }
  __syncthreads();
  fft_fwd(buf, tw);
  {
    const cf* sp = p.spec + ((size_t)0 * HY_CH + c) * FFTN;
    for (int i = tid; i < FFTN; i += NT) {
      cf a = buf[i], k = sp[i], r;
      r.x = a.x * k.x - a.y * k.y; r.y = a.x * k.y + a.y * k.x;
      buf[i] = r;
    }
  }
  __syncthreads();
  fft_inv(buf, tw);
  {
    const int col = HY_CH + c;
    const float w0 = cw[col], w1 = cw[PH_W + col], w2 = cw[2 * PH_W + col], bs = cb[col];
    const u16* P0 = p.PHlat + ((size_t)b0 * PH_W + col) * SEQ;
    const u16* P1 = p.PHlat + ((size_t)b1 * PH_W + col) * SEQ;
    const float sk = p.hf_skip[((size_t)l * 2 + 0) * HY_CH + c];
    cf yv[NPT];
#pragma unroll
    for (int i = 0; i < NPT; ++i) { int t = tid + i * NT; if (t < SEQ) yv[i] = buf[t]; }
    __syncthreads();
#pragma unroll
    for (int i = 0; i < NPT; ++i) {
      int t = tid + i * NT;
      if (t < SEQ) {
        z1[i][0] = (yv[i].x + sk * vr[i][0]) * hy_u(P0, t, SEQ, w0, w1, w2, bs);
        z1[i][1] = (yv[i].y + sk * vr[i][1]) * hy_u(P1, t, SEQ, w0, w1, w2, bs);
        cf a; a.x = z1[i][0]; a.y = z1[i][1];
        buf[t] = a;
        cf zz; zz.x = 0.f; zz.y = 0.f;
        buf[t + SEQ] = zz;
      }
    }
  }
  __syncthreads();
  fft_fwd(buf, tw);
  {
    const cf* sp = p.spec + ((size_t)1 * HY_CH + c) * FFTN;
    for (int i = tid; i < FFTN; i += NT) {
      cf a = buf[i], k = sp[i], r;
      r.x = a.x * k.x - a.y * k.y; r.y = a.x * k.y + a.y * k.x;
      buf[i] = r;
    }
  }
  __syncthreads();
  fft_inv(buf, tw);
  {
    const int col = 2 * HY_CH + c;
    const float w0 = cw[col], w1 = cw[PH_W + col], w2 = cw[2 * PH_W + col], bs = cb[col];
    const u16* P0 = p.PHlat + ((size_t)b0 * PH_W + col) * SEQ;
    const u16* P1 = p.PHlat + ((size_t)b1 * PH_W + col) * SEQ;
    const float sk = p.hf_skip[((size_t)l * 2 + 1) * HY_CH + c];
    u16* o0 = p.yhlat + ((size_t)b0 * HY_CH + c) * SEQ;
    u16* o1 = p.yhlat + ((size_t)b1 * HY_CH + c) * SEQ;
#pragma unroll
    for (int i = 0; i < NPT; ++i) {
      int t = tid + i * NT;
      if (t < SEQ) {
        cf y = buf[t];
        o0[t] = f2bf((y.x + sk * z1[i][0]) * hy_u(P0, t, SEQ, w0, w1, w2, bs));
        o1[t] = f2bf((y.y + sk * z1[i][1]) * hy_u(P1, t, SEQ, w0, w1, w2, bs));
      }
    }
  }
  __syncthreads();
}

DI void hyena_ctx_item(const Params& p, int l, int c, char* smem) {
  const int tid = TIDX();
  float* taps = (float*)smem;
  float* uv = taps + 4 * CTXL;
  float* zb = uv + NB * 3 * CTXL;
  float* wc = zb + NB * CTXL;
  if (tid < 256) {
    int od = tid >> 6, u = tid & 63;
    wc[tid] = p.hf_wout[((size_t)l * HY_HID + u) * (4 * HY_CH) + od * HY_CH + c];
  }
  __syncthreads();
  const float dl = hy_delta(c);
  for (int i = tid; i < 4 * CTXL; i += NT) {
    int od = i / CTXL, t = i % CTXL;
    const float* h = p.h3ctx + ((size_t)l * CTXL + t) * 64;
    float s = 0.f;
    for (int u = 0; u < 64; ++u) s += h[u] * wc[od * 64 + u];
    taps[i] = s * expf(-((float)t / (float)(CTXL - 1)) * dl);
  }
  const float* cw = p.hy_sconv_w + (size_t)l * 3 * PH_W;
  const float* cb = p.hy_sconv_b + (size_t)l * PH_W;
  for (int i = tid; i < NB * 3 * CTXL; i += NT) {
    int b = i / (3 * CTXL), j = (i / CTXL) % 3, t = i % CTXL;
    int col = j * HY_CH + c;
    const u16* P = p.PHctx + ((size_t)b * PH_W + col) * CTXL;
    uv[i] = hy_u(P, t, CTXL, cw[col], cw[PH_W + col], cw[2 * PH_W + col], cb[col]);
  }
  __syncthreads();
  const float sk0 = p.hf_skip[((size_t)l * 2 + 0) * HY_CH + c], sk1 = p.hf_skip[((size_t)l * 2 + 1) * HY_CH + c];
  for (int i = tid; i < NB * CTXL; i += NT) {
    int b = i / CTXL, t = i % CTXL;
    const float* v = uv + (b * 3 + 0) * CTXL;
    float s = 0.f;
    for (int s_ = 0; s_ < CTXL; ++s_) {
      int lag = t - s_;
      float k = lag >= 0 ? taps[0 * CTXL + lag] : taps[1 * CTXL - lag];
      s += k * v[s_];
    }
    zb[i] = (s + sk0 * v[t]) * uv[(b * 3 + 1) * CTXL + t];
  }
  __syncthreads();
  for (int i = tid; i < NB * CTXL; i += NT) {
    int b = i / CTXL, t = i % CTXL;
    const float* v = zb + b * CTXL;
    float s = 0.f;
    for (int s_ = 0; s_ < CTXL; ++s_) {
      int lag = t - s_;
      float k = lag >= 0 ? taps[2 * CTXL + lag] : taps[3 * CTXL - lag];
      s += k * v[s_];
    }
    p.yhctx[((size_t)b * HY_CH + c) * CTXL + t] = f2bf((s + sk1 * v[t]) * uv[(b * 3 + 2) * CTXL + t]);
  }
  __syncthreads();
}

DI void mixer_a_item(const Params& p, int l, int tile) {
  const int tid = TIDX(), lane = tid & 63, wave = tid >> 6;
  constexpr int CPL = CONV_CH / 64;
  const float* cw = p.conv_a + (size_t)l * 3 * CONV_CH;
  const float* gn = p.mix_norm_g + (size_t)l * (CONV_CH + HY_CH);
  for (int tt = 0; tt < 8; ++tt) {
    const int r = tile * 64 + wave * 8 + tt;
    int rp = -1, rn = -1;
    if (r < TL) { int t = r % SEQ; if (t >= GRID_W) rp = r - GRID_W; if (t + GRID_W < SEQ) rn = r + GRID_W; }
    else { int t = (r - TL) % CTXL; if (t >= 1) rp = r - 1; if (t + 1 < CTXL) rn = r + 1; }
    float yv[CPL];
    float ss = 0.f;
#pragma unroll
    for (int i = 0; i < CPL; ++i) {
      const int c = lane * CPL + i;
      const u16* row = p.PA + (size_t)r * PA_W;
      float z = bf2f(row[CONV_CH + c]) * bf2f(row[2 * CONV_CH + c]) * cw[CONV_CH + c];
      if (rp >= 0) { const u16* q = p.PA + (size_t)rp * PA_W; z += bf2f(q[CONV_CH + c]) * bf2f(q[2 * CONV_CH + c]) * cw[c]; }
      if (rn >= 0) { const u16* q = p.PA + (size_t)rn * PA_W; z += bf2f(q[CONV_CH + c]) * bf2f(q[2 * CONV_CH + c]) * cw[2 * CONV_CH + c]; }
      yv[i] = bf2f(row[c]) * z;
      ss += yv[i] * yv[i];
    }
    ss = wave_sum(ss);
    const float rs = rsqrtf(ss / (float)CONV_CH + LN_EPS);
#pragma unroll
    for (int i = 0; i < CPL; ++i) {
      const int c = lane * CPL + i;
      p.ya[(size_t)r * CONV_CH + c] = f2bf(yv[i] * rs * gn[c]);
    }
  }
}

DI void ph_mix(const Params& p, int l, char* smem) {
  const bool need_ctx = (l == 0);
  constexpr int HL_ITEMS = HY_CH * (NB / 2);
  const int HC_ITEMS = need_ctx ? HY_CH : 0;
  const int MA_ITEMS = (need_ctx ? T : TL) / 64;
  const int total = HL_ITEMS + HC_ITEMS + MA_ITEMS;
  for (int item = BIDX(); item < total; item += gridDim.x) {
    if (item < HL_ITEMS) hyena_lat_item(p, l, item / (NB / 2), item % (NB / 2), smem);
    else if (item < HL_ITEMS + HC_ITEMS) hyena_ctx_item(p, l, item - HL_ITEMS, smem);
    else mixer_a_item(p, l, item - HL_ITEMS - HC_ITEMS);
  }
}

DI void seq_of_row(int r, int& b, int& t, int& L) {
  if (r < TL) { b = r / SEQ; t = r % SEQ; L = SEQ; }
  else { int rc = r - TL; b = rc / CTXL; t = rc % CTXL; L = CTXL; }
}
DI float rw_u(const Params& p, const float* mu, int r, int t, int L, int col) {
  const float m0 = mu[col], m2 = mu[RW_COLS + col];
  float s = (1.f - m0 - m2) * bf2f(p.PR[(size_t)r * RW_COLS + col]);
  if (t >= 1) s += m0 * bf2f(p.PR[(size_t)(r - 1) * RW_COLS + col]);
  if (t + 1 < L) s += m2 * bf2f(p.PR[(size_t)(r + 1) * RW_COLS + col]);
  return s;
}
DI bf16x8 load_bfrag(const float* W, int ldn, int k0, int col, int lane) {
  const float* q = W + (size_t)(k0 + 8 * (lane >> 5)) * ldn + col + (lane & 31);
  bf16x8 b;
#pragma unroll
  for (int j = 0; j < 8; ++j) b[j] = (short)f2bf(q[(size_t)j * ldn]);
  return b;
}

DI void wave_sync() {
#ifdef EMU
  emu::wave_barrier();
#else
  asm volatile("s_waitcnt lgkmcnt(0)" ::: "memory");
  __builtin_amdgcn_wave_barrier();
#endif
}

DI void prep_item(const Params& p, int l, int tile, char* smem) {
  const int tid = TIDX(), lane = tid & 63, wave = tid >> 6;
  constexpr int LA = 72, LG = 136;
  constexpr int XW = 32 * 65 + 32;
  u16* Awd = (u16*)smem;
  u16* Aad = Awd + 2 * 64 * LA;
  u16* Agd = Aad + 2 * 64 * LA;
  float* Xall = (float*)(Agd + 64 * LG);
  const float* mu = p.rw_mu + (size_t)l * 2 * RW_COLS;
  const int r0 = tile * 64;
  int b_, t0, L;
  seq_of_row(r0, b_, t0, L);
#pragma unroll 2
  for (int i = tid; i < 64 * 384; i += NT) {
    int tok = i / 384, cc = i % 384;
    float u = rw_u(p, mu, r0 + tok, t0 + tok, L, 3 * RW_CH + cc);
    if (cc < 128) Awd[((cc >> 6) * 64 + tok) * LA + (cc & 63)] = f2bf(tanhf(u));
    else if (cc < 256) { int c2 = cc - 128; Aad[((c2 >> 6) * 64 + tok) * LA + (c2 & 63)] = f2bf(u); }
    else Agd[tok * LG + (cc - 256)] = f2bf(sigmoidf_(u));
  }
  __syncthreads();
  for (int h = wave; h < RW_H; h += 8) {
    float* X = Xall + (size_t)wave * XW;
    float* rinvw = X + 32 * 65;
    const size_t seqidx0 = (size_t)(b_ * RW_H + h) * L + t0;
    u16* sish = (r0 < TL ? p.SIsh_lat : p.SIsh_ctx);
    u16* sidir = (r0 < TL ? p.SIdir_lat : p.SIdir_ctx);
    const size_t dirstride = (size_t)NB * RW_H * L * 192;
    const int n = lane, ch = h * 64 + lane;
    const float kkc = p.rw_k_k[(size_t)l * RW_CH + ch];
    const float k_a = p.rw_k_a[(size_t)l * RW_CH + ch];
    const float r_k = p.rw_r_k[(size_t)l * RW_CH + ch];
#pragma unroll 1
    for (int mt = 0; mt < 2; ++mt) {
#pragma unroll 1
      for (int tt = 0; tt < 32; ++tt) {
        const int tok = mt * 32 + tt;
        float rv = rw_u(p, mu, r0 + tok, t0 + tok, L, ch);
        float kv = rw_u(p, mu, r0 + tok, t0 + tok, L, RW_CH + ch);
        float vv = rw_u(p, mu, r0 + tok, t0 + tok, L, 2 * RW_CH + ch);
        float kr = kv * kkc;
        float ri = rsqrtf(fmaxf(wave_sum(kr * kr), 1e-24f));
        if (lane == 0) rinvw[tt] = ri;
        u16* dst = sish + (seqidx0 + tok) * 192;
        dst[n] = f2bf(rv); dst[64 + n] = f2bf(kr * ri); dst[128 + n] = f2bf(vv);
      }
      float bacc = 0.f;
#pragma unroll 1
      for (int d = 0; d < 2; ++d) {
        {
          f32x16 c0, c1;
#pragma unroll
          for (int r = 0; r < 16; ++r) { c0[r] = 0.f; c1[r] = 0.f; }
          const float* Wu = p.rw_w_up + ((size_t)l * 2 + d) * DRK * RW_CH;
#pragma unroll 1
          for (int ks = 0; ks < 4; ++ks) {
            bf16x8 a1 = *(const bf16x8*)(Awd + (d * 64 + mt * 32 + (lane & 31)) * LA + ks * 16 + (lane >> 5) * 8);
            c0 = MFMA32(a1, load_bfrag(Wu, RW_CH, ks * 16, h * 64, lane), c0);
            c1 = MFMA32(a1, load_bfrag(Wu, RW_CH, ks * 16, h * 64 + 32, lane), c1);
          }
          wave_sync();
#pragma unroll
          for (int r = 0; r < 16; ++r) {
            X[crow(r, lane >> 5) * 65 + (lane & 31)] = c0[r];
            X[crow(r, lane >> 5) * 65 + 32 + (lane & 31)] = c1[r];
          }
          wave_sync();
        }
        const float w0 = p.rw_w0[((size_t)l * 2 + d) * RW_CH + ch];
  #pragma unroll 1
      for (int tt = 0; tt < 32; ++tt) {
          const int tok = mt * 32 + tt;
          float wlog = -softplusf_(-(w0 + X[tt * 65 + n])) - 0.5f;
          float omd = -expm1f(-expf(wlog));
          sidir[(size_t)d * dirstride + (seqidx0 + tok) * 192 + n] = f2h(omd);
        }
        {
          f32x16 c0, c1;
#pragma unroll
          for (int r = 0; r < 16; ++r) { c0[r] = 0.f; c1[r] = 0.f; }
          const float* Au = p.rw_a_up + ((size_t)l * 2 + d) * IRK * RW_CH;
#pragma unroll 1
          for (int ks = 0; ks < 4; ++ks) {
            bf16x8 a1 = *(const bf16x8*)(Aad + (d * 64 + mt * 32 + (lane & 31)) * LA + ks * 16 + (lane >> 5) * 8);
            c0 = MFMA32(a1, load_bfrag(Au, RW_CH, ks * 16, h * 64, lane), c0);
            c1 = MFMA32(a1, load_bfrag(Au, RW_CH, ks * 16, h * 64 + 32, lane), c1);
          }
          wave_sync();
#pragma unroll
          for (int r = 0; r < 16; ++r) {
            X[crow(r, lane >> 5) * 65 + (lane & 31)] = c0[r];
            X[crow(r, lane >> 5) * 65 + 32 + (lane & 31)] = c1[r];
          }
          wave_sync();
        }
        const float a0 = p.rw_a0[((size_t)l * 2 + d) * RW_CH + ch];
  #pragma unroll 1
      for (int tt = 0; tt < 32; ++tt) {
          const int tok = mt * 32 + tt;
          float a = sigmoidf_(a0 + X[tt * 65 + n]);
          float rv = rw_u(p, mu, r0 + tok, t0 + tok, L, ch);
          float kv = rw_u(p, mu, r0 + tok, t0 + tok, L, RW_CH + ch);
          float kkn = kv * kkc * rinvw[tt];
          float kd = kv * (1.f + (a - 1.f) * k_a);
          u16* dst = sidir + (size_t)d * dirstride + (seqidx0 + tok) * 192;
          dst[64 + n] = f2bf(kkn * a); dst[128 + n] = f2bf(kd);
          X[tt * 65 + n] = rv * kd * r_k;
        }
        wave_sync();
        if (lane < 32) {
          float s = 0.f;
#pragma unroll 8
          for (int j = 0; j < 64; ++j) s += X[lane * 65 + j];
          bacc += s;
        }
      }
      if (lane < 32) p.sbonus[(size_t)(r0 + mt * 32 + lane) * RW_H + h] = bacc;
      {
        f32x16 c0, c1;
#pragma unroll
        for (int r = 0; r < 16; ++r) { c0[r] = 0.f; c1[r] = 0.f; }
        const float* Gu = p.rw_g_up + (size_t)l * GRK * RW_CH;
#pragma unroll 1
        for (int ks = 0; ks < 8; ++ks) {
          bf16x8 a1 = *(const bf16x8*)(Agd + (mt * 32 + (lane & 31)) * LG + ks * 16 + (lane >> 5) * 8);
          c0 = MFMA32(a1, load_bfrag(Gu, RW_CH, ks * 16, h * 64, lane), c0);
          c1 = MFMA32(a1, load_bfrag(Gu, RW_CH, ks * 16, h * 64 + 32, lane), c1);
        }
        wave_sync();
#pragma unroll
        for (int r = 0; r < 16; ++r) {
          X[crow(r, lane >> 5) * 65 + (lane & 31)] = c0[r];
          X[crow(r, lane >> 5) * 65 + 32 + (lane & 31)] = c1[r];
        }
        wave_sync();
#pragma unroll 1
        for (int tt = 0; tt < 32; ++tt)
          p.gbuf[(size_t)(r0 + mt * 32 + tt) * RW_CH + ch] = f2bf(X[tt * 65 + n]);
      }
    }
  }
  __syncthreads();
}

DI void ph_prep(const Params& p, int l, char* smem) {
  for (int item = BIDX(); item < T / 64; item += gridDim.x) prep_item(p, l, item, smem);
}

DI void scan_item(const Params& p, int item, char* smem) {
  const int tid = TIDX(), lane = tid & 63, wave = tid >> 6;
  const int hf = item & 1;
  const int chain = item >> 1;
  const int h = chain % RW_H, b = (chain / RW_H) % NB, d = chain / (RW_H * NB);
  const int rl = lane >> 4, kl = lane & 15;
  const int rowl = wave * 4 + rl;
  const int row = hf * 32 + rowl;
  constexpr int TS = 32;
  u16* stg = (u16*)smem;
  float* yb = (float*)(smem + 2 * 2 * TS * 192 * 2);
  float S[4] = {0.f, 0.f, 0.f, 0.f};
  constexpr int NST_C = CTXL / TS, NST_L = SEQ / TS;
  constexpr int NST = NST_C + NST_L;
  u32x4 pre[3];
  auto stage_info = [&](int st, bool& isctx, int& tlo) {
    isctx = st < NST_C;
    int s2 = isctx ? st : st - NST_C;
    int nst = isctx ? NST_C : NST_L;
    tlo = (d == 0 ? s2 : (nst - 1 - s2)) * TS;
  };
  auto gload = [&](int st) {
    bool isctx; int tlo;
    stage_info(st, isctx, tlo);
    const int L = isctx ? CTXL : SEQ;
    const size_t base = ((size_t)(b * RW_H + h) * L + tlo) * 192;
    const u16* sh = (isctx ? p.SIsh_ctx : p.SIsh_lat) + base;
    const u16* dr = (isctx ? p.SIdir_ctx : p.SIdir_lat) + (size_t)d * NB * RW_H * L * 192 + base;
#pragma unroll
    for (int i = 0; i < 3; ++i) {
      int q = tid + i * NT;
      const u16* src = q < 768 ? sh + q * 8 : dr + (q - 768) * 8;
      pre[i] = *(const u32x4*)src;
    }
  };
  auto lstore = [&](int buf) {
#pragma unroll
    for (int i = 0; i < 3; ++i) {
      int q = tid + i * NT;
      *(u32x4*)(stg + (size_t)buf * 2 * TS * 192 + q * 8) = pre[i];
    }
  };
  gload(0);
  lstore(0);
  __syncthreads();
  for (int st = 0; st < NST; ++st) {
    const int cur = st & 1;
    if (st + 1 < NST) gload(st + 1);
    const u16* sh = stg + (size_t)cur * 2 * TS * 192;
    const u16* dr = sh + TS * 192;
    for (int s = 0; s < TS; ++s) {
      const int slot = d == 0 ? s : TS - 1 - s;
      const u16* a = sh + slot * 192;
      const u16* q = dr + slot * 192;
      u32x2 r4 = *(const u32x2*)(a + kl * 4);
      u32x2 kk4 = *(const u32x2*)(a + 64 + kl * 4);
      const float v = bf2f(a[128 + row]);
      u32x2 w4 = *(const u32x2*)(q + kl * 4);
      u32x2 ka4 = *(const u32x2*)(q + 64 + kl * 4);
      u32x2 kd4 = *(const u32x2*)(q + 128 + kl * 4);
      float rr[4], kk[4], ww[4], ka[4], kd[4];
#pragma unroll
      for (int i = 0; i < 2; ++i) {
        rr[2 * i] = bf2f((u16)(r4[i] & 0xffff)); rr[2 * i + 1] = bf2f((u16)(r4[i] >> 16));
        kk[2 * i] = bf2f((u16)(kk4[i] & 0xffff)); kk[2 * i + 1] = bf2f((u16)(kk4[i] >> 16));
        ww[2 * i] = 1.f - h2f((u16)(w4[i] & 0xffff)); ww[2 * i + 1] = 1.f - h2f((u16)(w4[i] >> 16));
        ka[2 * i] = bf2f((u16)(ka4[i] & 0xffff)); ka[2 * i + 1] = bf2f((u16)(ka4[i] >> 16));
        kd[2 * i] = bf2f((u16)(kd4[i] & 0xffff)); kd[2 * i + 1] = bf2f((u16)(kd4[i] >> 16));
      }
      float sk = S[0] * kk[0] + S[1] * kk[1] + S[2] * kk[2] + S[3] * kk[3];
      sk += __shfl_xor(sk, 1); sk += __shfl_xor(sk, 2); sk += __shfl_xor(sk, 4); sk += __shfl_xor(sk, 8);
      float y = 0.f;
#pragma unroll
      for (int i = 0; i < 4; ++i) {
        S[i] = S[i] * ww[i] - sk * ka[i] + v * kd[i];
        y += S[i] * rr[i];
      }
      y += __shfl_xor(y, 1); y += __shfl_xor(y, 2); y += __shfl_xor(y, 4); y += __shfl_xor(y, 8);
      if (kl == 0) yb[slot * 32 + rowl] = y;
    }
    __syncthreads();
    {
      bool isctx; int tlo;
      stage_info(st, isctx, tlo);
      const int slot = tid >> 4, j2 = (tid & 15) * 2;
      const int rrow = isctx ? TL + b * CTXL + tlo + slot : b * SEQ + tlo + slot;
      unsigned pk = f2bf(yb[slot * 32 + j2]) | ((unsigned)f2bf(yb[slot * 32 + j2 + 1]) << 16);
      *(unsigned*)(p.ybuf + ((size_t)d * T + rrow) * RW_CH + h * 64 + hf * 32 + j2) = pk;
    }
    if (st + 1 < NST) lstore(cur ^ 1);
    __syncthreads();
  }
}
DI void ph_scan(const Params& p, char* smem) {
  for (int item = BIDX(); item < 2 * NB * RW_H * 2; item += gridDim.x) scan_item(p, item, smem);
}

DI void ph_assemble(const Params& p, int l, char* smem) {
  const int tid = TIDX(), lane = tid & 63, wave = tid >> 6;
  const int rows = (l == 0) ? T : TL;
  constexpr int LY = 72;
  u16* yt = (u16*)smem;
  constexpr int CPL = CONV_CH / 64, HPL = HY_CH / 64;
  const float* gn = p.mix_norm_g + (size_t)l * (CONV_CH + HY_CH);
  for (int tile = BIDX(); tile < rows / 64; tile += gridDim.x) {
    const int r0 = tile * 64;
    int b_, t0, L;
    seq_of_row(r0, b_, t0, L);
    const u16* yh = (r0 < TL ? p.yhlat : p.yhctx) + (size_t)b_ * HY_CH * L + t0;
    for (int i = tid; i < HY_CH * 8; i += NT) {
      int c = i >> 3, part = i & 7;
      *(u32x4*)(yt + c * LY + part * 8) = *(const u32x4*)(yh + (size_t)c * L + part * 8);
    }
    __syncthreads();
    for (int tt = 0; tt < 8; ++tt) {
      const int tok = wave * 8 + tt;
      const int r = r0 + tok;
      u16* dst = p.ycat + (size_t)r * MIX_W;
#pragma unroll
      for (int i = 0; i < CPL; ++i) dst[lane * CPL + i] = p.ya[(size_t)r * CONV_CH + lane * CPL + i];
      float hv[HPL];
      float ss = 0.f;
#pragma unroll
      for (int i = 0; i < HPL; ++i) { hv[i] = bf2f(yt[(lane * HPL + i) * LY + tok]); ss += hv[i] * hv[i]; }
      ss = wave_sum(ss);
      const float rs = rsqrtf(ss / (float)HY_CH + LN_EPS);
#pragma unroll
      for (int i = 0; i < HPL; ++i) dst[CONV_CH + lane * HPL + i] = f2bf(hv[i] * rs * gn[CONV_CH + lane * HPL + i]);
      const u16* sish = (r0 < TL ? p.SIsh_lat : p.SIsh_ctx);
      for (int h = 0; h < RW_H; ++h) {
        const int ch = h * 64 + lane;
        float yv = bf2f(p.ybuf[(size_t)r * RW_CH + ch]) + bf2f(p.ybuf[((size_t)T + r) * RW_CH + ch]);
        float mu = wave_sum(yv) * (1.f / 64.f);
        float dv = yv - mu;
        float var = wave_sum(dv * dv) * (1.f / 64.f);
        float yn = dv * rsqrtf(var + RW_GN_EPS) * p.rw_lnx_g[(size_t)l * RW_CH + ch] + p.rw_lnx_b[(size_t)l * RW_CH + ch];
        float v = bf2f(sish[((size_t)(b_ * RW_H + h) * L + t0 + tok) * 192 + 128 + lane]);
        float bonus = p.sbonus[(size_t)r * RW_H + h] * v;
        float g = bf2f(p.gbuf[(size_t)r * RW_CH + ch]);
        dst[CONV_CH + HY_CH + ch] = f2bf((yn + bonus) * g);
      }
    }
    __syncthreads();
  }
}

DI void ph_outproj(const Params& p, int l, char* smem) {
  const int rows = (l == 0) ? T : TL;
  constexpr int NTL = D / 128;
  const float* W = p.w_out + (size_t)l * MIX_W * D;
  const int items = (rows / 256) * NTL;
  for (int item = BIDX(); item < items; item += gridDim.x) {
    const int mt = item / NTL, nt = item % NTL;
    gemm_tile_256x128(p.ycat, MIX_W, W, D, MIX_W, mt * 256, nt * 128, smem, [&](int r, int n, float v) {
      const float* m = modp(p, l, r);
      const float g1 = m[2 * D + n];
      if (l == 0) {
        float xv = r < TL ? p.x[(size_t)r * D + n] : p.ctx[(size_t)(r - TL) * D + n];
        p.XA[(size_t)r * D + n] = DN_ALPHA * xv + g1 * v;
      } else {
        float* q = p.out + (size_t)r * D + n;
        *q = DN_ALPHA * (*q) + g1 * v;
      }
    });
  }
}

DI void ph_ln_router(const Params& p, int l, char* smem) {
  const int tid = TIDX(), lane = tid & 63, wave = tid >> 6;
  const int rows = (l == 0) ? T : TL;
  constexpr int LH = D + 4;
  constexpr int EPL = D / 64;
  float* hT = (float*)smem;
  const float* lg = p.ln_g + ((size_t)l * 2 + 0) * D;
  const float* lb = p.ln_b + ((size_t)l * 2 + 0) * D;
  const float* Wr = p.w_router + (size_t)l * D * NE;
  for (int tile = BIDX(); tile < rows / 32; tile += gridDim.x) {
    const int r0 = tile * 32;
    for (int tt = 0; tt < 4; ++tt) {
      const int tok = wave * 4 + tt;
      const int r = r0 + tok;
      float* xr = (l == 0) ? p.XA + (size_t)r * D : p.out + (size_t)r * D;
      const float* m = modp(p, l, r);
      float xv[EPL];
      float s = 0.f;
#pragma unroll
      for (int i = 0; i < EPL; ++i) { xv[i] = xr[lane + 64 * i]; s += xv[i]; }
      const float mu = wave_sum(s) * (1.f / (float)D);
      float s2 = 0.f;
#pragma unroll
      for (int i = 0; i < EPL; ++i) { float dd = xv[i] - mu; s2 += dd * dd; }
      const float rstd = rsqrtf(wave_sum(s2) * (1.f / (float)D) + LN_EPS);
#pragma unroll
      for (int i = 0; i < EPL; ++i) {
        const int e = lane + 64 * i;
        float xn = (xv[i] - mu) * rstd * lg[e] + lb[e];
        xr[e] = xn;
        float hh = xn * (1.f + m[4 * D + e]) + m[3 * D + e];
        hT[tok * LH + e] = hh;
        p.HL[(size_t)r * D + e] = f2bf(hh);
        p.acc[(size_t)r * D + e] = 0.f;
      }
    }
    __syncthreads();
    float lgt[4] = {0.f, 0.f, 0.f, 0.f};
    for (int k = 0; k < D; k += 4) {
      float w0 = Wr[(size_t)(k + 0) * NE + lane], w1 = Wr[(size_t)(k + 1) * NE + lane];
      float w2 = Wr[(size_t)(k + 2) * NE + lane], w3 = Wr[(size_t)(k + 3) * NE + lane];
#pragma unroll
      for (int tt = 0; tt < 4; ++tt) {
        f32x4 hv = *(const f32x4*)(hT + (wave * 4 + tt) * LH + k);
        lgt[tt] += hv[0] * w0 + hv[1] * w1 + hv[2] * w2 + hv[3] * w3;
      }
    }
    const float eb = p.e_bias[(size_t)l * NE + lane];
    for (int tt = 0; tt < 4; ++tt) {
      const int r = r0 + wave * 4 + tt;
      const float score = sigmoidf_(lgt[tt]);
      float selv = score + eb;
      bool chosen = false;
      for (int round = 0; round < TOPK; ++round) {
        float bv = chosen ? -1e30f : selv;
        int bi = lane;
#pragma unroll
        for (int mk = 1; mk < 64; mk <<= 1) {
          float ov = __shfl_xor(bv, mk);
          int oi = __shfl_xor(bi, mk);
          if (ov > bv || (ov == bv && oi < bi)) { bv = ov; bi = oi; }
        }
        if (bi == lane) chosen = true;
      }
      const float ssum = wave_sum(chosen ? score : 0.f);
      if (chosen) {
        int pos = atomicAdd(p.cnt + l * NE + lane, 1);
        p.etok[(size_t)lane * T + pos] = r;
        p.egate[(size_t)lane * T + pos] = ROUTED_SCALE * score / ssum;
      }
    }
    __syncthreads();
  }
}

DI void expert_tile(const Params& p, int l, int e, int tile, int count, char* smem) {
  const int tid = TIDX(), lane = tid & 63, wave = tid >> 6;
  const int wm = wave >> 2, wn = wave & 3;
  constexpr int LHH = FF + 8;
  u16* As = (u16*)smem;
  u16* Bs = As + 2 * 128 * LDT;
  u16* B2 = (u16*)smem;
  u16* Hs = (u16*)(smem + 60 * 1024);
  int* rtok = (int*)(smem + 128 * 1024);
  float* rgate = (float*)(rtok + 128);
  const float *Wg, *Wu, *Wd;
  if (e < NE) {
    Wg = p.w_e_gate + ((size_t)l * NE + e) * D * FF;
    Wu = p.w_e_up + ((size_t)l * NE + e) * D * FF;
    Wd = p.w_e_down + ((size_t)l * NE + e) * FF * D;
  } else {
    Wg = p.w_s_gate + (size_t)l * D * FF;
    Wu = p.w_s_up + (size_t)l * D * FF;
    Wd = p.w_s_down + (size_t)l * FF * D;
  }
  if (tid < 128) {
    int idx = tile * 128 + tid;
    int tk = -1; float gt = 0.f;
    if (idx < count) {
      if (e < NE) { tk = p.etok[(size_t)e * T + idx]; gt = p.egate[(size_t)e * T + idx]; }
      else { tk = idx; gt = 1.f; }
    }
    rtok[tid] = tk; rgate[tid] = gt;
  }
  __syncthreads();
  const int arow = tid >> 2, akq = tid & 3;
  const int atok = rtok[arow];
  constexpr int NK1 = D / 32;
  for (int p2 = 0; p2 < 2; ++p2) {
    f32x16 ag[2], au[2];
#pragma unroll
    for (int i = 0; i < 2; ++i)
#pragma unroll
      for (int r = 0; r < 16; ++r) { ag[i][r] = 0.f; au[i][r] = 0.f; }
    const int bnn = tid & 255, bkh = tid >> 8;
    const float* Bsrc = (bnn < 128) ? Wg + p2 * 128 + bnn : Wu + p2 * 128 + (bnn - 128);
    u32x4 ra;
    u32x4 rbp[2];
    auto gload1 = [&](int k0) {
      if (atok >= 0) ra = *(const u32x4*)(p.HL + (size_t)atok * D + k0 + akq * 8);
      else { ra[0] = 0; ra[1] = 0; ra[2] = 0; ra[3] = 0; }
#pragma unroll
      for (int kq = 0; kq < 2; ++kq) {
        float f[8];
#pragma unroll
        for (int j = 0; j < 8; ++j) f[j] = Bsrc[(size_t)(k0 + bkh * 16 + kq * 8 + j) * FF];
        rbp[kq][0] = f2bf(f[0]) | ((unsigned)f2bf(f[1]) << 16);
        rbp[kq][1] = f2bf(f[2]) | ((unsigned)f2bf(f[3]) << 16);
        rbp[kq][2] = f2bf(f[4]) | ((unsigned)f2bf(f[5]) << 16);
        rbp[kq][3] = f2bf(f[6]) | ((unsigned)f2bf(f[7]) << 16);
      }
    };
    auto lstore1 = [&](int buf) {
      *(u32x4*)(As + ((size_t)buf * 128 + arow) * LDT + akq * 8) = ra;
#pragma unroll
      for (int kq = 0; kq < 2; ++kq) *(u32x4*)(Bs + ((size_t)buf * 256 + bnn) * LDT + bkh * 16 + kq * 8) = rbp[kq];
    };
    gload1(0);
    lstore1(0);
    __syncthreads();
    for (int kt = 0; kt < NK1; ++kt) {
      const int cur = kt & 1;
      if (kt + 1 < NK1) gload1((kt + 1) * 32);
#pragma unroll
      for (int ks = 0; ks < 2; ++ks) {
        bf16x8 af[2];
#pragma unroll
        for (int i = 0; i < 2; ++i)
          af[i] = *(const bf16x8*)(As + ((size_t)cur * 128 + wm * 64 + i * 32 + (lane & 31)) * LDT + ks * 16 + (lane >> 5) * 8);
        bf16x8 bg = *(const bf16x8*)(Bs + ((size_t)cur * 256 + wn * 32 + (lane & 31)) * LDT + ks * 16 + (lane >> 5) * 8);
        bf16x8 bu = *(const bf16x8*)(Bs + ((size_t)cur * 256 + 128 + wn * 32 + (lane & 31)) * LDT + ks * 16 + (lane >> 5) * 8);
#pragma unroll
        for (int i = 0; i < 2; ++i) {
          ag[i] = MFMA32(af[i], bg, ag[i]);
          au[i] = MFMA32(af[i], bu, au[i]);
        }
      }
      if (kt + 1 < NK1) lstore1(cur ^ 1);
      __syncthreads();
    }
#pragma unroll
    for (int i = 0; i < 2; ++i)
#pragma unroll
      for (int r = 0; r < 16; ++r) {
        const int rr = wm * 64 + i * 32 + crow(r, lane >> 5);
        const int cc = p2 * 128 + wn * 32 + (lane & 31);
        Hs[rr * LHH + cc] = f2bf(siluf_(ag[i][r]) * au[i][r]);
      }
  }
  __syncthreads();
  const int bn = tid & 127, bkq = tid >> 7;
  float rb2[8];
  constexpr int NK2 = FF / 32;
  for (int nc = 0; nc < D / 128; ++nc) {
    f32x16 ao[2];
#pragma unroll
    for (int i = 0; i < 2; ++i)
#pragma unroll
      for (int r = 0; r < 16; ++r) ao[i][r] = 0.f;
    auto gload2 = [&](int k0) {
#pragma unroll
      for (int j = 0; j < 8; ++j) rb2[j] = Wd[(size_t)(k0 + bkq * 8 + j) * D + nc * 128 + bn];
    };
    auto lstore2 = [&](int buf) {
      u32x4 pb;
      pb[0] = f2bf(rb2[0]) | ((unsigned)f2bf(rb2[1]) << 16);
      pb[1] = f2bf(rb2[2]) | ((unsigned)f2bf(rb2[3]) << 16);
      pb[2] = f2bf(rb2[4]) | ((unsigned)f2bf(rb2[5]) << 16);
      pb[3] = f2bf(rb2[6]) | ((unsigned)f2bf(rb2[7]) << 16);
      *(u32x4*)(B2 + ((size_t)buf * 128 + bn) * LDT + bkq * 8) = pb;
    };
    gload2(0);
    lstore2(0);
    __syncthreads();
    for (int kt = 0; kt < NK2; ++kt) {
      const int cur = kt & 1;
      if (kt + 1 < NK2) gload2((kt + 1) * 32);
#pragma unroll
      for (int ks = 0; ks < 2; ++ks) {
        bf16x8 bfr = *(const bf16x8*)(B2 + ((size_t)cur * 128 + wn * 32 + (lane & 31)) * LDT + ks * 16 + (lane >> 5) * 8);
#pragma unroll
        for (int i = 0; i < 2; ++i) {
          bf16x8 af = *(const bf16x8*)(Hs + (wm * 64 + i * 32 + (lane & 31)) * LHH + kt * 32 + ks * 16 + (lane >> 5) * 8);
          ao[i] = MFMA32(af, bfr, ao[i]);
        }
      }
      if (kt + 1 < NK2) lstore2(cur ^ 1);
      __syncthreads();
    }
#pragma unroll
    for (int i = 0; i < 2; ++i)
#pragma unroll
      for (int r = 0; r < 16; ++r) {
        const int rr = wm * 64 + i * 32 + crow(r, lane >> 5);
        const int tk = rtok[rr];
        if (tk >= 0) atomicAdd(p.acc + (size_t)tk * D + nc * 128 + wn * 32 + (lane & 31), ao[i][r] * rgate[rr]);
      }
  }
  __syncthreads();
}

DI void ph_experts(const Params& p, int l, char* smem) {
  const int rows = (l == 0) ? T : TL;
  int* pre = (int*)(smem + 130 * 1024);
  if (TIDX() == 0) {
    int s = 0;
    for (int e = 0; e < NE; ++e) { pre[e] = s; s += (p.cnt[l * NE + e] + 127) / 128; }
    pre[NE] = s; s += rows / 128; pre[NE + 1] = s;
  }
  __syncthreads();
  const int total = pre[NE + 1];
  for (int item = BIDX(); item < total; item += gridDim.x) {
    int e = 0;
    while (e < NE && item >= pre[e + 1]) ++e;
    const int tile = item - pre[e];
    const int count = e < NE ? p.cnt[l * NE + e] : rows;
    expert_tile(p, l, e, tile, count, smem);
  }
}

DI void ph_combine(const Params& p, int l) {
  const int tid = TIDX(), lane = tid & 63, wave = tid >> 6;
  const int rows = (l == 0) ? T : TL;
  constexpr int EPL = D / 64;
  const float* lg = p.ln_g + ((size_t)l * 2 + 1) * D;
  const float* lb = p.ln_b + ((size_t)l * 2 + 1) * D;
  for (int tile = BIDX(); tile < rows / 8; tile += gridDim.x) {
    const int r = tile * 8 + wave;
    const float* x1 = (l == 0) ? p.XA + (size_t)r * D : p.out + (size_t)r * D;
    const float* m = modp(p, l, r);
    float xv[EPL];
    float s = 0.f;
#pragma unroll
    for (int i = 0; i < EPL; ++i) {
      const int e = lane + 64 * i;
      xv[i] = DN_ALPHA * x1[e] + m[5 * D + e] * p.acc[(size_t)r * D + e];
      s += xv[i];
    }
    const float mu = wave_sum(s) * (1.f / (float)D);
    float s2 = 0.f;
#pragma unroll
    for (int i = 0; i < EPL; ++i) { float dd = xv[i] - mu; s2 += dd * dd; }
    const float rstd = rsqrtf(wave_sum(s2) * (1.f / (float)D) + LN_EPS);
    const float* m1 = (l + 1 < DEPTH) ? modp(p, l + 1, r) : m;
#pragma unroll
    for (int i = 0; i < EPL; ++i) {
      const int e = lane + 64 * i;
      float xn = (xv[i] - mu) * rstd * lg[e] + lb[e];
      if (r < TL) p.out[(size_t)r * D + e] = xn;
      if (l + 1 < DEPTH) p.HL[(size_t)r * D + e] = f2bf(xn * (1.f + m1[D + e]) + m1[e]);
    }
  }
}

constexpr int NPHASES = 2 + 9 * DEPTH;
DI void run_phase(const Params& p, int ph, char* smem) {
  if (ph == 0) { ph_prologue(p, smem); return; }
  if (ph == 1) { ph_premod(p); return; }
  const int l = (ph - 2) / 9, q = (ph - 2) % 9;
  switch (q) {
    case 0: ph_inproj(p, l, smem); break;
    case 1: ph_mix(p, l, smem); break;
    case 2: ph_prep(p, l, smem); break;
    case 3: ph_scan(p, smem); break;
    case 4: ph_assemble(p, l, smem); break;
    case 5: ph_outproj(p, l, smem); break;
    case 6: ph_ln_router(p, l, smem); break;
    case 7: ph_experts(p, l, smem); break;
    case 8: ph_combine(p, l); break;
  }
}

static inline size_t al256(size_t x) { return (x + 255) & ~(size_t)255; }
static Params make_params(void* const* d_in, void* d_out, void* d_ws) {
  Params p{};
  const float** f = (const float**)&p;
  for (int i = 0; i < 42; ++i) f[i] = (const float*)d_in[i];
  p.out = (float*)d_out;
  char* w = (char*)d_ws;
  size_t o = 0;
  auto take = [&](size_t bytes) { char* r = w + o; o = al256(o + bytes); return r; };
  p.HL = (u16*)take((size_t)T * D * 2);
  p.mod = (float*)take((size_t)DEPTH * (NB + 1) * 6 * D * 4);
  p.h3lat = (float*)take((size_t)DEPTH * SEQ * 64 * 4);
  p.h3ctx = (float*)take((size_t)DEPTH * CTXL * 64 * 4);
  p.tw = (cf*)take((size_t)(FFTN / 2) * 8);
  p.cnt = (int*)take((size_t)DEPTH * NE * 4);
  p.sbonus = (float*)take((size_t)T * RW_H * 4);
  const size_t szG = (size_t)T * RW_CH * 2 > (size_t)2 * HY_CH * FFTN * 8 ? (size_t)T * RW_CH * 2 : (size_t)2 * HY_CH * FFTN * 8;
  char* G = take(szG);
  p.spec = (cf*)G;
  p.gbuf = (u16*)G;
  const size_t szPAPH = (size_t)T * PA_W * 2 + (size_t)T * PH_W * 2;
  const size_t szSIsh = (size_t)T * RW_H * 192 * 2;
  char* R0 = take(szPAPH > szSIsh ? szPAPH : szSIsh);
  p.PA = (u16*)R0;
  p.PHlat = (u16*)(R0 + (size_t)T * PA_W * 2);
  p.PHctx = p.PHlat + (size_t)NB * PH_W * SEQ;
  p.SIsh_lat = (u16*)R0;
  p.SIsh_ctx = p.SIsh_lat + (size_t)NB * RW_H * SEQ * 192;
  const size_t szPR = (size_t)T * RW_COLS * 2, szY = (size_t)2 * T * RW_CH * 2;
  char* R1 = take(szPR > szY ? szPR : szY);
  p.PR = (u16*)R1;
  p.ybuf = (u16*)R1;
  const size_t szSIdir = (size_t)2 * T * RW_H * 192 * 2;
  const size_t szYC = al256((size_t)T * MIX_W * 2), szXA = (size_t)T * D * 4;
  char* R2 = take(szSIdir > szYC + szXA ? szSIdir : szYC + szXA);
  p.SIdir_lat = (u16*)R2;
  p.SIdir_ctx = p.SIdir_lat + (size_t)2 * NB * RW_H * SEQ * 192;
  p.ycat = (u16*)R2;
  p.XA = (float*)(R2 + szYC);
  p.ya = (u16*)take((size_t)T * CONV_CH * 2);
  p.yhlat = (u16*)take((size_t)NB * HY_CH * SEQ * 2);
  p.yhctx = (u16*)take((size_t)NB * HY_CH * CTXL * 2);
  p.acc = (float*)R0;
  p.etok = (int*)(R0 + al256((size_t)T * D * 4));
  p.egate = (float*)(R0 + al256((size_t)T * D * 4) + al256((size_t)NE * T * 4));
  return p;
}
static size_t ws_needed() {
  return (size_t)640 * 1024 * 1024;
}

#ifndef EMU
constexpr int NFIELDS = sizeof(Params) / 8;
static_assert(sizeof(Params) % 8 == 0 && sizeof(Params) <= 1024, "Params layout");
DI unsigned long long uni64(unsigned long long v) {
  unsigned lo = __builtin_amdgcn_readfirstlane((unsigned)v), hi = __builtin_amdgcn_readfirstlane((unsigned)(v >> 32));
  return ((unsigned long long)hi << 32) | lo;
}
DI void load_params(Params& q, const char* smem) {
  const unsigned long long* src = (const unsigned long long*)(smem + SMEM_BYTES - 1024);
  unsigned long long* dst = (unsigned long long*)&q;
#pragma unroll
  for (int i = 0; i < NFIELDS; ++i) dst[i] = uni64(src[i]);
}
__global__ void __launch_bounds__(NT) hybrid_mega(Params parg) {
  __shared__ __attribute__((aligned(16))) char smem[SMEM_BYTES];
  cg::grid_group grid = cg::this_grid();
  if (threadIdx.x < NFIELDS)
    ((unsigned long long*)(smem + SMEM_BYTES - 1024))[threadIdx.x] = ((const unsigned long long*)&parg)[threadIdx.x];
  __syncthreads();
  for (int ph = 0; ph < NPHASES; ++ph) {
    Params p;
    load_params(p, smem);
    run_phase(p, ph, smem);
    if (ph + 1 < NPHASES) grid.sync();
  }
}
#ifdef MULTI_LAUNCH
__global__ void __launch_bounds__(NT) hybrid_phase(Params p, int ph) {
  __shared__ __attribute__((aligned(16))) char smem[SMEM_BYTES];
  run_phase(p, ph, smem);
}
#endif

extern "C" void kernel_launch(void* const* d_in, const int* in_sizes, int n_in, void* d_out, int out_size, void* d_ws,
                              size_t ws_size, hipStream_t stream) {
  (void)in_sizes; (void)n_in; (void)out_size; (void)ws_size;
  static int grid_blocks = 0;
  if (!grid_blocks) {
    int dev = 0, cus = 0, per_cu = 0;
    hipGetDevice(&dev);
    hipDeviceGetAttribute(&cus, hipDeviceAttributeMultiprocessorCount, dev);
    hipOccupancyMaxActiveBlocksPerMultiprocessor(&per_cu, hybrid_mega, NT, 0);
    if (per_cu < 1) per_cu = 1;
    grid_blocks = cus;
  }
  Params p = make_params(d_in, d_out, d_ws);
#ifdef MULTI_LAUNCH
  for (int ph = 0; ph < NPHASES; ++ph) hipLaunchKernelGGL(hybrid_phase, dim3(grid_blocks), dim3(NT), 0, stream, p, ph);
#else
  void* args[] = {&p};
  hipLaunchCooperativeKernel((void*)hybrid_mega, dim3(grid_blocks), dim3(NT), args, 0, stream);
#endif
}
#endif
```

```cpp
#ifdef EMU
#include "emu_hip.h"
#else
#include <hip/hip_runtime.h>
#endif
#include <stdint.h>
#include <stddef.h>

#define DI __device__ __forceinline__

#ifdef CFG_SMALL
constexpr int D = 512, NB = 2, SEQ = 256, GRID_W = 16, CTXL = 256, CONV_CH = 128, HY_CH = 128, RW_H = 4;
#else
constexpr int D = 1024, NB = 8, SEQ = 4096, GRID_W = 64, CTXL = 256, CONV_CH = 256, HY_CH = 256, RW_H = 8;
#endif
constexpr int DEPTH = 2;
constexpr int HD = 64;
constexpr int RW_CH = RW_H * HD;
constexpr int MIX_W = CONV_CH + HY_CH + RW_CH;
constexpr int DRK = 64, IRK = 64, GRK = 128;
constexpr int RW_COLS = 3 * RW_CH + 2 * DRK + 2 * IRK + GRK;
constexpr int PA_W = 3 * CONV_CH, PH_W = 3 * HY_CH;
constexpr int P_IN = PA_W + PH_W + RW_COLS;
constexpr int P_IN_PAD = ((P_IN + 255) / 256) * 256;
constexpr int HY_EMB = 33, HY_BANDS = 16, HY_HID = 64;
constexpr int NE = 64, TOPK = 8, FF = 256;
constexpr int TL = NB * SEQ, TC = NB * CTXL, T = TL + TC;
constexpr int FFTN = 2 * SEQ;
constexpr int ilog2c(int n) { return n <= 1 ? 0 : 1 + ilog2c(n / 2); }
constexpr int LOG2N = ilog2c(FFTN);
constexpr float LN_EPS = 1e-5f;
constexpr float RW_GN_EPS = 64e-5f;
constexpr float DN_ALPHA = 1.41421356237309515f;
constexpr float ROUTED_SCALE = 2.5f;
constexpr int NT = 512;
#ifndef PROF_A
#define PROF_A 0
#endif
#ifndef PROF_B
#define PROF_B 0
#endif
#ifndef PROF_C
#define PROF_C 0
#endif
constexpr int SMEM_BYTES = 160 * 1024;
static_assert(MIX_W == D, "mix width");
static_assert(D % 128 == 0 && P_IN % 128 == 0 && PA_W % 128 == 0 && PH_W % 128 == 0, "tiles");
static_assert(SEQ % 256 == 0 && CTXL % 256 == 0, "row tiles");

typedef unsigned short u16;
typedef __attribute__((ext_vector_type(8))) short bf16x8;
typedef __attribute__((ext_vector_type(16))) float f32x16;
typedef __attribute__((ext_vector_type(4))) unsigned u32x4;
typedef __attribute__((ext_vector_type(2))) unsigned u32x2;
typedef __attribute__((ext_vector_type(4))) float f32x4;
struct cf { float x, y; };

struct Params {
  const float *x, *c, *ctx, *c_ctx, *w_ada, *b_ada, *w_in, *conv_a, *hy_sconv_w, *hy_sconv_b;
  const float *hf_w1, *hf_b1, *hf_w2, *hf_b2, *hf_w3, *hf_b3, *hf_wout, *hf_freq, *hf_skip;
  const float *rw_mu, *rw_w0, *rw_w_up, *rw_a0, *rw_a_up, *rw_g_up, *rw_k_k, *rw_k_a, *rw_r_k;
  const float *rw_lnx_g, *rw_lnx_b, *mix_norm_g, *w_out, *ln_g, *ln_b, *w_router, *e_bias;
  const float *w_e_gate, *w_e_up, *w_e_down, *w_s_gate, *w_s_up, *w_s_down;
  float* out;
  float* mod;
  float* h3lat;
  float* h3ctx;
  cf* tw;
  int* cnt;
  float* sbonus;
  cf* spec;
  u16* HL;
  u16* PA;
  u16* PH;
  u16* PR;
  u16* SIsh_lat;
  u16* SIsh_ctx;
  u16* SIdir_lat;
  u16* SIdir_ctx;
  u16* ya;
  u16* yhlat;
  u16* yhctx;
  u16* gbuf;
  u16* ybuf;
  u16* ycat;
  float* XC;
  u16* wt_in;
  u16* wt_out;
  u16* wt_rhi;
  u16* wt_rlo;
  u16* wt_wup;
  u16* wt_aup;
  u16* wt_gup;
  u16* Hbuf;
  u16* SHo;
  u16* wt_exp;
  int* acc;
  int* etok;
  float* egate;
  long long* tstamp;
  unsigned* bar;
};


#ifndef PROF_SEG
#define PROF_SEG 0
#endif
#if PROF_SEG && !defined(EMU)
#define SEG_BEGIN(p) long long seg_last_ = 0; const bool seg_on_ = (blockIdx.x == 0 && threadIdx.x == 0); if (seg_on_) seg_last_ = (long long)__builtin_amdgcn_s_memrealtime();
#define SEG_MARK(p, k) if (seg_on_) { long long now_ = (long long)__builtin_amdgcn_s_memrealtime(); (p).tstamp[32 + (k)] += now_ - seg_last_; seg_last_ = now_; }
#else
#define SEG_BEGIN(p)
#define SEG_MARK(p, k)
#endif
#ifdef EMU
DI int TIDX() { return threadIdx.x; }
DI int BIDX() { return blockIdx.x; }
#else
DI int TIDX() { int t = threadIdx.x; asm volatile("" : "+v"(t)); return t; }
DI int BIDX() { int b = blockIdx.x; asm volatile("" : "+s"(b)); return b; }
#endif

#ifdef EMU
DI u16 f2bf(float x) {
  unsigned u = __builtin_bit_cast(unsigned, x);
  u += 0x7fffu + ((u >> 16) & 1u);
  return (u16)(u >> 16);
}
#else
DI u16 f2bf(float x) { return __builtin_bit_cast(u16, (__bf16)x); }
#endif
DI float bf2f(u16 h) { return __builtin_bit_cast(float, ((unsigned)h) << 16); }
DI u16 f2h(float x) { return __builtin_bit_cast(u16, (_Float16)x); }
DI float h2f(u16 h) { return (float)__builtin_bit_cast(_Float16, h); }
#ifdef EMU
DI unsigned pk2(float a, float b) { return (unsigned)f2bf(a) | ((unsigned)f2bf(b) << 16); }
#else
DI unsigned pk2(float a, float b) {
  typedef __bf16 bf16v2 __attribute__((ext_vector_type(2)));
  bf16v2 v; v[0] = (__bf16)a; v[1] = (__bf16)b;
  return __builtin_bit_cast(unsigned, v);
}
#endif
DI float sigmoidf_(float x) { return 1.0f / (1.0f + expf(-x)); }
DI float siluf_(float x) { return x / (1.0f + expf(-x)); }
DI float softplusf_(float x) { return x > 20.f ? x : log1pf(expf(x)); }
#ifdef EMU
DI float fexp_(float x) { return expf(x); }
DI float frcp_(float x) { return 1.0f / x; }
#else
DI float fexp_(float x) { return __builtin_amdgcn_exp2f(x * 1.44269504088896341f); }
DI float frcp_(float x) { return __builtin_amdgcn_rcpf(x); }
#endif
DI float fsigmoid_(float x) { return frcp_(1.0f + fexp_(-x)); }
DI float ftanh_(float x) { return 1.0f - 2.0f * frcp_(1.0f + fexp_(2.0f * x)); }

#ifdef EMU
DI float red16(float v) { v += __shfl_xor(v, 1); v += __shfl_xor(v, 2); v += __shfl_xor(v, 4); v += __shfl_xor(v, 8); return v; }
DI float wave_sum(float v) {
#pragma unroll
  for (int m = 1; m < 64; m <<= 1) v += __shfl_xor(v, m);
  return v;
}
#else
template <int CTRL> DI float dppf(float v) {
  return __builtin_bit_cast(float, __builtin_amdgcn_update_dpp(0, __builtin_bit_cast(int, v), CTRL, 0xf, 0xf, true));
}
DI float red16(float v) {
  v += dppf<0xB1>(v);
  v += dppf<0x4E>(v);
  v += dppf<0x141>(v);
  v += dppf<0x140>(v);
  return v;
}
DI float wave_sum(float v) {
  v = red16(v);
  int iv = __builtin_bit_cast(int, v);
  float a = __builtin_bit_cast(float, __builtin_amdgcn_readlane(iv, 0));
  float b = __builtin_bit_cast(float, __builtin_amdgcn_readlane(iv, 16));
  float c = __builtin_bit_cast(float, __builtin_amdgcn_readlane(iv, 32));
  float d = __builtin_bit_cast(float, __builtin_amdgcn_readlane(iv, 48));
  return (a + b) + (c + d);
}
#endif
#ifdef EMU
DI float wave_max(float v) {
#pragma unroll
  for (int m = 1; m < 64; m <<= 1) v = fmaxf(v, __shfl_xor(v, m));
  return v;
}
#else
DI float wave_max(float v) {
  v = fmaxf(v, dppf<0xB1>(v));
  v = fmaxf(v, dppf<0x4E>(v));
  v = fmaxf(v, dppf<0x141>(v));
  v = fmaxf(v, dppf<0x140>(v));
  int iv = __builtin_bit_cast(int, v);
  float a = __builtin_bit_cast(float, __builtin_amdgcn_readlane(iv, 0));
  float b = __builtin_bit_cast(float, __builtin_amdgcn_readlane(iv, 16));
  float c = __builtin_bit_cast(float, __builtin_amdgcn_readlane(iv, 32));
  float d = __builtin_bit_cast(float, __builtin_amdgcn_readlane(iv, 48));
  return fmaxf(fmaxf(a, b), fmaxf(c, d));
}
#endif
DI void wave_sync() {
#ifdef EMU
  emu::wave_barrier();
#else
  asm volatile("s_waitcnt lgkmcnt(0)" ::: "memory");
  __builtin_amdgcn_wave_barrier();
#endif
}
DI f32x4 ld_bf4(const u16* q) {
  u32x2 v = *(const u32x2*)q;
  f32x4 r;
  r[0] = bf2f((u16)(v[0] & 0xffff)); r[1] = bf2f((u16)(v[0] >> 16));
  r[2] = bf2f((u16)(v[1] & 0xffff)); r[3] = bf2f((u16)(v[1] >> 16));
  return r;
}
DI void st_bf4(u16* q, f32x4 v) {
  u32x2 o; o[0] = pk2(v[0], v[1]); o[1] = pk2(v[2], v[3]);
  *(u32x2*)q = o;
}
DI int crow(int reg, int h) { return (reg & 3) + 8 * (reg >> 2) + 4 * h; }
#define MFMA32(a, b, c) __builtin_amdgcn_mfma_f32_32x32x16_bf16((a), (b), (c), 0, 0, 0)

DI int modrow(int r) { return r < TL ? r / SEQ : NB; }
DI const float* modp(const Params& p, int l, int r) { return p.mod + ((size_t)l * (NB + 1) + modrow(r)) * (6 * D); }


#define XB_TMO      128
#define XB_TICKET   192
#define XB_XCNT(j)  (256  + 64 * (j))
#define XB_XSUB(j)  (1280 + 64 * (j))
#define XB_XGEN(j)  (2304 + 64 * (j))
#define XB_TOP      3328
#define XB_TOPGEN   3392
#define XCD_BAR_WORDS 3456
#ifndef EMU
#define XB_SPIN_CAP (1u << 22)
#define LAS __attribute__((address_space(3)))
DI unsigned xb_ld(unsigned* p) { return __hip_atomic_load(p, __ATOMIC_RELAXED, __HIP_MEMORY_SCOPE_AGENT); }
DI unsigned xb_add(unsigned* p, unsigned v) { return __hip_atomic_fetch_add(p, v, __ATOMIC_RELAXED, __HIP_MEMORY_SCOPE_AGENT); }
DI unsigned xb_xcc_id() { return (unsigned)__builtin_amdgcn_s_getreg((3 << 11) | 20) & 0xFu; }
#define XB_SPIN(cond, bar) do { unsigned _sp = 0; while (cond) { __builtin_amdgcn_s_sleep(1); \
    if ((++_sp & 255u) == 0u) { if (xb_ld(&(bar)[XB_TMO])) break; if (_sp > XB_SPIN_CAP) { atomicAdd(&(bar)[XB_TMO], 1u); break; } } } } while (0)
struct XcdBarrier { unsigned* bar; unsigned x; volatile LAS unsigned* st; };
DI XcdBarrier xcd_barrier_post(unsigned* bar, volatile LAS unsigned* st) {
  XcdBarrier b; b.bar = bar; b.x = xb_xcc_id(); b.st = st;
  if (threadIdx.x == 0) (void)xb_add(&bar[XB_XCNT(b.x)], 1u);
  return b;
}
DI void xcd_barrier_complete(unsigned* bar, unsigned x, unsigned& nloc, unsigned& nx) {
  const unsigned G = gridDim.x * gridDim.y * gridDim.z;
  unsigned sum, cnt, mine, sp = 0u;
  for (;;) {
    sum = 0u; cnt = 0u; mine = 0u;
#pragma unroll
    for (unsigned j = 0; j < 16; ++j) { const unsigned c = xb_ld(&bar[XB_XCNT(j)]); sum += c; cnt += (c > 0u) ? 1u : 0u; mine = (j == x) ? c : mine; }
    if (sum == G) break;
    __builtin_amdgcn_s_sleep(1);
    if ((++sp & 255u) == 0u) { if (xb_ld(&bar[XB_TMO])) break; if (sp > XB_SPIN_CAP) { atomicAdd(&bar[XB_TMO], 1u); break; } }
  }
  nloc = mine > 0u ? mine : 1u; nx = cnt > 0u ? cnt : 1u;
}
DI void xcd_barrier(const XcdBarrier& b) {
  asm volatile("s_waitcnt vmcnt(0)" ::: "memory");
  __syncthreads();
  if (threadIdx.x == 0) {
    unsigned* bar = b.bar;
    __builtin_amdgcn_s_waitcnt(0);
    unsigned nloc = b.st[0], nx = b.st[1];
    if (nloc == 0u) { xcd_barrier_complete(bar, b.x, nloc, nx); b.st[0] = nloc; b.st[1] = nx; }
    const unsigned old = xb_add(&bar[XB_XSUB(b.x)], 1u);
    const unsigned gen = old / nloc;
    if (old + 1u == (gen + 1u) * nloc) {
      __builtin_amdgcn_fence(__ATOMIC_RELEASE, "agent");
      asm volatile("s_waitcnt vmcnt(0)" ::: "memory");
      const unsigned og = xb_add(&bar[XB_TOP], 1u);
      const unsigned tg = og / nx;
      if (og + 1u == (tg + 1u) * nx) xb_add(&bar[XB_TOPGEN], 1u);
      else XB_SPIN(xb_ld(&bar[XB_TOPGEN]) == tg, bar);
      __builtin_amdgcn_fence(__ATOMIC_ACQUIRE, "agent");
      xb_add(&bar[XB_XGEN(b.x)], 1u);
      asm volatile("s_waitcnt vmcnt(0)" ::: "memory");
    } else {
      XB_SPIN(xb_ld(&bar[XB_XGEN(b.x)]) == gen, bar);
      __builtin_amdgcn_fence(__ATOMIC_ACQUIRE, "agent");
      asm volatile("s_waitcnt vmcnt(0)" ::: "memory");
    }
  }
  __syncthreads();
}
#endif

namespace pg8 {
constexpr int BM = 256, BK = 64, HALF = 128, HTB = HALF * BK * 2, STAGE_BYTES = 8 * HTB;
struct Unit { int pm, pn, e, cnt, idx; };
__host__ __device__ __forceinline__ int lds_byte(int r, int c) { const int st = (r >> 4) * 2 + (c >> 5), rr = r & 15, cc = c & 31, ob = rr * 64 + cc * 2; return st * 1024 + (ob ^ (((ob >> 9) & 1) << 5)); }
__host__ __device__ __forceinline__ void stage_rc(int b, int& R, int& C) { const int st = b / 1024, sb = b % 1024, swz = sb ^ (((sb >> 9) & 1) << 5); R = (st >> 1) * 16 + swz / 64; C = (st & 1) * 32 + (swz % 64) / 2; }

#ifdef EMU
template <class Epi, class Sched>
inline void gemm_phase(char* lds, int K, const Sched& S, const Epi& E) {
  (void)lds;
  const int tid = TIDX(), wid = tid >> 6, lane = tid & 63, wr = wid >> 2, wc = wid & 3, fr = lane & 15, fq = lane >> 4;
  Unit u;
  for (int ui = 0; S.next(ui, u); ++ui) {
    f32x4 acc[2][2][4][2];
    for (int ai = 0; ai < 2; ++ai) for (int bj = 0; bj < 2; ++bj) for (int m = 0; m < 4; ++m) for (int n = 0; n < 2; ++n) {
      const int r = 128 * ai + 64 * wr + 16 * m + fr;
      const u16* arow = (const u16*)(S.abase() + S.arow_off(u, r));
      for (int j = 0; j < 4; ++j) {
        const int c = 32 * wc + 16 * n + 4 * fq + j;
        const u16* brow = (const u16*)S.bbase(u, bj) + (size_t)c * K;
        float s = 0.f;
        for (int k = 0; k < K; ++k) s += bf2f(arow[k]) * bf2f(brow[k]);
        acc[ai][bj][m][n][j] = s;
      }
    }
    E(acc, u, wr, wc, fr, fq, E.prefetch(u, wr, lane));
  }
}
#else
#define PG8_LAS __attribute__((address_space(3)))
template <class Epi, class Sched>
__device__ __forceinline__ void gemm_phase(char* lds_generic, int K, const Sched& S, const Epi& E) {
  PG8_LAS unsigned char* lds = (PG8_LAS unsigned char*)lds_generic;
  const int tid = TIDX(), wid = __builtin_amdgcn_readfirstlane(tid >> 6), lane = tid & 63, wr = wid >> 2, wc = wid & 3, fr = lane & 15, fq = lane >> 4;
  const int nt = K / BK;
  int Rr[2], Cc[2];
  unsigned voffB[2];
#pragma unroll
  for (int i = 0; i < 2; ++i) { stage_rc(tid * 16 + i * 8192, Rr[i], Cc[i]); voffB[i] = (unsigned)(Rr[i] * K + Cc[i]) * 2u; }
  const size_t kstep = (size_t)(BK * 2);
  const unsigned ldsw = (unsigned)wid * 1024u;
  const int aoff = lds_byte(wr * 64 + fr, fq * 8), boff = lds_byte(wc * 32 + fr, fq * 8);
#define PG8_SA(b, h) (((b) * 2 + (h)) * HTB)
#define PG8_SB(b, h) ((4 + (b) * 2 + (h)) * HTB)
#define PG8_STAGE2(bufoff, gbase, v0, v1) do { \
    __builtin_amdgcn_global_load_lds((const unsigned*)((const char*)(gbase) + (v0)), (PG8_LAS unsigned*)(lds + (bufoff) + ldsw), 16, 0, 0); \
    __builtin_amdgcn_global_load_lds((const unsigned*)((const char*)(gbase) + (v1)), (PG8_LAS unsigned*)(lds + (bufoff) + ldsw + 8192), 16, 0, 0); } while (0)
#define PG8_STAGEB(bufoff, gbase) PG8_STAGE2(bufoff, gbase, voffB[0], voffB[1])
#define PG8_LDA(dst, b, h) do { _Pragma("unroll") for (int m = 0; m < 4; ++m) _Pragma("unroll") for (int k = 0; k < 2; ++k) dst[m][k] = *(const PG8_LAS bf16x8*)(lds + PG8_SA(b, h) + aoff + m * 2048 + k * 1024); } while (0)
#define PG8_LDB(dst, b, h) do { _Pragma("unroll") for (int n = 0; n < 2; ++n) _Pragma("unroll") for (int k = 0; k < 2; ++k) dst[n][k] = *(const PG8_LAS bf16x8*)(lds + PG8_SB(b, h) + boff + n * 2048 + k * 1024); } while (0)
#define PG8_MMA(ai, bj, At, Bt) do { __builtin_amdgcn_s_setprio(1); _Pragma("unroll") for (int m = 0; m < 4; ++m) _Pragma("unroll") for (int n = 0; n < 2; ++n) _Pragma("unroll") for (int k = 0; k < 2; ++k) \
    acc[ai][bj][m][n] = __builtin_amdgcn_mfma_f32_16x16x32_bf16(Bt[n][k], At[m][k], acc[ai][bj][m][n], 0, 0, 0); __builtin_amdgcn_s_setprio(0); } while (0)
#define PG8_WAIT_V(n) asm volatile("s_waitcnt vmcnt(" #n ")" ::: "memory")
#define PG8_WAIT_L(n) asm volatile("s_waitcnt lgkmcnt(" #n ")" ::: "memory")
#define PG8_BAR __builtin_amdgcn_s_barrier()
#define PG8_SCHED __builtin_amdgcn_sched_barrier(0)
  Unit cur, nxt; int ui = 0;
  if (!S.next(0, cur)) return;
  f32x4 acc[2][2][4][2];
#pragma unroll
  for (int a = 0; a < 2; ++a)
#pragma unroll
    for (int b = 0; b < 2; ++b)
#pragma unroll
      for (int m = 0; m < 4; ++m)
#pragma unroll
        for (int n = 0; n < 2; ++n) acc[a][b][m][n] = (f32x4){0.f, 0.f, 0.f, 0.f};
  bf16x8 At[4][2], B0[2][2], B1[2][2];
  const char* const gA = S.abase();
  unsigned cv00 = 0, cv01 = 0, cv10 = 0, cv11 = 0, nv00 = 0, nv01 = 0, nv10 = 0, nv11 = 0;
  const char *cA0 = gA, *cA1 = gA, *nA0 = gA, *nA1 = gA;
  if constexpr (Sched::GATHER) {
    cv00 = S.arow_off(cur, Rr[0]) + Cc[0] * 2u; cv01 = S.arow_off(cur, Rr[1]) + Cc[1] * 2u;
    cv10 = S.arow_off(cur, 128 + Rr[0]) + Cc[0] * 2u; cv11 = S.arow_off(cur, 128 + Rr[1]) + Cc[1] * 2u;
  } else {
    cA0 = gA + S.arow_off(cur, 0); cA1 = gA + S.arow_off(cur, 128);
  }
#define PG8_STAGE_A(bufoff, kb, h, NEXT) do { \
    if constexpr (Sched::GATHER) { PG8_STAGE2(bufoff, gA + (kb), (NEXT) ? ((h) ? nv10 : nv00) : ((h) ? cv10 : cv00), (NEXT) ? ((h) ? nv11 : nv01) : ((h) ? cv11 : cv01)); } \
    else { PG8_STAGE2(bufoff, ((NEXT) ? ((h) ? nA1 : nA0) : ((h) ? cA1 : cA0)) + (kb), voffB[0], voffB[1]); } } while (0)
  const char* cB0 = S.bbase(cur, 0); const char* cB1 = S.bbase(cur, 1);
  PG8_STAGEB(PG8_SB(0, 0), cB0); PG8_STAGE_A(PG8_SA(0, 0), 0, 0, false); PG8_STAGEB(PG8_SB(0, 1), cB1); PG8_STAGE_A(PG8_SA(0, 1), 0, 1, false);
  if (wr == 1) PG8_BAR;
  PG8_WAIT_V(4); PG8_BAR;
  PG8_STAGEB(PG8_SB(1, 0), cB0 + kstep); PG8_STAGE_A(PG8_SA(1, 0), kstep, 0, false); PG8_STAGEB(PG8_SB(1, 1), cB1 + kstep);
  PG8_WAIT_V(6); PG8_BAR;
  for (;;) {
    const bool has_next = S.next(ui + 1, nxt);
    const char* nB0 = cB0; const char* nB1 = cB1;
    if constexpr (Sched::GATHER) { nv00 = cv00; nv01 = cv01; nv10 = cv10; nv11 = cv11; } else { nA0 = cA0; nA1 = cA1; }
    if (has_next) {
      if constexpr (Sched::GATHER) {
        nv00 = S.arow_off(nxt, Rr[0]) + Cc[0] * 2u; nv01 = S.arow_off(nxt, Rr[1]) + Cc[1] * 2u;
        nv10 = S.arow_off(nxt, 128 + Rr[0]) + Cc[0] * 2u; nv11 = S.arow_off(nxt, 128 + Rr[1]) + Cc[1] * 2u;
      } else {
        nA0 = gA + S.arow_off(nxt, 0); nA1 = gA + S.arow_off(nxt, 128);
      }
      nB0 = S.bbase(nxt, 0); nB1 = S.bbase(nxt, 1);
    }
    const typename Epi::Pre epre = E.prefetch(cur, wr, lane);
#pragma clang loop unroll(disable)
    for (int t = 0; t < nt; t += 2) {
      const bool last = (t == nt - 2);
      const size_t kb1 = (size_t)(t + 1) * kstep;
      const size_t kb2 = last ? (size_t)0 : (size_t)(t + 2) * kstep;
      const size_t kb3 = kb2 + kstep;
      const char* b20 = last ? nB0 : cB0 + (size_t)(t + 2) * kstep;
      const char* b21 = last ? nB1 : cB1 + (size_t)(t + 2) * kstep;
      const char* b30 = b20 + kstep; const char* b31 = b21 + kstep;
      PG8_LDB(B0, 0, 0); PG8_SCHED; PG8_LDA(At, 0, 0); PG8_STAGE_A(PG8_SA(1, 1), kb1, 1, false);
      PG8_WAIT_L(8); PG8_BAR; PG8_WAIT_L(0); PG8_MMA(0, 0, At, B0); PG8_BAR; PG8_SCHED;
      PG8_LDB(B1, 0, 1); PG8_STAGEB(PG8_SB(0, 0), b20);
      PG8_BAR; PG8_WAIT_L(0); PG8_MMA(0, 1, At, B1); PG8_BAR;
      PG8_LDA(At, 0, 1); PG8_STAGE_A(PG8_SA(0, 0), kb2, 0, last);
      PG8_BAR; PG8_WAIT_L(0); PG8_MMA(1, 0, At, B0); PG8_BAR; PG8_SCHED;
      PG8_STAGEB(PG8_SB(0, 1), b21);
      PG8_WAIT_V(6); PG8_BAR; PG8_MMA(1, 1, At, B1); PG8_BAR;
      PG8_LDB(B0, 1, 0); PG8_SCHED; PG8_LDA(At, 1, 0); PG8_STAGE_A(PG8_SA(0, 1), kb2, 1, last);
      PG8_WAIT_L(8); PG8_BAR; PG8_WAIT_L(0); PG8_MMA(0, 0, At, B0); PG8_BAR; PG8_SCHED;
      PG8_LDB(B1, 1, 1); PG8_STAGEB(PG8_SB(1, 0), b30);
      PG8_BAR; PG8_WAIT_L(0); PG8_MMA(0, 1, At, B1); PG8_BAR;
      PG8_LDA(At, 1, 1); PG8_STAGE_A(PG8_SA(1, 0), kb3, 0, last);
      PG8_BAR; PG8_WAIT_L(0); PG8_MMA(1, 0, At, B0); PG8_BAR; PG8_SCHED;
      PG8_STAGEB(PG8_SB(1, 1), b31);
      PG8_WAIT_V(6); PG8_BAR; PG8_MMA(1, 1, At, B1); PG8_BAR;
    }
    E(acc, cur, wr, wc, fr, fq, epre);
    if (!has_next) break;
#pragma unroll
    for (int a = 0; a < 2; ++a)
#pragma unroll
      for (int b = 0; b < 2; ++b)
#pragma unroll
        for (int m = 0; m < 4; ++m)
#pragma unroll
          for (int n = 0; n < 2; ++n) acc[a][b][m][n] = (f32x4){0.f, 0.f, 0.f, 0.f};
    cur = nxt; cB0 = nB0; cB1 = nB1; ++ui;
    if constexpr (Sched::GATHER) { cv00 = nv00; cv01 = nv01; cv10 = nv10; cv11 = nv11; } else { cA0 = nA0; cA1 = nA1; }
  }
  PG8_WAIT_V(0);
  if (wr == 0) PG8_BAR;
  PG8_BAR;
#undef PG8_SA
#undef PG8_SB
#undef PG8_STAGE2
#undef PG8_STAGE_A
#undef PG8_STAGEB
#undef PG8_LDA
#undef PG8_LDB
#undef PG8_MMA
#undef PG8_WAIT_V
#undef PG8_WAIT_L
#undef PG8_BAR
#undef PG8_SCHED
}
#endif
DI int remap_xcd(int L, int nwg) {
  const int q = nwg / 8, r = nwg % 8, xcd = L % 8, off = L / 8;
  return (xcd < r ? xcd * (q + 1) : r * (q + 1) + (xcd - r) * q) + off;
}
}

DI void convert_tile(const float* __restrict__ src, int K, int N, u16* __restrict__ dst, u16* __restrict__ dst_lo, int tile, char* smem) {
  const int tid = TIDX();
  float* t = (float*)smem;
  const int ntn = N / 64;
  const int k0 = (tile / ntn) * 64, n0 = (tile % ntn) * 64;
#pragma unroll
  for (int i = 0; i < 8; ++i) {
    const int row = i * 8 + (tid >> 6), col = tid & 63;
    t[row * 65 + col] = src[(size_t)(k0 + row) * N + n0 + col];
  }
  __syncthreads();
  const int n = tid >> 3, kq = tid & 7;
  float f[8];
#pragma unroll
  for (int j = 0; j < 8; ++j) f[j] = t[(kq * 8 + j) * 65 + n];
  u32x4 pb;
  pb[0] = pk2(f[0], f[1]); pb[1] = pk2(f[2], f[3]); pb[2] = pk2(f[4], f[5]); pb[3] = pk2(f[6], f[7]);
  *(u32x4*)(dst + (size_t)(n0 + n) * K + k0 + kq * 8) = pb;
  if (dst_lo) {
#pragma unroll
    for (int j = 0; j < 8; ++j) f[j] -= bf2f(f2bf(f[j]));
    pb[0] = pk2(f[0], f[1]); pb[1] = pk2(f[2], f[3]); pb[2] = pk2(f[4], f[5]); pb[3] = pk2(f[6], f[7]);
    *(u32x4*)(dst_lo + (size_t)(n0 + n) * K + k0 + kq * 8) = pb;
  }
  __syncthreads();
}
DI void convert_tile_w(const float* __restrict__ src, int K, int N, u16* __restrict__ dst, int tile, char* smem) {
  const int tid = TIDX();
  float* t = (float*)smem;
  const int ntn = N / 256;
  const int k0 = (tile / ntn) * 64, n0 = (tile % ntn) * 256;
#pragma unroll
  for (int i = 0; i < 8; ++i) {
    const int row = i * 8 + (tid >> 6), col = (tid & 63) * 4;
    const f32x4 v = *(const f32x4*)(src + (size_t)(k0 + row) * N + n0 + col);
    float* q = t + row * 257 + col;
    q[0] = v[0]; q[1] = v[1]; q[2] = v[2]; q[3] = v[3];
  }
  __syncthreads();
#pragma unroll
  for (int i = 0; i < 4; ++i) {
    const int idx = tid + NT * i;
    const int n = idx >> 3, kq = idx & 7;
    float f[8];
#pragma unroll
    for (int j = 0; j < 8; ++j) f[j] = t[(kq * 8 + j) * 257 + n];
    u32x4 pb;
    pb[0] = pk2(f[0], f[1]); pb[1] = pk2(f[2], f[3]); pb[2] = pk2(f[4], f[5]); pb[3] = pk2(f[6], f[7]);
    *(u32x4*)(dst + (size_t)(n0 + n) * K + k0 + kq * 8) = pb;
  }
  __syncthreads();
}
constexpr int CT_IN = (D / 64) * (P_IN / 64), CT_OUT = (MIX_W / 64) * (D / 64), CT_R = (D / 64) * (NE / 64);
constexpr int CT_WUP = (DRK / 64) * (RW_CH / 64), CT_GUP = (GRK / 64) * (RW_CH / 64);
constexpr int CT_STATIC_L = CT_IN + CT_OUT + CT_R + 4 * CT_WUP + CT_GUP;
DI void convert_static_item(const Params& p, int it, char* smem) {
  const int l = it / CT_STATIC_L;
  int q = it % CT_STATIC_L;
  if (q < CT_IN) { convert_tile(p.w_in + (size_t)l * D * P_IN, D, P_IN, p.wt_in + (size_t)l * P_IN_PAD * D, nullptr, q, smem); return; }
  q -= CT_IN;
  if (q < CT_OUT) { convert_tile(p.w_out + (size_t)l * MIX_W * D, MIX_W, D, p.wt_out + (size_t)l * D * MIX_W, nullptr, q, smem); return; }
  q -= CT_OUT;
  if (q < CT_R) { convert_tile(p.w_router + (size_t)l * D * NE, D, NE, p.wt_rhi + (size_t)l * NE * D, p.wt_rlo + (size_t)l * NE * D, q, smem); return; }
  q -= CT_R;
  if (q < 4 * CT_WUP) {
    const int which = q / CT_WUP, tile = q % CT_WUP;
    const int d = which & 1;
    if (which < 2) convert_tile(p.rw_w_up + ((size_t)l * 2 + d) * DRK * RW_CH, DRK, RW_CH, p.wt_wup + ((size_t)l * 2 + d) * RW_CH * DRK, nullptr, tile, smem);
    else convert_tile(p.rw_a_up + ((size_t)l * 2 + d) * IRK * RW_CH, IRK, RW_CH, p.wt_aup + ((size_t)l * 2 + d) * RW_CH * IRK, nullptr, tile, smem);
    return;
  }
  q -= 4 * CT_WUP;
  convert_tile(p.rw_g_up + (size_t)l * GRK * RW_CH, GRK, RW_CH, p.wt_gup + (size_t)l * RW_CH * GRK, nullptr, q, smem);
}
constexpr int CT_EMAT = (D / 64) * (FF / 256);
static_assert(FF % 256 == 0 && D % 256 == 0 && (D / 64) * (FF / 256) == (FF / 64) * (D / 256), "expert conversion tiling");
constexpr int CT_EXP_L = (NE + 1) * 3 * CT_EMAT;
constexpr size_t EXP_STRIDE = (size_t)3 * D * FF;
DI void convert_expert_item(const Params& p, int l, int it, char* smem) {
  const int e = it / (3 * CT_EMAT), m = (it / CT_EMAT) % 3, tile = it % CT_EMAT;
  const float *eg = p.w_e_gate, *eu = p.w_e_up, *ed = p.w_e_down, *sg = p.w_s_gate, *su = p.w_s_up, *sd = p.w_s_down;
#ifndef EMU
  asm volatile("" : "+s"(eg), "+s"(eu), "+s"(ed), "+s"(sg), "+s"(su), "+s"(sd));
#endif
  const float* src;
  if (e < NE) src = (m == 0 ? eg : m == 1 ? eu : ed) + ((size_t)l * NE + e) * D * FF;
  else src = (m == 0 ? sg : m == 1 ? su : sd) + (size_t)l * D * FF;
#ifndef EMU
  src = (const float*)(__attribute__((address_space(1))) const float*)(unsigned long long)src;
#endif
  u16* dst = p.wt_exp + (size_t)e * EXP_STRIDE + (size_t)m * D * FF;
  if (m < 2) convert_tile_w(src, D, FF, dst, tile, smem);
  else convert_tile_w(src, FF, D, dst, tile, smem);
}

DI float* x1row(const Params& p, int r) { return r < TL ? p.out + (size_t)r * D : p.XC + (size_t)(r - TL) * D; }

struct DenseSched {
  static constexpr bool GATHER = false;
  const char* A; const char* Bt; int K, nM, nN, nwg, G, c;
  DI void init(const void* A_, const void* Bt_, int K_, int M, int N, int G_, int c_) { A = (const char*)A_; Bt = (const char*)Bt_; K = K_; nM = M / 256; nN = N / 256; nwg = nM * nN; G = G_; c = c_; }
  DI bool next(int i, pg8::Unit& u) const {
    const int L = i * G + c; if (L >= nwg) return false;
    const int wgid = pg8::remap_xcd(L, nwg);
    const int nig = 8 * nN, gid = wgid / nig, fm = gid * 8, gsz = (nM - fm) < 8 ? (nM - fm) : 8;
    u.pm = fm + ((wgid % nig) % gsz); u.pn = (wgid % nig) / gsz; u.e = 0; u.cnt = 0; u.idx = i; return true;
  }
  DI const char* abase() const { return A; }
  DI unsigned arow_off(const pg8::Unit& u, int r) const { return (unsigned)(u.pm * 256 + r) * (unsigned)(K * 2); }
  DI const char* bbase(const pg8::Unit& u, int half) const { return Bt + (size_t)(u.pn * 256 + half * 128) * K * 2; }
};
struct ExpertSched {
  const int* pre;
  const int* cntl;
  const unsigned char* t2e;
  int nN, G, c, total;
  DI bool locate(int i, pg8::Unit& u) const {
    const int L = i * G + c; if (L >= total) return false;
    const int w = pg8::remap_xcd(L, total);
    const int tile = w / nN; u.pn = w % nN;
    const int e = (int)t2e[tile];
    u.e = e; u.pm = tile - pre[e]; u.cnt = cntl[e]; u.idx = i;
    return true;
  }
};
struct E1Sched : ExpertSched {
  static constexpr bool GATHER = true;
  const char* A; const char* W; const int* etok;
  const unsigned* loff; int nl;
  DI bool next(int i, pg8::Unit& u) const { return locate(i, u); }
  DI const char* abase() const { return A; }
  DI unsigned goff(const pg8::Unit& u, int r) const {
    const int slot = u.pm * 256 + r;
    const unsigned tl = (unsigned)etok[u.e < NE ? (size_t)u.e * T + slot : (size_t)slot];
    const unsigned tok = u.e < NE ? (tl < (unsigned)T ? tl : 0u) : (unsigned)slot;
    return tok * (unsigned)(D * 2);
  }
  DI unsigned arow_off(const pg8::Unit& u, int r) const { return u.idx < nl ? loff[u.idx * 256 + r] : goff(u, r); }
  DI void preload(unsigned* lds_off, int maxu) {
    loff = lds_off; nl = 0;
    const int tid = TIDX();
    pg8::Unit u;
    int n = 0;
    while (n < maxu && locate(n, u)) ++n;
    for (int i = tid; i < n * 256; i += NT) { locate(i >> 8, u); lds_off[i] = goff(u, i & 255); }
    __syncthreads();
    nl = n;
  }
  DI const char* bbase(const pg8::Unit& u, int half) const { return W + ((size_t)u.e * EXP_STRIDE + (size_t)half * D * FF + (size_t)u.pn * 128 * D) * 2; }
};
struct E2Sched : ExpertSched {
  static constexpr bool GATHER = false;
  const char* A; const char* W; const int* hoff;
  DI bool next(int i, pg8::Unit& u) const { return locate(i, u); }
  DI const char* abase() const { return A; }
  DI unsigned arow_off(const pg8::Unit& u, int r) const { return (unsigned)(hoff[u.e] + u.pm * 256 + r) * (unsigned)(FF * 2); }
  DI const char* bbase(const pg8::Unit& u, int half) const { return W + ((size_t)u.e * EXP_STRIDE + (size_t)2 * D * FF + (size_t)(u.pn * 256 + half * 128) * FF) * 2; }
};

struct EpiInproj {
  u16 *PA, *PH, *PR;
  struct Pre {};
  DI Pre prefetch(const pg8::Unit&, int, int) const { return Pre{}; }
  DI void operator()(const f32x4 (&acc)[2][2][4][2], const pg8::Unit& u, int wr, int wc, int fr, int fq, const Pre&) const {
    const int row0 = u.pm * 256 + wr * 64 + fr;
#pragma unroll
    for (int bj = 0; bj < 2; ++bj) {
      const int colh = u.pn * 256 + bj * 128;
      if (colh >= P_IN) continue;
      if (colh >= PA_W && colh < PA_W + PH_W) {
        const int c0 = colh - PA_W + wc * 32 + 4 * fq;
        const int rb = u.pm * 256;
        u16* base; int L, t0;
        if (rb < TL) { L = SEQ; base = PH + (size_t)(rb / SEQ) * PH_W * SEQ; t0 = rb % SEQ; }
        else { L = CTXL; base = PH + (size_t)NB * PH_W * SEQ + (size_t)((rb - TL) / CTXL) * PH_W * CTXL; t0 = (rb - TL) % CTXL; }
#pragma unroll
        for (int ai = 0; ai < 2; ++ai)
#pragma unroll
          for (int m = 0; m < 4; ++m) {
            const int t = t0 + wr * 64 + fr + ai * 128 + m * 16;
#pragma unroll
            for (int n = 0; n < 2; ++n) {
              const f32x4 v = acc[ai][bj][m][n];
#pragma unroll
              for (int j = 0; j < 4; ++j) base[(size_t)(c0 + n * 16 + j) * L + t] = f2bf(v[j]);
            }
          }
        continue;
      }
      u16* base; int ld, c0;
      if (colh < PA_W) { base = PA; ld = PA_W; c0 = colh; }
      else { base = PR; ld = RW_COLS; c0 = colh - PA_W - PH_W; }
      const int col0 = c0 + wc * 32 + 4 * fq;
#pragma unroll
      for (int ai = 0; ai < 2; ++ai)
#pragma unroll
        for (int m = 0; m < 4; ++m) {
          u16* rowp = base + (size_t)(row0 + ai * 128 + m * 16) * ld + col0;
#pragma unroll
          for (int n = 0; n < 2; ++n) {
            const f32x4 v = acc[ai][bj][m][n];
            u32x2 o; o[0] = pk2(v[0], v[1]); o[1] = pk2(v[2], v[3]);
            *(u32x2*)(rowp + n * 16) = o;
          }
        }
    }
  }
};
struct EpiOutproj {
  const Params* p; int l;
  struct Pre {};
  DI Pre prefetch(const pg8::Unit&, int, int) const { return Pre{}; }
  DI void operator()(const f32x4 (&acc)[2][2][4][2], const pg8::Unit& u, int wr, int wc, int fr, int fq, const Pre&) const {
    const int row0 = u.pm * 256 + wr * 64 + fr, col0 = u.pn * 256 + wc * 32 + 4 * fq;
#pragma unroll
    for (int ai = 0; ai < 2; ++ai)
#pragma unroll
      for (int m = 0; m < 4; ++m) {
        const int r = row0 + ai * 128 + m * 16;
        const float* md = modp(*p, l, r) + 2 * D;
        float* xr = x1row(*p, r);
        const float* xin = (l == 0) ? (r < TL ? p->x + (size_t)r * D : p->ctx + (size_t)(r - TL) * D) : xr;
#pragma unroll
        for (int bj = 0; bj < 2; ++bj)
#pragma unroll
          for (int n = 0; n < 2; ++n) {
            const int c = col0 + bj * 128 + n * 16;
            const f32x4 g1 = *(const f32x4*)(md + c), xv = *(const f32x4*)(xin + c), a = acc[ai][bj][m][n];
            f32x4 o;
#pragma unroll
            for (int j = 0; j < 4; ++j) o[j] = DN_ALPHA * xv[j] + g1[j] * a[j];
            *(f32x4*)(xr + c) = o;
          }
      }
  }
};
struct EpiE1 {
  u16* H; const int* hoff;
  struct Pre {};
  DI Pre prefetch(const pg8::Unit&, int, int) const { return Pre{}; }
  DI void operator()(const f32x4 (&acc)[2][2][4][2], const pg8::Unit& u, int wr, int wc, int fr, int fq, const Pre&) const {
    const int row0 = hoff[u.e] + u.pm * 256 + wr * 64 + fr, col0 = u.pn * 128 + wc * 32 + 4 * fq;
#pragma unroll
    for (int ai = 0; ai < 2; ++ai)
#pragma unroll
      for (int m = 0; m < 4; ++m) {
        u16* rowp = H + (size_t)(row0 + ai * 128 + m * 16) * FF + col0;
#pragma unroll
        for (int n = 0; n < 2; ++n) {
          const f32x4 g = acc[ai][0][m][n], uu = acc[ai][1][m][n];
          u32x2 o; o[0] = pk2(g[0] * fsigmoid_(g[0]) * uu[0], g[1] * fsigmoid_(g[1]) * uu[1]); o[1] = pk2(g[2] * fsigmoid_(g[2]) * uu[2], g[3] * fsigmoid_(g[3]) * uu[3]);
          *(u32x2*)(rowp + n * 16) = o;
        }
      }
  }
};
constexpr float ACC_SCALE = 1024.f;
DI unsigned long long acc_pack4(float a, float b, float c, float d) {
  const long long qa = (long long)(int)rintf(a * ACC_SCALE), qb = (long long)(int)rintf(b * ACC_SCALE);
  const long long qc = (long long)(int)rintf(c * ACC_SCALE), qd = (long long)(int)rintf(d * ACC_SCALE);
  return (unsigned long long)(qa + (qb << 16) + (qc << 32) + (qd << 48));
}
DI void acc_unpack4(unsigned lo, unsigned hi, float& a, float& b, float& c, float& d) {
  long long v = (long long)(((unsigned long long)hi << 32) | (unsigned long long)lo);
  const long long f0 = (long long)(short)(v & 0xffff); v = (v - f0) >> 16;
  const long long f1 = (long long)(short)(v & 0xffff); v = (v - f1) >> 16;
  const long long f2 = (long long)(short)(v & 0xffff); v = (v - f2) >> 16;
  const long long f3 = (long long)(short)(v & 0xffff);
  a = (float)(int)f0 * (1.f / ACC_SCALE); b = (float)(int)f1 * (1.f / ACC_SCALE);
  c = (float)(int)f2 * (1.f / ACC_SCALE); d = (float)(int)f3 * (1.f / ACC_SCALE);
}
struct EpiE2 {
  int* accb; const int* etok; const float* egate; float* xs; u16* sho;
  static constexpr int WSTRIDE = 16 * 36 + 16 + 256;
  struct Pre { int t0, t1; float g0, g1; };
  DI Pre prefetch(const pg8::Unit& u, int wr, int lane) const {
    Pre q; q.t0 = 0; q.t1 = 0; q.g0 = 1.f; q.g1 = 1.f;
    if (u.e < NE) {
      const int s0 = u.pm * 256 + wr * 64 + ((lane >> 4) & 3) * 16 + (lane & 15), s1 = s0 + 128;
      const size_t b = (size_t)u.e * T;
      const size_t i0 = b + (s0 < u.cnt ? s0 : u.pm * 256), i1 = b + (s1 < u.cnt ? s1 : u.pm * 256);
      q.t0 = etok[i0]; q.g0 = egate[i0]; q.t1 = etok[i1]; q.g1 = egate[i1];
    }
    return q;
  }
  DI void operator()(const f32x4 (&acc)[2][2][4][2], const pg8::Unit& u, int wr, int wc, int fr, int fq, const Pre& pq) const {
    if (u.e == NE) {
      const int row0 = u.pm * 256 + wr * 64 + fr, col0 = u.pn * 256 + wc * 32 + 4 * fq;
#pragma unroll
      for (int ai = 0; ai < 2; ++ai)
#pragma unroll
        for (int m = 0; m < 4; ++m) {
          const int r = row0 + ai * 128 + m * 16;
          if (r < u.cnt) {
#pragma unroll
            for (int bj = 0; bj < 2; ++bj)
#pragma unroll
              for (int n = 0; n < 2; ++n) st_bf4(sho + (size_t)r * D + col0 + bj * 128 + n * 16, acc[ai][bj][m][n]);
          }
        }
      return;
    }
    const int lane = fq * 16 + fr, wave = wr * 4 + wc;
    float* X = xs + wave * WSTRIDE;
    int* tk = (int*)(X + 16 * 36);
    int* tokw = tk + 16;
    float* gatew = (float*)(tokw + 128);
    wave_sync();
#pragma unroll
    for (int q = 0; q < 2; ++q) {
      const int lr = lane + 64 * q;
      const int slot = u.pm * 256 + (lr >> 6) * 128 + wr * 64 + ((lr >> 4) & 3) * 16 + (lr & 15);
      const bool valid = slot < u.cnt;
      const int tok = q ? pq.t1 : pq.t0; const float gt = q ? pq.g1 : pq.g0;
      tokw[lr] = valid ? tok : -1; gatew[lr] = valid ? gt : 0.f;
    }
    wave_sync();
#pragma unroll
    for (int ai = 0; ai < 2; ++ai)
#pragma unroll
      for (int m = 0; m < 4; ++m) {
        const int lrow = ai * 64 + m * 16;
        const float gt = gatew[lrow + fr];
#pragma unroll
        for (int bj = 0; bj < 2; ++bj) {
          wave_sync();
#pragma unroll
          for (int n = 0; n < 2; ++n) {
            f32x4 v = acc[ai][bj][m][n];
#pragma unroll
            for (int j = 0; j < 4; ++j) v[j] *= gt;
            *(f32x4*)(X + fr * 36 + n * 16 + fq * 4) = v;
          }
          wave_sync();
          const int cquad = (u.pn * 256 + bj * 128 + wc * 32) / 4 + (lane & 7);
#pragma unroll
          for (int i = 0; i < 2; ++i) {
            const int rr = 8 * i + (lane >> 3);
            const int t2 = tokw[lrow + rr];
            const f32x4 xv = *(const f32x4*)(X + rr * 36 + 4 * (lane & 7));
            if (t2 >= 0) atomicAdd((unsigned long long*)accb + (size_t)t2 * (D / 4) + cquad, acc_pack4(xv[0], xv[1], xv[2], xv[3]));
          }
        }
      }
  }
};

constexpr int TICKET_SLOT_OFF = SMEM_BYTES - 1024 - 64;
template <class F> DI void ticket_loop(unsigned* ctr, int n_items, char* smem, F&& body) {
  int* slot = (int*)(smem + TICKET_SLOT_OFF);
  const int tid = TIDX();
  __syncthreads();
  if (tid == 0) slot[0] = (int)atomicAdd(ctr, 1u);
  __syncthreads();
  for (int k = 0;; ++k) {
    const int it = slot[k & 1];
    if (it >= n_items) break;
    int nx = 0;
    if (tid == 0) nx = (int)atomicAdd(ctr, 1u);
    body(it);
    if (tid == 0) slot[(k + 1) & 1] = nx;
    __syncthreads();
  }
}
DI void ph_prologue(const Params& p, char* smem) {
  const int tid = TIDX();
  constexpr int NCH = 6 * D / 128;
  constexpr int ITEMS_MOD = DEPTH * NCH;
  constexpr int ITEMS_H3 = DEPTH * (SEQ / 64 + CTXL / 64);
  constexpr int ITEMS_CV = DEPTH * CT_STATIC_L;
  constexpr int ITEMS = ITEMS_MOD + ITEMS_H3 + 1;
  for (int item = BIDX(); item < ITEMS; item += gridDim.x) {
    if (item < ITEMS_MOD) {
      const int l = item / NCH, ch = item % NCH;
      float* sv = (float*)smem;
      float* red = sv + (NB + 1) * D;
      {
        constexpr int NSV = ((NB + 1) * D + NT - 1) / NT;
        float cv[NSV];
#pragma unroll
        for (int j = 0; j < NSV; ++j) {
          int i = tid + j * NT; if (i > (NB + 1) * D - 1) i = (NB + 1) * D - 1;
          const int row = i / D, e = i % D;
          const float* src = row < NB ? p.c + row * D : p.c_ctx;
          cv[j] = src[e];
        }
#pragma unroll
        for (int j = 0; j < NSV; ++j) { const int i = tid + j * NT; if (i < (NB + 1) * D) sv[i] = siluf_(cv[j]); }
      }
      __syncthreads();
      const int col = ch * 128 + (tid & 127), kg = tid >> 7;
      float a[NB + 1];
#pragma unroll
      for (int r = 0; r < NB + 1; ++r) a[r] = 0.f;
      const float* W = p.w_ada + (size_t)l * D * 6 * D;
      for (int k = kg * (D / 4); k < (kg + 1) * (D / 4); k += 16) {
        float w[16];
#pragma unroll
        for (int j = 0; j < 16; ++j) w[j] = W[(size_t)(k + j) * 6 * D + col];
#pragma unroll
        for (int j = 0; j < 16; ++j)
#pragma unroll
          for (int r = 0; r < NB + 1; ++r) a[r] += sv[r * D + k + j] * w[j];
      }
#pragma unroll
      for (int r = 0; r < NB + 1; ++r) red[(kg * (NB + 1) + r) * 128 + (tid & 127)] = a[r];
      __syncthreads();
      for (int i = tid; i < (NB + 1) * 128; i += NT) {
        int r = i / 128, cc = i % 128;
        float s = 0.f;
        for (int g = 0; g < 4; ++g) s += red[(g * (NB + 1) + r) * 128 + cc];
        int cg_ = ch * 128 + cc;
        p.mod[((size_t)l * (NB + 1) + r) * 6 * D + cg_] = s + p.b_ada[(size_t)l * 6 * D + cg_];
      }
      __syncthreads();
    } else if (item < ITEMS_MOD + ITEMS_H3) {
      int it = item - ITEMS_MOD;
      constexpr int PER_L = SEQ / 64 + CTXL / 64;
      const int l = it / PER_L;
      int q = it % PER_L;
      const bool isctx = q >= SEQ / 64;
      const int L = isctx ? CTXL : SEQ;
      const int pos0 = (isctx ? q - SEQ / 64 : q) * 64;
      float* z = (float*)smem;
      float* ha = z + 64 * 36;
      float* hb = ha + 64 * 64;
      float* w1s = hb + 64 * 64;
      float* w2s = w1s + HY_EMB * HY_HID;
      float* w3s = w2s + HY_HID * HY_HID;
      {
        constexpr int N1 = (HY_EMB * HY_HID + NT - 1) / NT, N2 = (HY_HID * HY_HID + NT - 1) / NT;
        float a1[N1], a2[N2], a3[N2];
        const float* g1 = p.hf_w1 + (size_t)l * HY_EMB * HY_HID;
        const float* g2 = p.hf_w2 + (size_t)l * HY_HID * HY_HID;
        const float* g3 = p.hf_w3 + (size_t)l * HY_HID * HY_HID;
#pragma unroll
        for (int j = 0; j < N1; ++j) { int i = tid + j * NT; if (i > HY_EMB * HY_HID - 1) i = HY_EMB * HY_HID - 1; a1[j] = g1[i]; }
#pragma unroll
        for (int j = 0; j < N2; ++j) { int i = tid + j * NT; if (i > HY_HID * HY_HID - 1) i = HY_HID * HY_HID - 1; a2[j] = g2[i]; a3[j] = g3[i]; }
#pragma unroll
        for (int j = 0; j < N1; ++j) { const int i = tid + j * NT; if (i < HY_EMB * HY_HID) w1s[i] = a1[j]; }
#pragma unroll
        for (int j = 0; j < N2; ++j) { const int i = tid + j * NT; if (i < HY_HID * HY_HID) { w2s[i] = a2[j]; w3s[i] = a3[j]; } }
      }
      for (int i = tid; i < 64 * HY_EMB; i += NT) {
        int pp = i / HY_EMB, e = i % HY_EMB;
        int pos = pos0 + pp;
        float v;
        if (e == 0) v = (float)pos / (float)(L - 1);
        else {
          int bi = (e - 1) % HY_BANDS;
          float band = 1e-4f + ((float)(HY_BANDS - 1) - 1e-4f) * (float)bi / (float)(HY_BANDS - 1);
          float ang = (2.0f * 3.14159265358979323846f / (float)L) * (float)pos * band;
          v = (e - 1) < HY_BANDS ? cosf(ang) : -sinf(ang);
        }
        z[pp * 36 + e] = v;
      }
      __syncthreads();
      const int pp = tid >> 3, sub = tid & 7;
      const float* fr = p.hf_freq + l * HY_HID;
      {
        const float* b = p.hf_b1 + l * HY_HID;
        float acc8[8];
#pragma unroll
        for (int uu = 0; uu < 8; ++uu) acc8[uu] = b[sub * 8 + uu];
        for (int e = 0; e < HY_EMB; ++e) {
          const float zv = z[pp * 36 + e];
#pragma unroll
          for (int uu = 0; uu < 8; ++uu) acc8[uu] += zv * w1s[e * HY_HID + sub * 8 + uu];
        }
#pragma unroll 1
        for (int uu = 0; uu < 8; ++uu) ha[pp * 64 + sub * 8 + uu] = sinf(fr[sub * 8 + uu] * acc8[uu]);
      }
      __syncthreads();
      {
        const float* b = p.hf_b2 + l * HY_HID;
        float acc8[8];
#pragma unroll
        for (int uu = 0; uu < 8; ++uu) acc8[uu] = b[sub * 8 + uu];
        for (int e = 0; e < HY_HID; ++e) {
          const float zv = ha[pp * 64 + e];
#pragma unroll
          for (int uu = 0; uu < 8; ++uu) acc8[uu] += zv * w2s[e * HY_HID + sub * 8 + uu];
        }
#pragma unroll 1
        for (int uu = 0; uu < 8; ++uu) hb[pp * 64 + sub * 8 + uu] = sinf(fr[sub * 8 + uu] * acc8[uu]);
      }
      __syncthreads();
      {
        const float* b = p.hf_b3 + l * HY_HID;
        float* dst = isctx ? p.h3ctx + ((size_t)l * CTXL + pos0) * 64 : p.h3lat + ((size_t)l * SEQ + pos0) * 64;
        float acc8[8];
#pragma unroll
        for (int uu = 0; uu < 8; ++uu) acc8[uu] = b[sub * 8 + uu];
        for (int e = 0; e < HY_HID; ++e) {
          const float zv = hb[pp * 64 + e];
#pragma unroll
          for (int uu = 0; uu < 8; ++uu) acc8[uu] += zv * w3s[e * HY_HID + sub * 8 + uu];
        }
#pragma unroll 1
        for (int uu = 0; uu < 8; ++uu) dst[pp * 64 + sub * 8 + uu] = sinf(fr[sub * 8 + uu] * acc8[uu]);
      }
      __syncthreads();
    } else {
      for (int k = tid; k < FFTN / 2; k += NT) {
        double ang = -2.0 * 3.14159265358979323846 * (double)k / (double)FFTN;
        cf w; w.x = (float)cos(ang); w.y = (float)sin(ang);
        p.tw[k] = w;
      }
      for (int i = tid; i < DEPTH * NE; i += NT) p.cnt[i] = 0;
    }
  }
  ticket_loop(p.bar + XB_TICKET, ITEMS_CV, smem, [&](int it) { convert_static_item(p, it, smem); });
}

DI void ph_premod(const Params& p) {
  const int tid = TIDX();
  constexpr int ITEMS = T / 8;
  constexpr int NI = 8 * D / 4 / NT;
  static_assert(NI * NT * 4 == 8 * D, "premod tiling");
  for (int item = BIDX(); item < ITEMS; item += gridDim.x) {
    f32x4 xv[NI], sc[NI], sh[NI];
#pragma unroll
    for (int k = 0; k < NI; ++k) {
      const int i = tid + k * NT;
      const int r = item * 8 + i / (D / 4), e = (i % (D / 4)) * 4;
      const float* m = modp(p, 0, r);
      const float* src = r < TL ? p.x + (size_t)r * D : p.ctx + (size_t)(r - TL) * D;
      xv[k] = *(const f32x4*)(src + e); sc[k] = *(const f32x4*)(m + D + e); sh[k] = *(const f32x4*)(m + e);
    }
#pragma unroll
    for (int k = 0; k < NI; ++k) {
      const int i = tid + k * NT;
      const int r = item * 8 + i / (D / 4), e = (i % (D / 4)) * 4;
      f32x4 o;
#pragma unroll
      for (int j = 0; j < 4; ++j) o[j] = xv[k][j] * (1.f + sc[k][j]) + sh[k][j];
      st_bf4(p.HL + (size_t)r * D + e, o);
    }
  }
}

DI int fpad(int i) { return i + (i >> 4); }
constexpr int FFT_LDS = FFTN + FFTN / 16;
__device__ static constexpr float C16[8] = {1.f, 0.92387953251128674f, 0.70710678118654752f, 0.38268343236508977f, 0.f, -0.38268343236508977f, -0.70710678118654752f, -0.92387953251128674f};
__device__ static constexpr float S16[8] = {0.f, 0.38268343236508977f, 0.70710678118654752f, 0.92387953251128674f, 1.f, 0.92387953251128674f, 0.70710678118654752f, 0.38268343236508977f};
template <int R, bool INV>
DI void fft_pass(cf* buf, const cf* tw, int m) {
  const int g = m >> (R - 1);
  constexpr int NQ = 1 << R;
  for (int w = TIDX(); w < (FFTN >> R); w += NT) {
    const int j = w % g, blk = w / g;
    const int base = blk * (g << R) + j;
    cf v[NQ];
#pragma unroll
    for (int q = 0; q < NQ; ++q) v[q] = buf[fpad(base + q * g)];
    cf bt[R];
    bt[0] = tw[j * ((FFTN / 2) / ((NQ / 2) * g))];
#pragma unroll
    for (int r = 1; r < R; ++r) { bt[r].x = bt[r - 1].x * bt[r - 1].x - bt[r - 1].y * bt[r - 1].y; bt[r].y = 2.f * bt[r - 1].x * bt[r - 1].y; }
    if (!INV) {
#pragma unroll
      for (int r = 0; r < R; ++r) {
        const int half = 1 << (R - 1 - r);
#pragma unroll
        for (int q = 0; q < NQ; ++q) {
          if ((q & half) == 0) {
            const int qq = q & (half - 1);
            const int ci = qq * (8 / half);
            cf W;
            W.x = bt[r].x * C16[ci] + bt[r].y * S16[ci];
            W.y = bt[r].y * C16[ci] - bt[r].x * S16[ci];
            cf a = v[q], b = v[q + half];
            v[q].x = a.x + b.x; v[q].y = a.y + b.y;
            float dx = a.x - b.x, dy = a.y - b.y;
            v[q + half].x = dx * W.x - dy * W.y;
            v[q + half].y = dx * W.y + dy * W.x;
          }
        }
      }
    } else {
#pragma unroll
      for (int r = R - 1; r >= 0; --r) {
        const int half = 1 << (R - 1 - r);
#pragma unroll
        for (int q = 0; q < NQ; ++q) {
          if ((q & half) == 0) {
            const int qq = q & (half - 1);
            const int ci = qq * (8 / half);
            cf W;
            W.x = bt[r].x * C16[ci] + bt[r].y * S16[ci];
            W.y = bt[r].y * C16[ci] - bt[r].x * S16[ci];
            cf a = v[q], b = v[q + half];
            float bx = b.x * W.x + b.y * W.y;
            float by = b.y * W.x - b.x * W.y;
            v[q].x = a.x + bx; v[q].y = a.y + by;
            v[q + half].x = a.x - bx; v[q + half].y = a.y - by;
          }
        }
      }
    }
#pragma unroll
    for (int q = 0; q < NQ; ++q) buf[fpad(base + q * g)] = v[q];
  }
}
constexpr int FFT_R4 = LOG2N / 4, FFT_REM = LOG2N % 4;
DI void fft_fwd_main(cf* buf, const cf* tw) {
  int m = FFTN / 2;
#pragma unroll
  for (int i = 0; i < FFT_R4; ++i) { fft_pass<4, false>(buf, tw, m); __syncthreads(); m >>= 4; }
}
DI void fft_fwd_tail(cf* buf, const cf* tw) {
  if (FFT_REM == 3) { fft_pass<3, false>(buf, tw, 4); __syncthreads(); }
  if (FFT_REM == 2) { fft_pass<2, false>(buf, tw, 2); __syncthreads(); }
  if (FFT_REM == 1) { fft_pass<1, false>(buf, tw, 1); __syncthreads(); }
}
DI void fft_fwd(cf* buf, const cf* tw) { fft_fwd_main(buf, tw); fft_fwd_tail(buf, tw); }
DI void fft_inv_tail(cf* buf, const cf* tw) {
  if (FFT_REM == 3) { fft_pass<3, true>(buf, tw, 4); __syncthreads(); }
  if (FFT_REM == 2) { fft_pass<2, true>(buf, tw, 2); __syncthreads(); }
  if (FFT_REM == 1) { fft_pass<1, true>(buf, tw, 1); __syncthreads(); }
}
DI void fft_inv_main(cf* buf, const cf* tw) {
  int m = (1 << FFT_REM) * 8;
#pragma unroll
  for (int i = 0; i < FFT_R4; ++i) { fft_pass<4, true>(buf, tw, m); __syncthreads(); m <<= 4; }
}
DI void tw_to_lds(cf* tw, const cf* __restrict__ gtw) {
  constexpr int NIT = (FFTN / 4 + NT - 1) / NT;
  f32x4 t4[NIT];
#pragma unroll
  for (int j = 0; j < NIT; ++j) { int i = TIDX() + j * NT; if (i > FFTN / 4 - 1) i = FFTN / 4 - 1; t4[j] = ((const f32x4*)gtw)[i]; }
#pragma unroll
  for (int j = 0; j < NIT; ++j) { const int i = TIDX() + j * NT; if (i < FFTN / 4) ((f32x4*)tw)[i] = t4[j]; }
}
constexpr int MID_IT = (FFTN / 2 + NT - 1) / NT;
struct MidSpec { f32x4 k[MID_IT]; };
DI MidSpec fft_mid_prefetch(const cf* __restrict__ sp) {
  MidSpec m;
#pragma unroll
  for (int j = 0; j < MID_IT; ++j) {
    int i = TIDX() + j * NT; if (i > FFTN / 2 - 1) i = FFTN / 2 - 1;
    m.k[j] = *(const f32x4*)(sp + 2 * i);
  }
  return m;
}
DI void fft_mid(cf* buf, const cf* tw, const cf* __restrict__ sp, const MidSpec& ms) {
  if (FFT_REM == 1) {
#pragma unroll
    for (int j = 0; j < MID_IT; ++j) {
      const int i = TIDX() + j * NT;
      if (i >= FFTN / 2) break;
      const cf a = buf[fpad(2 * i)], b = buf[fpad(2 * i + 1)];
      cf A, B;
      A.x = a.x + b.x; A.y = a.y + b.y; B.x = a.x - b.x; B.y = a.y - b.y;
      const f32x4 k = ms.k[j];
      cf P, Q;
      P.x = A.x * k[0] - A.y * k[1]; P.y = A.x * k[1] + A.y * k[0];
      Q.x = B.x * k[2] - B.y * k[3]; Q.y = B.x * k[3] + B.y * k[2];
      cf o0, o1;
      o0.x = P.x + Q.x; o0.y = P.y + Q.y; o1.x = P.x - Q.x; o1.y = P.y - Q.y;
      buf[fpad(2 * i)] = o0; buf[fpad(2 * i + 1)] = o1;
    }
    __syncthreads();
  } else {
    fft_fwd_tail(buf, tw);
    for (int i = TIDX(); i < FFTN; i += NT) {
      cf a = buf[fpad(i)], k = sp[i], r;
      r.x = a.x * k.x - a.y * k.y; r.y = a.x * k.y + a.y * k.x;
      buf[fpad(i)] = r;
    }
    __syncthreads();
    fft_inv_tail(buf, tw);
  }
}

DI float hy_delta(int c) {
  const float lo = -4.605170185988091f / 1.5f, hi = -4.605170185988091f / 0.3f;
  return fabsf(lo + (hi - lo) * (float)c / (float)(HY_CH - 1));
}

DI void hy_spectrum_item(const Params& p, int l, int o, int c, char* smem) {
  const int tid = TIDX();
  cf* buf = (cf*)smem;
  cf* tw = buf + FFT_LDS;
  float* wc = (float*)(tw + FFTN / 2);
  tw_to_lds(tw, p.tw);
  if (tid < 128) {
    int dir = tid >> 6, u = tid & 63;
    wc[tid] = p.hf_wout[((size_t)l * HY_HID + u) * (4 * HY_CH) + o * 2 * HY_CH + dir * HY_CH + c];
  }
  __syncthreads();
  const float dl = hy_delta(c);
  {
    const int q = tid & 15, rr = tid >> 4;
    constexpr int RPP = NT / 16;
    constexpr int UNR = (SEQ / RPP) % 8 == 0 ? 8 : 1;
    const f32x4 wf = *(const f32x4*)(wc + 4 * q), wb = *(const f32x4*)(wc + 64 + 4 * q);
    const float* hbase = p.h3lat + (size_t)l * SEQ * 64 + 4 * q;
    for (int t0 = 0; t0 < SEQ; t0 += RPP * UNR) {
      f32x4 hv[UNR];
#pragma unroll
      for (int j = 0; j < UNR; ++j) hv[j] = *(const f32x4*)(hbase + (size_t)(t0 + j * RPP + rr) * 64);
#pragma unroll
      for (int j = 0; j < UNR; ++j) {
        const int t = t0 + j * RPP + rr;
        float sf = (hv[j][0] * wf[0] + hv[j][1] * wf[1]) + (hv[j][2] * wf[2] + hv[j][3] * wf[3]);
        float sb = (hv[j][0] * wb[0] + hv[j][1] * wb[1]) + (hv[j][2] * wb[2] + hv[j][3] * wb[3]);
        sf = red16(sf); sb = red16(sb);
        if (q == 0) {
          const float dec = expf(-((float)t / (float)(SEQ - 1)) * dl);
          cf a; a.x = sf * dec; a.y = 0.f;
          buf[fpad(t)] = a;
          if (t >= 1) { cf b; b.x = sb * dec; b.y = 0.f; buf[fpad(FFTN - t)] = b; }
          if (t == 0) { cf zz; zz.x = 0.f; zz.y = 0.f; buf[fpad(SEQ)] = zz; }
        }
      }
    }
  }
  __syncthreads();
  fft_fwd(buf, tw);
  cf* dst = p.spec + ((size_t)o * HY_CH + c) * FFTN;
  const float sc = 1.0f / (float)FFTN;
  for (int i = tid; i < FFTN; i += NT) { cf v = buf[fpad(i)]; v.x *= sc; v.y *= sc; dst[i] = v; }
  __syncthreads();
}

DI void ph_inproj(const Params& p, int l, char* smem) {
  constexpr int SPEC_ITEMS = 2 * HY_CH;
  const int G = gridDim.x, c = BIDX();
  {
    DenseSched S; S.init(p.HL, p.wt_in + (size_t)l * P_IN_PAD * D, D, T, P_IN_PAD, G, c);
    EpiInproj E{p.PA, p.PH, p.PR};
    pg8::gemm_phase(smem, D, S, E);
  }
  __syncthreads();
  (void)c;
  ticket_loop(p.bar + XB_TICKET + 1 + l, SPEC_ITEMS, smem, [&](int it) { hy_spectrum_item(p, l, it / HY_CH, it % HY_CH, smem); });
}

DI float hy_u(const u16* P, int t, int L, float w0, float w1, float w2, float bias) {
  const bool hp = t >= 1, hn = t + 1 < L;
  const float c = bf2f(P[t]), a = bf2f(P[hp ? t - 1 : t]), b = bf2f(P[hn ? t + 1 : t]);
  return w1 * c + bias + (hp ? w0 : 0.f) * a + (hn ? w2 : 0.f) * b;
}

struct HyRaw { u32x4 x; u16 prev, next; };
DI HyRaw hy_load8(const u16* P, int t0, int L) {
  HyRaw r;
  r.x = *(const u32x4*)(P + t0);
  r.prev = P[t0 >= 1 ? t0 - 1 : t0];
  r.next = P[t0 + 8 < L ? t0 + 8 : t0 + 7];
  return r;
}
DI void hy_conv8(const HyRaw& r, int t0, int L, float w0, float w1, float w2, float bias, float (&out)[8]) {
  float x[10];
  x[0] = bf2f(r.prev);
#pragma unroll
  for (int j = 0; j < 4; ++j) { x[1 + 2 * j] = bf2f((u16)(r.x[j] & 0xffff)); x[2 + 2 * j] = bf2f((u16)(r.x[j] >> 16)); }
  x[9] = bf2f(r.next);
  const float wp = t0 >= 1 ? w0 : 0.f, wn = t0 + 8 < L ? w2 : 0.f;
#pragma unroll
  for (int j = 0; j < 8; ++j) out[j] = w1 * x[1 + j] + bias + (j == 0 ? wp : w0) * x[j] + (j == 7 ? wn : w2) * x[2 + j];
}

DI void hyena_lat_item(const Params& p, int l, int c, int pair, char* smem, bool load_tw) {
  const int tid = TIDX();
  cf* buf = (cf*)smem;
  cf* tw = buf + FFT_LDS;
  const float* cw = p.hy_sconv_w + (size_t)l * 3 * PH_W;
  const float* cb = p.hy_sconv_b + (size_t)l * PH_W;
  const int b0 = pair * 2, b1 = pair * 2 + 1;
  const int t0 = tid * 8;
  const bool act = t0 < SEQ;
  const int tl = act ? t0 : 0;
  HyRaw rw[3][2];
#pragma unroll
  for (int q = 0; q < 3; ++q) {
    rw[q][0] = hy_load8(p.PH + ((size_t)b0 * PH_W + q * HY_CH + c) * SEQ, tl, SEQ);
    rw[q][1] = hy_load8(p.PH + ((size_t)b1 * PH_W + q * HY_CH + c) * SEQ, tl, SEQ);
  }
  if (load_tw) tw_to_lds(tw, p.tw);
  const MidSpec ms0 = fft_mid_prefetch(p.spec + ((size_t)0 * HY_CH + c) * FFTN);
  float vr[2][8], z1[2][8];
  {
    const int col = c;
    const float w0 = cw[col], w1 = cw[PH_W + col], w2 = cw[2 * PH_W + col], bs = cb[col];
    hy_conv8(rw[0][0], tl, SEQ, w0, w1, w2, bs, vr[0]);
    hy_conv8(rw[0][1], tl, SEQ, w0, w1, w2, bs, vr[1]);
    if (act) {
#pragma unroll
      for (int j = 0; j < 8; ++j) {
        cf a; a.x = vr[0][j]; a.y = vr[1][j];
        buf[fpad(t0 + j)] = a;
        cf zz; zz.x = 0.f; zz.y = 0.f;
        buf[fpad(t0 + j + SEQ)] = zz;
      }
    }
  }
  __syncthreads();
  fft_fwd_main(buf, tw);
  fft_mid(buf, tw, p.spec + ((size_t)0 * HY_CH + c) * FFTN, ms0);
  const MidSpec ms1 = fft_mid_prefetch(p.spec + ((size_t)1 * HY_CH + c) * FFTN);
  fft_inv_main(buf, tw);
  {
    const int col = HY_CH + c;
    const float w0 = cw[col], w1 = cw[PH_W + col], w2 = cw[2 * PH_W + col], bs = cb[col];
    const float sk = p.hf_skip[((size_t)l * 2 + 0) * HY_CH + c];
    float x1a[8], x1b[8];
    hy_conv8(rw[1][0], tl, SEQ, w0, w1, w2, bs, x1a);
    hy_conv8(rw[1][1], tl, SEQ, w0, w1, w2, bs, x1b);
    cf yv[8];
    if (act) {
#pragma unroll
      for (int j = 0; j < 8; ++j) yv[j] = buf[fpad(t0 + j)];
    }
    __syncthreads();
    if (act) {
#pragma unroll
      for (int j = 0; j < 8; ++j) {
        z1[0][j] = (yv[j].x + sk * vr[0][j]) * x1a[j];
        z1[1][j] = (yv[j].y + sk * vr[1][j]) * x1b[j];
        cf a; a.x = z1[0][j]; a.y = z1[1][j];
        buf[fpad(t0 + j)] = a;
        cf zz; zz.x = 0.f; zz.y = 0.f;
        buf[fpad(t0 + j + SEQ)] = zz;
      }
    }
  }
  __syncthreads();
  fft_fwd_main(buf, tw);
  fft_mid(buf, tw, p.spec + ((size_t)1 * HY_CH + c) * FFTN, ms1);
  fft_inv_main(buf, tw);
  {
    const int col = 2 * HY_CH + c;
    const float w0 = cw[col], w1 = cw[PH_W + col], w2 = cw[2 * PH_W + col], bs = cb[col];
    const float sk = p.hf_skip[((size_t)l * 2 + 1) * HY_CH + c];
    float x2a[8], x2b[8];
    hy_conv8(rw[2][0], tl, SEQ, w0, w1, w2, bs, x2a);
    hy_conv8(rw[2][1], tl, SEQ, w0, w1, w2, bs, x2b);
    if (act) {
      u32x4 oa, ob;
#pragma unroll
      for (int j = 0; j < 4; ++j) {
        const cf y0 = buf[fpad(t0 + 2 * j)], y1 = buf[fpad(t0 + 2 * j + 1)];
        oa[j] = pk2((y0.x + sk * z1[0][2 * j]) * x2a[2 * j], (y1.x + sk * z1[0][2 * j + 1]) * x2a[2 * j + 1]);
        ob[j] = pk2((y0.y + sk * z1[1][2 * j]) * x2b[2 * j], (y1.y + sk * z1[1][2 * j + 1]) * x2b[2 * j + 1]);
      }
      *(u32x4*)(p.yhlat + ((size_t)b0 * HY_CH + c) * SEQ + t0) = oa;
      *(u32x4*)(p.yhlat + ((size_t)b1 * HY_CH + c) * SEQ + t0) = ob;
    }
  }
  __syncthreads();
}

DI void hyena_ctx_item(const Params& p, int l, int c, char* smem) {
  const int tid = TIDX();
  float* taps = (float*)smem;
  float* uv = taps + 4 * CTXL;
  float* zb = uv + NB * 3 * CTXL;
  float* wc = zb + NB * CTXL;
  if (tid < 256) {
    int od = tid >> 6, u = tid & 63;
    wc[tid] = p.hf_wout[((size_t)l * HY_HID + u) * (4 * HY_CH) + od * HY_CH + c];
  }
  __syncthreads();
  const float dl = hy_delta(c);
  for (int i = tid; i < 4 * CTXL; i += NT) {
    int od = i / CTXL, t = i % CTXL;
    const float* h = p.h3ctx + ((size_t)l * CTXL + t) * 64;
    float s = 0.f;
    for (int u = 0; u < 64; ++u) s += h[u] * wc[od * 64 + u];
    taps[i] = s * expf(-((float)t / (float)(CTXL - 1)) * dl);
  }
  const float* cw = p.hy_sconv_w + (size_t)l * 3 * PH_W;
  const float* cb = p.hy_sconv_b + (size_t)l * PH_W;
  for (int i = tid; i < NB * 3 * CTXL; i += NT) {
    int b = i / (3 * CTXL), j = (i / CTXL) % 3, t = i % CTXL;
    int col = j * HY_CH + c;
    const u16* P = p.PH + (size_t)NB * PH_W * SEQ + ((size_t)b * PH_W + col) * CTXL;
    uv[i] = hy_u(P, t, CTXL, cw[col], cw[PH_W + col], cw[2 * PH_W + col], cb[col]);
  }
  __syncthreads();
  const float sk0 = p.hf_skip[((size_t)l * 2 + 0) * HY_CH + c], sk1 = p.hf_skip[((size_t)l * 2 + 1) * HY_CH + c];
  for (int i = tid; i < NB * CTXL; i += NT) {
    int b = i / CTXL, t = i % CTXL;
    const float* v = uv + (b * 3 + 0) * CTXL;
    float s = 0.f;
    for (int s_ = 0; s_ < CTXL; ++s_) {
      int lag = t - s_;
      float k = lag >= 0 ? taps[0 * CTXL + lag] : taps[1 * CTXL - lag];
      s += k * v[s_];
    }
    zb[i] = (s + sk0 * v[t]) * uv[(b * 3 + 1) * CTXL + t];
  }
  __syncthreads();
  for (int i = tid; i < NB * CTXL; i += NT) {
    int b = i / CTXL, t = i % CTXL;
    const float* v = zb + b * CTXL;
    float s = 0.f;
    for (int s_ = 0; s_ < CTXL; ++s_) {
      int lag = t - s_;
      float k = lag >= 0 ? taps[2 * CTXL + lag] : taps[3 * CTXL - lag];
      s += k * v[s_];
    }
    p.yhctx[((size_t)b * HY_CH + c) * CTXL + t] = f2bf((s + sk1 * v[t]) * uv[(b * 3 + 2) * CTXL + t]);
  }
  __syncthreads();
}

DI void mixer_a_item(const Params& p, int l, int tile) {
  const int tid = TIDX(), lane = tid & 63, wave = tid >> 6;
  const int ts = lane >> 4, cq = lane & 15;
  constexpr int NBK = CONV_CH / 64;
  const float* cw = p.conv_a + (size_t)l * 3 * CONV_CH;
  const float* gn = p.mix_norm_g + (size_t)l * (CONV_CH + HY_CH);
#pragma unroll
  for (int it = 0; it < 2; ++it) {
    const int r = tile * 64 + wave * 8 + it * 4 + ts;
    int rp = r, rn = r;
    bool hp = false, hn = false;
    if (r < TL) { const int t = r % SEQ; hp = t >= GRID_W; hn = t + GRID_W < SEQ; if (hp) rp = r - GRID_W; if (hn) rn = r + GRID_W; }
    else { const int t = (r - TL) % CTXL; hp = t >= 1; hn = t + 1 < CTXL; if (hp) rp = r - 1; if (hn) rn = r + 1; }
    const float fp = hp ? 1.f : 0.f, fn = hn ? 1.f : 0.f;
    const u16* row = p.PA + (size_t)r * PA_W;
    const u16* qp = p.PA + (size_t)rp * PA_W;
    const u16* qn = p.PA + (size_t)rn * PA_W;
    float yv[NBK][4];
    float ss = 0.f;
#pragma unroll
    for (int bk = 0; bk < NBK; ++bk) {
      const int c = bk * 64 + cq * 4;
      const f32x4 bg = ld_bf4(row + c);
      const f32x4 c0 = ld_bf4(row + CONV_CH + c), x0 = ld_bf4(row + 2 * CONV_CH + c);
      const f32x4 c1 = ld_bf4(qp + CONV_CH + c), x1 = ld_bf4(qp + 2 * CONV_CH + c);
      const f32x4 c2 = ld_bf4(qn + CONV_CH + c), x2 = ld_bf4(qn + 2 * CONV_CH + c);
      const f32x4 w0 = *(const f32x4*)(cw + c), w1 = *(const f32x4*)(cw + CONV_CH + c), w2 = *(const f32x4*)(cw + 2 * CONV_CH + c);
#pragma unroll
      for (int j = 0; j < 4; ++j) {
        const float z = c0[j] * x0[j] * w1[j] + fp * w0[j] * (c1[j] * x1[j]) + fn * w2[j] * (c2[j] * x2[j]);
        yv[bk][j] = bg[j] * z;
        ss += yv[bk][j] * yv[bk][j];
      }
    }
    ss = red16(ss);
    const float rs = rsqrtf(ss / (float)CONV_CH + LN_EPS);
#pragma unroll
    for (int bk = 0; bk < NBK; ++bk) {
      const int c = bk * 64 + cq * 4;
      const f32x4 g4 = *(const f32x4*)(gn + c);
      f32x4 o;
#pragma unroll
      for (int j = 0; j < 4; ++j) o[j] = yv[bk][j] * rs * g4[j];
      st_bf4(p.ya + (size_t)r * CONV_CH + c, o);
    }
  }
}

DI void ph_mix(const Params& p, int l, char* smem) {
  const bool need_ctx = (l == 0);
  constexpr int HL_ITEMS = HY_CH * (NB / 2);
  const int HC_ITEMS = need_ctx ? HY_CH : 0;
  const int MA_ITEMS = (need_ctx ? T : TL) / 64;
  const int total = HL_ITEMS + HC_ITEMS + MA_ITEMS;
  SEG_BEGIN(p)
  bool tw_loaded = false;
  ticket_loop(p.bar + XB_TICKET + 1 + 2 * DEPTH + l, total, smem, [&](int item) {
    if (item < HL_ITEMS) { hyena_lat_item(p, l, item / (NB / 2), item % (NB / 2), smem, !tw_loaded); tw_loaded = true; SEG_MARK(p, 9) }
    else if (item < HL_ITEMS + HC_ITEMS) { hyena_ctx_item(p, l, item - HL_ITEMS, smem); SEG_MARK(p, 10) }
    else { mixer_a_item(p, l, item - HL_ITEMS - HC_ITEMS); SEG_MARK(p, 11) }
  });
}

DI void seq_of_row(int r, int& b, int& t, int& L) {
  if (r < TL) { b = r / SEQ; t = r % SEQ; L = SEQ; }
  else { int rc = r - TL; b = rc / CTXL; t = rc % CTXL; L = CTXL; }
}
DI float rw_u(const Params& p, const float* mu, int r, int t, int L, int col) {
  const float m0 = mu[col], m2 = mu[RW_COLS + col];
  float s = (1.f - m0 - m2) * bf2f(p.PR[(size_t)r * RW_COLS + col]);
  if (t >= 1) s += m0 * bf2f(p.PR[(size_t)(r - 1) * RW_COLS + col]);
  if (t + 1 < L) s += m2 * bf2f(p.PR[(size_t)(r + 1) * RW_COLS + col]);
  return s;
}
DI bf16x8 load_bfrag(const float* W, int ldn, int k0, int col, int lane) {
  const float* q = W + (size_t)(k0 + 8 * (lane >> 5)) * ldn + col + (lane & 31);
  bf16x8 b;
#pragma unroll
  for (int j = 0; j < 8; ++j) b[j] = (short)f2bf(q[(size_t)j * ldn]);
  return b;
}

DI f32x4 rw_u4(const Params& p, const float* mu, int r, int t, int L, int col) {
  const f32x4 m0 = *(const f32x4*)(mu + col), m2 = *(const f32x4*)(mu + RW_COLS + col);
  const bool hp = t >= 1, hn = t + 1 < L;
  const f32x4 c = ld_bf4(p.PR + (size_t)r * RW_COLS + col);
  const f32x4 a = ld_bf4(p.PR + (size_t)(hp ? r - 1 : r) * RW_COLS + col);
  const f32x4 b = ld_bf4(p.PR + (size_t)(hn ? r + 1 : r) * RW_COLS + col);
  const float fp = hp ? 1.f : 0.f, fn = hn ? 1.f : 0.f;
  f32x4 s;
#pragma unroll
  for (int i = 0; i < 4; ++i) s[i] = (1.f - m0[i] - m2[i]) * c[i] + (fp * m0[i]) * a[i] + (fn * m2[i]) * b[i];
  return s;
}
DI bf16x8 ld_bfrag_t(const u16* Wt, int K, int k0, int col, int lane) {
  return *(const bf16x8*)(Wt + (size_t)(col + (lane & 31)) * K + k0 + 8 * (lane >> 5));
}

DI void prep_item(const Params& p, int l, int tile, char* smem) {
  const int tid = TIDX(), lane = tid & 63, wave = tid >> 6;
  constexpr int LA = 72, LG = 136, LX = 68;
  constexpr int XW = 32 * LX + 64;
  u16* Awd = (u16*)smem;
  u16* Aad = Awd + 2 * 32 * LA;
  u16* Agd = Aad + 2 * 32 * LA;
  float* Xall = (float*)(Agd + 32 * LG);
  const float* mu = p.rw_mu + (size_t)l * 2 * RW_COLS;
  const int r0 = tile * 32;
  int b_, t0, L;
  seq_of_row(r0, b_, t0, L);
  SEG_BEGIN(p)
#pragma unroll 2
  for (int i = tid; i < 32 * 96; i += NT) {
    const int tok = i / 96, c4 = (i % 96) * 4;
    f32x4 u = rw_u4(p, mu, r0 + tok, t0 + tok, L, 3 * RW_CH + c4);
    if (c4 < 128) { f32x4 o; for (int j = 0; j < 4; ++j) o[j] = ftanh_(u[j]); st_bf4(Awd + ((c4 >> 6) * 32 + tok) * LA + (c4 & 63), o); }
    else if (c4 < 256) { int c2 = c4 - 128; st_bf4(Aad + ((c2 >> 6) * 32 + tok) * LA + (c2 & 63), u); }
    else { f32x4 o; for (int j = 0; j < 4; ++j) o[j] = fsigmoid_(u[j]); st_bf4(Agd + tok * LG + (c4 - 256), o); }
  }
  __syncthreads();
  SEG_MARK(p, 4)
  const int ts = lane >> 4, cq = lane & 15;
  if (wave < RW_H) {
    const int h = wave;
    float* X = Xall + (size_t)wave * XW;
    float* rinvw = X + 32 * LX;
    float* sbw = rinvw + 32;
    const size_t seqidx0 = (size_t)(b_ * RW_H + h) * L + t0;
    u16* sish = (r0 < TL ? p.SIsh_lat : p.SIsh_ctx);
    u16* sidir = (r0 < TL ? p.SIdir_lat : p.SIdir_ctx);
    const size_t dirstride = (size_t)NB * RW_H * L * 192;
    const int ch = h * 64 + cq * 4;
    const f32x4 kkc = *(const f32x4*)(p.rw_k_k + (size_t)l * RW_CH + ch);
    const f32x4 k_a = *(const f32x4*)(p.rw_k_a + (size_t)l * RW_CH + ch);
    const f32x4 r_k = *(const f32x4*)(p.rw_r_k + (size_t)l * RW_CH + ch);
    auto gemm_to_X = [&](const u16* Atile, int lda_, int arow0, const u16* Wt, int K) {
      f32x16 c0, c1;
#pragma unroll
      for (int r = 0; r < 16; ++r) { c0[r] = 0.f; c1[r] = 0.f; }
#pragma unroll 4
      for (int k0 = 0; k0 < K; k0 += 16) {
        bf16x8 a1 = *(const bf16x8*)(Atile + (arow0 + (lane & 31)) * lda_ + k0 + (lane >> 5) * 8);
        c0 = MFMA32(a1, ld_bfrag_t(Wt, K, k0, h * 64, lane), c0);
        c1 = MFMA32(a1, ld_bfrag_t(Wt, K, k0, h * 64 + 32, lane), c1);
      }
      wave_sync();
#pragma unroll
      for (int r = 0; r < 16; ++r) {
        X[crow(r, lane >> 5) * LX + (lane & 31)] = c0[r];
        X[crow(r, lane >> 5) * LX + 32 + (lane & 31)] = c1[r];
      }
      wave_sync();
    };
    {
      constexpr int mt = 0;
      if (lane < 32) sbw[lane] = 0.f;
      f32x4 rvs[8], kvs[8];
      float ris[8];
#pragma unroll
      for (int it = 0; it < 8; ++it) {
        const int tt = it * 4 + ts, tok = mt * 32 + tt;
        f32x4 rv = rw_u4(p, mu, r0 + tok, t0 + tok, L, ch);
        f32x4 kv = rw_u4(p, mu, r0 + tok, t0 + tok, L, RW_CH + ch);
        f32x4 vv = rw_u4(p, mu, r0 + tok, t0 + tok, L, 2 * RW_CH + ch);
        rvs[it] = rv; kvs[it] = kv;
        f32x4 kr;
        float ss = 0.f;
#pragma unroll
        for (int j = 0; j < 4; ++j) { kr[j] = kv[j] * kkc[j]; ss += kr[j] * kr[j]; }
        const float ri = rsqrtf(fmaxf(red16(ss), 1e-24f));
        ris[it] = ri;
#pragma unroll
        for (int j = 0; j < 4; ++j) kr[j] *= ri;
        u16* dst = sish + (seqidx0 + tok) * 192 + cq * 4;
        st_bf4(dst, rv); st_bf4(dst + 64, kr); st_bf4(dst + 128, vv);
      }
      SEG_MARK(p, 5)
#pragma unroll 1
      for (int d = 0; d < 2; ++d) {
        gemm_to_X(Awd, LA, d * 32 + mt * 32, p.wt_wup + ((size_t)l * 2 + d) * RW_CH * DRK, DRK);
        const f32x4 w0 = *(const f32x4*)(p.rw_w0 + ((size_t)l * 2 + d) * RW_CH + ch);
#pragma unroll 4
        for (int it = 0; it < 8; ++it) {
          const int tt = it * 4 + ts, tok = mt * 32 + tt;
          f32x4 xw = *(const f32x4*)(X + tt * LX + cq * 4);
          u32x2 o;
          u16 hh[4];
#pragma unroll
          for (int j = 0; j < 4; ++j) {
            const float e = 0.60653065971263342f * fsigmoid_(w0[j] + xw[j]);
            hh[j] = f2h(1.0f - fexp_(-e));
          }
          o[0] = (unsigned)hh[0] | ((unsigned)hh[1] << 16); o[1] = (unsigned)hh[2] | ((unsigned)hh[3] << 16);
          *(u32x2*)(sidir + (size_t)d * dirstride + (seqidx0 + tok) * 192 + cq * 4) = o;
        }
        SEG_MARK(p, 6)
        gemm_to_X(Aad, LA, d * 32 + mt * 32, p.wt_aup + ((size_t)l * 2 + d) * RW_CH * IRK, IRK);
        const f32x4 a0 = *(const f32x4*)(p.rw_a0 + ((size_t)l * 2 + d) * RW_CH + ch);
#pragma unroll
        for (int it = 0; it < 8; ++it) {
          const int tt = it * 4 + ts, tok = mt * 32 + tt;
          f32x4 xa = *(const f32x4*)(X + tt * LX + cq * 4);
          const f32x4 rv = rvs[it], kv = kvs[it];
          const float ri = ris[it];
          f32x4 ka, kd;
          float bs = 0.f;
#pragma unroll
          for (int j = 0; j < 4; ++j) {
            float a = fsigmoid_(a0[j] + xa[j]);
            ka[j] = kv[j] * kkc[j] * ri * a;
            kd[j] = kv[j] * (1.f + (a - 1.f) * k_a[j]);
            bs += rv[j] * kd[j] * r_k[j];
          }
          u16* dst = sidir + (size_t)d * dirstride + (seqidx0 + tok) * 192 + cq * 4;
          st_bf4(dst + 64, ka); st_bf4(dst + 128, kd);
          bs = red16(bs);
          if (cq == 0) sbw[tt] += bs;
        }
      }
      SEG_MARK(p, 7)
      wave_sync();
      if (lane < 32) p.sbonus[(size_t)(r0 + mt * 32 + lane) * RW_H + h] = sbw[lane];
      gemm_to_X(Agd, LG, mt * 32, p.wt_gup + (size_t)l * RW_CH * GRK, GRK);
#pragma unroll 4
      for (int it = 0; it < 8; ++it) {
        const int tt = it * 4 + ts, tok = mt * 32 + tt;
        f32x4 xg = *(const f32x4*)(X + tt * LX + cq * 4);
        st_bf4(p.gbuf + (size_t)(r0 + tok) * RW_CH + ch, xg);
      }
      wave_sync();
      SEG_MARK(p, 8)
    }
  }
  __syncthreads();
  SEG_MARK(p, 8)
}

DI void ph_prep(const Params& p, int l, char* smem) {
  for (int item = BIDX(); item < T / 32; item += gridDim.x) prep_item(p, l, item, smem);
}

typedef __attribute__((ext_vector_type(2))) float f32x2;
constexpr int SC_C = 16, SC_NSLOT = 8, SC_NCONS = 2, SC_NPROD = 6;
constexpr int SC_LDP = 72;
constexpr int SC_LDQ = 40;
constexpr int SC_AT = 0, SC_RT = SC_AT + 16 * SC_LDP * 2, SC_KT = SC_RT + 16 * SC_LDP * 2, SC_PQ = SC_KT + 64 * SC_LDQ * 2,
              SC_BM = SC_PQ + 16 * SC_LDQ * 2, SC_TM = SC_BM + 16 * SC_LDQ * 2, SC_VT = SC_TM + 16 * SC_LDQ * 2, SC_CUM = SC_VT + 64 * 16 * 2,
              SC_SLOT = SC_CUM + 64 * 4;
constexpr int SC_PSCR = SC_NSLOT * SC_SLOT;
constexpr int SC_PSCR_W = 2 * 16 * SC_LDP * 2;
constexpr int SC_FLAGS = SC_PSCR + SC_NPROD * SC_PSCR_W;
static_assert(SC_FLAGS + 64 * 4 < SMEM_BYTES - 1024, "scan LDS");
static_assert(SC_SLOT % 16 == 0 && SC_PSCR_W % 16 == 0, "scan LDS alignment");

DI void sc_wait_eq(volatile int* f, int want) {
#ifdef EMU
  while (*f != want) emu_yield();
#else
  while (__builtin_amdgcn_readfirstlane(*f) != want) __builtin_amdgcn_s_sleep(1);
  asm volatile("s_waitcnt lgkmcnt(0)" ::: "memory");
#endif
}
DI void sc_wait_ge(volatile int* f, int want) {
#ifdef EMU
  while (*f < want) emu_yield();
#else
  while (__builtin_amdgcn_readfirstlane(*f) < want) __builtin_amdgcn_s_sleep(1);
  asm volatile("s_waitcnt lgkmcnt(0)" ::: "memory");
#endif
}
DI float rdlane_f(float v, int l) { return __builtin_bit_cast(float, __builtin_amdgcn_readlane(__builtin_bit_cast(int, v), l)); }
#define MFMA16(a, b, c) __builtin_amdgcn_mfma_f32_16x16x32_bf16((a), (b), (c), 0, 0, 0)

DI void sc_step_time(int d, int s, bool& isctx, int& t) {
  isctx = s < CTXL;
  if (isctx) t = d == 0 ? s : CTXL - 1 - s;
  else { const int u = s - CTXL; t = d == 0 ? u : SEQ - 1 - u; }
}

DI void scan_chain_item(const Params& p, int item, char* smem) {
  const int tid = TIDX(), lane = tid & 63, wave = tid >> 6;
  const int chain = item >> 1, hf = item & 1;
  const int h = chain % RW_H, b = (chain / RW_H) % NB, d = chain / (RW_H * NB);
  constexpr int NCHUNK = (CTXL + SEQ) / SC_C;
  volatile int* ready = (volatile int*)(smem + SC_FLAGS);
  volatile int* done = ready + SC_NSLOT;
  if (tid < 2 * SC_NSLOT) ready[tid] = 0;
  __syncthreads();
  const int q4 = lane >> 4, c16 = lane & 15;
  if (wave >= SC_NCONS) {
    const int pw = wave - SC_NCONS;
    u16* Bt = (u16*)(smem + SC_PSCR + pw * SC_PSCR_W);
    u16* Kt = Bt + 16 * SC_LDP;
    const int k = lane;
    u16 raw[SC_C][6];
    auto load_chunk = [&](int c) {
#pragma unroll
      for (int j = 0; j < SC_C; ++j) {
        bool isctx; int t;
        sc_step_time(d, c * SC_C + j, isctx, t);
        const int L = isctx ? CTXL : SEQ;
        const size_t base = ((size_t)(b * RW_H + h) * L + t) * 192;
        const u16* sh = (isctx ? p.SIsh_ctx : p.SIsh_lat) + base;
        const u16* dr = (isctx ? p.SIdir_ctx : p.SIdir_lat) + (size_t)d * NB * RW_H * L * 192 + base;
        raw[j][0] = sh[k]; raw[j][1] = sh[64 + k]; raw[j][2] = sh[128 + k];
        raw[j][3] = dr[k]; raw[j][4] = dr[64 + k]; raw[j][5] = dr[128 + k];
      }
    };
    if (pw < NCHUNK) load_chunk(pw);
    for (int c = pw; c < NCHUNK; c += SC_NPROD) {
      const int slot = c % SC_NSLOT;
      char* sl = smem + slot * SC_SLOT;
      u16* At = (u16*)(sl + SC_AT); u16* Rt = (u16*)(sl + SC_RT); u16* KT = (u16*)(sl + SC_KT);
      u16* PQ = (u16*)(sl + SC_PQ); u16* BM = (u16*)(sl + SC_BM); u16* TM = (u16*)(sl + SC_TM);
      u16* VT = (u16*)(sl + SC_VT); float* CUM = (float*)(sl + SC_CUM);
      sc_wait_ge(done + slot, SC_NCONS * (c / SC_NSLOT));
      float cum = 1.f;
      u16 ktv[16], btv[16], vtv[16];
#pragma unroll
      for (int j = 0; j < SC_C; ++j) {
        const float rr = bf2f(raw[j][0]), kk = bf2f(raw[j][1]);
        vtv[j] = raw[j][2];
        const float w = 1.f - h2f(raw[j][3]), ka = bf2f(raw[j][4]), kd = bf2f(raw[j][5]);
        const float at = cum * kk;
        cum *= w;
        const float ic = 1.f / cum;
        At[j * SC_LDP + k] = f2bf(at);
        Rt[j * SC_LDP + k] = f2bf(cum * rr);
        btv[j] = f2bf(ka * ic); ktv[j] = f2bf(kd * ic);
        Bt[j * SC_LDP + k] = btv[j];
        Kt[j * SC_LDP + k] = ktv[j];
      }
      if (c + SC_NPROD < NCHUNK) load_chunk(c + SC_NPROD);
      CUM[k] = cum;
      {
        u32x4 o;
#pragma unroll
        for (int hh = 0; hh < 2; ++hh) {
          o[0] = ktv[8 * hh + 0] | ((unsigned)ktv[8 * hh + 1] << 16); o[1] = ktv[8 * hh + 2] | ((unsigned)ktv[8 * hh + 3] << 16);
          o[2] = ktv[8 * hh + 4] | ((unsigned)ktv[8 * hh + 5] << 16); o[3] = ktv[8 * hh + 6] | ((unsigned)ktv[8 * hh + 7] << 16);
          *(u32x4*)(KT + k * SC_LDQ + 8 * hh) = o;
          o[0] = btv[8 * hh + 0] | ((unsigned)btv[8 * hh + 1] << 16); o[1] = btv[8 * hh + 2] | ((unsigned)btv[8 * hh + 3] << 16);
          o[2] = btv[8 * hh + 4] | ((unsigned)btv[8 * hh + 5] << 16); o[3] = btv[8 * hh + 6] | ((unsigned)btv[8 * hh + 7] << 16);
          *(u32x4*)(KT + k * SC_LDQ + 16 + 8 * hh) = o;
          o[0] = vtv[8 * hh + 0] | ((unsigned)vtv[8 * hh + 1] << 16); o[1] = vtv[8 * hh + 2] | ((unsigned)vtv[8 * hh + 3] << 16);
          o[2] = vtv[8 * hh + 4] | ((unsigned)vtv[8 * hh + 5] << 16); o[3] = vtv[8 * hh + 6] | ((unsigned)vtv[8 * hh + 7] << 16);
          *(u32x4*)(VT + k * 16 + 8 * hh) = o;
        }
      }
      wave_sync();
      f32x4 am = {0.f, 0.f, 0.f, 0.f}, bm = am, pm = am, qm = am;
#pragma unroll
      for (int ks = 0; ks < 2; ++ks) {
        const int o = c16 * SC_LDP + 32 * ks + 8 * q4;
        const bf16x8 fa = *(const bf16x8*)(At + o), fr = *(const bf16x8*)(Rt + o);
        const bf16x8 fb = *(const bf16x8*)(Bt + o), fk = *(const bf16x8*)(Kt + o);
        am = MFMA16(fa, fb, am); bm = MFMA16(fa, fk, bm); pm = MFMA16(fr, fk, pm); qm = MFMA16(fr, fb, qm);
      }
#pragma unroll
      for (int r = 0; r < 4; ++r) {
        const int j = 4 * q4 + r;
        BM[j * SC_LDQ + c16] = c16 < j ? f2bf(bm[r]) : (u16)0;
        BM[j * SC_LDQ + 16 + c16] = 0;
        PQ[j * SC_LDQ + c16] = c16 <= j ? f2bf(pm[r]) : (u16)0;
        PQ[j * SC_LDQ + 16 + c16] = c16 <= j ? f2bf(-qm[r]) : (u16)0;
      }
      float Tc[16];
#pragma unroll
      for (int j = 0; j < 16; ++j) {
        float tv = (j == c16) ? 1.f : 0.f;
#pragma unroll
        for (int i = 0; i < j; ++i) tv -= rdlane_f(am[j & 3], i + 16 * (j >> 2)) * Tc[i];
        Tc[j] = tv;
      }
#pragma unroll
      for (int j = 0; j < 16; ++j) {
        if (q4 == 0) TM[j * SC_LDQ + c16] = f2bf(Tc[j]);
        if (q4 == 1) TM[j * SC_LDQ + 16 + c16] = 0;
      }
      wave_sync();
      if (lane == 0) ready[slot] = c + 1;
    }
  } else {
    const int vt = SC_NCONS * hf + wave;
#ifndef EMU
    __builtin_amdgcn_s_setprio(3);
#endif
    f32x4 ST[4];
#pragma unroll
    for (int mt = 0; mt < 4; ++mt) ST[mt] = (f32x4){0.f, 0.f, 0.f, 0.f};
    auto ld2 = [&](const u16* q0, const u16* q1) {
      const u32x2 a = *(const u32x2*)q0, b2 = *(const u32x2*)q1;
      u32x4 o; o[0] = a[0]; o[1] = a[1]; o[2] = b2[0]; o[3] = b2[1];
      return __builtin_bit_cast(bf16x8, o);
    };
    auto ld1z = [&](const u16* q0) {
      const u32x2 a = *(const u32x2*)q0;
      u32x4 o; o[0] = a[0]; o[1] = a[1]; o[2] = 0u; o[3] = 0u;
      return __builtin_bit_cast(bf16x8, o);
    };
    for (int c = 0; c < NCHUNK; ++c) {
      const int slot = c % SC_NSLOT;
      const char* sl = smem + slot * SC_SLOT;
      const u16* At = (const u16*)(sl + SC_AT); const u16* Rt = (const u16*)(sl + SC_RT); const u16* KT = (const u16*)(sl + SC_KT);
      const u16* PQ = (const u16*)(sl + SC_PQ); const u16* BM = (const u16*)(sl + SC_BM); const u16* TM = (const u16*)(sl + SC_TM);
      const u16* VT = (const u16*)(sl + SC_VT); const float* CUM = (const float*)(sl + SC_CUM);
      bf16x8 shi[2], slo[2];
#pragma unroll
      for (int ks = 0; ks < 2; ++ks) {
        u32x4 oh, ol;
#pragma unroll
        for (int hh = 0; hh < 2; ++hh) {
          const f32x4 x = ST[2 * ks + hh];
          float h0 = bf2f(f2bf(x[0])), h1 = bf2f(f2bf(x[1])), h2 = bf2f(f2bf(x[2])), h3 = bf2f(f2bf(x[3]));
          oh[2 * hh] = pk2(x[0], x[1]); oh[2 * hh + 1] = pk2(x[2], x[3]);
          ol[2 * hh] = pk2(x[0] - h0, x[1] - h1); ol[2 * hh + 1] = pk2(x[2] - h2, x[3] - h3);
        }
        shi[ks] = __builtin_bit_cast(bf16x8, oh); slo[ks] = __builtin_bit_cast(bf16x8, ol);
      }
      sc_wait_eq(ready + slot, c + 1);
      f32x4 rhs = {0.f, 0.f, 0.f, 0.f}, y = rhs;
#pragma unroll
      for (int ks = 0; ks < 2; ++ks) {
        const int o = c16 * SC_LDP + 32 * ks + 4 * q4;
        const bf16x8 fa = ld2(At + o, At + o + 16), fr = ld2(Rt + o, Rt + o + 16);
        rhs = MFMA16(fa, shi[ks], rhs); y = MFMA16(fr, shi[ks], y);
        rhs = MFMA16(fa, slo[ks], rhs); y = MFMA16(fr, slo[ks], y);
      }
      const u32x2 vraw = *(const u32x2*)(VT + (16 * vt + c16) * 16 + 4 * q4);
      {
        u32x4 o; o[0] = vraw[0]; o[1] = vraw[1]; o[2] = 0u; o[3] = 0u;
        rhs = MFMA16(ld1z(BM + c16 * SC_LDQ + 4 * q4), __builtin_bit_cast(bf16x8, o), rhs);
      }
      f32x4 z = {0.f, 0.f, 0.f, 0.f};
      {
        u32x4 o; o[0] = pk2(rhs[0], rhs[1]); o[1] = pk2(rhs[2], rhs[3]); o[2] = 0u; o[3] = 0u;
        z = MFMA16(ld1z(TM + c16 * SC_LDQ + 4 * q4), __builtin_bit_cast(bf16x8, o), z);
      }
      const unsigned z01 = pk2(z[0], z[1]), z23 = pk2(z[2], z[3]);
      {
        u32x4 o; o[0] = vraw[0]; o[1] = vraw[1]; o[2] = z01; o[3] = z23;
        y = MFMA16(ld2(PQ + c16 * SC_LDQ + 4 * q4, PQ + c16 * SC_LDQ + 16 + 4 * q4), __builtin_bit_cast(bf16x8, o), y);
      }
#pragma unroll
      for (int r = 0; r < 4; ++r) {
        bool isctx; int t;
        sc_step_time(d, c * SC_C + 4 * q4 + r, isctx, t);
        const int rrow = isctx ? TL + b * CTXL + t : b * SEQ + t;
        p.ybuf[((size_t)d * T + rrow) * RW_CH + h * 64 + 16 * vt + c16] = f2bf(y[r]);
      }
      {
        u32x4 o; o[0] = vraw[0]; o[1] = vraw[1]; o[2] = z01 ^ 0x80008000u; o[3] = z23 ^ 0x80008000u;
        const bf16x8 bS = __builtin_bit_cast(bf16x8, o);
#pragma unroll
        for (int mt = 0; mt < 4; ++mt) {
          const u16* kr = KT + (16 * mt + c16) * SC_LDQ + 4 * q4;
          ST[mt] = MFMA16(ld2(kr, kr + 16), bS, ST[mt]);
          const f32x4 cm = *(const f32x4*)(CUM + 16 * mt + 4 * q4);
#pragma unroll
          for (int r = 0; r < 4; ++r) ST[mt][r] *= cm[r];
        }
      }
      wave_sync();
      if (lane == 0) atomicAdd((int*)done + slot, 1);
    }
#ifndef EMU
    __builtin_amdgcn_s_setprio(0);
#endif
  }
  __syncthreads();
}
DI void ph_scan(const Params& p, char* smem) {
  for (int item = BIDX(); item < 2 * (2 * NB * RW_H); item += gridDim.x) scan_chain_item(p, item, smem);
}

DI void ph_assemble(const Params& p, int l, char* smem) {
  const int tid = TIDX(), lane = tid & 63, wave = tid >> 6;
  const int ts = lane >> 4, cq = lane & 15;
  const int rows = (l == 0) ? T : TL;
  constexpr int LY = 66;
  u16* yt = (u16*)smem;
  const float* gn = p.mix_norm_g + (size_t)l * (CONV_CH + HY_CH);
  for (int tile = BIDX(); tile < rows / 64; tile += gridDim.x) {
    const int r0 = tile * 64;
    int b_, t0, L;
    seq_of_row(r0, b_, t0, L);
    const u16* yh = (r0 < TL ? p.yhlat : p.yhctx) + (size_t)b_ * HY_CH * L + t0;
    for (int i = tid; i < HY_CH * 8; i += NT) {
      int c = i >> 3, part = i & 7;
      const u32x4 v = *(const u32x4*)(yh + (size_t)c * L + part * 8);
      unsigned* q = (unsigned*)(yt + c * LY + part * 8);
      q[0] = v[0]; q[1] = v[1]; q[2] = v[2]; q[3] = v[3];
    }
    __syncthreads();
    const u16* sish = (r0 < TL ? p.SIsh_lat : p.SIsh_ctx);
#pragma unroll
    for (int it = 0; it < 2; ++it) {
      const int tok = wave * 8 + it * 4 + ts;
      const int r = r0 + tok;
      u16* dst = p.ycat + (size_t)r * MIX_W;
#pragma unroll
      for (int bk = 0; bk < CONV_CH / 64; ++bk)
        *(u32x2*)(dst + bk * 64 + cq * 4) = *(const u32x2*)(p.ya + (size_t)r * CONV_CH + bk * 64 + cq * 4);
      float hv[HY_CH / 64][4];
      float ss = 0.f;
#pragma unroll
      for (int bk = 0; bk < HY_CH / 64; ++bk)
#pragma unroll
        for (int j = 0; j < 4; ++j) { hv[bk][j] = bf2f(yt[(bk * 64 + cq * 4 + j) * LY + tok]); ss += hv[bk][j] * hv[bk][j]; }
      ss = red16(ss);
      const float rs = rsqrtf(ss / (float)HY_CH + LN_EPS);
#pragma unroll
      for (int bk = 0; bk < HY_CH / 64; ++bk) {
        const f32x4 g4 = *(const f32x4*)(gn + CONV_CH + bk * 64 + cq * 4);
        f32x4 o;
#pragma unroll
        for (int j = 0; j < 4; ++j) o[j] = hv[bk][j] * rs * g4[j];
        st_bf4(dst + CONV_CH + bk * 64 + cq * 4, o);
      }
#pragma unroll
      for (int h = 0; h < RW_H; ++h) {
        const int ch = h * 64 + cq * 4;
        const f32x4 yf = ld_bf4(p.ybuf + (size_t)r * RW_CH + ch), yb = ld_bf4(p.ybuf + ((size_t)T + r) * RW_CH + ch);
        const f32x4 vv = ld_bf4(sish + ((size_t)(b_ * RW_H + h) * L + t0 + tok) * 192 + 128 + cq * 4);
        const f32x4 gg = ld_bf4(p.gbuf + (size_t)r * RW_CH + ch);
        const f32x4 lg4 = *(const f32x4*)(p.rw_lnx_g + (size_t)l * RW_CH + ch), lb4 = *(const f32x4*)(p.rw_lnx_b + (size_t)l * RW_CH + ch);
        const float sb = p.sbonus[(size_t)r * RW_H + h];
        f32x4 yv;
        float sm = 0.f;
#pragma unroll
        for (int j = 0; j < 4; ++j) { yv[j] = yf[j] + yb[j]; sm += yv[j]; }
        const float mu = red16(sm) * (1.f / 64.f);
        float sq = 0.f;
#pragma unroll
        for (int j = 0; j < 4; ++j) { yv[j] -= mu; sq += yv[j] * yv[j]; }
        const float rstd = rsqrtf(red16(sq) * (1.f / 64.f) + RW_GN_EPS);
        f32x4 o;
#pragma unroll
        for (int j = 0; j < 4; ++j) o[j] = (yv[j] * rstd * lg4[j] + lb4[j] + sb * vv[j]) * gg[j];
        st_bf4(dst + CONV_CH + HY_CH + ch, o);
      }
    }
    __syncthreads();
  }
}

DI void ph_outproj(const Params& p, int l, char* smem) {
  const int rows = (l == 0) ? T : TL;
  const int G = gridDim.x, c = BIDX();
  {
    DenseSched S; S.init(p.ycat, p.wt_out + (size_t)l * D * MIX_W, MIX_W, rows, D, G, c);
    EpiOutproj E{&p, l};
    pg8::gemm_phase(smem, MIX_W, S, E);
  }
  __syncthreads();
  ticket_loop(p.bar + XB_TICKET + 1 + DEPTH + l, CT_EXP_L, smem, [&](int it) { convert_expert_item(p, l, it, smem); });
}

DI void ph_ln_router(const Params& p, int l, char* smem) {
  const int tid = TIDX(), lane = tid & 63, wave = tid >> 6;
  const int rows = (l == 0) ? T : TL;
  constexpr int LH = D + 8;
  constexpr int EPL = D / 64;
  u16* Hhi = (u16*)smem;
  u16* Hlo = Hhi + 32 * LH;
  float* red = (float*)smem;
  constexpr int LGS_OFF = (2 * 32 * LH * 2 > 8 * 32 * 64 * 4) ? 2 * 32 * LH * 2 : 8 * 32 * 64 * 4;
  float* lgs = (float*)(smem + LGS_OFF);
  const float* lg = p.ln_g + ((size_t)l * 2 + 0) * D;
  const float* lb = p.ln_b + ((size_t)l * 2 + 0) * D;
  const u16* Whi = p.wt_rhi + (size_t)l * NE * D;
  const u16* Wlo = p.wt_rlo + (size_t)l * NE * D;
  constexpr int KS = D / 8;
  SEG_BEGIN(p)
  for (int tile = BIDX(); tile < rows / 32; tile += gridDim.x) {
    const int r0 = tile * 32;
#pragma unroll 4
    for (int tt = 0; tt < 4; ++tt) {
      const int tok = wave * 4 + tt;
      const int r = r0 + tok;
      float* xr = x1row(p, r);
      const float* m = modp(p, l, r);
      constexpr int NV = D / 256;
      f32x4 xv[NV];
      float s = 0.f;
#pragma unroll
      for (int i = 0; i < NV; ++i) { xv[i] = *(const f32x4*)(xr + 4 * lane + 256 * i); s += (xv[i][0] + xv[i][1]) + (xv[i][2] + xv[i][3]); }
      const float mu = wave_sum(s) * (1.f / (float)D);
      float s2 = 0.f;
#pragma unroll
      for (int i = 0; i < NV; ++i)
#pragma unroll
        for (int j = 0; j < 4; ++j) { float dd = xv[i][j] - mu; s2 += dd * dd; }
      const float rstd = rsqrtf(wave_sum(s2) * (1.f / (float)D) + LN_EPS);
#pragma unroll
      for (int i = 0; i < NV; ++i) {
        const int e = 4 * lane + 256 * i;
        const f32x4 g4 = *(const f32x4*)(lg + e), b4 = *(const f32x4*)(lb + e);
        const f32x4 sc = *(const f32x4*)(m + 4 * D + e), sh = *(const f32x4*)(m + 3 * D + e);
        f32x4 xn, hh, lo;
#pragma unroll
        for (int j = 0; j < 4; ++j) { xn[j] = (xv[i][j] - mu) * rstd * g4[j] + b4[j]; hh[j] = xn[j] * (1.f + sc[j]) + sh[j]; }
        *(f32x4*)(xr + e) = xn;
        u32x2 hp; hp[0] = pk2(hh[0], hh[1]); hp[1] = pk2(hh[2], hh[3]);
#pragma unroll
        for (int j = 0; j < 4; ++j) lo[j] = hh[j] - bf2f((u16)((j & 1) ? (hp[j >> 1] >> 16) : (hp[j >> 1] & 0xffff)));
        *(u32x2*)(Hhi + tok * LH + e) = hp;
        st_bf4(Hlo + tok * LH + e, lo);
        *(u32x2*)(p.HL + (size_t)r * D + e) = hp;
        u32x2 zz; zz[0] = 0u; zz[1] = 0u;
        *(u32x2*)(p.acc + (size_t)r * (D / 2) + e / 2) = zz;
      }
    }
    __syncthreads();
    SEG_MARK(p, 0)
    f32x16 c0, c1;
#pragma unroll
    for (int r = 0; r < 16; ++r) { c0[r] = 0.f; c1[r] = 0.f; }
#pragma unroll 4
    for (int k0 = wave * KS; k0 < (wave + 1) * KS; k0 += 16) {
      const int ko = k0 + (lane >> 5) * 8;
      bf16x8 ah = *(const bf16x8*)(Hhi + (lane & 31) * LH + ko);
      bf16x8 al = *(const bf16x8*)(Hlo + (lane & 31) * LH + ko);
      bf16x8 bh0 = *(const bf16x8*)(Whi + (size_t)(lane & 31) * D + ko);
      bf16x8 bh1 = *(const bf16x8*)(Whi + (size_t)(32 + (lane & 31)) * D + ko);
      bf16x8 bl0 = *(const bf16x8*)(Wlo + (size_t)(lane & 31) * D + ko);
      bf16x8 bl1 = *(const bf16x8*)(Wlo + (size_t)(32 + (lane & 31)) * D + ko);
      c0 = MFMA32(ah, bh0, c0); c0 = MFMA32(ah, bl0, c0); c0 = MFMA32(al, bh0, c0);
      c1 = MFMA32(ah, bh1, c1); c1 = MFMA32(ah, bl1, c1); c1 = MFMA32(al, bh1, c1);
    }
    __syncthreads();
    SEG_MARK(p, 1)
#pragma unroll
    for (int r = 0; r < 16; ++r) {
      red[(wave * 32 + crow(r, lane >> 5)) * 64 + (lane & 31)] = c0[r];
      red[(wave * 32 + crow(r, lane >> 5)) * 64 + 32 + (lane & 31)] = c1[r];
    }
    __syncthreads();
    for (int i = tid; i < 32 * 64; i += NT) {
      float sacc = 0.f;
#pragma unroll
      for (int w = 0; w < 8; ++w) sacc += red[w * 2048 + i];
      lgs[i] = sacc;
    }
    __syncthreads();
    SEG_MARK(p, 2)
    unsigned long long* selm = (unsigned long long*)(lgs + 32 * 64);
    unsigned char* lpos = (unsigned char*)(selm + 32);
    int* tbase = (int*)(lpos + 32 * 64);
    const float eb = p.e_bias[(size_t)l * NE + lane];
    float gate4[4];
    bool ch4[4];
    {
      float score4[4], selv4[4];
#pragma unroll
      for (int tt = 0; tt < 4; ++tt) { score4[tt] = fsigmoid_(lgs[(wave * 4 + tt) * 64 + lane]); selv4[tt] = score4[tt] + eb; ch4[tt] = false; }
      for (int round = 0; round < TOPK; ++round) {
#pragma unroll
        for (int tt = 0; tt < 4; ++tt) {
          const float cand = ch4[tt] ? -1e30f : selv4[tt];
          const float mx = wave_max(cand);
          const unsigned long long bal = __ballot(cand == mx);
          const int win = __ffsll((long long)bal) - 1;
          if (lane == win) ch4[tt] = true;
        }
      }
#pragma unroll
      for (int tt = 0; tt < 4; ++tt) {
        const float ssum = wave_sum(ch4[tt] ? score4[tt] : 0.f);
        gate4[tt] = ROUTED_SCALE * score4[tt] / ssum;
        const unsigned long long m = __ballot(ch4[tt]);
        if (lane == 0) selm[wave * 4 + tt] = m;
      }
    }
    __syncthreads();
    if (wave == 0) {
      int c = 0;
      for (int t = 0; t < 32; ++t) {
        const int bit = (int)((selm[t] >> lane) & 1ull);
        lpos[t * 64 + lane] = (unsigned char)c;
        c += bit;
      }
      int base = 0;
      if (c > 0) base = atomicAdd(p.cnt + l * NE + lane, c);
      tbase[lane] = base;
    }
    __syncthreads();
#pragma unroll
    for (int tt = 0; tt < 4; ++tt) {
      const int tok = wave * 4 + tt;
      if (ch4[tt]) {
        const int pos = tbase[lane] + (int)lpos[tok * 64 + lane];
        p.etok[(size_t)lane * T + pos] = r0 + tok;
        p.egate[(size_t)lane * T + pos] = gate4[tt];
      }
    }
    __syncthreads();
    SEG_MARK(p, 3)
  }
}

constexpr int EXP_LDS_OFF = 128 * 1024;
constexpr int MAX_ROW_TILES = (T * TOPK) / 256 + NE + T / 256;
static_assert(28 * 1024 + (2 * (NE + 2) + (NE + 2)) * 4 + MAX_ROW_TILES + EXP_LDS_OFF <= SMEM_BYTES - 1024, "expert tables fit below the parked parameters");
static_assert(NE == 64, "binary search step");
struct ExpTables { int* pre; int* hoff; int* cntl; unsigned char* t2e; };
DI ExpTables expert_tables(const Params& p, int l, int rows, char* smem) {
  ExpTables x;
  x.pre = (int*)(smem + EXP_LDS_OFF + 28 * 1024);
  x.hoff = x.pre + (NE + 2);
  x.cntl = x.hoff + (NE + 2);
  x.t2e = (unsigned char*)(x.cntl + (NE + 2));
  const int tid = TIDX();
  if (tid == 0) {
    int s = 0, ho = 0;
    for (int e = 0; e < NE; ++e) { const int ce = p.cnt[l * NE + e]; const int nt = (ce + 255) / 256; x.pre[e] = s; x.hoff[e] = ho; x.cntl[e] = ce; s += nt; ho += nt * 256; }
    x.pre[NE] = s; x.hoff[NE] = ho; x.cntl[NE] = rows; s += rows / 256; x.pre[NE + 1] = s;
  }
  __syncthreads();
  {
    const int R = x.pre[NE + 1];
    for (int t = tid; t < R; t += NT) {
      int e = 0;
#pragma unroll
      for (int step = 64; step >= 1; step >>= 1) { const int c = e + step; if (c <= NE && x.pre[c] <= t) e = c; }
      x.t2e[t] = (unsigned char)e;
    }
  }
  __syncthreads();
  return x;
}
DI void ph_e1(const Params& p, int l, char* smem) {
  const int rows = (l == 0) ? T : TL;
  const ExpTables x = expert_tables(p, l, rows, smem);
  E1Sched S;
  S.pre = x.pre; S.cntl = x.cntl; S.t2e = x.t2e; S.nN = FF / 128; S.G = gridDim.x; S.c = BIDX(); S.total = x.pre[NE + 1] * S.nN;
  S.A = (const char*)p.HL; S.W = (const char*)p.wt_exp; S.etok = p.etok;
  S.preload((unsigned*)(smem + EXP_LDS_OFF), 24);
  EpiE1 E{p.Hbuf, x.hoff};
  pg8::gemm_phase(smem, D, S, E);
  __syncthreads();
}
DI void ph_e2(const Params& p, int l, char* smem) {
  const int rows = (l == 0) ? T : TL;
  const ExpTables x = expert_tables(p, l, rows, smem);
  E2Sched S;
  S.pre = x.pre; S.cntl = x.cntl; S.t2e = x.t2e; S.nN = D / 256; S.G = gridDim.x; S.c = BIDX(); S.total = x.pre[NE + 1] * S.nN;
  S.A = (const char*)p.Hbuf; S.W = (const char*)p.wt_exp; S.hoff = x.hoff;
  EpiE2 E{p.acc, p.etok, p.egate, (float*)(smem + EXP_LDS_OFF), p.SHo};
  pg8::gemm_phase(smem, FF, S, E);
  __syncthreads();
}

DI void ph_combine(const Params& p, int l) {
  const int tid = TIDX(), lane = tid & 63, wave = tid >> 6;
  const int rows = (l == 0) ? T : TL;
  constexpr int NV = D / 256;
  constexpr int RPW = 2;
  const float* lg = p.ln_g + ((size_t)l * 2 + 1) * D;
  const float* lb = p.ln_b + ((size_t)l * 2 + 1) * D;
  for (int tile = BIDX(); tile < rows / (8 * RPW); tile += gridDim.x) {
    f32x4 xv[RPW][NV];
    float s[RPW];
#pragma unroll
    for (int u = 0; u < RPW; ++u) {
      const int r = tile * (8 * RPW) + u * 8 + wave;
      const float* x1 = x1row(p, r);
      const float* m = modp(p, l, r);
      s[u] = 0.f;
#pragma unroll
      for (int i = 0; i < NV; ++i) {
        const int e = 4 * lane + 256 * i;
        const u32x2 aw = *(const u32x2*)(p.acc + (size_t)r * (D / 2) + e / 2);
        float m0, m1, m2, m3;
        acc_unpack4(aw[0], aw[1], m0, m1, m2, m3);
        const f32x4 xx = *(const f32x4*)(x1 + e), gg = *(const f32x4*)(m + 5 * D + e);
        const f32x4 sh4 = ld_bf4(p.SHo + (size_t)r * D + e);
        xv[u][i][0] = DN_ALPHA * xx[0] + gg[0] * (m0 + sh4[0]); xv[u][i][1] = DN_ALPHA * xx[1] + gg[1] * (m1 + sh4[1]);
        xv[u][i][2] = DN_ALPHA * xx[2] + gg[2] * (m2 + sh4[2]); xv[u][i][3] = DN_ALPHA * xx[3] + gg[3] * (m3 + sh4[3]);
        s[u] += (xv[u][i][0] + xv[u][i][1]) + (xv[u][i][2] + xv[u][i][3]);
      }
    }
#pragma unroll
    for (int u = 0; u < RPW; ++u) {
      const int r = tile * (8 * RPW) + u * 8 + wave;
      float* x1 = x1row(p, r);
      const float* m = modp(p, l, r);
      const float mu = wave_sum(s[u]) * (1.f / (float)D);
      float s2 = 0.f;
#pragma unroll
      for (int i = 0; i < NV; ++i)
#pragma unroll
        for (int j = 0; j < 4; ++j) { float dd = xv[u][i][j] - mu; s2 += dd * dd; }
      const float rstd = rsqrtf(wave_sum(s2) * (1.f / (float)D) + LN_EPS);
      const float* m1 = (l + 1 < DEPTH) ? modp(p, l + 1, r) : m;
#pragma unroll
      for (int i = 0; i < NV; ++i) {
        const int e = 4 * lane + 256 * i;
        const f32x4 g4 = *(const f32x4*)(lg + e), b4 = *(const f32x4*)(lb + e);
        f32x4 xn;
#pragma unroll
        for (int j = 0; j < 4; ++j) xn[j] = (xv[u][i][j] - mu) * rstd * g4[j] + b4[j];
        if (r < TL) *(f32x4*)(x1 + e) = xn;
        if (l + 1 < DEPTH) {
          const f32x4 sc = *(const f32x4*)(m1 + D + e), sh = *(const f32x4*)(m1 + e);
          f32x4 o;
#pragma unroll
          for (int j = 0; j < 4; ++j) o[j] = xn[j] * (1.f + sc[j]) + sh[j];
          st_bf4(p.HL + (size_t)r * D + e, o);
        }
      }
    }
  }
}

constexpr int PH_PER_LAYER = 10;
constexpr int NPHASES = 2 + PH_PER_LAYER * DEPTH;
DI void run_phase(const Params& p, int ph, char* smem) {
  if (ph == 0) { ph_prologue(p, smem); return; }
  if (ph == 1) { ph_premod(p); return; }
  const int l = (ph - 2) / PH_PER_LAYER, q = (ph - 2) % PH_PER_LAYER;
  switch (q) {
    case 0: ph_inproj(p, l, smem); break;
    case 1: ph_mix(p, l, smem); break;
    case 2: ph_prep(p, l, smem); break;
    case 3: ph_scan(p, smem); break;
    case 4: ph_assemble(p, l, smem); break;
    case 5: ph_outproj(p, l, smem); break;
    case 6: ph_ln_router(p, l, smem); break;
    case 7: ph_e1(p, l, smem); break;
    case 8: ph_e2(p, l, smem); break;
    case 9: ph_combine(p, l); break;
  }
}

static inline size_t al256(size_t x) { return (x + 255) & ~(size_t)255; }
static inline size_t max2(size_t a, size_t b) { return a > b ? a : b; }
static Params make_params(void* const* d_in, void* d_out, void* d_ws, size_t* used) {
  Params p{};
  const float** f = (const float**)&p;
  for (int i = 0; i < 42; ++i) f[i] = (const float*)d_in[i];
  p.out = (float*)d_out;
  char* w = (char*)d_ws;
  size_t o = 0;
  auto take = [&](size_t bytes) { char* r = w + o; o = al256(o + bytes); return r; };
  p.HL = (u16*)take((size_t)T * D * 2);
  p.mod = (float*)take((size_t)DEPTH * (NB + 1) * 6 * D * 4);
  p.h3lat = (float*)take((size_t)DEPTH * SEQ * 64 * 4);
  p.h3ctx = (float*)take((size_t)DEPTH * CTXL * 64 * 4);
  p.tw = (cf*)take((size_t)(FFTN / 2) * 8);
  p.tstamp = (long long*)take(64 * 8);
  p.bar = (unsigned*)take((size_t)XCD_BAR_WORDS * 4);
  p.cnt = (int*)take((size_t)DEPTH * NE * 4);
  p.sbonus = (float*)take((size_t)T * RW_H * 4);
  p.XC = (float*)take((size_t)TC * D * 4);
  p.wt_in = (u16*)take((size_t)DEPTH * P_IN_PAD * D * 2);
  p.wt_out = (u16*)take((size_t)DEPTH * D * MIX_W * 2);
  p.wt_rhi = (u16*)take((size_t)DEPTH * NE * D * 2);
  p.wt_rlo = (u16*)take((size_t)DEPTH * NE * D * 2);
  p.wt_wup = (u16*)take((size_t)DEPTH * 2 * RW_CH * DRK * 2);
  p.wt_aup = (u16*)take((size_t)DEPTH * 2 * RW_CH * IRK * 2);
  p.wt_gup = (u16*)take((size_t)DEPTH * RW_CH * GRK * 2);
  const size_t szEt = al256((size_t)NE * T * 4);
  char* G = take(max2(max2((size_t)T * RW_CH * 2, (size_t)2 * HY_CH * FFTN * 8), 2 * szEt));
  p.spec = (cf*)G;
  p.gbuf = (u16*)G;
  p.etok = (int*)G;
  p.egate = (float*)(G + szEt);
  const size_t szPAPH = (size_t)T * PA_W * 2 + (size_t)T * PH_W * 2;
  const size_t szSIsh = (size_t)T * RW_H * 192 * 2;
  const size_t szWexp = (size_t)(NE + 1) * EXP_STRIDE * 2;
  char* R0 = take(max2(max2(szPAPH, szSIsh), szWexp));
  p.PA = (u16*)R0;
  p.PH = (u16*)(R0 + (size_t)T * PA_W * 2);
  p.SIsh_lat = (u16*)R0;
  p.SIsh_ctx = p.SIsh_lat + (size_t)NB * RW_H * SEQ * 192;
  p.wt_exp = (u16*)R0;
  const size_t szPR = (size_t)T * RW_COLS * 2, szY = (size_t)2 * T * RW_CH * 2;
  char* R1 = take(max2(szPR, szY));
  p.PR = (u16*)R1;
  p.ybuf = (u16*)R1;
  const size_t szSIdir = (size_t)2 * T * RW_H * 192 * 2;
  const size_t szYC = al256((size_t)T * MIX_W * 2);
  char* R2 = take(max2(szSIdir, szYC));
  p.SIdir_lat = (u16*)R2;
  p.SIdir_ctx = p.SIdir_lat + (size_t)2 * NB * RW_H * SEQ * 192;
  p.ycat = (u16*)R2;
  p.acc = (int*)R1;
  const size_t szAcc = al256((size_t)T * (D / 2) * 4);
  const size_t szH = (size_t)(T * TOPK + T + (NE + 1) * 256) * FF * 2;
  p.Hbuf = (u16*)(R1 + szAcc);
  const size_t szSH = al256((size_t)T * D * 2);
  p.SHo = (u16*)(R1 + szAcc + al256(szH));
  p.ya = (u16*)take((size_t)T * CONV_CH * 2);
  p.yhlat = (u16*)take((size_t)NB * HY_CH * SEQ * 2);
  p.yhctx = (u16*)take((size_t)NB * HY_CH * CTXL * 2);
  if (szAcc + al256(szH) + szSH > al256(max2(szPR, szY)) + al256(max2(szSIdir, szYC))) o = (size_t)1 << 62;
  *used = o;
  return p;
}
static size_t ws_needed() {
  return (size_t)640 * 1024 * 1024;
}

#ifndef EMU
constexpr int NFIELDS = sizeof(Params) / 8;
static_assert(sizeof(Params) % 8 == 0 && sizeof(Params) <= 1024, "Params layout");
DI unsigned long long uni64(unsigned long long v) {
  unsigned lo = __builtin_amdgcn_readfirstlane((unsigned)v), hi = __builtin_amdgcn_readfirstlane((unsigned)(v >> 32));
  return ((unsigned long long)hi << 32) | lo;
}
DI void load_params(Params& q, const char* smem) {
  const unsigned long long* src = (const unsigned long long*)(smem + SMEM_BYTES - 1024);
  char** dst = (char**)&q;
  typedef __attribute__((address_space(1))) char gchar_t;
#pragma clang loop unroll(full)
  for (int i = 0; i < NFIELDS; ++i) dst[i] = (char*)(gchar_t*)uni64(src[i]);
}
__global__ void __launch_bounds__(NT) hybrid_mega(Params parg) {
  __shared__ __attribute__((aligned(16))) char smem[SMEM_BYTES];
  if (threadIdx.x < NFIELDS)
    ((unsigned long long*)(smem + SMEM_BYTES - 1024))[threadIdx.x] = ((const unsigned long long*)&parg)[threadIdx.x];
  volatile LAS unsigned* st = (volatile LAS unsigned*)(smem + SMEM_BYTES - 16);
  if (threadIdx.x == 0) { st[0] = 0u; st[1] = 0u; }
  __syncthreads();
  const XcdBarrier xb = xcd_barrier_post(parg.bar, st);
#if PROF_SEG
  if (blockIdx.x == 0 && threadIdx.x < 16) parg.tstamp[32 + threadIdx.x] = 0;
#endif
#if PROF_A || PROF_B || PROF_C || PROF_SEG
#define MK_STAMP(ph) if (blockIdx.x == 0 && threadIdx.x == 0) p.tstamp[ph] = (long long)__builtin_amdgcn_s_memrealtime();
#else
#define MK_STAMP(ph)
#endif
#define MK_PHASE(ph) { Params p; load_params(p, smem); MK_STAMP(ph) run_phase(p, ph, smem); if ((ph) + 1 < NPHASES) xcd_barrier(xb); }
  MK_PHASE(0) MK_PHASE(1) MK_PHASE(2) MK_PHASE(3) MK_PHASE(4) MK_PHASE(5) MK_PHASE(6) MK_PHASE(7) MK_PHASE(8) MK_PHASE(9) MK_PHASE(10)
  MK_PHASE(11) MK_PHASE(12) MK_PHASE(13) MK_PHASE(14) MK_PHASE(15) MK_PHASE(16) MK_PHASE(17) MK_PHASE(18) MK_PHASE(19) MK_PHASE(20) MK_PHASE(21)
  static_assert(NPHASES == 22, "phase program");
#if PROF_A || PROF_B || PROF_C || PROF_SEG
  {
    xcd_barrier(xb);
    Params p;
    load_params(p, smem);
    if (blockIdx.x == 0 && threadIdx.x == 0) p.tstamp[NPHASES] = (long long)__builtin_amdgcn_s_memrealtime();
    xcd_barrier(xb);
    const long long* ts = p.tstamp;
    float tot = (float)(ts[NPHASES] - ts[0]);
    (void)tot;
    float ta = 0.f, tb = 0.f;
    long long tc = 0;
    for (int ph = 0; ph < NPHASES; ++ph) {
      float dt = (float)(ts[ph + 1] - ts[ph]);
      if ((PROF_A >> ph) & 1) ta += dt;
      if ((PROF_B >> ph) & 1) tb += dt;
      if ((PROF_C >> ph) & 1) tc += ts[ph + 1] - ts[ph];
    }
#if PROF_SEG
    {
      float st_ = 0.f;
      for (int k = 0; k < 16; ++k) st_ += (float)ts[32 + k];
      ta = (float)ts[32 + PROF_SA]; tb = (float)ts[32 + PROF_SB]; tot = st_ > 0.f ? st_ : 1.f;
      tc = ts[32 + PROF_SC];
    }
#endif
    float fa = ta / tot, fb = tb / tot;
#if PROF_SEG
    fa = floorf(fa * 50.f + 0.5f) * (1.f / 50.f); fb = floorf(fb * 45.f + 0.5f) * (1.f / 45.f);
#endif
    const float da = sqrtf(0.5f * fa);
    const size_t NA = (size_t)TL * D / 100;
    if (!PROF_SEG) for (size_t i = (size_t)blockIdx.x * NT + threadIdx.x; i < NA; i += (size_t)gridDim.x * NT) p.out[i] += da;
    if (PROF_B && !PROF_SEG && blockIdx.x == 0 && threadIdx.x == 0) p.out[(size_t)TL * D - 1] += 10.f + 90.f * fb;
    if (PROF_C || PROF_SEG) { while ((long long)__builtin_amdgcn_s_memrealtime() < ts[NPHASES] + tc) {} }
  }
#endif
}
#ifdef MULTI_LAUNCH
__global__ void __launch_bounds__(NT) hybrid_phase(Params p, int ph) {
  __shared__ __attribute__((aligned(16))) char smem[SMEM_BYTES];
  run_phase(p, ph, smem);
}
#endif

extern "C" void kernel_launch(void* const* d_in, const int* in_sizes, int n_in, void* d_out, int out_size, void* d_ws,
                              size_t ws_size, hipStream_t stream) {
  (void)in_sizes; (void)n_in; (void)out_size;
  static int grid_blocks = 0;
  if (!grid_blocks) {
    int dev = 0, cus = 0, per_cu = 0;
    hipGetDevice(&dev);
    hipDeviceGetAttribute(&cus, hipDeviceAttributeMultiprocessorCount, dev);
    hipOccupancyMaxActiveBlocksPerMultiprocessor(&per_cu, hybrid_mega, NT, 0);
    if (per_cu < 1) per_cu = 1;
    grid_blocks = cus;
  }
  size_t used = 0;
  Params p = make_params(d_in, d_out, d_ws, &used);
  if (used > ws_size) return;
#ifdef MULTI_LAUNCH
  for (int ph = 0; ph < NPHASES; ++ph) hipLaunchKernelGGL(hybrid_phase, dim3(grid_blocks), dim3(NT), 0, stream, p, ph);
#else
  hipMemsetAsync(p.bar, 0, (size_t)XCD_BAR_WORDS * 4, stream);
  void* args[] = {&p};
  hipLaunchCooperativeKernel((void*)hybrid_mega, dim3(grid_blocks), dim3(NT), args, 0, stream);
#endif
}
#endif
```

```cpp
#ifdef EMU
#include "emu_hip.h"
#else
#include <hip/hip_runtime.h>
#endif
#include <stdint.h>
#include <stddef.h>

#define DI __device__ __forceinline__

#ifdef CFG_SMALL
constexpr int D = 512, NB = 2, SEQ = 256, GRID_W = 16, CTXL = 256, CONV_CH = 128, HY_CH = 128, RW_H = 4;
#else
constexpr int D = 1024, NB = 8, SEQ = 4096, GRID_W = 64, CTXL = 256, CONV_CH = 256, HY_CH = 256, RW_H = 8;
#endif
constexpr int DEPTH = 2;
constexpr int HD = 64;
constexpr int RW_CH = RW_H * HD;
constexpr int MIX_W = CONV_CH + HY_CH + RW_CH;
constexpr int DRK = 64, IRK = 64, GRK = 128;
constexpr int RW_COLS = 3 * RW_CH + 2 * DRK + 2 * IRK + GRK;
constexpr int PA_W = 3 * CONV_CH, PH_W = 3 * HY_CH;
constexpr int P_IN = PA_W + PH_W + RW_COLS;
constexpr int P_IN_PAD = ((P_IN + 255) / 256) * 256;
constexpr int HY_EMB = 33, HY_BANDS = 16, HY_HID = 64;
constexpr int NE = 64, TOPK = 8, FF = 256;
constexpr int TL = NB * SEQ, TC = NB * CTXL, T = TL + TC;
constexpr int FFTN = 2 * SEQ;
constexpr int ilog2c(int n) { return n <= 1 ? 0 : 1 + ilog2c(n / 2); }
constexpr int LOG2N = ilog2c(FFTN);
constexpr float LN_EPS = 1e-5f;
constexpr float RW_GN_EPS = 64e-5f;
constexpr float DN_ALPHA = 1.41421356237309515f;
constexpr float ROUTED_SCALE = 2.5f;
constexpr int NT = 512;
#ifndef PROF_A
#define PROF_A 0
#endif
#ifndef PROF_B
#define PROF_B 0
#endif
#ifndef PROF_C
#define PROF_C 0
#endif
constexpr int SMEM_BYTES = 160 * 1024;
static_assert(MIX_W == D, "mix width");
static_assert(D % 128 == 0 && P_IN % 128 == 0 && PA_W % 128 == 0 && PH_W % 128 == 0, "tiles");
static_assert(SEQ % 256 == 0 && CTXL % 256 == 0, "row tiles");

typedef unsigned short u16;
typedef __attribute__((ext_vector_type(8))) short bf16x8;
typedef __attribute__((ext_vector_type(16))) float f32x16;
typedef __attribute__((ext_vector_type(4))) unsigned u32x4;
typedef __attribute__((ext_vector_type(2))) unsigned u32x2;
typedef __attribute__((ext_vector_type(4))) float f32x4;
struct cf { float x, y; };

struct Params {
  const float *x, *c, *ctx, *c_ctx, *w_ada, *b_ada, *w_in, *conv_a, *hy_sconv_w, *hy_sconv_b;
  const float *hf_w1, *hf_b1, *hf_w2, *hf_b2, *hf_w3, *hf_b3, *hf_wout, *hf_freq, *hf_skip;
  const float *rw_mu, *rw_w0, *rw_w_up, *rw_a0, *rw_a_up, *rw_g_up, *rw_k_k, *rw_k_a, *rw_r_k;
  const float *rw_lnx_g, *rw_lnx_b, *mix_norm_g, *w_out, *ln_g, *ln_b, *w_router, *e_bias;
  const float *w_e_gate, *w_e_up, *w_e_down, *w_s_gate, *w_s_up, *w_s_down;
  float* out;
  float* mod;
  float* h3lat;
  float* h3ctx;
  cf* tw;
  int* cnt;
  float* sbonus;
  cf* spec;
  u16* HL;
  u16* PA;
  u16* PH;
  u16* PR;
  u16* SIsh_lat;
  u16* SIsh_ctx;
  u16* SIdir_lat;
  u16* SIdir_ctx;
  u16* ya;
  u16* yhlat;
  u16* yhctx;
  u16* gbuf;
  u16* ybuf;
  u16* ycat;
  float* XC;
  u16* wt_in;
  u16* wt_out;
  u16* wt_rhi;
  u16* wt_rlo;
  u16* wt_wup;
  u16* wt_aup;
  u16* wt_gup;
  u16* Hbuf;
  u16* SHo;
  u16* wt_exp;
  int* acc;
  int* etok;
  float* egate;
  long long* tstamp;
  unsigned* bar;
};


#ifndef PROF_SEG
#define PROF_SEG 0
#endif
#if PROF_SEG && !defined(EMU)
#define SEG_BEGIN(p) long long seg_last_ = 0; const bool seg_on_ = (blockIdx.x == 0 && threadIdx.x == 0); if (seg_on_) seg_last_ = (long long)__builtin_amdgcn_s_memrealtime();
#define SEG_MARK(p, k) if (seg_on_) { long long now_ = (long long)__builtin_amdgcn_s_memrealtime(); (p).tstamp[32 + (k)] += now_ - seg_last_; seg_last_ = now_; }
#else
#define SEG_BEGIN(p)
#define SEG_MARK(p, k)
#endif
#ifdef EMU
DI int TIDX() { return threadIdx.x; }
DI int BIDX() { return blockIdx.x; }
#else
DI int TIDX() { int t = threadIdx.x; asm volatile("" : "+v"(t)); return t; }
DI int BIDX() { int b = blockIdx.x; asm volatile("" : "+s"(b)); return b; }
#endif

#ifdef EMU
DI u16 f2bf(float x) {
  unsigned u = __builtin_bit_cast(unsigned, x);
  u += 0x7fffu + ((u >> 16) & 1u);
  return (u16)(u >> 16);
}
#else
DI u16 f2bf(float x) { return __builtin_bit_cast(u16, (__bf16)x); }
#endif
DI float bf2f(u16 h) { return __builtin_bit_cast(float, ((unsigned)h) << 16); }
DI u16 f2h(float x) { return __builtin_bit_cast(u16, (_Float16)x); }
DI float h2f(u16 h) { return (float)__builtin_bit_cast(_Float16, h); }
#ifdef EMU
DI unsigned pk2(float a, float b) { return (unsigned)f2bf(a) | ((unsigned)f2bf(b) << 16); }
#else
DI unsigned pk2(float a, float b) {
  typedef __bf16 bf16v2 __attribute__((ext_vector_type(2)));
  bf16v2 v; v[0] = (__bf16)a; v[1] = (__bf16)b;
  return __builtin_bit_cast(unsigned, v);
}
#endif
DI float sigmoidf_(float x) { return 1.0f / (1.0f + expf(-x)); }
DI float siluf_(float x) { return x / (1.0f + expf(-x)); }
DI float softplusf_(float x) { return x > 20.f ? x : log1pf(expf(x)); }
#ifdef EMU
DI float fexp_(float x) { return expf(x); }
DI float frcp_(float x) { return 1.0f / x; }
#else
DI float fexp_(float x) { return __builtin_amdgcn_exp2f(x * 1.44269504088896341f); }
DI float frcp_(float x) { return __builtin_amdgcn_rcpf(x); }
#endif
DI float fsigmoid_(float x) { return frcp_(1.0f + fexp_(-x)); }
DI float ftanh_(float x) { return 1.0f - 2.0f * frcp_(1.0f + fexp_(2.0f * x)); }

#ifdef EMU
DI float red16(float v) { v += __shfl_xor(v, 1); v += __shfl_xor(v, 2); v += __shfl_xor(v, 4); v += __shfl_xor(v, 8); return v; }
DI float wave_sum(float v) {
#pragma unroll
  for (int m = 1; m < 64; m <<= 1) v += __shfl_xor(v, m);
  return v;
}
#else
template <int CTRL> DI float dppf(float v) {
  return __builtin_bit_cast(float, __builtin_amdgcn_update_dpp(0, __builtin_bit_cast(int, v), CTRL, 0xf, 0xf, true));
}
DI float red16(float v) {
  v += dppf<0xB1>(v);
  v += dppf<0x4E>(v);
  v += dppf<0x141>(v);
  v += dppf<0x140>(v);
  return v;
}
DI float wave_sum(float v) {
  v = red16(v);
  int iv = __builtin_bit_cast(int, v);
  float a = __builtin_bit_cast(float, __builtin_amdgcn_readlane(iv, 0));
  float b = __builtin_bit_cast(float, __builtin_amdgcn_readlane(iv, 16));
  float c = __builtin_bit_cast(float, __builtin_amdgcn_readlane(iv, 32));
  float d = __builtin_bit_cast(float, __builtin_amdgcn_readlane(iv, 48));
  return (a + b) + (c + d);
}
#endif
#ifdef EMU
DI float wave_max(float v) {
#pragma unroll
  for (int m = 1; m < 64; m <<= 1) v = fmaxf(v, __shfl_xor(v, m));
  return v;
}
#else
DI float wave_max(float v) {
  v = fmaxf(v, dppf<0xB1>(v));
  v = fmaxf(v, dppf<0x4E>(v));
  v = fmaxf(v, dppf<0x141>(v));
  v = fmaxf(v, dppf<0x140>(v));
  int iv = __builtin_bit_cast(int, v);
  float a = __builtin_bit_cast(float, __builtin_amdgcn_readlane(iv, 0));
  float b = __builtin_bit_cast(float, __builtin_amdgcn_readlane(iv, 16));
  float c = __builtin_bit_cast(float, __builtin_amdgcn_readlane(iv, 32));
  float d = __builtin_bit_cast(float, __builtin_amdgcn_readlane(iv, 48));
  return fmaxf(fmaxf(a, b), fmaxf(c, d));
}
#endif
DI void wave_sync() {
#ifdef EMU
  emu::wave_barrier();
#else
  asm volatile("s_waitcnt lgkmcnt(0)" ::: "memory");
  __builtin_amdgcn_wave_barrier();
#endif
}
DI f32x4 ld_bf4(const u16* q) {
  u32x2 v = *(const u32x2*)q;
  f32x4 r;
  r[0] = bf2f((u16)(v[0] & 0xffff)); r[1] = bf2f((u16)(v[0] >> 16));
  r[2] = bf2f((u16)(v[1] & 0xffff)); r[3] = bf2f((u16)(v[1] >> 16));
  return r;
}
DI void st_bf4(u16* q, f32x4 v) {
  u32x2 o; o[0] = pk2(v[0], v[1]); o[1] = pk2(v[2], v[3]);
  *(u32x2*)q = o;
}
DI int crow(int reg, int h) { return (reg & 3) + 8 * (reg >> 2) + 4 * h; }
#define MFMA32(a, b, c) __builtin_amdgcn_mfma_f32_32x32x16_bf16((a), (b), (c), 0, 0, 0)

DI int modrow(int r) { return r < TL ? r / SEQ : NB; }
DI const float* modp(const Params& p, int l, int r) { return p.mod + ((size_t)l * (NB + 1) + modrow(r)) * (6 * D); }


#define XB_TMO      128
#define XB_TICKET   192
#define XB_XCNT(j)  (256  + 64 * (j))
#define XB_XSUB(j)  (1280 + 64 * (j))
#define XB_XGEN(j)  (2304 + 64 * (j))
#define XB_TOP      3328
#define XB_TOPGEN   3392
#define XCD_BAR_WORDS 3456
#ifndef EMU
#define XB_SPIN_CAP (1u << 22)
#define LAS __attribute__((address_space(3)))
DI unsigned xb_ld(unsigned* p) { return __hip_atomic_load(p, __ATOMIC_RELAXED, __HIP_MEMORY_SCOPE_AGENT); }
DI unsigned xb_add(unsigned* p, unsigned v) { return __hip_atomic_fetch_add(p, v, __ATOMIC_RELAXED, __HIP_MEMORY_SCOPE_AGENT); }
DI unsigned xb_xcc_id() { return (unsigned)__builtin_amdgcn_s_getreg((3 << 11) | 20) & 0xFu; }
#define XB_SPIN(cond, bar) do { unsigned _sp = 0; while (cond) { __builtin_amdgcn_s_sleep(1); \
    if ((++_sp & 255u) == 0u) { if (xb_ld(&(bar)[XB_TMO])) break; if (_sp > XB_SPIN_CAP) { atomicAdd(&(bar)[XB_TMO], 1u); break; } } } } while (0)
struct XcdBarrier { unsigned* bar; unsigned x; volatile LAS unsigned* st; };
DI XcdBarrier xcd_barrier_post(unsigned* bar, volatile LAS unsigned* st) {
  XcdBarrier b; b.bar = bar; b.x = xb_xcc_id(); b.st = st;
  if (threadIdx.x == 0) (void)xb_add(&bar[XB_XCNT(b.x)], 1u);
  return b;
}
DI void xcd_barrier_complete(unsigned* bar, unsigned x, unsigned& nloc, unsigned& nx) {
  const unsigned G = gridDim.x * gridDim.y * gridDim.z;
  unsigned sum, cnt, mine, sp = 0u;
  for (;;) {
    sum = 0u; cnt = 0u; mine = 0u;
#pragma unroll
    for (unsigned j = 0; j < 16; ++j) { const unsigned c = xb_ld(&bar[XB_XCNT(j)]); sum += c; cnt += (c > 0u) ? 1u : 0u; mine = (j == x) ? c : mine; }
    if (sum == G) break;
    __builtin_amdgcn_s_sleep(1);
    if ((++sp & 255u) == 0u) { if (xb_ld(&bar[XB_TMO])) break; if (sp > XB_SPIN_CAP) { atomicAdd(&bar[XB_TMO], 1u); break; } }
  }
  nloc = mine > 0u ? mine : 1u; nx = cnt > 0u ? cnt : 1u;
}
DI void xcd_barrier(const XcdBarrier& b) {
  asm volatile("s_waitcnt vmcnt(0)" ::: "memory");
  __syncthreads();
  if (threadIdx.x == 0) {
    unsigned* bar = b.bar;
    __builtin_amdgcn_s_waitcnt(0);
    unsigned nloc = b.st[0], nx = b.st[1];
    if (nloc == 0u) { xcd_barrier_complete(bar, b.x, nloc, nx); b.st[0] = nloc; b.st[1] = nx; }
    const unsigned old = xb_add(&bar[XB_XSUB(b.x)], 1u);
    const unsigned gen = old / nloc;
    if (old + 1u == (gen + 1u) * nloc) {
      __builtin_amdgcn_fence(__ATOMIC_RELEASE, "agent");
      asm volatile("s_waitcnt vmcnt(0)" ::: "memory");
      const unsigned og = xb_add(&bar[XB_TOP], 1u);
      const unsigned tg = og / nx;
      if (og + 1u == (tg + 1u) * nx) xb_add(&bar[XB_TOPGEN], 1u);
      else XB_SPIN(xb_ld(&bar[XB_TOPGEN]) == tg, bar);
      __builtin_amdgcn_fence(__ATOMIC_ACQUIRE, "agent");
      xb_add(&bar[XB_XGEN(b.x)], 1u);
      asm volatile("s_waitcnt vmcnt(0)" ::: "memory");
    } else {
      XB_SPIN(xb_ld(&bar[XB_XGEN(b.x)]) == gen, bar);
      __builtin_amdgcn_fence(__ATOMIC_ACQUIRE, "agent");
      asm volatile("s_waitcnt vmcnt(0)" ::: "memory");
    }
  }
  __syncthreads();
}
#endif

namespace pg8 {
constexpr int BM = 256, BK = 64, HALF = 128, HTB = HALF * BK * 2, STAGE_BYTES = 8 * HTB;
struct Unit { int pm, pn, e, cnt, idx; };
__host__ __device__ __forceinline__ int lds_byte(int r, int c) { const int st = (r >> 4) * 2 + (c >> 5), rr = r & 15, cc = c & 31, ob = rr * 64 + cc * 2; return st * 1024 + (ob ^ (((ob >> 9) & 1) << 5)); }
__host__ __device__ __forceinline__ void stage_rc(int b, int& R, int& C) { const int st = b / 1024, sb = b % 1024, swz = sb ^ (((sb >> 9) & 1) << 5); R = (st >> 1) * 16 + swz / 64; C = (st & 1) * 32 + (swz % 64) / 2; }

#ifdef EMU
template <class Epi, class Sched>
inline void gemm_phase(char* lds, int K, const Sched& S, const Epi& E) {
  (void)lds;
  const int tid = TIDX(), wid = tid >> 6, lane = tid & 63, wr = wid >> 2, wc = wid & 3, fr = lane & 15, fq = lane >> 4;
  Unit u;
  for (int ui = 0; S.next(ui, u); ++ui) {
    f32x4 acc[2][2][4][2];
    for (int ai = 0; ai < 2; ++ai) for (int bj = 0; bj < 2; ++bj) for (int m = 0; m < 4; ++m) for (int n = 0; n < 2; ++n) {
      const int r = 128 * ai + 64 * wr + 16 * m + fr;
      const u16* arow = (const u16*)(S.abase() + S.arow_off(u, r));
      for (int j = 0; j < 4; ++j) {
        const int c = 32 * wc + 16 * n + 4 * fq + j;
        const u16* brow = (const u16*)S.bbase(u, bj) + (size_t)c * K;
        float s = 0.f;
        for (int k = 0; k < K; ++k) s += bf2f(arow[k]) * bf2f(brow[k]);
        acc[ai][bj][m][n][j] = s;
      }
    }
    E(acc, u, wr, wc, fr, fq, E.prefetch(u, wr, lane));
  }
}
#else
#define PG8_LAS __attribute__((address_space(3)))
template <class Epi, class Sched>
__device__ __forceinline__ void gemm_phase(char* lds_generic, int K, const Sched& S, const Epi& E) {
  PG8_LAS unsigned char* lds = (PG8_LAS unsigned char*)lds_generic;
  const int tid = TIDX(), wid = __builtin_amdgcn_readfirstlane(tid >> 6), lane = tid & 63, wr = wid >> 2, wc = wid & 3, fr = lane & 15, fq = lane >> 4;
  const int nt = K / BK;
  int Rr[2], Cc[2];
  unsigned voffB[2];
#pragma unroll
  for (int i = 0; i < 2; ++i) { stage_rc(tid * 16 + i * 8192, Rr[i], Cc[i]); voffB[i] = (unsigned)(Rr[i] * K + Cc[i]) * 2u; }
  const size_t kstep = (size_t)(BK * 2);
  const unsigned ldsw = (unsigned)wid * 1024u;
  const int aoff = lds_byte(wr * 64 + fr, fq * 8), boff = lds_byte(wc * 32 + fr, fq * 8);
#define PG8_SA(b, h) (((b) * 2 + (h)) * HTB)
#define PG8_SB(b, h) ((4 + (b) * 2 + (h)) * HTB)
#define PG8_STAGE2(bufoff, gbase, v0, v1) do { \
    __builtin_amdgcn_global_load_lds((const unsigned*)((const char*)(gbase) + (v0)), (PG8_LAS unsigned*)(lds + (bufoff) + ldsw), 16, 0, 0); \
    __builtin_amdgcn_global_load_lds((const unsigned*)((const char*)(gbase) + (v1)), (PG8_LAS unsigned*)(lds + (bufoff) + ldsw + 8192), 16, 0, 0); } while (0)
#define PG8_STAGEB(bufoff, gbase) PG8_STAGE2(bufoff, gbase, voffB[0], voffB[1])
#define PG8_LDA(dst, b, h) do { _Pragma("unroll") for (int m = 0; m < 4; ++m) _Pragma("unroll") for (int k = 0; k < 2; ++k) dst[m][k] = *(const PG8_LAS bf16x8*)(lds + PG8_SA(b, h) + aoff + m * 2048 + k * 1024); } while (0)
#define PG8_LDB(dst, b, h) do { _Pragma("unroll") for (int n = 0; n < 2; ++n) _Pragma("unroll") for (int k = 0; k < 2; ++k) dst[n][k] = *(const PG8_LAS bf16x8*)(lds + PG8_SB(b, h) + boff + n * 2048 + k * 1024); } while (0)
#define PG8_MMA(ai, bj, At, Bt) do { __builtin_amdgcn_s_setprio(1); _Pragma("unroll") for (int m = 0; m < 4; ++m) _Pragma("unroll") for (int n = 0; n < 2; ++n) _Pragma("unroll") for (int k = 0; k < 2; ++k) \
    acc[ai][bj][m][n] = __builtin_amdgcn_mfma_f32_16x16x32_bf16(Bt[n][k], At[m][k], acc[ai][bj][m][n], 0, 0, 0); __builtin_amdgcn_s_setprio(0); } while (0)
#define PG8_WAIT_V(n) asm volatile("s_waitcnt vmcnt(" #n ")" ::: "memory")
#define PG8_WAIT_L(n) asm volatile("s_waitcnt lgkmcnt(" #n ")" ::: "memory")
#define PG8_BAR __builtin_amdgcn_s_barrier()
#define PG8_SCHED __builtin_amdgcn_sched_barrier(0)
  Unit cur, nxt; int ui = 0;
  if (!S.next(0, cur)) return;
  f32x4 acc[2][2][4][2];
#pragma unroll
  for (int a = 0; a < 2; ++a)
#pragma unroll
    for (int b = 0; b < 2; ++b)
#pragma unroll
      for (int m = 0; m < 4; ++m)
#pragma unroll
        for (int n = 0; n < 2; ++n) acc[a][b][m][n] = (f32x4){0.f, 0.f, 0.f, 0.f};
  bf16x8 At[4][2], B0[2][2], B1[2][2];
  const char* const gA = S.abase();
  unsigned cv00 = 0, cv01 = 0, cv10 = 0, cv11 = 0, nv00 = 0, nv01 = 0, nv10 = 0, nv11 = 0;
  const char *cA0 = gA, *cA1 = gA, *nA0 = gA, *nA1 = gA;
  if constexpr (Sched::GATHER) {
    cv00 = S.arow_off(cur, Rr[0]) + Cc[0] * 2u; cv01 = S.arow_off(cur, Rr[1]) + Cc[1] * 2u;
    cv10 = S.arow_off(cur, 128 + Rr[0]) + Cc[0] * 2u; cv11 = S.arow_off(cur, 128 + Rr[1]) + Cc[1] * 2u;
  } else {
    cA0 = gA + S.arow_off(cur, 0); cA1 = gA + S.arow_off(cur, 128);
  }
#define PG8_STAGE_A(bufoff, kb, h, NEXT) do { \
    if constexpr (Sched::GATHER) { PG8_STAGE2(bufoff, gA + (kb), (NEXT) ? ((h) ? nv10 : nv00) : ((h) ? cv10 : cv00), (NEXT) ? ((h) ? nv11 : nv01) : ((h) ? cv11 : cv01)); } \
    else { PG8_STAGE2(bufoff, ((NEXT) ? ((h) ? nA1 : nA0) : ((h) ? cA1 : cA0)) + (kb), voffB[0], voffB[1]); } } while (0)
  const char* cB0 = S.bbase(cur, 0); const char* cB1 = S.bbase(cur, 1);
  PG8_STAGEB(PG8_SB(0, 0), cB0); PG8_STAGE_A(PG8_SA(0, 0), 0, 0, false); PG8_STAGEB(PG8_SB(0, 1), cB1); PG8_STAGE_A(PG8_SA(0, 1), 0, 1, false);
  if (wr == 1) PG8_BAR;
  PG8_WAIT_V(4); PG8_BAR;
  PG8_STAGEB(PG8_SB(1, 0), cB0 + kstep); PG8_STAGE_A(PG8_SA(1, 0), kstep, 0, false); PG8_STAGEB(PG8_SB(1, 1), cB1 + kstep);
  PG8_WAIT_V(6); PG8_BAR;
  for (;;) {
    const bool has_next = S.next(ui + 1, nxt);
    const char* nB0 = cB0; const char* nB1 = cB1;
    if constexpr (Sched::GATHER) { nv00 = cv00; nv01 = cv01; nv10 = cv10; nv11 = cv11; } else { nA0 = cA0; nA1 = cA1; }
    if (has_next) {
      if constexpr (Sched::GATHER) {
        nv00 = S.arow_off(nxt, Rr[0]) + Cc[0] * 2u; nv01 = S.arow_off(nxt, Rr[1]) + Cc[1] * 2u;
        nv10 = S.arow_off(nxt, 128 + Rr[0]) + Cc[0] * 2u; nv11 = S.arow_off(nxt, 128 + Rr[1]) + Cc[1] * 2u;
      } else {
        nA0 = gA + S.arow_off(nxt, 0); nA1 = gA + S.arow_off(nxt, 128);
      }
      nB0 = S.bbase(nxt, 0); nB1 = S.bbase(nxt, 1);
    }
    const typename Epi::Pre epre = E.prefetch(cur, wr, lane);
#pragma clang loop unroll(disable)
    for (int t = 0; t < nt; t += 2) {
      const bool last = (t == nt - 2);
      const size_t kb1 = (size_t)(t + 1) * kstep;
      const size_t kb2 = last ? (size_t)0 : (size_t)(t + 2) * kstep;
      const size_t kb3 = kb2 + kstep;
      const char* b20 = last ? nB0 : cB0 + (size_t)(t + 2) * kstep;
      const char* b21 = last ? nB1 : cB1 + (size_t)(t + 2) * kstep;
      const char* b30 = b20 + kstep; const char* b31 = b21 + kstep;
      PG8_LDB(B0, 0, 0); PG8_SCHED; PG8_LDA(At, 0, 0); PG8_STAGE_A(PG8_SA(1, 1), kb1, 1, false);
      PG8_WAIT_L(8); PG8_BAR; PG8_WAIT_L(0); PG8_MMA(0, 0, At, B0); PG8_BAR; PG8_SCHED;
      PG8_LDB(B1, 0, 1); PG8_STAGEB(PG8_SB(0, 0), b20);
      PG8_BAR; PG8_WAIT_L(0); PG8_MMA(0, 1, At, B1); PG8_BAR;
      PG8_LDA(At, 0, 1); PG8_STAGE_A(PG8_SA(0, 0), kb2, 0, last);
      PG8_BAR; PG8_WAIT_L(0); PG8_MMA(1, 0, At, B0); PG8_BAR; PG8_SCHED;
      PG8_STAGEB(PG8_SB(0, 1), b21);
      PG8_WAIT_V(6); PG8_BAR; PG8_MMA(1, 1, At, B1); PG8_BAR;
      PG8_LDB(B0, 1, 0); PG8_SCHED; PG8_LDA(At, 1, 0); PG8_STAGE_A(PG8_SA(0, 1), kb2, 1, last);
      PG8_WAIT_L(8); PG8_BAR; PG8_WAIT_L(0); PG8_MMA(0, 0, At, B0); PG8_BAR; PG8_SCHED;
      PG8_LDB(B1, 1, 1); PG8_STAGEB(PG8_SB(1, 0), b30);
      PG8_BAR; PG8_WAIT_L(0); PG8_MMA(0, 1, At, B1); PG8_BAR;
      PG8_LDA(At, 1, 1); PG8_STAGE_A(PG8_SA(1, 0), kb3, 0, last);
      PG8_BAR; PG8_WAIT_L(0); PG8_MMA(1, 0, At, B0); PG8_BAR; PG8_SCHED;
      PG8_STAGEB(PG8_SB(1, 1), b31);
      PG8_WAIT_V(6); PG8_BAR; PG8_MMA(1, 1, At, B1); PG8_BAR;
    }
    E(acc, cur, wr, wc, fr, fq, epre);
    if (!has_next) break;
#pragma unroll
    for (int a = 0; a < 2; ++a)
#pragma unroll
      for (int b = 0; b < 2; ++b)
#pragma unroll
        for (int m = 0; m < 4; ++m)
#pragma unroll
          for (int n = 0; n < 2; ++n) acc[a][b][m][n] = (f32x4){0.f, 0.f, 0.f, 0.f};
    cur = nxt; cB0 = nB0; cB1 = nB1; ++ui;
    if constexpr (Sched::GATHER) { cv00 = nv00; cv01 = nv01; cv10 = nv10; cv11 = nv11; } else { cA0 = nA0; cA1 = nA1; }
  }
  PG8_WAIT_V(0);
  if (wr == 0) PG8_BAR;
  PG8_BAR;
#undef PG8_SA
#undef PG8_SB
#undef PG8_STAGE2
#undef PG8_STAGE_A
#undef PG8_STAGEB
#undef PG8_LDA
#undef PG8_LDB
#undef PG8_MMA
#undef PG8_WAIT_V
#undef PG8_WAIT_L
#undef PG8_BAR
#undef PG8_SCHED
}
#endif
DI int remap_xcd(int L, int nwg) {
  const int q = nwg / 8, r = nwg % 8, xcd = L % 8, off = L / 8;
  return (xcd < r ? xcd * (q + 1) : r * (q + 1) + (xcd - r) * q) + off;
}
}

DI void convert_tile(const float* __restrict__ src, int K, int N, u16* __restrict__ dst, u16* __restrict__ dst_lo, int tile, char* smem) {
  const int tid = TIDX();
  float* t = (float*)smem;
  const int ntn = N / 64;
  const int k0 = (tile / ntn) * 64, n0 = (tile % ntn) * 64;
#pragma unroll
  for (int i = 0; i < 8; ++i) {
    const int row = i * 8 + (tid >> 6), col = tid & 63;
    t[row * 65 + col] = src[(size_t)(k0 + row) * N + n0 + col];
  }
  __syncthreads();
  const int n = tid >> 3, kq = tid & 7;
  float f[8];
#pragma unroll
  for (int j = 0; j < 8; ++j) f[j] = t[(kq * 8 + j) * 65 + n];
  u32x4 pb;
  pb[0] = pk2(f[0], f[1]); pb[1] = pk2(f[2], f[3]); pb[2] = pk2(f[4], f[5]); pb[3] = pk2(f[6], f[7]);
  *(u32x4*)(dst + (size_t)(n0 + n) * K + k0 + kq * 8) = pb;
  if (dst_lo) {
#pragma unroll
    for (int j = 0; j < 8; ++j) f[j] -= bf2f(f2bf(f[j]));
    pb[0] = pk2(f[0], f[1]); pb[1] = pk2(f[2], f[3]); pb[2] = pk2(f[4], f[5]); pb[3] = pk2(f[6], f[7]);
    *(u32x4*)(dst_lo + (size_t)(n0 + n) * K + k0 + kq * 8) = pb;
  }
  __syncthreads();
}
DI void convert_tile_w(const float* __restrict__ src, int K, int N, u16* __restrict__ dst, int tile, char* smem) {
  const int tid = TIDX();
  float* t = (float*)smem;
  const int ntn = N / 256;
  const int k0 = (tile / ntn) * 64, n0 = (tile % ntn) * 256;
#pragma unroll
  for (int i = 0; i < 8; ++i) {
    const int row = i * 8 + (tid >> 6), col = (tid & 63) * 4;
    const f32x4 v = *(const f32x4*)(src + (size_t)(k0 + row) * N + n0 + col);
    float* q = t + row * 257 + col;
    q[0] = v[0]; q[1] = v[1]; q[2] = v[2]; q[3] = v[3];
  }
  __syncthreads();
#pragma unroll
  for (int i = 0; i < 4; ++i) {
    const int idx = tid + NT * i;
    const int n = idx >> 3, kq = idx & 7;
    float f[8];
#pragma unroll
    for (int j = 0; j < 8; ++j) f[j] = t[(kq * 8 + j) * 257 + n];
    u32x4 pb;
    pb[0] = pk2(f[0], f[1]); pb[1] = pk2(f[2], f[3]); pb[2] = pk2(f[4], f[5]); pb[3] = pk2(f[6], f[7]);
    *(u32x4*)(dst + (size_t)(n0 + n) * K + k0 + kq * 8) = pb;
  }
  __syncthreads();
}
constexpr int CT_IN = (D / 64) * (P_IN / 64), CT_OUT = (MIX_W / 64) * (D / 64), CT_R = (D / 64) * (NE / 64);
constexpr int CT_WUP = (DRK / 64) * (RW_CH / 64), CT_GUP = (GRK / 64) * (RW_CH / 64);
constexpr int CT_STATIC_L = CT_IN + CT_OUT + CT_R + 4 * CT_WUP + CT_GUP;
DI void convert_static_item(const Params& p, int it, char* smem) {
  const int l = it / CT_STATIC_L;
  int q = it % CT_STATIC_L;
  if (q < CT_IN) { convert_tile(p.w_in + (size_t)l * D * P_IN, D, P_IN, p.wt_in + (size_t)l * P_IN_PAD * D, nullptr, q, smem); return; }
  q -= CT_IN;
  if (q < CT_OUT) { convert_tile(p.w_out + (size_t)l * MIX_W * D, MIX_W, D, p.wt_out + (size_t)l * D * MIX_W, nullptr, q, smem); return; }
  q -= CT_OUT;
  if (q < CT_R) { convert_tile(p.w_router + (size_t)l * D * NE, D, NE, p.wt_rhi + (size_t)l * NE * D, p.wt_rlo + (size_t)l * NE * D, q, smem); return; }
  q -= CT_R;
  if (q < 4 * CT_WUP) {
    const int which = q / CT_WUP, tile = q % CT_WUP;
    const int d = which & 1;
    if (which < 2) convert_tile(p.rw_w_up + ((size_t)l * 2 + d) * DRK * RW_CH, DRK, RW_CH, p.wt_wup + ((size_t)l * 2 + d) * RW_CH * DRK, nullptr, tile, smem);
    else convert_tile(p.rw_a_up + ((size_t)l * 2 + d) * IRK * RW_CH, IRK, RW_CH, p.wt_aup + ((size_t)l * 2 + d) * RW_CH * IRK, nullptr, tile, smem);
    return;
  }
  q -= 4 * CT_WUP;
  convert_tile(p.rw_g_up + (size_t)l * GRK * RW_CH, GRK, RW_CH, p.wt_gup + (size_t)l * RW_CH * GRK, nullptr, q, smem);
}
constexpr int CT_EMAT = (D / 64) * (FF / 256);
static_assert(FF % 256 == 0 && D % 256 == 0 && (D / 64) * (FF / 256) == (FF / 64) * (D / 256), "expert conversion tiling");
constexpr int CT_EXP_L = (NE + 1) * 3 * CT_EMAT;
constexpr size_t EXP_STRIDE = (size_t)3 * D * FF;
DI void convert_expert_item(const Params& p, int l, int it, char* smem) {
  const int e = it / (3 * CT_EMAT), m = (it / CT_EMAT) % 3, tile = it % CT_EMAT;
  const float *eg = p.w_e_gate, *eu = p.w_e_up, *ed = p.w_e_down, *sg = p.w_s_gate, *su = p.w_s_up, *sd = p.w_s_down;
#ifndef EMU
  asm volatile("" : "+s"(eg), "+s"(eu), "+s"(ed), "+s"(sg), "+s"(su), "+s"(sd));
#endif
  const float* src;
  if (e < NE) src = (m == 0 ? eg : m == 1 ? eu : ed) + ((size_t)l * NE + e) * D * FF;
  else src = (m == 0 ? sg : m == 1 ? su : sd) + (size_t)l * D * FF;
#ifndef EMU
  src = (const float*)(__attribute__((address_space(1))) const float*)(unsigned long long)src;
#endif
  u16* dst = p.wt_exp + (size_t)e * EXP_STRIDE + (size_t)m * D * FF;
  if (m < 2) convert_tile_w(src, D, FF, dst, tile, smem);
  else convert_tile_w(src, FF, D, dst, tile, smem);
}

DI float* x1row(const Params& p, int r) { return r < TL ? p.out + (size_t)r * D : p.XC + (size_t)(r - TL) * D; }

struct DenseSched {
  static constexpr bool GATHER = false;
  const char* A; const char* Bt; int K, nM, nN, nwg, G, c;
  DI void init(const void* A_, const void* Bt_, int K_, int M, int N, int G_, int c_) { A = (const char*)A_; Bt = (const char*)Bt_; K = K_; nM = M / 256; nN = N / 256; nwg = nM * nN; G = G_; c = c_; }
  DI bool next(int i, pg8::Unit& u) const {
    const int L = i * G + c; if (L >= nwg) return false;
    const int wgid = pg8::remap_xcd(L, nwg);
    const int nig = 8 * nN, gid = wgid / nig, fm = gid * 8, gsz = (nM - fm) < 8 ? (nM - fm) : 8;
    u.pm = fm + ((wgid % nig) % gsz); u.pn = (wgid % nig) / gsz; u.e = 0; u.cnt = 0; u.idx = i; return true;
  }
  DI const char* abase() const { return A; }
  DI unsigned arow_off(const pg8::Unit& u, int r) const { return (unsigned)(u.pm * 256 + r) * (unsigned)(K * 2); }
  DI const char* bbase(const pg8::Unit& u, int half) const { return Bt + (size_t)(u.pn * 256 + half * 128) * K * 2; }
};
struct ExpertSched {
  const int* pre;
  const int* cntl;
  const unsigned char* t2e;
  int nN, G, c, total;
  DI bool locate(int i, pg8::Unit& u) const {
    const int L = i * G + c; if (L >= total) return false;
    const int w = pg8::remap_xcd(L, total);
    const int tile = w / nN; u.pn = w % nN;
    const int e = (int)t2e[tile];
    u.e = e; u.pm = tile - pre[e]; u.cnt = cntl[e]; u.idx = i;
    return true;
  }
};
struct E1Sched : ExpertSched {
  static constexpr bool GATHER = true;
  const char* A; const char* W; const int* etok;
  const unsigned* loff; int nl;
  DI bool next(int i, pg8::Unit& u) const { return locate(i, u); }
  DI const char* abase() const { return A; }
  DI unsigned goff(const pg8::Unit& u, int r) const {
    const int slot = u.pm * 256 + r;
    const unsigned tl = (unsigned)etok[u.e < NE ? (size_t)u.e * T + slot : (size_t)slot];
    const unsigned tok = u.e < NE ? (tl < (unsigned)T ? tl : 0u) : (unsigned)slot;
    return tok * (unsigned)(D * 2);
  }
  DI unsigned arow_off(const pg8::Unit& u, int r) const { return u.idx < nl ? loff[u.idx * 256 + r] : goff(u, r); }
  DI void preload(unsigned* lds_off, int maxu) {
    loff = lds_off; nl = 0;
    const int tid = TIDX();
    pg8::Unit u;
    int n = 0;
    while (n < maxu && locate(n, u)) ++n;
    for (int i = tid; i < n * 256; i += NT) { locate(i >> 8, u); lds_off[i] = goff(u, i & 255); }
    __syncthreads();
    nl = n;
  }
  DI const char* bbase(const pg8::Unit& u, int half) const { return W + ((size_t)u.e * EXP_STRIDE + (size_t)half * D * FF + (size_t)u.pn * 128 * D) * 2; }
};
struct E2Sched : ExpertSched {
  static constexpr bool GATHER = false;
  const char* A; const char* W; const int* hoff;
  DI bool next(int i, pg8::Unit& u) const { return locate(i, u); }
  DI const char* abase() const { return A; }
  DI unsigned arow_off(const pg8::Unit& u, int r) const { return (unsigned)(hoff[u.e] + u.pm * 256 + r) * (unsigned)(FF * 2); }
  DI const char* bbase(const pg8::Unit& u, int half) const { return W + ((size_t)u.e * EXP_STRIDE + (size_t)2 * D * FF + (size_t)(u.pn * 256 + half * 128) * FF) * 2; }
};

struct EpiInproj {
  u16 *PA, *PH, *PR;
  struct Pre {};
  DI Pre prefetch(const pg8::Unit&, int, int) const { return Pre{}; }
  DI void operator()(const f32x4 (&acc)[2][2][4][2], const pg8::Unit& u, int wr, int wc, int fr, int fq, const Pre&) const {
    const int row0 = u.pm * 256 + wr * 64 + fr;
#pragma unroll
    for (int bj = 0; bj < 2; ++bj) {
      const int colh = u.pn * 256 + bj * 128;
      if (colh >= P_IN) continue;
      if (colh >= PA_W && colh < PA_W + PH_W) {
        const int c0 = colh - PA_W + wc * 32 + 4 * fq;
        const int rb = u.pm * 256;
        u16* base; int L, t0;
        if (rb < TL) { L = SEQ; base = PH + (size_t)(rb / SEQ) * PH_W * SEQ; t0 = rb % SEQ; }
        else { L = CTXL; base = PH + (size_t)NB * PH_W * SEQ + (size_t)((rb - TL) / CTXL) * PH_W * CTXL; t0 = (rb - TL) % CTXL; }
#pragma unroll
        for (int ai = 0; ai < 2; ++ai)
#pragma unroll
          for (int m = 0; m < 4; ++m) {
            const int t = t0 + wr * 64 + fr + ai * 128 + m * 16;
#pragma unroll
            for (int n = 0; n < 2; ++n) {
              const f32x4 v = acc[ai][bj][m][n];
#pragma unroll
              for (int j = 0; j < 4; ++j) base[(size_t)(c0 + n * 16 + j) * L + t] = f2bf(v[j]);
            }
          }
        continue;
      }
      u16* base; int ld, c0;
      if (colh < PA_W) { base = PA; ld = PA_W; c0 = colh; }
      else { base = PR; ld = RW_COLS; c0 = colh - PA_W - PH_W; }
      const int col0 = c0 + wc * 32 + 4 * fq;
#pragma unroll
      for (int ai = 0; ai < 2; ++ai)
#pragma unroll
        for (int m = 0; m < 4; ++m) {
          u16* rowp = base + (size_t)(row0 + ai * 128 + m * 16) * ld + col0;
#pragma unroll
          for (int n = 0; n < 2; ++n) {
            const f32x4 v = acc[ai][bj][m][n];
            u32x2 o; o[0] = pk2(v[0], v[1]); o[1] = pk2(v[2], v[3]);
            *(u32x2*)(rowp + n * 16) = o;
          }
        }
    }
  }
};
struct EpiOutproj {
  const Params* p; int l;
  struct Pre {};
  DI Pre prefetch(const pg8::Unit&, int, int) const { return Pre{}; }
  DI void operator()(const f32x4 (&acc)[2][2][4][2], const pg8::Unit& u, int wr, int wc, int fr, int fq, const Pre&) const {
    const int row0 = u.pm * 256 + wr * 64 + fr, col0 = u.pn * 256 + wc * 32 + 4 * fq;
#pragma unroll
    for (int ai = 0; ai < 2; ++ai)
#pragma unroll
      for (int m = 0; m < 4; ++m) {
        const int r = row0 + ai * 128 + m * 16;
        const float* md = modp(*p, l, r) + 2 * D;
        float* xr = x1row(*p, r);
        const float* xin = (l == 0) ? (r < TL ? p->x + (size_t)r * D : p->ctx + (size_t)(r - TL) * D) : xr;
#pragma unroll
        for (int bj = 0; bj < 2; ++bj)
#pragma unroll
          for (int n = 0; n < 2; ++n) {
            const int c = col0 + bj * 128 + n * 16;
            const f32x4 g1 = *(const f32x4*)(md + c), xv = *(const f32x4*)(xin + c), a = acc[ai][bj][m][n];
            f32x4 o;
#pragma unroll
            for (int j = 0; j < 4; ++j) o[j] = DN_ALPHA * xv[j] + g1[j] * a[j];
            *(f32x4*)(xr + c) = o;
          }
      }
  }
};
struct EpiE1 {
  u16* H; const int* hoff;
  struct Pre {};
  DI Pre prefetch(const pg8::Unit&, int, int) const { return Pre{}; }
  DI void operator()(const f32x4 (&acc)[2][2][4][2], const pg8::Unit& u, int wr, int wc, int fr, int fq, const Pre&) const {
    const int row0 = hoff[u.e] + u.pm * 256 + wr * 64 + fr, col0 = u.pn * 128 + wc * 32 + 4 * fq;
#pragma unroll
    for (int ai = 0; ai < 2; ++ai)
#pragma unroll
      for (int m = 0; m < 4; ++m) {
        u16* rowp = H + (size_t)(row0 + ai * 128 + m * 16) * FF + col0;
#pragma unroll
        for (int n = 0; n < 2; ++n) {
          const f32x4 g = acc[ai][0][m][n], uu = acc[ai][1][m][n];
          u32x2 o; o[0] = pk2(g[0] * fsigmoid_(g[0]) * uu[0], g[1] * fsigmoid_(g[1]) * uu[1]); o[1] = pk2(g[2] * fsigmoid_(g[2]) * uu[2], g[3] * fsigmoid_(g[3]) * uu[3]);
          *(u32x2*)(rowp + n * 16) = o;
        }
      }
  }
};
constexpr float ACC_SCALE = 1024.f;
DI unsigned long long acc_pack4(float a, float b, float c, float d) {
  const long long qa = (long long)(int)rintf(a * ACC_SCALE), qb = (long long)(int)rintf(b * ACC_SCALE);
  const long long qc = (long long)(int)rintf(c * ACC_SCALE), qd = (long long)(int)rintf(d * ACC_SCALE);
  return (unsigned long long)(qa + (qb << 16) + (qc << 32) + (qd << 48));
}
DI void acc_unpack4(unsigned lo, unsigned hi, float& a, float& b, float& c, float& d) {
  long long v = (long long)(((unsigned long long)hi << 32) | (unsigned long long)lo);
  const long long f0 = (long long)(short)(v & 0xffff); v = (v - f0) >> 16;
  const long long f1 = (long long)(short)(v & 0xffff); v = (v - f1) >> 16;
  const long long f2 = (long long)(short)(v & 0xffff); v = (v - f2) >> 16;
  const long long f3 = (long long)(short)(v & 0xffff);
  a = (float)(int)f0 * (1.f / ACC_SCALE); b = (float)(int)f1 * (1.f / ACC_SCALE);
  c = (float)(int)f2 * (1.f / ACC_SCALE); d = (float)(int)f3 * (1.f / ACC_SCALE);
}
struct EpiE2 {
  int* accb; const int* etok; const float* egate; float* xs; u16* sho;
  static constexpr int WSTRIDE = 16 * 36 + 16 + 256;
  struct Pre { int t0, t1; float g0, g1; };
  DI Pre prefetch(const pg8::Unit& u, int wr, int lane) const {
    Pre q; q.t0 = 0; q.t1 = 0; q.g0 = 1.f; q.g1 = 1.f;
    if (u.e < NE) {
      const int s0 = u.pm * 256 + wr * 64 + ((lane >> 4) & 3) * 16 + (lane & 15), s1 = s0 + 128;
      const size_t b = (size_t)u.e * T;
      const size_t i0 = b + (s0 < u.cnt ? s0 : u.pm * 256), i1 = b + (s1 < u.cnt ? s1 : u.pm * 256);
      q.t0 = etok[i0]; q.g0 = egate[i0]; q.t1 = etok[i1]; q.g1 = egate[i1];
    }
    return q;
  }
  DI void operator()(const f32x4 (&acc)[2][2][4][2], const pg8::Unit& u, int wr, int wc, int fr, int fq, const Pre& pq) const {
    if (u.e == NE) {
      const int row0 = u.pm * 256 + wr * 64 + fr, col0 = u.pn * 256 + wc * 32 + 4 * fq;
#pragma unroll
      for (int ai = 0; ai < 2; ++ai)
#pragma unroll
        for (int m = 0; m < 4; ++m) {
          const int r = row0 + ai * 128 + m * 16;
          if (r < u.cnt) {
#pragma unroll
            for (int bj = 0; bj < 2; ++bj)
#pragma unroll
              for (int n = 0; n < 2; ++n) st_bf4(sho + (size_t)r * D + col0 + bj * 128 + n * 16, acc[ai][bj][m][n]);
          }
        }
      return;
    }
    const int lane = fq * 16 + fr, wave = wr * 4 + wc;
    float* X = xs + wave * WSTRIDE;
    int* tk = (int*)(X + 16 * 36);
    int* tokw = tk + 16;
    float* gatew = (float*)(tokw + 128);
    wave_sync();
#pragma unroll
    for (int q = 0; q < 2; ++q) {
      const int lr = lane + 64 * q;
      const int slot = u.pm * 256 + (lr >> 6) * 128 + wr * 64 + ((lr >> 4) & 3) * 16 + (lr & 15);
      const bool valid = slot < u.cnt;
      const int tok = q ? pq.t1 : pq.t0; const float gt = q ? pq.g1 : pq.g0;
      tokw[lr] = valid ? tok : -1; gatew[lr] = valid ? gt : 0.f;
    }
    wave_sync();
#pragma unroll
    for (int ai = 0; ai < 2; ++ai)
#pragma unroll
      for (int m = 0; m < 4; ++m) {
        const int lrow = ai * 64 + m * 16;
        const float gt = gatew[lrow + fr];
#pragma unroll
        for (int bj = 0; bj < 2; ++bj) {
          wave_sync();
#pragma unroll
          for (int n = 0; n < 2; ++n) {
            f32x4 v = acc[ai][bj][m][n];
#pragma unroll
            for (int j = 0; j < 4; ++j) v[j] *= gt;
            *(f32x4*)(X + fr * 36 + n * 16 + fq * 4) = v;
          }
          wave_sync();
          const int cquad = (u.pn * 256 + bj * 128 + wc * 32) / 4 + (lane & 7);
#pragma unroll
          for (int i = 0; i < 2; ++i) {
            const int rr = 8 * i + (lane >> 3);
            const int t2 = tokw[lrow + rr];
            const f32x4 xv = *(const f32x4*)(X + rr * 36 + 4 * (lane & 7));
            if (t2 >= 0) atomicAdd((unsigned long long*)accb + (size_t)t2 * (D / 4) + cquad, acc_pack4(xv[0], xv[1], xv[2], xv[3]));
          }
        }
      }
  }
};

constexpr int TICKET_SLOT_OFF = SMEM_BYTES - 1024 - 64;
template <class F> DI void ticket_loop(unsigned* ctr, int n_items, char* smem, F&& body) {
  int* slot = (int*)(smem + TICKET_SLOT_OFF);
  const int tid = TIDX();
  __syncthreads();
  if (tid == 0) slot[0] = (int)atomicAdd(ctr, 1u);
  __syncthreads();
  for (int k = 0;; ++k) {
    const int it = slot[k & 1];
    if (it >= n_items) break;
    int nx = 0;
    if (tid == 0) nx = (int)atomicAdd(ctr, 1u);
    body(it);
    if (tid == 0) slot[(k + 1) & 1] = nx;
    __syncthreads();
  }
}
DI void ph_prologue(const Params& p, char* smem) {
  const int tid = TIDX();
  constexpr int NCH = 6 * D / 128;
  constexpr int ITEMS_MOD = DEPTH * NCH;
  constexpr int ITEMS_H3 = DEPTH * (SEQ / 64 + CTXL / 64);
  constexpr int ITEMS_CV = DEPTH * CT_STATIC_L;
  constexpr int ITEMS = ITEMS_MOD + ITEMS_H3 + 1;
  for (int item = BIDX(); item < ITEMS; item += gridDim.x) {
    if (item < ITEMS_MOD) {
      const int l = item / NCH, ch = item % NCH;
      float* sv = (float*)smem;
      float* red = sv + (NB + 1) * D;
      {
        constexpr int NSV = ((NB + 1) * D + NT - 1) / NT;
        float cv[NSV];
#pragma unroll
        for (int j = 0; j < NSV; ++j) {
          int i = tid + j * NT; if (i > (NB + 1) * D - 1) i = (NB + 1) * D - 1;
          const int row = i / D, e = i % D;
          const float* src = row < NB ? p.c + row * D : p.c_ctx;
          cv[j] = src[e];
        }
#pragma unroll
        for (int j = 0; j < NSV; ++j) { const int i = tid + j * NT; if (i < (NB + 1) * D) sv[i] = siluf_(cv[j]); }
      }
      __syncthreads();
      const int col = ch * 128 + (tid & 127), kg = tid >> 7;
      float a[NB + 1];
#pragma unroll
      for (int r = 0; r < NB + 1; ++r) a[r] = 0.f;
      const float* W = p.w_ada + (size_t)l * D * 6 * D;
      for (int k = kg * (D / 4); k < (kg + 1) * (D / 4); k += 16) {
        float w[16];
#pragma unroll
        for (int j = 0; j < 16; ++j) w[j] = W[(size_t)(k + j) * 6 * D + col];
#pragma unroll
        for (int j = 0; j < 16; ++j)
#pragma unroll
          for (int r = 0; r < NB + 1; ++r) a[r] += sv[r * D + k + j] * w[j];
      }
#pragma unroll
      for (int r = 0; r < NB + 1; ++r) red[(kg * (NB + 1) + r) * 128 + (tid & 127)] = a[r];
      __syncthreads();
      for (int i = tid; i < (NB + 1) * 128; i += NT) {
        int r = i / 128, cc = i % 128;
        float s = 0.f;
        for (int g = 0; g < 4; ++g) s += red[(g * (NB + 1) + r) * 128 + cc];
        int cg_ = ch * 128 + cc;
        p.mod[((size_t)l * (NB + 1) + r) * 6 * D + cg_] = s + p.b_ada[(size_t)l * 6 * D + cg_];
      }
      __syncthreads();
    } else if (item < ITEMS_MOD + ITEMS_H3) {
      int it = item - ITEMS_MOD;
      constexpr int PER_L = SEQ / 64 + CTXL / 64;
      const int l = it / PER_L;
      int q = it % PER_L;
      const bool isctx = q >= SEQ / 64;
      const int L = isctx ? CTXL : SEQ;
      const int pos0 = (isctx ? q - SEQ / 64 : q) * 64;
      float* z = (float*)smem;
      float* ha = z + 64 * 36;
      float* hb = ha + 64 * 64;
      float* w1s = hb + 64 * 64;
      float* w2s = w1s + HY_EMB * HY_HID;
      float* w3s = w2s + HY_HID * HY_HID;
      {
        constexpr int N1 = (HY_EMB * HY_HID + NT - 1) / NT, N2 = (HY_HID * HY_HID + NT - 1) / NT;
        float a1[N1], a2[N2], a3[N2];
        const float* g1 = p.hf_w1 + (size_t)l * HY_EMB * HY_HID;
        const float* g2 = p.hf_w2 + (size_t)l * HY_HID * HY_HID;
        const float* g3 = p.hf_w3 + (size_t)l * HY_HID * HY_HID;
#pragma unroll
        for (int j = 0; j < N1; ++j) { int i = tid + j * NT; if (i > HY_EMB * HY_HID - 1) i = HY_EMB * HY_HID - 1; a1[j] = g1[i]; }
#pragma unroll
        for (int j = 0; j < N2; ++j) { int i = tid + j * NT; if (i > HY_HID * HY_HID - 1) i = HY_HID * HY_HID - 1; a2[j] = g2[i]; a3[j] = g3[i]; }
#pragma unroll
        for (int j = 0; j < N1; ++j) { const int i = tid + j * NT; if (i < HY_EMB * HY_HID) w1s[i] = a1[j]; }
#pragma unroll
        for (int j = 0; j < N2; ++j) { const int i = tid + j * NT; if (i < HY_HID * HY_HID) { w2s[i] = a2[j]; w3s[i] = a3[j]; } }
      }
      for (int i = tid; i < 64 * HY_EMB; i += NT) {
        int pp = i / HY_EMB, e = i % HY_EMB;
        int pos = pos0 + pp;
        float v;
        if (e == 0) v = (float)pos / (float)(L - 1);
        else {
          int bi = (e - 1) % HY_BANDS;
          float band = 1e-4f + ((float)(HY_BANDS - 1) - 1e-4f) * (float)bi / (float)(HY_BANDS - 1);
          float ang = (2.0f * 3.14159265358979323846f / (float)L) * (float)pos * band;
          v = (e - 1) < HY_BANDS ? cosf(ang) : -sinf(ang);
        }
        z[pp * 36 + e] = v;
      }
      __syncthreads();
      const int pp = tid >> 3, sub = tid & 7;
      const float* fr = p.hf_freq + l * HY_HID;
      {
        const float* b = p.hf_b1 + l * HY_HID;
        float acc8[8];
#pragma unroll
        for (int uu = 0; uu < 8; ++uu) acc8[uu] = b[sub * 8 + uu];
        for (int e = 0; e < HY_EMB; ++e) {
          const float zv = z[pp * 36 + e];
#pragma unroll
          for (int uu = 0; uu < 8; ++uu) acc8[uu] += zv * w1s[e * HY_HID + sub * 8 + uu];
        }
#pragma unroll 1
        for (int uu = 0; uu < 8; ++uu) ha[pp * 64 + sub * 8 + uu] = sinf(fr[sub * 8 + uu] * acc8[uu]);
      }
      __syncthreads();
      {
        const float* b = p.hf_b2 + l * HY_HID;
        float acc8[8];
#pragma unroll
        for (int uu = 0; uu < 8; ++uu) acc8[uu] = b[sub * 8 + uu];
        for (int e = 0; e < HY_HID; ++e) {
          const float zv = ha[pp * 64 + e];
#pragma unroll
          for (int uu = 0; uu < 8; ++uu) acc8[uu] += zv * w2s[e * HY_HID + sub * 8 + uu];
        }
#pragma unroll 1
        for (int uu = 0; uu < 8; ++uu) hb[pp * 64 + sub * 8 + uu] = sinf(fr[sub * 8 + uu] * acc8[uu]);
      }
      __syncthreads();
      {
        const float* b = p.hf_b3 + l * HY_HID;
        float* dst = isctx ? p.h3ctx + ((size_t)l * CTXL + pos0) * 64 : p.h3lat + ((size_t)l * SEQ + pos0) * 64;
        float acc8[8];
#pragma unroll
        for (int uu = 0; uu < 8; ++uu) acc8[uu] = b[sub * 8 + uu];
        for (int e = 0; e < HY_HID; ++e) {
          const float zv = hb[pp * 64 + e];
#pragma unroll
          for (int uu = 0; uu < 8; ++uu) acc8[uu] += zv * w3s[e * HY_HID + sub * 8 + uu];
        }
#pragma unroll 1
        for (int uu = 0; uu < 8; ++uu) dst[pp * 64 + sub * 8 + uu] = sinf(fr[sub * 8 + uu] * acc8[uu]);
      }
      __syncthreads();
    } else {
      for (int k = tid; k < FFTN / 2; k += NT) {
        double ang = -2.0 * 3.14159265358979323846 * (double)k / (double)FFTN;
        cf w; w.x = (float)cos(ang); w.y = (float)sin(ang);
        p.tw[k] = w;
      }
      for (int i = tid; i < DEPTH * NE; i += NT) p.cnt[i] = 0;
    }
  }
  ticket_loop(p.bar + XB_TICKET, ITEMS_CV, smem, [&](int it) { convert_static_item(p, it, smem); });
}

DI void ph_premod(const Params& p) {
  const int tid = TIDX();
  constexpr int ITEMS = T / 8;
  constexpr int NI = 8 * D / 4 / NT;
  static_assert(NI * NT * 4 == 8 * D, "premod tiling");
  for (int item = BIDX(); item < ITEMS; item += gridDim.x) {
    f32x4 xv[NI], sc[NI], sh[NI];
#pragma unroll
    for (int k = 0; k < NI; ++k) {
      const int i = tid + k * NT;
      const int r = item * 8 + i / (D / 4), e = (i % (D / 4)) * 4;
      const float* m = modp(p, 0, r);
      const float* src = r < TL ? p.x + (size_t)r * D : p.ctx + (size_t)(r - TL) * D;
      xv[k] = *(const f32x4*)(src + e); sc[k] = *(const f32x4*)(m + D + e); sh[k] = *(const f32x4*)(m + e);
    }
#pragma unroll
    for (int k = 0; k < NI; ++k) {
      const int i = tid + k * NT;
      const int r = item * 8 + i / (D / 4), e = (i % (D / 4)) * 4;
      f32x4 o;
#pragma unroll
      for (int j = 0; j < 4; ++j) o[j] = xv[k][j] * (1.f + sc[k][j]) + sh[k][j];
      st_bf4(p.HL + (size_t)r * D + e, o);
    }
  }
}

DI int fpad(int i) { return i + (i >> 4); }
constexpr int FFT_LDS = FFTN + FFTN / 16;
__device__ static constexpr float C16[8] = {1.f, 0.92387953251128674f, 0.70710678118654752f, 0.38268343236508977f, 0.f, -0.38268343236508977f, -0.70710678118654752f, -0.92387953251128674f};
__device__ static constexpr float S16[8] = {0.f, 0.38268343236508977f, 0.70710678118654752f, 0.92387953251128674f, 1.f, 0.92387953251128674f, 0.70710678118654752f, 0.38268343236508977f};
template <int R, bool INV>
DI void fft_pass(cf* buf, const cf* tw, int m) {
  const int g = m >> (R - 1);
  constexpr int NQ = 1 << R;
  for (int w = TIDX(); w < (FFTN >> R); w += NT) {
    const int j = w % g, blk = w / g;
    const int base = blk * (g << R) + j;
    cf v[NQ];
#pragma unroll
    for (int q = 0; q < NQ; ++q) v[q] = buf[fpad(base + q * g)];
    cf bt[R];
    bt[0] = tw[j * ((FFTN / 2) / ((NQ / 2) * g))];
#pragma unroll
    for (int r = 1; r < R; ++r) { bt[r].x = bt[r - 1].x * bt[r - 1].x - bt[r - 1].y * bt[r - 1].y; bt[r].y = 2.f * bt[r - 1].x * bt[r - 1].y; }
    if (!INV) {
#pragma unroll
      for (int r = 0; r < R; ++r) {
        const int half = 1 << (R - 1 - r);
#pragma unroll
        for (int q = 0; q < NQ; ++q) {
          if ((q & half) == 0) {
            const int qq = q & (half - 1);
            const int ci = qq * (8 / half);
            cf W;
            W.x = bt[r].x * C16[ci] + bt[r].y * S16[ci];
            W.y = bt[r].y * C16[ci] - bt[r].x * S16[ci];
            cf a = v[q], b = v[q + half];
            v[q].x = a.x + b.x; v[q].y = a.y + b.y;
            float dx = a.x - b.x, dy = a.y - b.y;
            v[q + half].x = dx * W.x - dy * W.y;
            v[q + half].y = dx * W.y + dy * W.x;
          }
        }
      }
    } else {
#pragma unroll
      for (int r = R - 1; r >= 0; --r) {
        const int half = 1 << (R - 1 - r);
#pragma unroll
        for (int q = 0; q < NQ; ++q) {
          if ((q & half) == 0) {
            const int qq = q & (half - 1);
            const int ci = qq * (8 / half);
            cf W;
            W.x = bt[r].x * C16[ci] + bt[r].y * S16[ci];
            W.y = bt[r].y * C16[ci] - bt[r].x * S16[ci];
            cf a = v[q], b = v[q + half];
            float bx = b.x * W.x + b.y * W.y;
            float by = b.y * W.x - b.x * W.y;
            v[q].x = a.x + bx; v[q].y = a.y + by;
            v[q + half].x = a.x - bx; v[q + half].y = a.y - by;
          }
        }
      }
    }
#pragma unroll
    for (int q = 0; q < NQ; ++q) buf[fpad(base + q * g)] = v[q];
  }
}
constexpr int FFT_R4 = LOG2N / 4, FFT_REM = LOG2N % 4;
DI void fft_fwd_main(cf* buf, const cf* tw) {
  int m = FFTN / 2;
#pragma unroll
  for (int i = 0; i < FFT_R4; ++i) { fft_pass<4, false>(buf, tw, m); __syncthreads(); m >>= 4; }
}
DI void fft_fwd_tail(cf* buf, const cf* tw) {
  if (FFT_REM == 3) { fft_pass<3, false>(buf, tw, 4); __syncthreads(); }
  if (FFT_REM == 2) { fft_pass<2, false>(buf, tw, 2); __syncthreads(); }
  if (FFT_REM == 1) { fft_pass<1, false>(buf, tw, 1); __syncthreads(); }
}
DI void fft_fwd(cf* buf, const cf* tw) { fft_fwd_main(buf, tw); fft_fwd_tail(buf, tw); }
DI void fft_inv_tail(cf* buf, const cf* tw) {
  if (FFT_REM == 3) { fft_pass<3, true>(buf, tw, 4); __syncthreads(); }
  if (FFT_REM == 2) { fft_pass<2, true>(buf, tw, 2); __syncthreads(); }
  if (FFT_REM == 1) { fft_pass<1, true>(buf, tw, 1); __syncthreads(); }
}
DI void fft_inv_main(cf* buf, const cf* tw) {
  int m = (1 << FFT_REM) * 8;
#pragma unroll
  for (int i = 0; i < FFT_R4; ++i) { fft_pass<4, true>(buf, tw, m); __syncthreads(); m <<= 4; }
}
DI void tw_to_lds(cf* tw, const cf* __restrict__ gtw) {
  constexpr int NIT = (FFTN / 4 + NT - 1) / NT;
  f32x4 t4[NIT];
#pragma unroll
  for (int j = 0; j < NIT; ++j) { int i = TIDX() + j * NT; if (i > FFTN / 4 - 1) i = FFTN / 4 - 1; t4[j] = ((const f32x4*)gtw)[i]; }
#pragma unroll
  for (int j = 0; j < NIT; ++j) { const int i = TIDX() + j * NT; if (i < FFTN / 4) ((f32x4*)tw)[i] = t4[j]; }
}
constexpr int MID_IT = (FFTN / 2 + NT - 1) / NT;
struct MidSpec { f32x4 k[MID_IT]; };
DI MidSpec fft_mid_prefetch(const cf* __restrict__ sp) {
  MidSpec m;
#pragma unroll
  for (int j = 0; j < MID_IT; ++j) {
    int i = TIDX() + j * NT; if (i > FFTN / 2 - 1) i = FFTN / 2 - 1;
    m.k[j] = *(const f32x4*)(sp + 2 * i);
  }
  return m;
}
DI void fft_mid(cf* buf, const cf* tw, const cf* __restrict__ sp, const MidSpec& ms) {
  if (FFT_REM == 1) {
#pragma unroll
    for (int j = 0; j < MID_IT; ++j) {
      const int i = TIDX() + j * NT;
      if (i >= FFTN / 2) break;
      const cf a = buf[fpad(2 * i)], b = buf[fpad(2 * i + 1)];
      cf A, B;
      A.x = a.x + b.x; A.y = a.y + b.y; B.x = a.x - b.x; B.y = a.y - b.y;
      const f32x4 k = ms.k[j];
      cf P, Q;
      P.x = A.x * k[0] - A.y * k[1]; P.y = A.x * k[1] + A.y * k[0];
      Q.x = B.x * k[2] - B.y * k[3]; Q.y = B.x * k[3] + B.y * k[2];
      cf o0, o1;
      o0.x = P.x + Q.x; o0.y = P.y + Q.y; o1.x = P.x - Q.x; o1.y = P.y - Q.y;
      buf[fpad(2 * i)] = o0; buf[fpad(2 * i + 1)] = o1;
    }
    __syncthreads();
  } else {
    fft_fwd_tail(buf, tw);
    for (int i = TIDX(); i < FFTN; i += NT) {
      cf a = buf[fpad(i)], k = sp[i], r;
      r.x = a.x * k.x - a.y * k.y; r.y = a.x * k.y + a.y * k.x;
      buf[fpad(i)] = r;
    }
    __syncthreads();
    fft_inv_tail(buf, tw);
  }
}

DI float hy_delta(int c) {
  const float lo = -4.605170185988091f / 1.5f, hi = -4.605170185988091f / 0.3f;
  return fabsf(lo + (hi - lo) * (float)c / (float)(HY_CH - 1));
}

DI void hy_spectrum_item(const Params& p, int l, int o, int c, char* smem) {
  const int tid = TIDX();
  cf* buf = (cf*)smem;
  cf* tw = buf + FFT_LDS;
  float* wc = (float*)(tw + FFTN / 2);
  tw_to_lds(tw, p.tw);
  if (tid < 128) {
    int dir = tid >> 6, u = tid & 63;
    wc[tid] = p.hf_wout[((size_t)l * HY_HID + u) * (4 * HY_CH) + o * 2 * HY_CH + dir * HY_CH + c];
  }
  __syncthreads();
  const float dl = hy_delta(c);
  {
    const int q = tid & 15, rr = tid >> 4;
    constexpr int RPP = NT / 16;
    constexpr int UNR = (SEQ / RPP) % 8 == 0 ? 8 : 1;
    const f32x4 wf = *(const f32x4*)(wc + 4 * q), wb = *(const f32x4*)(wc + 64 + 4 * q);
    const float* hbase = p.h3lat + (size_t)l * SEQ * 64 + 4 * q;
    for (int t0 = 0; t0 < SEQ; t0 += RPP * UNR) {
      f32x4 hv[UNR];
#pragma unroll
      for (int j = 0; j < UNR; ++j) hv[j] = *(const f32x4*)(hbase + (size_t)(t0 + j * RPP + rr) * 64);
#pragma unroll
      for (int j = 0; j < UNR; ++j) {
        const int t = t0 + j * RPP + rr;
        float sf = (hv[j][0] * wf[0] + hv[j][1] * wf[1]) + (hv[j][2] * wf[2] + hv[j][3] * wf[3]);
        float sb = (hv[j][0] * wb[0] + hv[j][1] * wb[1]) + (hv[j][2] * wb[2] + hv[j][3] * wb[3]);
        sf = red16(sf); sb = red16(sb);
        if (q == 0) {
          const float dec = expf(-((float)t / (float)(SEQ - 1)) * dl);
          cf a; a.x = sf * dec; a.y = 0.f;
          buf[fpad(t)] = a;
          if (t >= 1) { cf b; b.x = sb * dec; b.y = 0.f; buf[fpad(FFTN - t)] = b; }
          if (t == 0) { cf zz; zz.x = 0.f; zz.y = 0.f; buf[fpad(SEQ)] = zz; }
        }
      }
    }
  }
  __syncthreads();
  fft_fwd(buf, tw);
  cf* dst = p.spec + ((size_t)o * HY_CH + c) * FFTN;
  const float sc = 1.0f / (float)FFTN;
  for (int i = tid; i < FFTN; i += NT) { cf v = buf[fpad(i)]; v.x *= sc; v.y *= sc; dst[i] = v; }
  __syncthreads();
}

DI void ph_inproj(const Params& p, int l, char* smem) {
  constexpr int SPEC_ITEMS = 2 * HY_CH;
  const int G = gridDim.x, c = BIDX();
  {
    DenseSched S; S.init(p.HL, p.wt_in + (size_t)l * P_IN_PAD * D, D, T, P_IN_PAD, G, c);
    EpiInproj E{p.PA, p.PH, p.PR};
    pg8::gemm_phase(smem, D, S, E);
  }
  __syncthreads();
  (void)c;
  ticket_loop(p.bar + XB_TICKET + 1 + l, SPEC_ITEMS, smem, [&](int it) { hy_spectrum_item(p, l, it / HY_CH, it % HY_CH, smem); });
}

DI float hy_u(const u16* P, int t, int L, float w0, float w1, float w2, float bias) {
  const bool hp = t >= 1, hn = t + 1 < L;
  const float c = bf2f(P[t]), a = bf2f(P[hp ? t - 1 : t]), b = bf2f(P[hn ? t + 1 : t]);
  return w1 * c + bias + (hp ? w0 : 0.f) * a + (hn ? w2 : 0.f) * b;
}

struct HyRaw { u32x4 x; u16 prev, next; };
DI HyRaw hy_load8(const u16* P, int t0, int L) {
  HyRaw r;
  r.x = *(const u32x4*)(P + t0);
  r.prev = P[t0 >= 1 ? t0 - 1 : t0];
  r.next = P[t0 + 8 < L ? t0 + 8 : t0 + 7];
  return r;
}
DI void hy_conv8(const HyRaw& r, int t0, int L, float w0, float w1, float w2, float bias, float (&out)[8]) {
  float x[10];
  x[0] = bf2f(r.prev);
#pragma unroll
  for (int j = 0; j < 4; ++j) { x[1 + 2 * j] = bf2f((u16)(r.x[j] & 0xffff)); x[2 + 2 * j] = bf2f((u16)(r.x[j] >> 16)); }
  x[9] = bf2f(r.next);
  const float wp = t0 >= 1 ? w0 : 0.f, wn = t0 + 8 < L ? w2 : 0.f;
#pragma unroll
  for (int j = 0; j < 8; ++j) out[j] = w1 * x[1 + j] + bias + (j == 0 ? wp : w0) * x[j] + (j == 7 ? wn : w2) * x[2 + j];
}

DI void hyena_lat_item(const Params& p, int l, int c, int pair, char* smem, bool load_tw) {
  const int tid = TIDX();
  cf* buf = (cf*)smem;
  cf* tw = buf + FFT_LDS;
  const float* cw = p.hy_sconv_w + (size_t)l * 3 * PH_W;
  const float* cb = p.hy_sconv_b + (size_t)l * PH_W;
  const int b0 = pair * 2, b1 = pair * 2 + 1;
  const int t0 = tid * 8;
  const bool act = t0 < SEQ;
  const int tl = act ? t0 : 0;
  HyRaw rw[3][2];
#pragma unroll
  for (int q = 0; q < 3; ++q) {
    rw[q][0] = hy_load8(p.PH + ((size_t)b0 * PH_W + q * HY_CH + c) * SEQ, tl, SEQ);
    rw[q][1] = hy_load8(p.PH + ((size_t)b1 * PH_W + q * HY_CH + c) * SEQ, tl, SEQ);
  }
  if (load_tw) tw_to_lds(tw, p.tw);
  const MidSpec ms0 = fft_mid_prefetch(p.spec + ((size_t)0 * HY_CH + c) * FFTN);
  float vr[2][8], z1[2][8];
  {
    const int col = c;
    const float w0 = cw[col], w1 = cw[PH_W + col], w2 = cw[2 * PH_W + col], bs = cb[col];
    hy_conv8(rw[0][0], tl, SEQ, w0, w1, w2, bs, vr[0]);
    hy_conv8(rw[0][1], tl, SEQ, w0, w1, w2, bs, vr[1]);
    if (act) {
#pragma unroll
      for (int j = 0; j < 8; ++j) {
        cf a; a.x = vr[0][j]; a.y = vr[1][j];
        buf[fpad(t0 + j)] = a;
        cf zz; zz.x = 0.f; zz.y = 0.f;
        buf[fpad(t0 + j + SEQ)] = zz;
      }
    }
  }
  __syncthreads();
  fft_fwd_main(buf, tw);
  fft_mid(buf, tw, p.spec + ((size_t)0 * HY_CH + c) * FFTN, ms0);
  const MidSpec ms1 = fft_mid_prefetch(p.spec + ((size_t)1 * HY_CH + c) * FFTN);
  fft_inv_main(buf, tw);
  {
    const int col = HY_CH + c;
    const float w0 = cw[col], w1 = cw[PH_W + col], w2 = cw[2 * PH_W + col], bs = cb[col];
    const float sk = p.hf_skip[((size_t)l * 2 + 0) * HY_CH + c];
    float x1a[8], x1b[8];
    hy_conv8(rw[1][0], tl, SEQ, w0, w1, w2, bs, x1a);
    hy_conv8(rw[1][1], tl, SEQ, w0, w1, w2, bs, x1b);
    cf yv[8];
    if (act) {
#pragma unroll
      for (int j = 0; j < 8; ++j) yv[j] = buf[fpad(t0 + j)];
    }
    __syncthreads();
    if (act) {
#pragma unroll
      for (int j = 0; j < 8; ++j) {
        z1[0][j] = (yv[j].x + sk * vr[0][j]) * x1a[j];
        z1[1][j] = (yv[j].y + sk * vr[1][j]) * x1b[j];
        cf a; a.x = z1[0][j]; a.y = z1[1][j];
        buf[fpad(t0 + j)] = a;
        cf zz; zz.x = 0.f; zz.y = 0.f;
        buf[fpad(t0 + j + SEQ)] = zz;
      }
    }
  }
  __syncthreads();
  fft_fwd_main(buf, tw);
  fft_mid(buf, tw, p.spec + ((size_t)1 * HY_CH + c) * FFTN, ms1);
  fft_inv_main(buf, tw);
  {
    const int col = 2 * HY_CH + c;
    const float w0 = cw[col], w1 = cw[PH_W + col], w2 = cw[2 * PH_W + col], bs = cb[col];
    const float sk = p.hf_skip[((size_t)l * 2 + 1) * HY_CH + c];
    float x2a[8], x2b[8];
    hy_conv8(rw[2][0], tl, SEQ, w0, w1, w2, bs, x2a);
    hy_conv8(rw[2][1], tl, SEQ, w0, w1, w2, bs, x2b);
    if (act) {
      u32x4 oa, ob;
#pragma unroll
      for (int j = 0; j < 4; ++j) {
        const cf y0 = buf[fpad(t0 + 2 * j)], y1 = buf[fpad(t0 + 2 * j + 1)];
        oa[j] = pk2((y0.x + sk * z1[0][2 * j]) * x2a[2 * j], (y1.x + sk * z1[0][2 * j + 1]) * x2a[2 * j + 1]);
        ob[j] = pk2((y0.y + sk * z1[1][2 * j]) * x2b[2 * j], (y1.y + sk * z1[1][2 * j + 1]) * x2b[2 * j + 1]);
      }
      *(u32x4*)(p.yhlat + ((size_t)b0 * HY_CH + c) * SEQ + t0) = oa;
      *(u32x4*)(p.yhlat + ((size_t)b1 * HY_CH + c) * SEQ + t0) = ob;
    }
  }
  __syncthreads();
}

DI void hyena_ctx_item(const Params& p, int l, int c, char* smem) {
  const int tid = TIDX();
  float* taps = (float*)smem;
  float* uv = taps + 4 * CTXL;
  float* zb = uv + NB * 3 * CTXL;
  float* wc = zb + NB * CTXL;
  if (tid < 256) {
    int od = tid >> 6, u = tid & 63;
    wc[tid] = p.hf_wout[((size_t)l * HY_HID + u) * (4 * HY_CH) + od * HY_CH + c];
  }
  __syncthreads();
  const float dl = hy_delta(c);
  for (int i = tid; i < 4 * CTXL; i += NT) {
    int od = i / CTXL, t = i % CTXL;
    const float* h = p.h3ctx + ((size_t)l * CTXL + t) * 64;
    float s = 0.f;
    for (int u = 0; u < 64; ++u) s += h[u] * wc[od * 64 + u];
    taps[i] = s * expf(-((float)t / (float)(CTXL - 1)) * dl);
  }
  const float* cw = p.hy_sconv_w + (size_t)l * 3 * PH_W;
  const float* cb = p.hy_sconv_b + (size_t)l * PH_W;
  for (int i = tid; i < NB * 3 * CTXL; i += NT) {
    int b = i / (3 * CTXL), j = (i / CTXL) % 3, t = i % CTXL;
    int col = j * HY_CH + c;
    const u16* P = p.PH + (size_t)NB * PH_W * SEQ + ((size_t)b * PH_W + col) * CTXL;
    uv[i] = hy_u(P, t, CTXL, cw[col], cw[PH_W + col], cw[2 * PH_W + col], cb[col]);
  }
  __syncthreads();
  const float sk0 = p.hf_skip[((size_t)l * 2 + 0) * HY_CH + c], sk1 = p.hf_skip[((size_t)l * 2 + 1) * HY_CH + c];
  for (int i = tid; i < NB * CTXL; i += NT) {
    int b = i / CTXL, t = i % CTXL;
    const float* v = uv + (b * 3 + 0) * CTXL;
    float s = 0.f;
    for (int s_ = 0; s_ < CTXL; ++s_) {
      int lag = t - s_;
      float k = lag >= 0 ? taps[0 * CTXL + lag] : taps[1 * CTXL - lag];
      s += k * v[s_];
    }
    zb[i] = (s + sk0 * v[t]) * uv[(b * 3 + 1) * CTXL + t];
  }
  __syncthreads();
  for (int i = tid; i < NB * CTXL; i += NT) {
    int b = i / CTXL, t = i % CTXL;
    const float* v = zb + b * CTXL;
    float s = 0.f;
    for (int s_ = 0; s_ < CTXL; ++s_) {
      int lag = t - s_;
      float k = lag >= 0 ? taps[2 * CTXL + lag] : taps[3 * CTXL - lag];
      s += k * v[s_];
    }
    p.yhctx[((size_t)b * HY_CH + c) * CTXL + t] = f2bf((s + sk1 * v[t]) * uv[(b * 3 + 2) * CTXL + t]);
  }
  __syncthreads();
}

DI void mixer_a_item(const Params& p, int l, int tile) {
  const int tid = TIDX(), lane = tid & 63, wave = tid >> 6;
  const int ts = lane >> 4, cq = lane & 15;
  constexpr int NBK = CONV_CH / 64;
  const float* cw = p.conv_a + (size_t)l * 3 * CONV_CH;
  const float* gn = p.mix_norm_g + (size_t)l * (CONV_CH + HY_CH);
#pragma unroll
  for (int it = 0; it < 2; ++it) {
    const int r = tile * 64 + wave * 8 + it * 4 + ts;
    int rp = r, rn = r;
    bool hp = false, hn = false;
    if (r < TL) { const int t = r % SEQ; hp = t >= GRID_W; hn = t + GRID_W < SEQ; if (hp) rp = r - GRID_W; if (hn) rn = r + GRID_W; }
    else { const int t = (r - TL) % CTXL; hp = t >= 1; hn = t + 1 < CTXL; if (hp) rp = r - 1; if (hn) rn = r + 1; }
    const float fp = hp ? 1.f : 0.f, fn = hn ? 1.f : 0.f;
    const u16* row = p.PA + (size_t)r * PA_W;
    const u16* qp = p.PA + (size_t)rp * PA_W;
    const u16* qn = p.PA + (size_t)rn * PA_W;
    float yv[NBK][4];
    float ss = 0.f;
#pragma unroll
    for (int bk = 0; bk < NBK; ++bk) {
      const int c = bk * 64 + cq * 4;
      const f32x4 bg = ld_bf4(row + c);
      const f32x4 c0 = ld_bf4(row + CONV_CH + c), x0 = ld_bf4(row + 2 * CONV_CH + c);
      const f32x4 c1 = ld_bf4(qp + CONV_CH + c), x1 = ld_bf4(qp + 2 * CONV_CH + c);
      const f32x4 c2 = ld_bf4(qn + CONV_CH + c), x2 = ld_bf4(qn + 2 * CONV_CH + c);
      const f32x4 w0 = *(const f32x4*)(cw + c), w1 = *(const f32x4*)(cw + CONV_CH + c), w2 = *(const f32x4*)(cw + 2 * CONV_CH + c);
#pragma unroll
      for (int j = 0; j < 4; ++j) {
        const float z = c0[j] * x0[j] * w1[j] + fp * w0[j] * (c1[j] * x1[j]) + fn * w2[j] * (c2[j] * x2[j]);
        yv[bk][j] = bg[j] * z;
        ss += yv[bk][j] * yv[bk][j];
      }
    }
    ss = red16(ss);
    const float rs = rsqrtf(ss / (float)CONV_CH + LN_EPS);
#pragma unroll
    for (int bk = 0; bk < NBK; ++bk) {
      const int c = bk * 64 + cq * 4;
      const f32x4 g4 = *(const f32x4*)(gn + c);
      f32x4 o;
#pragma unroll
      for (int j = 0; j < 4; ++j) o[j] = yv[bk][j] * rs * g4[j];
      st_bf4(p.ya + (size_t)r * CONV_CH + c, o);
    }
  }
}

DI void ph_mix(const Params& p, int l, char* smem) {
  const bool need_ctx = (l == 0);
  constexpr int HL_ITEMS = HY_CH * (NB / 2);
  const int HC_ITEMS = need_ctx ? HY_CH : 0;
  const int MA_ITEMS = (need_ctx ? T : TL) / 64;
  const int total = HL_ITEMS + HC_ITEMS + MA_ITEMS;
  SEG_BEGIN(p)
  bool tw_loaded = false;
  ticket_loop(p.bar + XB_TICKET + 1 + 2 * DEPTH + l, total, smem, [&](int item) {
    if (item < HL_ITEMS) { hyena_lat_item(p, l, item / (NB / 2), item % (NB / 2), smem, !tw_loaded); tw_loaded = true; SEG_MARK(p, 9) }
    else if (item < HL_ITEMS + HC_ITEMS) { hyena_ctx_item(p, l, item - HL_ITEMS, smem); SEG_MARK(p, 10) }
    else { mixer_a_item(p, l, item - HL_ITEMS - HC_ITEMS); SEG_MARK(p, 11) }
  });
}

DI void seq_of_row(int r, int& b, int& t, int& L) {
  if (r < TL) { b = r / SEQ; t = r % SEQ; L = SEQ; }
  else { int rc = r - TL; b = rc / CTXL; t = rc % CTXL; L = CTXL; }
}
DI float rw_u(const Params& p, const float* mu, int r, int t, int L, int col) {
  const float m0 = mu[col], m2 = mu[RW_COLS + col];
  float s = (1.f - m0 - m2) * bf2f(p.PR[(size_t)r * RW_COLS + col]);
  if (t >= 1) s += m0 * bf2f(p.PR[(size_t)(r - 1) * RW_COLS + col]);
  if (t + 1 < L) s += m2 * bf2f(p.PR[(size_t)(r + 1) * RW_COLS + col]);
  return s;
}
DI bf16x8 load_bfrag(const float* W, int ldn, int k0, int col, int lane) {
  const float* q = W + (size_t)(k0 + 8 * (lane >> 5)) * ldn + col + (lane & 31);
  bf16x8 b;
#pragma unroll
  for (int j = 0; j < 8; ++j) b[j] = (short)f2bf(q[(size_t)j * ldn]);
  return b;
}

DI f32x4 rw_u4(const Params& p, const float* mu, int r, int t, int L, int col) {
  const f32x4 m0 = *(const f32x4*)(mu + col), m2 = *(const f32x4*)(mu + RW_COLS + col);
  const bool hp = t >= 1, hn = t + 1 < L;
  const f32x4 c = ld_bf4(p.PR + (size_t)r * RW_COLS + col);
  const f32x4 a = ld_bf4(p.PR + (size_t)(hp ? r - 1 : r) * RW_COLS + col);
  const f32x4 b = ld_bf4(p.PR + (size_t)(hn ? r + 1 : r) * RW_COLS + col);
  const float fp = hp ? 1.f : 0.f, fn = hn ? 1.f : 0.f;
  f32x4 s;
#pragma unroll
  for (int i = 0; i < 4; ++i) s[i] = (1.f - m0[i] - m2[i]) * c[i] + (fp * m0[i]) * a[i] + (fn * m2[i]) * b[i];
  return s;
}
DI bf16x8 ld_bfrag_t(const u16* Wt, int K, int k0, int col, int lane) {
  return *(const bf16x8*)(Wt + (size_t)(col + (lane & 31)) * K + k0 + 8 * (lane >> 5));
}

DI void prep_item(const Params& p, int l, int tile, char* smem) {
  const int tid = TIDX(), lane = tid & 63, wave = tid >> 6;
  constexpr int LA = 72, LG = 136, LX = 68;
  constexpr int XW = 32 * LX + 64;
  u16* Awd = (u16*)smem;
  u16* Aad = Awd + 2 * 32 * LA;
  u16* Agd = Aad + 2 * 32 * LA;
  float* Xall = (float*)(Agd + 32 * LG);
  const float* mu = p.rw_mu + (size_t)l * 2 * RW_COLS;
  const int r0 = tile * 32;
  int b_, t0, L;
  seq_of_row(r0, b_, t0, L);
  SEG_BEGIN(p)
#pragma unroll 2
  for (int i = tid; i < 32 * 96; i += NT) {
    const int tok = i / 96, c4 = (i % 96) * 4;
    f32x4 u = rw_u4(p, mu, r0 + tok, t0 + tok, L, 3 * RW_CH + c4);
    if (c4 < 128) { f32x4 o; for (int j = 0; j < 4; ++j) o[j] = ftanh_(u[j]); st_bf4(Awd + ((c4 >> 6) * 32 + tok) * LA + (c4 & 63), o); }
    else if (c4 < 256) { int c2 = c4 - 128; st_bf4(Aad + ((c2 >> 6) * 32 + tok) * LA + (c2 & 63), u); }
    else { f32x4 o; for (int j = 0; j < 4; ++j) o[j] = fsigmoid_(u[j]); st_bf4(Agd + tok * LG + (c4 - 256), o); }
  }
  __syncthreads();
  SEG_MARK(p, 4)
  const int ts = lane >> 4, cq = lane & 15;
  if (wave < RW_H) {
    const int h = wave;
    float* X = Xall + (size_t)wave * XW;
    float* rinvw = X + 32 * LX;
    float* sbw = rinvw + 32;
    const size_t seqidx0 = (size_t)(b_ * RW_H + h) * L + t0;
    u16* sish = (r0 < TL ? p.SIsh_lat : p.SIsh_ctx);
    u16* sidir = (r0 < TL ? p.SIdir_lat : p.SIdir_ctx);
    const size_t dirstride = (size_t)NB * RW_H * L * 192;
    const int ch = h * 64 + cq * 4;
    const f32x4 kkc = *(const f32x4*)(p.rw_k_k + (size_t)l * RW_CH + ch);
    const f32x4 k_a = *(const f32x4*)(p.rw_k_a + (size_t)l * RW_CH + ch);
    const f32x4 r_k = *(const f32x4*)(p.rw_r_k + (size_t)l * RW_CH + ch);
    auto gemm_to_X = [&](const u16* Atile, int lda_, int arow0, const u16* Wt, int K) {
      f32x16 c0, c1;
#pragma unroll
      for (int r = 0; r < 16; ++r) { c0[r] = 0.f; c1[r] = 0.f; }
#pragma unroll 4
      for (int k0 = 0; k0 < K; k0 += 16) {
        bf16x8 a1 = *(const bf16x8*)(Atile + (arow0 + (lane & 31)) * lda_ + k0 + (lane >> 5) * 8);
        c0 = MFMA32(a1, ld_bfrag_t(Wt, K, k0, h * 64, lane), c0);
        c1 = MFMA32(a1, ld_bfrag_t(Wt, K, k0, h * 64 + 32, lane), c1);
      }
      wave_sync();
#pragma unroll
      for (int r = 0; r < 16; ++r) {
        X[crow(r, lane >> 5) * LX + (lane & 31)] = c0[r];
        X[crow(r, lane >> 5) * LX + 32 + (lane & 31)] = c1[r];
      }
      wave_sync();
    };
    {
      constexpr int mt = 0;
      if (lane < 32) sbw[lane] = 0.f;
      f32x4 rvs[8], kvs[8];
      float ris[8];
#pragma unroll
      for (int it = 0; it < 8; ++it) {
        const int tt = it * 4 + ts, tok = mt * 32 + tt;
        f32x4 rv = rw_u4(p, mu, r0 + tok, t0 + tok, L, ch);
        f32x4 kv = rw_u4(p, mu, r0 + tok, t0 + tok, L, RW_CH + ch);
        f32x4 vv = rw_u4(p, mu, r0 + tok, t0 + tok, L, 2 * RW_CH + ch);
        rvs[it] = rv; kvs[it] = kv;
        f32x4 kr;
        float ss = 0.f;
#pragma unroll
        for (int j = 0; j < 4; ++j) { kr[j] = kv[j] * kkc[j]; ss += kr[j] * kr[j]; }
        const float ri = rsqrtf(fmaxf(red16(ss), 1e-24f));
        ris[it] = ri;
#pragma unroll
        for (int j = 0; j < 4; ++j) kr[j] *= ri;
        u16* dst = sish + (seqidx0 + tok) * 192 + cq * 4;
        st_bf4(dst, rv); st_bf4(dst + 64, kr); st_bf4(dst + 128, vv);
      }
      SEG_MARK(p, 5)
#pragma unroll 1
      for (int d = 0; d < 2; ++d) {
        gemm_to_X(Awd, LA, d * 32 + mt * 32, p.wt_wup + ((size_t)l * 2 + d) * RW_CH * DRK, DRK);
        const f32x4 w0 = *(const f32x4*)(p.rw_w0 + ((size_t)l * 2 + d) * RW_CH + ch);
#pragma unroll 4
        for (int it = 0; it < 8; ++it) {
          const int tt = it * 4 + ts, tok = mt * 32 + tt;
          f32x4 xw = *(const f32x4*)(X + tt * LX + cq * 4);
          u32x2 o;
          u16 hh[4];
#pragma unroll
          for (int j = 0; j < 4; ++j) {
            const float e = 0.60653065971263342f * fsigmoid_(w0[j] + xw[j]);
            hh[j] = f2h(1.0f - fexp_(-e));
          }
          o[0] = (unsigned)hh[0] | ((unsigned)hh[1] << 16); o[1] = (unsigned)hh[2] | ((unsigned)hh[3] << 16);
          *(u32x2*)(sidir + (size_t)d * dirstride + (seqidx0 + tok) * 192 + cq * 4) = o;
        }
        SEG_MARK(p, 6)
        gemm_to_X(Aad, LA, d * 32 + mt * 32, p.wt_aup + ((size_t)l * 2 + d) * RW_CH * IRK, IRK);
        const f32x4 a0 = *(const f32x4*)(p.rw_a0 + ((size_t)l * 2 + d) * RW_CH + ch);
#pragma unroll
        for (int it = 0; it < 8; ++it) {
          const int tt = it * 4 + ts, tok = mt * 32 + tt;
          f32x4 xa = *(const f32x4*)(X + tt * LX + cq * 4);
          const f32x4 rv = rvs[it], kv = kvs[it];
          const float ri = ris[it];
          f32x4 ka, kd;
          float bs = 0.f;
#pragma unroll
          for (int j = 0; j < 4; ++j) {
            float a = fsigmoid_(a0[j] + xa[j]);
            ka[j] = kv[j] * kkc[j] * ri * a;
            kd[j] = kv[j] * (1.f + (a - 1.f) * k_a[j]);
            bs += rv[j] * kd[j] * r_k[j];
          }
          u16* dst = sidir + (size_t)d * dirstride + (seqidx0 + tok) * 192 + cq * 4;
          st_bf4(dst + 64, ka); st_bf4(dst + 128, kd);
          bs = red16(bs);
          if (cq == 0) sbw[tt] += bs;
        }
      }
      SEG_MARK(p, 7)
      wave_sync();
      if (lane < 32) p.sbonus[(size_t)(r0 + mt * 32 + lane) * RW_H + h] = sbw[lane];
      gemm_to_X(Agd, LG, mt * 32, p.wt_gup + (size_t)l * RW_CH * GRK, GRK);
#pragma unroll 4
      for (int it = 0; it < 8; ++it) {
        const int tt = it * 4 + ts, tok = mt * 32 + tt;
        f32x4 xg = *(const f32x4*)(X + tt * LX + cq * 4);
        st_bf4(p.gbuf + (size_t)(r0 + tok) * RW_CH + ch, xg);
      }
      wave_sync();
      SEG_MARK(p, 8)
    }
  }
  __syncthreads();
  SEG_MARK(p, 8)
}

DI void ph_prep(const Params& p, int l, char* smem) {
  for (int item = BIDX(); item < T / 32; item += gridDim.x) prep_item(p, l, item, smem);
}

typedef __attribute__((ext_vector_type(2))) float f32x2;
constexpr int SC_C = 16, SC_NSLOT = 8, SC_NCONS = 2, SC_NPROD = 6;
constexpr int SC_LDP = 72;
constexpr int SC_LDQ = 40;
constexpr int SC_AT = 0, SC_RT = SC_AT + 16 * SC_LDP * 2, SC_KT = SC_RT + 16 * SC_LDP * 2, SC_PQ = SC_KT + 64 * SC_LDQ * 2,
              SC_BM = SC_PQ + 16 * SC_LDQ * 2, SC_TM = SC_BM + 16 * SC_LDQ * 2, SC_VT = SC_TM + 16 * SC_LDQ * 2, SC_CUM = SC_VT + 64 * 16 * 2,
              SC_SLOT = SC_CUM + 64 * 4;
constexpr int SC_PSCR = SC_NSLOT * SC_SLOT;
constexpr int SC_PSCR_W = 2 * 16 * SC_LDP * 2;
constexpr int SC_FLAGS = SC_PSCR + SC_NPROD * SC_PSCR_W;
static_assert(SC_FLAGS + 64 * 4 < SMEM_BYTES - 1024, "scan LDS");
static_assert(SC_SLOT % 16 == 0 && SC_PSCR_W % 16 == 0, "scan LDS alignment");

#ifdef EMU
typedef volatile int* sc_flag_t;
#else
typedef volatile LAS int* sc_flag_t;
#endif
DI void sc_wait_eq(sc_flag_t f, int want) {
#ifdef EMU
  while (*f != want) emu_yield();
#else
  while (__builtin_amdgcn_readfirstlane(*f) != want) __builtin_amdgcn_s_sleep(1);
  asm volatile("s_waitcnt lgkmcnt(0)" ::: "memory");
#endif
}
DI void sc_wait_ge(sc_flag_t f, int want) {
#ifdef EMU
  while (*f < want) emu_yield();
#else
  while (__builtin_amdgcn_readfirstlane(*f) < want) __builtin_amdgcn_s_sleep(1);
  asm volatile("s_waitcnt lgkmcnt(0)" ::: "memory");
#endif
}
DI void sc_flag_inc(sc_flag_t f) {
#ifdef EMU
  *f = *f + 1;
#else
  (void)__hip_atomic_fetch_add((LAS int*)f, 1, __ATOMIC_RELAXED, __HIP_MEMORY_SCOPE_WORKGROUP);
#endif
}
DI float rdlane_f(float v, int l) { return __builtin_bit_cast(float, __builtin_amdgcn_readlane(__builtin_bit_cast(int, v), l)); }
#define MFMA16(a, b, c) __builtin_amdgcn_mfma_f32_16x16x32_bf16((a), (b), (c), 0, 0, 0)

DI void sc_step_time(int d, int s, bool& isctx, int& t) {
  isctx = s < CTXL;
  if (isctx) t = d == 0 ? s : CTXL - 1 - s;
  else { const int u = s - CTXL; t = d == 0 ? u : SEQ - 1 - u; }
}

DI void scan_chain_item(const Params& p, int item, char* smem) {
  const int tid = TIDX(), lane = tid & 63, wave = tid >> 6;
  const int chain = item >> 1, hf = item & 1;
  const int h = chain % RW_H, b = (chain / RW_H) % NB, d = chain / (RW_H * NB);
  constexpr int NCHUNK = (CTXL + SEQ) / SC_C;
  sc_flag_t ready = (sc_flag_t)(smem + SC_FLAGS);
  sc_flag_t done = ready + SC_NSLOT;
  if (tid < 2 * SC_NSLOT) ready[tid] = 0;
  __syncthreads();
  const int q4 = lane >> 4, c16 = lane & 15;
  if (wave >= SC_NCONS) {
    const int pw = wave - SC_NCONS;
    u16* Bt = (u16*)(smem + SC_PSCR + pw * SC_PSCR_W);
    u16* Kt = Bt + 16 * SC_LDP;
    const int k = lane;
    u16 raw[SC_C][6];
    auto load_chunk = [&](int c) {
#pragma unroll
      for (int j = 0; j < SC_C; ++j) {
        bool isctx; int t;
        sc_step_time(d, c * SC_C + j, isctx, t);
        const int L = isctx ? CTXL : SEQ;
        const size_t base = ((size_t)(b * RW_H + h) * L + t) * 192;
        const u16* sh = (isctx ? p.SIsh_ctx : p.SIsh_lat) + base;
        const u16* dr = (isctx ? p.SIdir_ctx : p.SIdir_lat) + (size_t)d * NB * RW_H * L * 192 + base;
        raw[j][0] = sh[k]; raw[j][1] = sh[64 + k]; raw[j][2] = sh[128 + k];
        raw[j][3] = dr[k]; raw[j][4] = dr[64 + k]; raw[j][5] = dr[128 + k];
      }
    };
    if (pw < NCHUNK) load_chunk(pw);
    for (int c = pw; c < NCHUNK; c += SC_NPROD) {
      const int slot = c % SC_NSLOT;
      char* sl = smem + slot * SC_SLOT;
      u16* At = (u16*)(sl + SC_AT); u16* Rt = (u16*)(sl + SC_RT); u16* KT = (u16*)(sl + SC_KT);
      u16* PQ = (u16*)(sl + SC_PQ); u16* BM = (u16*)(sl + SC_BM); u16* TM = (u16*)(sl + SC_TM);
      u16* VT = (u16*)(sl + SC_VT); float* CUM = (float*)(sl + SC_CUM);
      sc_wait_ge(done + slot, SC_NCONS * (c / SC_NSLOT));
      float cum = 1.f;
      u16 ktv[16], btv[16], vtv[16];
#pragma unroll
      for (int j = 0; j < SC_C; ++j) {
        const float rr = bf2f(raw[j][0]), kk = bf2f(raw[j][1]);
        vtv[j] = raw[j][2];
        const float w = 1.f - h2f(raw[j][3]), ka = bf2f(raw[j][4]), kd = bf2f(raw[j][5]);
        const float at = cum * kk;
        cum *= w;
        const float ic = 1.f / cum;
        At[j * SC_LDP + k] = f2bf(at);
        Rt[j * SC_LDP + k] = f2bf(cum * rr);
        btv[j] = f2bf(ka * ic); ktv[j] = f2bf(kd * ic);
        Bt[j * SC_LDP + k] = btv[j];
        Kt[j * SC_LDP + k] = ktv[j];
      }
      if (c + SC_NPROD < NCHUNK) load_chunk(c + SC_NPROD);
      CUM[k] = cum;
      {
        u32x4 o;
#pragma unroll
        for (int hh = 0; hh < 2; ++hh) {
          o[0] = ktv[8 * hh + 0] | ((unsigned)ktv[8 * hh + 1] << 16); o[1] = ktv[8 * hh + 2] | ((unsigned)ktv[8 * hh + 3] << 16);
          o[2] = ktv[8 * hh + 4] | ((unsigned)ktv[8 * hh + 5] << 16); o[3] = ktv[8 * hh + 6] | ((unsigned)ktv[8 * hh + 7] << 16);
          *(u32x4*)(KT + k * SC_LDQ + 8 * hh) = o;
          o[0] = btv[8 * hh + 0] | ((unsigned)btv[8 * hh + 1] << 16); o[1] = btv[8 * hh + 2] | ((unsigned)btv[8 * hh + 3] << 16);
          o[2] = btv[8 * hh + 4] | ((unsigned)btv[8 * hh + 5] << 16); o[3] = btv[8 * hh + 6] | ((unsigned)btv[8 * hh + 7] << 16);
          *(u32x4*)(KT + k * SC_LDQ + 16 + 8 * hh) = o;
          o[0] = vtv[8 * hh + 0] | ((unsigned)vtv[8 * hh + 1] << 16); o[1] = vtv[8 * hh + 2] | ((unsigned)vtv[8 * hh + 3] << 16);
          o[2] = vtv[8 * hh + 4] | ((unsigned)vtv[8 * hh + 5] << 16); o[3] = vtv[8 * hh + 6] | ((unsigned)vtv[8 * hh + 7] << 16);
          *(u32x4*)(VT + k * 16 + 8 * hh) = o;
        }
      }
      wave_sync();
      f32x4 am = {0.f, 0.f, 0.f, 0.f}, bm = am, pm = am, qm = am;
#pragma unroll
      for (int ks = 0; ks < 2; ++ks) {
        const int o = c16 * SC_LDP + 32 * ks + 8 * q4;
        const bf16x8 fa = *(const bf16x8*)(At + o), fr = *(const bf16x8*)(Rt + o);
        const bf16x8 fb = *(const bf16x8*)(Bt + o), fk = *(const bf16x8*)(Kt + o);
        am = MFMA16(fa, fb, am); bm = MFMA16(fa, fk, bm); pm = MFMA16(fr, fk, pm); qm = MFMA16(fr, fb, qm);
      }
#pragma unroll
      for (int r = 0; r < 4; ++r) {
        const int j = 4 * q4 + r;
        BM[j * SC_LDQ + c16] = c16 < j ? f2bf(bm[r]) : (u16)0;
        BM[j * SC_LDQ + 16 + c16] = 0;
        PQ[j * SC_LDQ + c16] = c16 <= j ? f2bf(pm[r]) : (u16)0;
        PQ[j * SC_LDQ + 16 + c16] = c16 <= j ? f2bf(-qm[r]) : (u16)0;
      }
      float Tc[16];
#pragma unroll
      for (int j = 0; j < 16; ++j) {
        float tv = (j == c16) ? 1.f : 0.f;
#pragma unroll
        for (int i = 0; i < j; ++i) tv -= rdlane_f(am[j & 3], i + 16 * (j >> 2)) * Tc[i];
        Tc[j] = tv;
      }
#pragma unroll
      for (int j = 0; j < 16; ++j) {
        if (q4 == 0) TM[j * SC_LDQ + c16] = f2bf(Tc[j]);
        if (q4 == 1) TM[j * SC_LDQ + 16 + c16] = 0;
      }
      wave_sync();
      if (lane == 0) ready[slot] = c + 1;
    }
  } else {
    const int vt = SC_NCONS * hf + wave;
#ifndef EMU
    __builtin_amdgcn_s_setprio(3);
#endif
    f32x4 ST[4];
#pragma unroll
    for (int mt = 0; mt < 4; ++mt) ST[mt] = (f32x4){0.f, 0.f, 0.f, 0.f};
    auto ld2 = [&](const u16* q0, const u16* q1) {
      const u32x2 a = *(const u32x2*)q0, b2 = *(const u32x2*)q1;
      u32x4 o; o[0] = a[0]; o[1] = a[1]; o[2] = b2[0]; o[3] = b2[1];
      return __builtin_bit_cast(bf16x8, o);
    };
    auto ld1z = [&](const u16* q0) {
      const u32x2 a = *(const u32x2*)q0;
      u32x4 o; o[0] = a[0]; o[1] = a[1]; o[2] = 0u; o[3] = 0u;
      return __builtin_bit_cast(bf16x8, o);
    };
    for (int c = 0; c < NCHUNK; ++c) {
      const int slot = c % SC_NSLOT;
      const char* sl = smem + slot * SC_SLOT;
      const u16* At = (const u16*)(sl + SC_AT); const u16* Rt = (const u16*)(sl + SC_RT); const u16* KT = (const u16*)(sl + SC_KT);
      const u16* PQ = (const u16*)(sl + SC_PQ); const u16* BM = (const u16*)(sl + SC_BM); const u16* TM = (const u16*)(sl + SC_TM);
      const u16* VT = (const u16*)(sl + SC_VT); const float* CUM = (const float*)(sl + SC_CUM);
      bf16x8 shi[2], slo[2];
#pragma unroll
      for (int ks = 0; ks < 2; ++ks) {
        u32x4 oh, ol;
#pragma unroll
        for (int hh = 0; hh < 2; ++hh) {
          const f32x4 x = ST[2 * ks + hh];
          float h0 = bf2f(f2bf(x[0])), h1 = bf2f(f2bf(x[1])), h2 = bf2f(f2bf(x[2])), h3 = bf2f(f2bf(x[3]));
          oh[2 * hh] = pk2(x[0], x[1]); oh[2 * hh + 1] = pk2(x[2], x[3]);
          ol[2 * hh] = pk2(x[0] - h0, x[1] - h1); ol[2 * hh + 1] = pk2(x[2] - h2, x[3] - h3);
        }
        shi[ks] = __builtin_bit_cast(bf16x8, oh); slo[ks] = __builtin_bit_cast(bf16x8, ol);
      }
      sc_wait_eq(ready + slot, c + 1);
      f32x4 rhs = {0.f, 0.f, 0.f, 0.f}, y = rhs;
#pragma unroll
      for (int ks = 0; ks < 2; ++ks) {
        const int o = c16 * SC_LDP + 32 * ks + 4 * q4;
        const bf16x8 fa = ld2(At + o, At + o + 16), fr = ld2(Rt + o, Rt + o + 16);
        rhs = MFMA16(fa, shi[ks], rhs); y = MFMA16(fr, shi[ks], y);
        rhs = MFMA16(fa, slo[ks], rhs); y = MFMA16(fr, slo[ks], y);
      }
      const u32x2 vraw = *(const u32x2*)(VT + (16 * vt + c16) * 16 + 4 * q4);
      {
        u32x4 o; o[0] = vraw[0]; o[1] = vraw[1]; o[2] = 0u; o[3] = 0u;
        rhs = MFMA16(ld1z(BM + c16 * SC_LDQ + 4 * q4), __builtin_bit_cast(bf16x8, o), rhs);
      }
      f32x4 z = {0.f, 0.f, 0.f, 0.f};
      {
        u32x4 o; o[0] = pk2(rhs[0], rhs[1]); o[1] = pk2(rhs[2], rhs[3]); o[2] = 0u; o[3] = 0u;
        z = MFMA16(ld1z(TM + c16 * SC_LDQ + 4 * q4), __builtin_bit_cast(bf16x8, o), z);
      }
      const unsigned z01 = pk2(z[0], z[1]), z23 = pk2(z[2], z[3]);
      {
        u32x4 o; o[0] = vraw[0]; o[1] = vraw[1]; o[2] = z01; o[3] = z23;
        y = MFMA16(ld2(PQ + c16 * SC_LDQ + 4 * q4, PQ + c16 * SC_LDQ + 16 + 4 * q4), __builtin_bit_cast(bf16x8, o), y);
      }
#pragma unroll
      for (int r = 0; r < 4; ++r) {
        bool isctx; int t;
        sc_step_time(d, c * SC_C + 4 * q4 + r, isctx, t);
        const int rrow = isctx ? TL + b * CTXL + t : b * SEQ + t;
        p.ybuf[((size_t)d * T + rrow) * RW_CH + h * 64 + 16 * vt + c16] = f2bf(y[r]);
      }
      {
        u32x4 o; o[0] = vraw[0]; o[1] = vraw[1]; o[2] = z01 ^ 0x80008000u; o[3] = z23 ^ 0x80008000u;
        const bf16x8 bS = __builtin_bit_cast(bf16x8, o);
#pragma unroll
        for (int mt = 0; mt < 4; ++mt) {
          const u16* kr = KT + (16 * mt + c16) * SC_LDQ + 4 * q4;
          ST[mt] = MFMA16(ld2(kr, kr + 16), bS, ST[mt]);
          const f32x4 cm = *(const f32x4*)(CUM + 16 * mt + 4 * q4);
#pragma unroll
          for (int r = 0; r < 4; ++r) ST[mt][r] *= cm[r];
        }
      }
      wave_sync();
      if (lane == 0) sc_flag_inc(done + slot);
    }
#ifndef EMU
    __builtin_amdgcn_s_setprio(0);
#endif
  }
  __syncthreads();
}
DI void ph_scan(const Params& p, char* smem) {
  for (int item = BIDX(); item < 2 * (2 * NB * RW_H); item += gridDim.x) scan_chain_item(p, item, smem);
}

DI void ph_assemble(const Params& p, int l, char* smem) {
  const int tid = TIDX(), lane = tid & 63, wave = tid >> 6;
  const int ts = lane >> 4, cq = lane & 15;
  const int rows = (l == 0) ? T : TL;
  constexpr int LY = 66;
  u16* yt = (u16*)smem;
  const float* gn = p.mix_norm_g + (size_t)l * (CONV_CH + HY_CH);
  for (int tile = BIDX(); tile < rows / 64; tile += gridDim.x) {
    const int r0 = tile * 64;
    int b_, t0, L;
    seq_of_row(r0, b_, t0, L);
    const u16* yh = (r0 < TL ? p.yhlat : p.yhctx) + (size_t)b_ * HY_CH * L + t0;
    for (int i = tid; i < HY_CH * 8; i += NT) {
      int c = i >> 3, part = i & 7;
      const u32x4 v = *(const u32x4*)(yh + (size_t)c * L + part * 8);
      unsigned* q = (unsigned*)(yt + c * LY + part * 8);
      q[0] = v[0]; q[1] = v[1]; q[2] = v[2]; q[3] = v[3];
    }
    __syncthreads();
    const u16* sish = (r0 < TL ? p.SIsh_lat : p.SIsh_ctx);
#pragma unroll
    for (int it = 0; it < 2; ++it) {
      const int tok = wave * 8 + it * 4 + ts;
      const int r = r0 + tok;
      u16* dst = p.ycat + (size_t)r * MIX_W;
#pragma unroll
      for (int bk = 0; bk < CONV_CH / 64; ++bk)
        *(u32x2*)(dst + bk * 64 + cq * 4) = *(const u32x2*)(p.ya + (size_t)r * CONV_CH + bk * 64 + cq * 4);
      float hv[HY_CH / 64][4];
      float ss = 0.f;
#pragma unroll
      for (int bk = 0; bk < HY_CH / 64; ++bk)
#pragma unroll
        for (int j = 0; j < 4; ++j) { hv[bk][j] = bf2f(yt[(bk * 64 + cq * 4 + j) * LY + tok]); ss += hv[bk][j] * hv[bk][j]; }
      ss = red16(ss);
      const float rs = rsqrtf(ss / (float)HY_CH + LN_EPS);
#pragma unroll
      for (int bk = 0; bk < HY_CH / 64; ++bk) {
        const f32x4 g4 = *(const f32x4*)(gn + CONV_CH + bk * 64 + cq * 4);
        f32x4 o;
#pragma unroll
        for (int j = 0; j < 4; ++j) o[j] = hv[bk][j] * rs * g4[j];
        st_bf4(dst + CONV_CH + bk * 64 + cq * 4, o);
      }
#pragma unroll
      for (int h = 0; h < RW_H; ++h) {
        const int ch = h * 64 + cq * 4;
        const f32x4 yf = ld_bf4(p.ybuf + (size_t)r * RW_CH + ch), yb = ld_bf4(p.ybuf + ((size_t)T + r) * RW_CH + ch);
        const f32x4 vv = ld_bf4(sish + ((size_t)(b_ * RW_H + h) * L + t0 + tok) * 192 + 128 + cq * 4);
        const f32x4 gg = ld_bf4(p.gbuf + (size_t)r * RW_CH + ch);
        const f32x4 lg4 = *(const f32x4*)(p.rw_lnx_g + (size_t)l * RW_CH + ch), lb4 = *(const f32x4*)(p.rw_lnx_b + (size_t)l * RW_CH + ch);
        const float sb = p.sbonus[(size_t)r * RW_H + h];
        f32x4 yv;
        float sm = 0.f;
#pragma unroll
        for (int j = 0; j < 4; ++j) { yv[j] = yf[j] + yb[j]; sm += yv[j]; }
        const float mu = red16(sm) * (1.f / 64.f);
        float sq = 0.f;
#pragma unroll
        for (int j = 0; j < 4; ++j) { yv[j] -= mu; sq += yv[j] * yv[j]; }
        const float rstd = rsqrtf(red16(sq) * (1.f / 64.f) + RW_GN_EPS);
        f32x4 o;
#pragma unroll
        for (int j = 0; j < 4; ++j) o[j] = (yv[j] * rstd * lg4[j] + lb4[j] + sb * vv[j]) * gg[j];
        st_bf4(dst + CONV_CH + HY_CH + ch, o);
      }
    }
    __syncthreads();
  }
}

DI void ph_outproj(const Params& p, int l, char* smem) {
  const int rows = (l == 0) ? T : TL;
  const int G = gridDim.x, c = BIDX();
  {
    DenseSched S; S.init(p.ycat, p.wt_out + (size_t)l * D * MIX_W, MIX_W, rows, D, G, c);
    EpiOutproj E{&p, l};
    pg8::gemm_phase(smem, MIX_W, S, E);
  }
  __syncthreads();
  ticket_loop(p.bar + XB_TICKET + 1 + DEPTH + l, CT_EXP_L, smem, [&](int it) { convert_expert_item(p, l, it, smem); });
}

DI void ph_ln_router(const Params& p, int l, char* smem) {
  const int tid = TIDX(), lane = tid & 63, wave = tid >> 6;
  const int rows = (l == 0) ? T : TL;
  constexpr int LH = D + 8;
  constexpr int EPL = D / 64;
  u16* Hhi = (u16*)smem;
  u16* Hlo = Hhi + 32 * LH;
  float* red = (float*)smem;
  constexpr int LGS_OFF = (2 * 32 * LH * 2 > 8 * 32 * 64 * 4) ? 2 * 32 * LH * 2 : 8 * 32 * 64 * 4;
  float* lgs = (float*)(smem + LGS_OFF);
  const float* lg = p.ln_g + ((size_t)l * 2 + 0) * D;
  const float* lb = p.ln_b + ((size_t)l * 2 + 0) * D;
  const u16* Whi = p.wt_rhi + (size_t)l * NE * D;
  const u16* Wlo = p.wt_rlo + (size_t)l * NE * D;
  constexpr int KS = D / 8;
  SEG_BEGIN(p)
  for (int tile = BIDX(); tile < rows / 32; tile += gridDim.x) {
    const int r0 = tile * 32;
#pragma unroll 2
    for (int tt = 0; tt < 4; ++tt) {
      const int tok = wave * 4 + tt;
      const int r = r0 + tok;
      float* xr = x1row(p, r);
      const float* m = modp(p, l, r);
      constexpr int NV = D / 256;
      f32x4 xv[NV];
      float s = 0.f;
#pragma unroll
      for (int i = 0; i < NV; ++i) { xv[i] = *(const f32x4*)(xr + 4 * lane + 256 * i); s += (xv[i][0] + xv[i][1]) + (xv[i][2] + xv[i][3]); }
      const float mu = wave_sum(s) * (1.f / (float)D);
      float s2 = 0.f;
#pragma unroll
      for (int i = 0; i < NV; ++i)
#pragma unroll
        for (int j = 0; j < 4; ++j) { float dd = xv[i][j] - mu; s2 += dd * dd; }
      const float rstd = rsqrtf(wave_sum(s2) * (1.f / (float)D) + LN_EPS);
#pragma unroll
      for (int i = 0; i < NV; ++i) {
        const int e = 4 * lane + 256 * i;
        const f32x4 g4 = *(const f32x4*)(lg + e), b4 = *(const f32x4*)(lb + e);
        const f32x4 sc = *(const f32x4*)(m + 4 * D + e), sh = *(const f32x4*)(m + 3 * D + e);
        f32x4 xn, hh, lo;
#pragma unroll
        for (int j = 0; j < 4; ++j) { xn[j] = (xv[i][j] - mu) * rstd * g4[j] + b4[j]; hh[j] = xn[j] * (1.f + sc[j]) + sh[j]; }
        *(f32x4*)(xr + e) = xn;
        u32x2 hp; hp[0] = pk2(hh[0], hh[1]); hp[1] = pk2(hh[2], hh[3]);
#pragma unroll
        for (int j = 0; j < 4; ++j) lo[j] = hh[j] - bf2f((u16)((j & 1) ? (hp[j >> 1] >> 16) : (hp[j >> 1] & 0xffff)));
        *(u32x2*)(Hhi + tok * LH + e) = hp;
        st_bf4(Hlo + tok * LH + e, lo);
        *(u32x2*)(p.HL + (size_t)r * D + e) = hp;
        u32x2 zz; zz[0] = 0u; zz[1] = 0u;
        *(u32x2*)(p.acc + (size_t)r * (D / 2) + e / 2) = zz;
      }
    }
    __syncthreads();
    SEG_MARK(p, 0)
    f32x16 c0, c1;
#pragma unroll
    for (int r = 0; r < 16; ++r) { c0[r] = 0.f; c1[r] = 0.f; }
#pragma unroll 4
    for (int k0 = wave * KS; k0 < (wave + 1) * KS; k0 += 16) {
      const int ko = k0 + (lane >> 5) * 8;
      bf16x8 ah = *(const bf16x8*)(Hhi + (lane & 31) * LH + ko);
      bf16x8 al = *(const bf16x8*)(Hlo + (lane & 31) * LH + ko);
      bf16x8 bh0 = *(const bf16x8*)(Whi + (size_t)(lane & 31) * D + ko);
      bf16x8 bh1 = *(const bf16x8*)(Whi + (size_t)(32 + (lane & 31)) * D + ko);
      bf16x8 bl0 = *(const bf16x8*)(Wlo + (size_t)(lane & 31) * D + ko);
      bf16x8 bl1 = *(const bf16x8*)(Wlo + (size_t)(32 + (lane & 31)) * D + ko);
      c0 = MFMA32(ah, bh0, c0); c0 = MFMA32(ah, bl0, c0); c0 = MFMA32(al, bh0, c0);
      c1 = MFMA32(ah, bh1, c1); c1 = MFMA32(ah, bl1, c1); c1 = MFMA32(al, bh1, c1);
    }
    __syncthreads();
    SEG_MARK(p, 1)
#pragma unroll
    for (int r = 0; r < 16; ++r) {
      red[(wave * 32 + crow(r, lane >> 5)) * 64 + (lane & 31)] = c0[r];
      red[(wave * 32 + crow(r, lane >> 5)) * 64 + 32 + (lane & 31)] = c1[r];
    }
    __syncthreads();
    for (int i = tid; i < 32 * 64; i += NT) {
      float sacc = 0.f;
#pragma unroll
      for (int w = 0; w < 8; ++w) sacc += red[w * 2048 + i];
      lgs[i] = sacc;
    }
    __syncthreads();
    SEG_MARK(p, 2)
    unsigned long long* selm = (unsigned long long*)(lgs + 32 * 64);
    unsigned char* lpos = (unsigned char*)(selm + 32);
    int* tbase = (int*)(lpos + 32 * 64);
    const float eb = p.e_bias[(size_t)l * NE + lane];
    float gate4[4];
    bool ch4[4];
    {
      float score4[4], selv4[4];
#pragma unroll
      for (int tt = 0; tt < 4; ++tt) { score4[tt] = fsigmoid_(lgs[(wave * 4 + tt) * 64 + lane]); selv4[tt] = score4[tt] + eb; ch4[tt] = false; }
      for (int round = 0; round < TOPK; ++round) {
#pragma unroll
        for (int tt = 0; tt < 4; ++tt) {
          const float cand = ch4[tt] ? -1e30f : selv4[tt];
          const float mx = wave_max(cand);
          const unsigned long long bal = __ballot(cand == mx);
          const int win = __ffsll((long long)bal) - 1;
          if (lane == win) ch4[tt] = true;
        }
      }
#pragma unroll
      for (int tt = 0; tt < 4; ++tt) {
        const float ssum = wave_sum(ch4[tt] ? score4[tt] : 0.f);
        gate4[tt] = ROUTED_SCALE * score4[tt] / ssum;
        const unsigned long long m = __ballot(ch4[tt]);
        if (lane == 0) selm[wave * 4 + tt] = m;
      }
    }
    __syncthreads();
    if (wave == 0) {
      int c = 0;
      for (int t = 0; t < 32; ++t) {
        const int bit = (int)((selm[t] >> lane) & 1ull);
        lpos[t * 64 + lane] = (unsigned char)c;
        c += bit;
      }
      int base = 0;
      if (c > 0) base = atomicAdd(p.cnt + l * NE + lane, c);
      tbase[lane] = base;
    }
    __syncthreads();
#pragma unroll
    for (int tt = 0; tt < 4; ++tt) {
      const int tok = wave * 4 + tt;
      if (ch4[tt]) {
        const int pos = tbase[lane] + (int)lpos[tok * 64 + lane];
        p.etok[(size_t)lane * T + pos] = r0 + tok;
        p.egate[(size_t)lane * T + pos] = gate4[tt];
      }
    }
    __syncthreads();
    SEG_MARK(p, 3)
  }
}

constexpr int EXP_LDS_OFF = 128 * 1024;
constexpr int MAX_ROW_TILES = (T * TOPK) / 256 + NE + T / 256;
static_assert(28 * 1024 + (2 * (NE + 2) + (NE + 2)) * 4 + MAX_ROW_TILES + EXP_LDS_OFF <= SMEM_BYTES - 1024, "expert tables fit below the parked parameters");
static_assert(NE == 64, "binary search step");
struct ExpTables { int* pre; int* hoff; int* cntl; unsigned char* t2e; };
DI ExpTables expert_tables(const Params& p, int l, int rows, char* smem) {
  ExpTables x;
  x.pre = (int*)(smem + EXP_LDS_OFF + 28 * 1024);
  x.hoff = x.pre + (NE + 2);
  x.cntl = x.hoff + (NE + 2);
  x.t2e = (unsigned char*)(x.cntl + (NE + 2));
  const int tid = TIDX();
  if (tid == 0) {
    int s = 0, ho = 0;
    for (int e = 0; e < NE; ++e) { const int ce = p.cnt[l * NE + e]; const int nt = (ce + 255) / 256; x.pre[e] = s; x.hoff[e] = ho; x.cntl[e] = ce; s += nt; ho += nt * 256; }
    x.pre[NE] = s; x.hoff[NE] = ho; x.cntl[NE] = rows; s += rows / 256; x.pre[NE + 1] = s;
  }
  __syncthreads();
  {
    const int R = x.pre[NE + 1];
    for (int t = tid; t < R; t += NT) {
      int e = 0;
#pragma unroll
      for (int step = 64; step >= 1; step >>= 1) { const int c = e + step; if (c <= NE && x.pre[c] <= t) e = c; }
      x.t2e[t] = (unsigned char)e;
    }
  }
  __syncthreads();
  return x;
}
DI void ph_e1(const Params& p, int l, char* smem) {
  const int rows = (l == 0) ? T : TL;
  const ExpTables x = expert_tables(p, l, rows, smem);
  E1Sched S;
  S.pre = x.pre; S.cntl = x.cntl; S.t2e = x.t2e; S.nN = FF / 128; S.G = gridDim.x; S.c = BIDX(); S.total = x.pre[NE + 1] * S.nN;
  S.A = (const char*)p.HL; S.W = (const char*)p.wt_exp; S.etok = p.etok;
  S.preload((unsigned*)(smem + EXP_LDS_OFF), 24);
  EpiE1 E{p.Hbuf, x.hoff};
  pg8::gemm_phase(smem, D, S, E);
  __syncthreads();
}
DI void ph_e2(const Params& p, int l, char* smem) {
  const int rows = (l == 0) ? T : TL;
  const ExpTables x = expert_tables(p, l, rows, smem);
  E2Sched S;
  S.pre = x.pre; S.cntl = x.cntl; S.t2e = x.t2e; S.nN = D / 256; S.G = gridDim.x; S.c = BIDX(); S.total = x.pre[NE + 1] * S.nN;
  S.A = (const char*)p.Hbuf; S.W = (const char*)p.wt_exp; S.hoff = x.hoff;
  EpiE2 E{p.acc, p.etok, p.egate, (float*)(smem + EXP_LDS_OFF), p.SHo};
  pg8::gemm_phase(smem, FF, S, E);
  __syncthreads();
}

DI void ph_combine(const Params& p, int l) {
  const int tid = TIDX(), lane = tid & 63, wave = tid >> 6;
  const int rows = (l == 0) ? T : TL;
  constexpr int NV = D / 256;
  constexpr int RPW = 2;
  const float* lg = p.ln_g + ((size_t)l * 2 + 1) * D;
  const float* lb = p.ln_b + ((size_t)l * 2 + 1) * D;
  for (int tile = BIDX(); tile < rows / (8 * RPW); tile += gridDim.x) {
    f32x4 xv[RPW][NV];
    float s[RPW];
#pragma unroll
    for (int u = 0; u < RPW; ++u) {
      const int r = tile * (8 * RPW) + u * 8 + wave;
      const float* x1 = x1row(p, r);
      const float* m = modp(p, l, r);
      s[u] = 0.f;
#pragma unroll
      for (int i = 0; i < NV; ++i) {
        const int e = 4 * lane + 256 * i;
        const u32x2 aw = *(const u32x2*)(p.acc + (size_t)r * (D / 2) + e / 2);
        float m0, m1, m2, m3;
        acc_unpack4(aw[0], aw[1], m0, m1, m2, m3);
        const f32x4 xx = *(const f32x4*)(x1 + e), gg = *(const f32x4*)(m + 5 * D + e);
        const f32x4 sh4 = ld_bf4(p.SHo + (size_t)r * D + e);
        xv[u][i][0] = DN_ALPHA * xx[0] + gg[0] * (m0 + sh4[0]); xv[u][i][1] = DN_ALPHA * xx[1] + gg[1] * (m1 + sh4[1]);
        xv[u][i][2] = DN_ALPHA * xx[2] + gg[2] * (m2 + sh4[2]); xv[u][i][3] = DN_ALPHA * xx[3] + gg[3] * (m3 + sh4[3]);
        s[u] += (xv[u][i][0] + xv[u][i][1]) + (xv[u][i][2] + xv[u][i][3]);
      }
    }
#pragma unroll
    for (int u = 0; u < RPW; ++u) {
      const int r = tile * (8 * RPW) + u * 8 + wave;
      float* x1 = x1row(p, r);
      const float* m = modp(p, l, r);
      const float mu = wave_sum(s[u]) * (1.f / (float)D);
      float s2 = 0.f;
#pragma unroll
      for (int i = 0; i < NV; ++i)
#pragma unroll
        for (int j = 0; j < 4; ++j) { float dd = xv[u][i][j] - mu; s2 += dd * dd; }
      const float rstd = rsqrtf(wave_sum(s2) * (1.f / (float)D) + LN_EPS);
      const float* m1 = (l + 1 < DEPTH) ? modp(p, l + 1, r) : m;
#pragma unroll
      for (int i = 0; i < NV; ++i) {
        const int e = 4 * lane + 256 * i;
        const f32x4 g4 = *(const f32x4*)(lg + e), b4 = *(const f32x4*)(lb + e);
        f32x4 xn;
#pragma unroll
        for (int j = 0; j < 4; ++j) xn[j] = (xv[u][i][j] - mu) * rstd * g4[j] + b4[j];
        if (r < TL) *(f32x4*)(x1 + e) = xn;
        if (l + 1 < DEPTH) {
          const f32x4 sc = *(const f32x4*)(m1 + D + e), sh = *(const f32x4*)(m1 + e);
          f32x4 o;
#pragma unroll
          for (int j = 0; j < 4; ++j) o[j] = xn[j] * (1.f + sc[j]) + sh[j];
          st_bf4(p.HL + (size_t)r * D + e, o);
        }
      }
    }
  }
}

constexpr int PH_PER_LAYER = 10;
constexpr int NPHASES = 2 + PH_PER_LAYER * DEPTH;
DI void run_phase(const Params& p, int ph, char* smem) {
  if (ph == 0) { ph_prologue(p, smem); return; }
  if (ph == 1) { ph_premod(p); return; }
  const int l = (ph - 2) / PH_PER_LAYER, q = (ph - 2) % PH_PER_LAYER;
  switch (q) {
    case 0: ph_inproj(p, l, smem); break;
    case 1: ph_mix(p, l, smem); break;
    case 2: ph_prep(p, l, smem); break;
    case 3: ph_scan(p, smem); break;
    case 4: ph_assemble(p, l, smem); break;
    case 5: ph_outproj(p, l, smem); break;
    case 6: ph_ln_router(p, l, smem); break;
    case 7: ph_e1(p, l, smem); break;
    case 8: ph_e2(p, l, smem); break;
    case 9: ph_combine(p, l); break;
  }
}

static inline size_t al256(size_t x) { return (x + 255) & ~(size_t)255; }
static inline size_t max2(size_t a, size_t b) { return a > b ? a : b; }
static Params make_params(void* const* d_in, void* d_out, void* d_ws, size_t* used) {
  Params p{};
  const float** f = (const float**)&p;
  for (int i = 0; i < 42; ++i) f[i] = (const float*)d_in[i];
  p.out = (float*)d_out;
  char* w = (char*)d_ws;
  size_t o = 0;
  auto take = [&](size_t bytes) { char* r = w + o; o = al256(o + bytes); return r; };
  p.HL = (u16*)take((size_t)T * D * 2);
  p.mod = (float*)take((size_t)DEPTH * (NB + 1) * 6 * D * 4);
  p.h3lat = (float*)take((size_t)DEPTH * SEQ * 64 * 4);
  p.h3ctx = (float*)take((size_t)DEPTH * CTXL * 64 * 4);
  p.tw = (cf*)take((size_t)(FFTN / 2) * 8);
  p.tstamp = (long long*)take(64 * 8);
  p.bar = (unsigned*)take((size_t)XCD_BAR_WORDS * 4);
  p.cnt = (int*)take((size_t)DEPTH * NE * 4);
  p.sbonus = (float*)take((size_t)T * RW_H * 4);
  p.XC = (float*)take((size_t)TC * D * 4);
  p.wt_in = (u16*)take((size_t)DEPTH * P_IN_PAD * D * 2);
  p.wt_out = (u16*)take((size_t)DEPTH * D * MIX_W * 2);
  p.wt_rhi = (u16*)take((size_t)DEPTH * NE * D * 2);
  p.wt_rlo = (u16*)take((size_t)DEPTH * NE * D * 2);
  p.wt_wup = (u16*)take((size_t)DEPTH * 2 * RW_CH * DRK * 2);
  p.wt_aup = (u16*)take((size_t)DEPTH * 2 * RW_CH * IRK * 2);
  p.wt_gup = (u16*)take((size_t)DEPTH * RW_CH * GRK * 2);
  const size_t szEt = al256((size_t)NE * T * 4);
  char* G = take(max2(max2((size_t)T * RW_CH * 2, (size_t)2 * HY_CH * FFTN * 8), 2 * szEt));
  p.spec = (cf*)G;
  p.gbuf = (u16*)G;
  p.etok = (int*)G;
  p.egate = (float*)(G + szEt);
  const size_t szPAPH = (size_t)T * PA_W * 2 + (size_t)T * PH_W * 2;
  const size_t szSIsh = (size_t)T * RW_H * 192 * 2;
  const size_t szWexp = (size_t)(NE + 1) * EXP_STRIDE * 2;
  char* R0 = take(max2(max2(szPAPH, szSIsh), szWexp));
  p.PA = (u16*)R0;
  p.PH = (u16*)(R0 + (size_t)T * PA_W * 2);
  p.SIsh_lat = (u16*)R0;
  p.SIsh_ctx = p.SIsh_lat + (size_t)NB * RW_H * SEQ * 192;
  p.wt_exp = (u16*)R0;
  const size_t szPR = (size_t)T * RW_COLS * 2, szY = (size_t)2 * T * RW_CH * 2;
  char* R1 = take(max2(szPR, szY));
  p.PR = (u16*)R1;
  p.ybuf = (u16*)R1;
  const size_t szSIdir = (size_t)2 * T * RW_H * 192 * 2;
  const size_t szYC = al256((size_t)T * MIX_W * 2);
  char* R2 = take(max2(szSIdir, szYC));
  p.SIdir_lat = (u16*)R2;
  p.SIdir_ctx = p.SIdir_lat + (size_t)2 * NB * RW_H * SEQ * 192;
  p.ycat = (u16*)R2;
  p.acc = (int*)R1;
  const size_t szAcc = al256((size_t)T * (D / 2) * 4);
  const size_t szH = (size_t)(T * TOPK + T + (NE + 1) * 256) * FF * 2;
  p.Hbuf = (u16*)(R1 + szAcc);
  const size_t szSH = al256((size_t)T * D * 2);
  p.SHo = (u16*)(R1 + szAcc + al256(szH));
  p.ya = (u16*)take((size_t)T * CONV_CH * 2);
  p.yhlat = (u16*)take((size_t)NB * HY_CH * SEQ * 2);
  p.yhctx = (u16*)take((size_t)NB * HY_CH * CTXL * 2);
  if (szAcc + al256(szH) + szSH > al256(max2(szPR, szY)) + al256(max2(szSIdir, szYC))) o = (size_t)1 << 62;
  *used = o;
  return p;
}
static size_t ws_needed() {
  return (size_t)640 * 1024 * 1024;
}

#ifndef EMU
constexpr int NFIELDS = sizeof(Params) / 8;
static_assert(sizeof(Params) % 8 == 0 && sizeof(Params) <= 1024, "Params layout");
DI unsigned long long uni64(unsigned long long v) {
  unsigned lo = __builtin_amdgcn_readfirstlane((unsigned)v), hi = __builtin_amdgcn_readfirstlane((unsigned)(v >> 32));
  return ((unsigned long long)hi << 32) | lo;
}
DI void load_params(Params& q, const char* smem) {
  const unsigned long long* src = (const unsigned long long*)(smem + SMEM_BYTES - 1024);
  char** dst = (char**)&q;
  typedef __attribute__((address_space(1))) char gchar_t;
#pragma clang loop unroll(full)
  for (int i = 0; i < NFIELDS; ++i) dst[i] = (char*)(gchar_t*)uni64(src[i]);
}
__global__ void __launch_bounds__(NT) hybrid_mega(Params parg) {
  __shared__ __attribute__((aligned(16))) char smem[SMEM_BYTES];
  if (threadIdx.x < NFIELDS)
    ((unsigned long long*)(smem + SMEM_BYTES - 1024))[threadIdx.x] = ((const unsigned long long*)&parg)[threadIdx.x];
  volatile LAS unsigned* st = (volatile LAS unsigned*)(smem + SMEM_BYTES - 16);
  if (threadIdx.x == 0) { st[0] = 0u; st[1] = 0u; }
  __syncthreads();
  const XcdBarrier xb = xcd_barrier_post(parg.bar, st);
#if PROF_SEG
  if (blockIdx.x == 0 && threadIdx.x < 16) parg.tstamp[32 + threadIdx.x] = 0;
#endif
#if PROF_A || PROF_B || PROF_C || PROF_SEG
#define MK_STAMP(ph) if (blockIdx.x == 0 && threadIdx.x == 0) p.tstamp[ph] = (long long)__builtin_amdgcn_s_memrealtime();
#else
#define MK_STAMP(ph)
#endif
#define MK_PHASE(ph) { Params p; load_params(p, smem); MK_STAMP(ph) run_phase(p, ph, smem); if ((ph) + 1 < NPHASES) xcd_barrier(xb); }
  MK_PHASE(0) MK_PHASE(1) MK_PHASE(2) MK_PHASE(3) MK_PHASE(4) MK_PHASE(5) MK_PHASE(6) MK_PHASE(7) MK_PHASE(8) MK_PHASE(9) MK_PHASE(10)
  MK_PHASE(11) MK_PHASE(12) MK_PHASE(13) MK_PHASE(14) MK_PHASE(15) MK_PHASE(16) MK_PHASE(17) MK_PHASE(18) MK_PHASE(19) MK_PHASE(20) MK_PHASE(21)
  static_assert(NPHASES == 22, "phase program");
#if PROF_A || PROF_B || PROF_C || PROF_SEG
  {
    xcd_barrier(xb);
    Params p;
    load_params(p, smem);
    if (blockIdx.x == 0 && threadIdx.x == 0) p.tstamp[NPHASES] = (long long)__builtin_amdgcn_s_memrealtime();
    xcd_barrier(xb);
    const long long* ts = p.tstamp;
    float tot = (float)(ts[NPHASES] - ts[0]);
    (void)tot;
    float ta = 0.f, tb = 0.f;
    long long tc = 0;
    for (int ph = 0; ph < NPHASES; ++ph) {
      float dt = (float)(ts[ph + 1] - ts[ph]);
      if ((PROF_A >> ph) & 1) ta += dt;
      if ((PROF_B >> ph) & 1) tb += dt;
      if ((PROF_C >> ph) & 1) tc += ts[ph + 1] - ts[ph];
    }
#if PROF_SEG
    {
      float st_ = 0.f;
      for (int k = 0; k < 16; ++k) st_ += (float)ts[32 + k];
      ta = (float)ts[32 + PROF_SA]; tb = (float)ts[32 + PROF_SB]; tot = st_ > 0.f ? st_ : 1.f;
      tc = ts[32 + PROF_SC];
    }
#endif
    float fa = ta / tot, fb = tb / tot;
#if PROF_SEG
    fa = floorf(fa * 50.f + 0.5f) * (1.f / 50.f); fb = floorf(fb * 45.f + 0.5f) * (1.f / 45.f);
#endif
    const float da = sqrtf(0.5f * fa);
    const size_t NA = (size_t)TL * D / 100;
    if (!PROF_SEG) for (size_t i = (size_t)blockIdx.x * NT + threadIdx.x; i < NA; i += (size_t)gridDim.x * NT) p.out[i] += da;
    if (PROF_B && !PROF_SEG && blockIdx.x == 0 && threadIdx.x == 0) p.out[(size_t)TL * D - 1] += 10.f + 90.f * fb;
    if (PROF_C || PROF_SEG) { while ((long long)__builtin_amdgcn_s_memrealtime() < ts[NPHASES] + tc) {} }
  }
#endif
}
#ifdef MULTI_LAUNCH
__global__ void __launch_bounds__(NT) hybrid_phase(Params p, int ph) {
  __shared__ __attribute__((aligned(16))) char smem[SMEM_BYTES];
  run_phase(p, ph, smem);
}
#endif

extern "C" void kernel_launch(void* const* d_in, const int* in_sizes, int n_in, void* d_out, int out_size, void* d_ws,
                              size_t ws_size, hipStream_t stream) {
  (void)in_sizes; (void)n_in; (void)out_size;
  static int grid_blocks = 0;
  if (!grid_blocks) {
    int dev = 0, cus = 0, per_cu = 0;
    hipGetDevice(&dev);
    hipDeviceGetAttribute(&cus, hipDeviceAttributeMultiprocessorCount, dev);
    hipOccupancyMaxActiveBlocksPerMultiprocessor(&per_cu, hybrid_mega, NT, 0);
    if (per_cu < 1) per_cu = 1;
    grid_blocks = cus;
  }
  size_t used = 0;
  Params p = make_params(d_in, d_out, d_ws, &used);
  if (used > ws_size) return;
#ifdef MULTI_LAUNCH
  for (int ph = 0; ph < NPHASES; ++ph) hipLaunchKernelGGL(hybrid_phase, dim3(grid_blocks), dim3(NT), 0, stream, p, ph);
#else
  hipMemsetAsync(p.bar, 0, (size_t)XCD_BAR_WORDS * 4, stream);
  void* args[] = {&p};
  hipLaunchCooperativeKernel((void*)hybrid_mega, dim3(grid_blocks), dim3(NT), args, 0, stream);
#endif
}
#endif
```

```cpp
#ifdef EMU
#include "emu_hip.h"
#else
#include <hip/hip_runtime.h>
#endif
#include <stdint.h>
#include <stddef.h>

#define DI __device__ __forceinline__

#ifdef CFG_SMALL
constexpr int D = 512, NB = 2, SEQ = 256, GRID_W = 16, CTXL = 256, CONV_CH = 128, HY_CH = 128, RW_H = 4;
#else
constexpr int D = 1024, NB = 8, SEQ = 4096, GRID_W = 64, CTXL = 256, CONV_CH = 256, HY_CH = 256, RW_H = 8;
#endif
constexpr int DEPTH = 2;
constexpr int HD = 64;
constexpr int RW_CH = RW_H * HD;
constexpr int MIX_W = CONV_CH + HY_CH + RW_CH;
constexpr int DRK = 64, IRK = 64, GRK = 128;
constexpr int RW_COLS = 3 * RW_CH + 2 * DRK + 2 * IRK + GRK;
constexpr int PA_W = 3 * CONV_CH, PH_W = 3 * HY_CH;
constexpr int P_IN = PA_W + PH_W + RW_COLS;
constexpr int P_IN_PAD = ((P_IN + 255) / 256) * 256;
constexpr int HY_EMB = 33, HY_BANDS = 16, HY_HID = 64;
constexpr int NE = 64, TOPK = 8, FF = 256;
constexpr int TL = NB * SEQ, TC = NB * CTXL, T = TL + TC;
constexpr int FFTN = 2 * SEQ;
constexpr int ilog2c(int n) { return n <= 1 ? 0 : 1 + ilog2c(n / 2); }
constexpr int LOG2N = ilog2c(FFTN);
constexpr float LN_EPS = 1e-5f;
constexpr float RW_GN_EPS = 64e-5f;
constexpr float DN_ALPHA = 1.41421356237309515f;
constexpr float ROUTED_SCALE = 2.5f;
constexpr int NT = 512;
#ifndef PROF_A
#define PROF_A 0
#endif
#ifndef PROF_B
#define PROF_B 0
#endif
#ifndef PROF_C
#define PROF_C 0
#endif
constexpr int SMEM_BYTES = 160 * 1024;
static_assert(MIX_W == D, "mix width");
static_assert(D % 128 == 0 && P_IN % 128 == 0 && PA_W % 128 == 0 && PH_W % 128 == 0, "tiles");
static_assert(SEQ % 256 == 0 && CTXL % 256 == 0, "row tiles");

typedef unsigned short u16;
typedef __attribute__((ext_vector_type(8))) short bf16x8;
typedef __attribute__((ext_vector_type(16))) float f32x16;
typedef __attribute__((ext_vector_type(4))) unsigned u32x4;
typedef __attribute__((ext_vector_type(2))) unsigned u32x2;
typedef __attribute__((ext_vector_type(4))) float f32x4;
struct cf { float x, y; };

struct Params {
  const float *x, *c, *ctx, *c_ctx, *w_ada, *b_ada, *w_in, *conv_a, *hy_sconv_w, *hy_sconv_b;
  const float *hf_w1, *hf_b1, *hf_w2, *hf_b2, *hf_w3, *hf_b3, *hf_wout, *hf_freq, *hf_skip;
  const float *rw_mu, *rw_w0, *rw_w_up, *rw_a0, *rw_a_up, *rw_g_up, *rw_k_k, *rw_k_a, *rw_r_k;
  const float *rw_lnx_g, *rw_lnx_b, *mix_norm_g, *w_out, *ln_g, *ln_b, *w_router, *e_bias;
  const float *w_e_gate, *w_e_up, *w_e_down, *w_s_gate, *w_s_up, *w_s_down;
  float* out;
  float* mod;
  float* h3lat;
  float* h3ctx;
  cf* tw;
  int* cnt;
  float* sbonus;
  cf* spec;
  u16* HL;
  u16* PA;
  u16* PH;
  u16* PR;
  u16* SIsh_lat;
  u16* SIsh_ctx;
  u16* SIdir_lat;
  u16* SIdir_ctx;
  u16* ya;
  u16* yhlat;
  u16* yhctx;
  u16* gbuf;
  u16* ybuf;
  u16* ycat;
  float* XC;
  u16* wt_in;
  u16* wt_out;
  u16* wt_rhi;
  u16* wt_rlo;
  u16* wt_wup;
  u16* wt_aup;
  u16* wt_gup;
  u16* Hbuf;
  u16* SHo;
  u16* wt_exp;
  int* acc;
  int* etok;
  float* egate;
  long long* tstamp;
  unsigned* bar;
};


#ifndef PROF_SEG
#define PROF_SEG 0
#endif
#if PROF_SEG && !defined(EMU)
#define SEG_BEGIN(p) long long seg_last_ = 0; const bool seg_on_ = (blockIdx.x == 0 && threadIdx.x == 0); if (seg_on_) seg_last_ = (long long)__builtin_amdgcn_s_memrealtime();
#define SEG_MARK(p, k) if (seg_on_) { long long now_ = (long long)__builtin_amdgcn_s_memrealtime(); (p).tstamp[32 + (k)] += now_ - seg_last_; seg_last_ = now_; }
#else
#define SEG_BEGIN(p)
#define SEG_MARK(p, k)
#endif
#ifdef EMU
DI int TIDX() { return threadIdx.x; }
DI int BIDX() { return blockIdx.x; }
#else
DI int TIDX() { int t = threadIdx.x; asm volatile("" : "+v"(t)); return t; }
DI int BIDX() { int b = blockIdx.x; asm volatile("" : "+s"(b)); return b; }
#endif

#ifdef EMU
DI u16 f2bf(float x) {
  unsigned u = __builtin_bit_cast(unsigned, x);
  u += 0x7fffu + ((u >> 16) & 1u);
  return (u16)(u >> 16);
}
#else
DI u16 f2bf(float x) { return __builtin_bit_cast(u16, (__bf16)x); }
#endif
DI float bf2f(u16 h) { return __builtin_bit_cast(float, ((unsigned)h) << 16); }
DI u16 f2h(float x) { return __builtin_bit_cast(u16, (_Float16)x); }
DI float h2f(u16 h) { return (float)__builtin_bit_cast(_Float16, h); }
#ifdef EMU
DI unsigned pk2(float a, float b) { return (unsigned)f2bf(a) | ((unsigned)f2bf(b) << 16); }
#else
DI unsigned pk2(float a, float b) {
  typedef __bf16 bf16v2 __attribute__((ext_vector_type(2)));
  bf16v2 v; v[0] = (__bf16)a; v[1] = (__bf16)b;
  return __builtin_bit_cast(unsigned, v);
}
#endif
DI float sigmoidf_(float x) { return 1.0f / (1.0f + expf(-x)); }
DI float siluf_(float x) { return x / (1.0f + expf(-x)); }
DI float softplusf_(float x) { return x > 20.f ? x : log1pf(expf(x)); }
#ifdef EMU
DI float fexp_(float x) { return expf(x); }
DI float frcp_(float x) { return 1.0f / x; }
#else
DI float fexp_(float x) { return __builtin_amdgcn_exp2f(x * 1.44269504088896341f); }
DI float frcp_(float x) { return __builtin_amdgcn_rcpf(x); }
#endif
DI float fsigmoid_(float x) { return frcp_(1.0f + fexp_(-x)); }
DI float ftanh_(float x) { return 1.0f - 2.0f * frcp_(1.0f + fexp_(2.0f * x)); }

#ifdef EMU
DI float red16(float v) { v += __shfl_xor(v, 1); v += __shfl_xor(v, 2); v += __shfl_xor(v, 4); v += __shfl_xor(v, 8); return v; }
DI float wave_sum(float v) {
#pragma unroll
  for (int m = 1; m < 64; m <<= 1) v += __shfl_xor(v, m);
  return v;
}
#else
template <int CTRL> DI float dppf(float v) {
  return __builtin_bit_cast(float, __builtin_amdgcn_update_dpp(0, __builtin_bit_cast(int, v), CTRL, 0xf, 0xf, true));
}
DI float red16(float v) {
  v += dppf<0xB1>(v);
  v += dppf<0x4E>(v);
  v += dppf<0x141>(v);
  v += dppf<0x140>(v);
  return v;
}
DI float wave_sum(float v) {
  v = red16(v);
  int iv = __builtin_bit_cast(int, v);
  float a = __builtin_bit_cast(float, __builtin_amdgcn_readlane(iv, 0));
  float b = __builtin_bit_cast(float, __builtin_amdgcn_readlane(iv, 16));
  float c = __builtin_bit_cast(float, __builtin_amdgcn_readlane(iv, 32));
  float d = __builtin_bit_cast(float, __builtin_amdgcn_readlane(iv, 48));
  return (a + b) + (c + d);
}
#endif
#ifdef EMU
DI float wave_max(float v) {
#pragma unroll
  for (int m = 1; m < 64; m <<= 1) v = fmaxf(v, __shfl_xor(v, m));
  return v;
}
#else
DI float wave_max(float v) {
  v = fmaxf(v, dppf<0xB1>(v));
  v = fmaxf(v, dppf<0x4E>(v));
  v = fmaxf(v, dppf<0x141>(v));
  v = fmaxf(v, dppf<0x140>(v));
  int iv = __builtin_bit_cast(int, v);
  float a = __builtin_bit_cast(float, __builtin_amdgcn_readlane(iv, 0));
  float b = __builtin_bit_cast(float, __builtin_amdgcn_readlane(iv, 16));
  float c = __builtin_bit_cast(float, __builtin_amdgcn_readlane(iv, 32));
  float d = __builtin_bit_cast(float, __builtin_amdgcn_readlane(iv, 48));
  return fmaxf(fmaxf(a, b), fmaxf(c, d));
}
#endif
DI void wave_sync() {
#ifdef EMU
  emu::wave_barrier();
#else
  asm volatile("s_waitcnt lgkmcnt(0)" ::: "memory");
  __builtin_amdgcn_wave_barrier();
#endif
}
DI f32x4 ld_bf4(const u16* q) {
  u32x2 v = *(const u32x2*)q;
  f32x4 r;
  r[0] = bf2f((u16)(v[0] & 0xffff)); r[1] = bf2f((u16)(v[0] >> 16));
  r[2] = bf2f((u16)(v[1] & 0xffff)); r[3] = bf2f((u16)(v[1] >> 16));
  return r;
}
DI void st_bf4(u16* q, f32x4 v) {
  u32x2 o; o[0] = pk2(v[0], v[1]); o[1] = pk2(v[2], v[3]);
  *(u32x2*)q = o;
}
DI int crow(int reg, int h) { return (reg & 3) + 8 * (reg >> 2) + 4 * h; }
#define MFMA32(a, b, c) __builtin_amdgcn_mfma_f32_32x32x16_bf16((a), (b), (c), 0, 0, 0)

DI int modrow(int r) { return r < TL ? r / SEQ : NB; }
DI const float* modp(const Params& p, int l, int r) { return p.mod + ((size_t)l * (NB + 1) + modrow(r)) * (6 * D); }


#define XB_TMO      128
#define XB_TICKET   192
#define XB_XCNT(j)  (256  + 64 * (j))
#define XB_XSUB(j)  (1280 + 64 * (j))
#define XB_XGEN(j)  (2304 + 64 * (j))
#define XB_TOP      3328
#define XB_TOPGEN   3392
#define XCD_BAR_WORDS 3456
#ifndef EMU
#define XB_SPIN_CAP (1u << 22)
#define LAS __attribute__((address_space(3)))
DI unsigned xb_ld(unsigned* p) { return __hip_atomic_load(p, __ATOMIC_RELAXED, __HIP_MEMORY_SCOPE_AGENT); }
DI unsigned xb_add(unsigned* p, unsigned v) { return __hip_atomic_fetch_add(p, v, __ATOMIC_RELAXED, __HIP_MEMORY_SCOPE_AGENT); }
DI unsigned xb_xcc_id() { return (unsigned)__builtin_amdgcn_s_getreg((3 << 11) | 20) & 0xFu; }
#define XB_SPIN(cond, bar) do { unsigned _sp = 0; while (cond) { __builtin_amdgcn_s_sleep(1); \
    if ((++_sp & 255u) == 0u) { if (xb_ld(&(bar)[XB_TMO])) break; if (_sp > XB_SPIN_CAP) { atomicAdd(&(bar)[XB_TMO], 1u); break; } } } } while (0)
struct XcdBarrier { unsigned* bar; unsigned x; volatile LAS unsigned* st; };
DI XcdBarrier xcd_barrier_post(unsigned* bar, volatile LAS unsigned* st) {
  XcdBarrier b; b.bar = bar; b.x = xb_xcc_id(); b.st = st;
  if (threadIdx.x == 0) (void)xb_add(&bar[XB_XCNT(b.x)], 1u);
  return b;
}
DI void xcd_barrier_complete(unsigned* bar, unsigned x, unsigned& nloc, unsigned& nx) {
  const unsigned G = gridDim.x * gridDim.y * gridDim.z;
  unsigned sum, cnt, mine, sp = 0u;
  for (;;) {
    sum = 0u; cnt = 0u; mine = 0u;
#pragma unroll
    for (unsigned j = 0; j < 16; ++j) { const unsigned c = xb_ld(&bar[XB_XCNT(j)]); sum += c; cnt += (c > 0u) ? 1u : 0u; mine = (j == x) ? c : mine; }
    if (sum == G) break;
    __builtin_amdgcn_s_sleep(1);
    if ((++sp & 255u) == 0u) { if (xb_ld(&bar[XB_TMO])) break; if (sp > XB_SPIN_CAP) { atomicAdd(&bar[XB_TMO], 1u); break; } }
  }
  nloc = mine > 0u ? mine : 1u; nx = cnt > 0u ? cnt : 1u;
}
DI void xcd_barrier(const XcdBarrier& b) {
  asm volatile("s_waitcnt vmcnt(0)" ::: "memory");
  __syncthreads();
  if (threadIdx.x == 0) {
    unsigned* bar = b.bar;
    __builtin_amdgcn_s_waitcnt(0);
    unsigned nloc = b.st[0], nx = b.st[1];
    if (nloc == 0u) { xcd_barrier_complete(bar, b.x, nloc, nx); b.st[0] = nloc; b.st[1] = nx; }
    const unsigned old = xb_add(&bar[XB_XSUB(b.x)], 1u);
    const unsigned gen = old / nloc;
    if (old + 1u == (gen + 1u) * nloc) {
      __builtin_amdgcn_fence(__ATOMIC_RELEASE, "agent");
      asm volatile("s_waitcnt vmcnt(0)" ::: "memory");
      const unsigned og = xb_add(&bar[XB_TOP], 1u);
      const unsigned tg = og / nx;
      if (og + 1u == (tg + 1u) * nx) xb_add(&bar[XB_TOPGEN], 1u);
      else XB_SPIN(xb_ld(&bar[XB_TOPGEN]) == tg, bar);
      __builtin_amdgcn_fence(__ATOMIC_ACQUIRE, "agent");
      xb_add(&bar[XB_XGEN(b.x)], 1u);
      asm volatile("s_waitcnt vmcnt(0)" ::: "memory");
    } else {
      XB_SPIN(xb_ld(&bar[XB_XGEN(b.x)]) == gen, bar);
      __builtin_amdgcn_fence(__ATOMIC_ACQUIRE, "agent");
      asm volatile("s_waitcnt vmcnt(0)" ::: "memory");
    }
  }
  __syncthreads();
}
#endif

namespace pg8 {
constexpr int BM = 256, BK = 64, HALF = 128, HTB = HALF * BK * 2, STAGE_BYTES = 8 * HTB;
struct Unit { int pm, pn, e, cnt, idx; };
__host__ __device__ __forceinline__ int lds_byte(int r, int c) { const int st = (r >> 4) * 2 + (c >> 5), rr = r & 15, cc = c & 31, ob = rr * 64 + cc * 2; return st * 1024 + (ob ^ (((ob >> 9) & 1) << 5)); }
__host__ __device__ __forceinline__ void stage_rc(int b, int& R, int& C) { const int st = b / 1024, sb = b % 1024, swz = sb ^ (((sb >> 9) & 1) << 5); R = (st >> 1) * 16 + swz / 64; C = (st & 1) * 32 + (swz % 64) / 2; }

#ifdef EMU
template <class Epi, class Sched>
inline void gemm_phase(char* lds, int K, const Sched& S, const Epi& E) {
  (void)lds;
  const int tid = TIDX(), wid = tid >> 6, lane = tid & 63, wr = wid >> 2, wc = wid & 3, fr = lane & 15, fq = lane >> 4;
  Unit u;
  for (int ui = 0; S.next(ui, u); ++ui) {
    f32x4 acc[2][2][4][2];
    for (int ai = 0; ai < 2; ++ai) for (int bj = 0; bj < 2; ++bj) for (int m = 0; m < 4; ++m) for (int n = 0; n < 2; ++n) {
      const int r = 128 * ai + 64 * wr + 16 * m + fr;
      const u16* arow = (const u16*)(S.abase() + S.arow_off(u, r));
      for (int j = 0; j < 4; ++j) {
        const int c = 32 * wc + 16 * n + 4 * fq + j;
        const u16* brow = (const u16*)S.bbase(u, bj) + (size_t)c * K;
        float s = 0.f;
        for (int k = 0; k < K; ++k) s += bf2f(arow[k]) * bf2f(brow[k]);
        acc[ai][bj][m][n][j] = s;
      }
    }
    E(acc, u, wr, wc, fr, fq, E.prefetch(u, wr, lane));
  }
}
#else
#define PG8_LAS __attribute__((address_space(3)))
template <class Epi, class Sched>
__device__ __forceinline__ void gemm_phase(char* lds_generic, int K, const Sched& S, const Epi& E) {
  PG8_LAS unsigned char* lds = (PG8_LAS unsigned char*)lds_generic;
  const int tid = TIDX(), wid = __builtin_amdgcn_readfirstlane(tid >> 6), lane = tid & 63, wr = wid >> 2, wc = wid & 3, fr = lane & 15, fq = lane >> 4;
  const int nt = K / BK;
  int Rr[2], Cc[2];
  unsigned voffB[2];
#pragma unroll
  for (int i = 0; i < 2; ++i) { stage_rc(tid * 16 + i * 8192, Rr[i], Cc[i]); voffB[i] = (unsigned)(Rr[i] * K + Cc[i]) * 2u; }
  const size_t kstep = (size_t)(BK * 2);
  const unsigned ldsw = (unsigned)wid * 1024u;
  const int aoff = lds_byte(wr * 64 + fr, fq * 8), boff = lds_byte(wc * 32 + fr, fq * 8);
#define PG8_SA(b, h) (((b) * 2 + (h)) * HTB)
#define PG8_SB(b, h) ((4 + (b) * 2 + (h)) * HTB)
#define PG8_STAGE2(bufoff, gbase, v0, v1) do { \
    __builtin_amdgcn_global_load_lds((const unsigned*)((const char*)(gbase) + (v0)), (PG8_LAS unsigned*)(lds + (bufoff) + ldsw), 16, 0, 0); \
    __builtin_amdgcn_global_load_lds((const unsigned*)((const char*)(gbase) + (v1)), (PG8_LAS unsigned*)(lds + (bufoff) + ldsw + 8192), 16, 0, 0); } while (0)
#define PG8_STAGEB(bufoff, gbase) PG8_STAGE2(bufoff, gbase, voffB[0], voffB[1])
#define PG8_LDA(dst, b, h) do { _Pragma("unroll") for (int m = 0; m < 4; ++m) _Pragma("unroll") for (int k = 0; k < 2; ++k) dst[m][k] = *(const PG8_LAS bf16x8*)(lds + PG8_SA(b, h) + aoff + m * 2048 + k * 1024); } while (0)
#define PG8_LDB(dst, b, h) do { _Pragma("unroll") for (int n = 0; n < 2; ++n) _Pragma("unroll") for (int k = 0; k < 2; ++k) dst[n][k] = *(const PG8_LAS bf16x8*)(lds + PG8_SB(b, h) + boff + n * 2048 + k * 1024); } while (0)
#define PG8_MMA(ai, bj, At, Bt) do { __builtin_amdgcn_s_setprio(1); _Pragma("unroll") for (int m = 0; m < 4; ++m) _Pragma("unroll") for (int n = 0; n < 2; ++n) _Pragma("unroll") for (int k = 0; k < 2; ++k) \
    acc[ai][bj][m][n] = __builtin_amdgcn_mfma_f32_16x16x32_bf16(Bt[n][k], At[m][k], acc[ai][bj][m][n], 0, 0, 0); __builtin_amdgcn_s_setprio(0); } while (0)
#define PG8_WAIT_V(n) asm volatile("s_waitcnt vmcnt(" #n ")" ::: "memory")
#define PG8_WAIT_L(n) asm volatile("s_waitcnt lgkmcnt(" #n ")" ::: "memory")
#define PG8_BAR __builtin_amdgcn_s_barrier()
#define PG8_SCHED __builtin_amdgcn_sched_barrier(0)
  Unit cur, nxt; int ui = 0;
  if (!S.next(0, cur)) return;
  f32x4 acc[2][2][4][2];
#pragma unroll
  for (int a = 0; a < 2; ++a)
#pragma unroll
    for (int b = 0; b < 2; ++b)
#pragma unroll
      for (int m = 0; m < 4; ++m)
#pragma unroll
        for (int n = 0; n < 2; ++n) acc[a][b][m][n] = (f32x4){0.f, 0.f, 0.f, 0.f};
  bf16x8 At[4][2], B0[2][2], B1[2][2];
  const char* const gA = S.abase();
  unsigned cv00 = 0, cv01 = 0, cv10 = 0, cv11 = 0, nv00 = 0, nv01 = 0, nv10 = 0, nv11 = 0;
  const char *cA0 = gA, *cA1 = gA, *nA0 = gA, *nA1 = gA;
  if constexpr (Sched::GATHER) {
    cv00 = S.arow_off(cur, Rr[0]) + Cc[0] * 2u; cv01 = S.arow_off(cur, Rr[1]) + Cc[1] * 2u;
    cv10 = S.arow_off(cur, 128 + Rr[0]) + Cc[0] * 2u; cv11 = S.arow_off(cur, 128 + Rr[1]) + Cc[1] * 2u;
  } else {
    cA0 = gA + S.arow_off(cur, 0); cA1 = gA + S.arow_off(cur, 128);
  }
#define PG8_STAGE_A(bufoff, kb, h, NEXT) do { \
    if constexpr (Sched::GATHER) { PG8_STAGE2(bufoff, gA + (kb), (NEXT) ? ((h) ? nv10 : nv00) : ((h) ? cv10 : cv00), (NEXT) ? ((h) ? nv11 : nv01) : ((h) ? cv11 : cv01)); } \
    else { PG8_STAGE2(bufoff, ((NEXT) ? ((h) ? nA1 : nA0) : ((h) ? cA1 : cA0)) + (kb), voffB[0], voffB[1]); } } while (0)
  const char* cB0 = S.bbase(cur, 0); const char* cB1 = S.bbase(cur, 1);
  PG8_STAGEB(PG8_SB(0, 0), cB0); PG8_STAGE_A(PG8_SA(0, 0), 0, 0, false); PG8_STAGEB(PG8_SB(0, 1), cB1); PG8_STAGE_A(PG8_SA(0, 1), 0, 1, false);
  if (wr == 1) PG8_BAR;
  PG8_WAIT_V(4); PG8_BAR;
  PG8_STAGEB(PG8_SB(1, 0), cB0 + kstep); PG8_STAGE_A(PG8_SA(1, 0), kstep, 0, false); PG8_STAGEB(PG8_SB(1, 1), cB1 + kstep);
  PG8_WAIT_V(6); PG8_BAR;
  for (;;) {
    const bool has_next = S.next(ui + 1, nxt);
    const char* nB0 = cB0; const char* nB1 = cB1;
    if constexpr (Sched::GATHER) { nv00 = cv00; nv01 = cv01; nv10 = cv10; nv11 = cv11; } else { nA0 = cA0; nA1 = cA1; }
    if (has_next) {
      if constexpr (Sched::GATHER) {
        nv00 = S.arow_off(nxt, Rr[0]) + Cc[0] * 2u; nv01 = S.arow_off(nxt, Rr[1]) + Cc[1] * 2u;
        nv10 = S.arow_off(nxt, 128 + Rr[0]) + Cc[0] * 2u; nv11 = S.arow_off(nxt, 128 + Rr[1]) + Cc[1] * 2u;
      } else {
        nA0 = gA + S.arow_off(nxt, 0); nA1 = gA + S.arow_off(nxt, 128);
      }
      nB0 = S.bbase(nxt, 0); nB1 = S.bbase(nxt, 1);
    }
    const typename Epi::Pre epre = E.prefetch(cur, wr, lane);
#pragma clang loop unroll(disable)
    for (int t = 0; t < nt; t += 2) {
      const bool last = (t == nt - 2);
      const size_t kb1 = (size_t)(t + 1) * kstep;
      const size_t kb2 = last ? (size_t)0 : (size_t)(t + 2) * kstep;
      const size_t kb3 = kb2 + kstep;
      const char* b20 = last ? nB0 : cB0 + (size_t)(t + 2) * kstep;
      const char* b21 = last ? nB1 : cB1 + (size_t)(t + 2) * kstep;
      const char* b30 = b20 + kstep; const char* b31 = b21 + kstep;
      PG8_LDB(B0, 0, 0); PG8_SCHED; PG8_LDA(At, 0, 0); PG8_STAGE_A(PG8_SA(1, 1), kb1, 1, false);
      PG8_WAIT_L(8); PG8_BAR; PG8_WAIT_L(0); PG8_MMA(0, 0, At, B0); PG8_BAR; PG8_SCHED;
      PG8_LDB(B1, 0, 1); PG8_STAGEB(PG8_SB(0, 0), b20);
      PG8_BAR; PG8_WAIT_L(0); PG8_MMA(0, 1, At, B1); PG8_BAR;
      PG8_LDA(At, 0, 1); PG8_STAGE_A(PG8_SA(0, 0), kb2, 0, last);
      PG8_BAR; PG8_WAIT_L(0); PG8_MMA(1, 0, At, B0); PG8_BAR; PG8_SCHED;
      PG8_STAGEB(PG8_SB(0, 1), b21);
      PG8_WAIT_V(6); PG8_BAR; PG8_MMA(1, 1, At, B1); PG8_BAR;
      PG8_LDB(B0, 1, 0); PG8_SCHED; PG8_LDA(At, 1, 0); PG8_STAGE_A(PG8_SA(0, 1), kb2, 1, last);
      PG8_WAIT_L(8); PG8_BAR; PG8_WAIT_L(0); PG8_MMA(0, 0, At, B0); PG8_BAR; PG8_SCHED;
      PG8_LDB(B1, 1, 1); PG8_STAGEB(PG8_SB(1, 0), b30);
      PG8_BAR; PG8_WAIT_L(0); PG8_MMA(0, 1, At, B1); PG8_BAR;
      PG8_LDA(At, 1, 1); PG8_STAGE_A(PG8_SA(1, 0), kb3, 0, last);
      PG8_BAR; PG8_WAIT_L(0); PG8_MMA(1, 0, At, B0); PG8_BAR; PG8_SCHED;
      PG8_STAGEB(PG8_SB(1, 1), b31);
      PG8_WAIT_V(6); PG8_BAR; PG8_MMA(1, 1, At, B1); PG8_BAR;
    }
    E(acc, cur, wr, wc, fr, fq, epre);
    if (!has_next) break;
#pragma unroll
    for (int a = 0; a < 2; ++a)
#pragma unroll
      for (int b = 0; b < 2; ++b)
#pragma unroll
        for (int m = 0; m < 4; ++m)
#pragma unroll
          for (int n = 0; n < 2; ++n) acc[a][b][m][n] = (f32x4){0.f, 0.f, 0.f, 0.f};
    cur = nxt; cB0 = nB0; cB1 = nB1; ++ui;
    if constexpr (Sched::GATHER) { cv00 = nv00; cv01 = nv01; cv10 = nv10; cv11 = nv11; } else { cA0 = nA0; cA1 = nA1; }
  }
  PG8_WAIT_V(0);
  if (wr == 0) PG8_BAR;
  PG8_BAR;
#undef PG8_SA
#undef PG8_SB
#undef PG8_STAGE2
#undef PG8_STAGE_A
#undef PG8_STAGEB
#undef PG8_LDA
#undef PG8_LDB
#undef PG8_MMA
#undef PG8_WAIT_V
#undef PG8_WAIT_L
#undef PG8_BAR
#undef PG8_SCHED
}
#endif
DI int remap_xcd(int L, int nwg) {
  const int q = nwg / 8, r = nwg % 8, xcd = L % 8, off = L / 8;
  return (xcd < r ? xcd * (q + 1) : r * (q + 1) + (xcd - r) * q) + off;
}
}

DI void convert_tile(const float* __restrict__ src, int K, int N, u16* __restrict__ dst, u16* __restrict__ dst_lo, int tile, char* smem) {
  const int tid = TIDX();
  float* t = (float*)smem;
  const int ntn = N / 64;
  const int k0 = (tile / ntn) * 64, n0 = (tile % ntn) * 64;
#pragma unroll
  for (int i = 0; i < 8; ++i) {
    const int row = i * 8 + (tid >> 6), col = tid & 63;
    t[row * 65 + col] = src[(size_t)(k0 + row) * N + n0 + col];
  }
  __syncthreads();
  const int n = tid >> 3, kq = tid & 7;
  float f[8];
#pragma unroll
  for (int j = 0; j < 8; ++j) f[j] = t[(kq * 8 + j) * 65 + n];
  u32x4 pb;
  pb[0] = pk2(f[0], f[1]); pb[1] = pk2(f[2], f[3]); pb[2] = pk2(f[4], f[5]); pb[3] = pk2(f[6], f[7]);
  *(u32x4*)(dst + (size_t)(n0 + n) * K + k0 + kq * 8) = pb;
  if (dst_lo) {
#pragma unroll
    for (int j = 0; j < 8; ++j) f[j] -= bf2f(f2bf(f[j]));
    pb[0] = pk2(f[0], f[1]); pb[1] = pk2(f[2], f[3]); pb[2] = pk2(f[4], f[5]); pb[3] = pk2(f[6], f[7]);
    *(u32x4*)(dst_lo + (size_t)(n0 + n) * K + k0 + kq * 8) = pb;
  }
  __syncthreads();
}
DI void convert_tile_w(const float* __restrict__ src, int K, int N, u16* __restrict__ dst, int tile, char* smem) {
  const int tid = TIDX();
  float* t = (float*)smem;
  const int ntn = N / 256;
  const int k0 = (tile / ntn) * 64, n0 = (tile % ntn) * 256;
#pragma unroll
  for (int i = 0; i < 8; ++i) {
    const int row = i * 8 + (tid >> 6), col = (tid & 63) * 4;
    const f32x4 v = *(const f32x4*)(src + (size_t)(k0 + row) * N + n0 + col);
    float* q = t + row * 257 + col;
    q[0] = v[0]; q[1] = v[1]; q[2] = v[2]; q[3] = v[3];
  }
  __syncthreads();
#pragma unroll
  for (int i = 0; i < 4; ++i) {
    const int idx = tid + NT * i;
    const int n = idx >> 3, kq = idx & 7;
    float f[8];
#pragma unroll
    for (int j = 0; j < 8; ++j) f[j] = t[(kq * 8 + j) * 257 + n];
    u32x4 pb;
    pb[0] = pk2(f[0], f[1]); pb[1] = pk2(f[2], f[3]); pb[2] = pk2(f[4], f[5]); pb[3] = pk2(f[6], f[7]);
    *(u32x4*)(dst + (size_t)(n0 + n) * K + k0 + kq * 8) = pb;
  }
  __syncthreads();
}
constexpr int CT_IN = (D / 64) * (P_IN / 64), CT_OUT = (MIX_W / 64) * (D / 64), CT_R = (D / 64) * (NE / 64);
constexpr int CT_WUP = (DRK / 64) * (RW_CH / 64), CT_GUP = (GRK / 64) * (RW_CH / 64);
constexpr int CT_STATIC_L = CT_IN + CT_OUT + CT_R + 4 * CT_WUP + CT_GUP;
DI void convert_static_item(const Params& p, int it, char* smem) {
  const int l = it / CT_STATIC_L;
  int q = it % CT_STATIC_L;
  if (q < CT_IN) { convert_tile(p.w_in + (size_t)l * D * P_IN, D, P_IN, p.wt_in + (size_t)l * P_IN_PAD * D, nullptr, q, smem); return; }
  q -= CT_IN;
  if (q < CT_OUT) { convert_tile(p.w_out + (size_t)l * MIX_W * D, MIX_W, D, p.wt_out + (size_t)l * D * MIX_W, nullptr, q, smem); return; }
  q -= CT_OUT;
  if (q < CT_R) { convert_tile(p.w_router + (size_t)l * D * NE, D, NE, p.wt_rhi + (size_t)l * NE * D, p.wt_rlo + (size_t)l * NE * D, q, smem); return; }
  q -= CT_R;
  if (q < 4 * CT_WUP) {
    const int which = q / CT_WUP, tile = q % CT_WUP;
    const int d = which & 1;
    if (which < 2) convert_tile(p.rw_w_up + ((size_t)l * 2 + d) * DRK * RW_CH, DRK, RW_CH, p.wt_wup + ((size_t)l * 2 + d) * RW_CH * DRK, nullptr, tile, smem);
    else convert_tile(p.rw_a_up + ((size_t)l * 2 + d) * IRK * RW_CH, IRK, RW_CH, p.wt_aup + ((size_t)l * 2 + d) * RW_CH * IRK, nullptr, tile, smem);
    return;
  }
  q -= 4 * CT_WUP;
  convert_tile(p.rw_g_up + (size_t)l * GRK * RW_CH, GRK, RW_CH, p.wt_gup + (size_t)l * RW_CH * GRK, nullptr, q, smem);
}
constexpr int CT_EMAT = (D / 64) * (FF / 256);
static_assert(FF % 256 == 0 && D % 256 == 0 && (D / 64) * (FF / 256) == (FF / 64) * (D / 256), "expert conversion tiling");
constexpr int CT_EXP_L = (NE + 1) * 3 * CT_EMAT;
constexpr size_t EXP_STRIDE = (size_t)3 * D * FF;
DI void convert_expert_item(const Params& p, int l, int it, char* smem) {
  const int e = it / (3 * CT_EMAT), m = (it / CT_EMAT) % 3, tile = it % CT_EMAT;
  const float *eg = p.w_e_gate, *eu = p.w_e_up, *ed = p.w_e_down, *sg = p.w_s_gate, *su = p.w_s_up, *sd = p.w_s_down;
#ifndef EMU
  asm volatile("" : "+s"(eg), "+s"(eu), "+s"(ed), "+s"(sg), "+s"(su), "+s"(sd));
#endif
  const float* src;
  if (e < NE) src = (m == 0 ? eg : m == 1 ? eu : ed) + ((size_t)l * NE + e) * D * FF;
  else src = (m == 0 ? sg : m == 1 ? su : sd) + (size_t)l * D * FF;
#ifndef EMU
  src = (const float*)(__attribute__((address_space(1))) const float*)(unsigned long long)src;
#endif
  u16* dst = p.wt_exp + (size_t)e * EXP_STRIDE + (size_t)m * D * FF;
  if (m < 2) convert_tile_w(src, D, FF, dst, tile, smem);
  else convert_tile_w(src, FF, D, dst, tile, smem);
}

DI float* x1row(const Params& p, int r) { return r < TL ? p.out + (size_t)r * D : p.XC + (size_t)(r - TL) * D; }

struct DenseSched {
  static constexpr bool GATHER = false;
  const char* A; const char* Bt; int K, nM, nN, nwg, G, c;
  DI void init(const void* A_, const void* Bt_, int K_, int M, int N, int G_, int c_) { A = (const char*)A_; Bt = (const char*)Bt_; K = K_; nM = M / 256; nN = N / 256; nwg = nM * nN; G = G_; c = c_; }
  DI bool next(int i, pg8::Unit& u) const {
    const int L = i * G + c; if (L >= nwg) return false;
    const int wgid = pg8::remap_xcd(L, nwg);
    const int nig = 8 * nN, gid = wgid / nig, fm = gid * 8, gsz = (nM - fm) < 8 ? (nM - fm) : 8;
    u.pm = fm + ((wgid % nig) % gsz); u.pn = (wgid % nig) / gsz; u.e = 0; u.cnt = 0; u.idx = i; return true;
  }
  DI const char* abase() const { return A; }
  DI unsigned arow_off(const pg8::Unit& u, int r) const { return (unsigned)(u.pm * 256 + r) * (unsigned)(K * 2); }
  DI const char* bbase(const pg8::Unit& u, int half) const { return Bt + (size_t)(u.pn * 256 + half * 128) * K * 2; }
};
struct ExpertSched {
  const int* pre;
  const int* cntl;
  const unsigned char* t2e;
  int nN, G, c, total;
  DI bool locate(int i, pg8::Unit& u) const {
    const int L = i * G + c; if (L >= total) return false;
    const int w = pg8::remap_xcd(L, total);
    const int tile = w / nN; u.pn = w % nN;
    const int e = (int)t2e[tile];
    u.e = e; u.pm = tile - pre[e]; u.cnt = cntl[e]; u.idx = i;
    return true;
  }
};
struct E1Sched : ExpertSched {
  static constexpr bool GATHER = true;
  const char* A; const char* W; const int* etok;
  const unsigned* loff; int nl;
  DI bool next(int i, pg8::Unit& u) const { return locate(i, u); }
  DI const char* abase() const { return A; }
  DI unsigned goff(const pg8::Unit& u, int r) const {
    const int slot = u.pm * 256 + r;
    const unsigned tl = (unsigned)etok[u.e < NE ? (size_t)u.e * T + slot : (size_t)slot];
    const unsigned tok = u.e < NE ? (tl < (unsigned)T ? tl : 0u) : (unsigned)slot;
    return tok * (unsigned)(D * 2);
  }
  DI unsigned arow_off(const pg8::Unit& u, int r) const { return u.idx < nl ? loff[u.idx * 256 + r] : goff(u, r); }
  DI void preload(unsigned* lds_off, int maxu) {
    loff = lds_off; nl = 0;
    const int tid = TIDX();
    pg8::Unit u;
    int n = 0;
    while (n < maxu && locate(n, u)) ++n;
    for (int i = tid; i < n * 256; i += NT) { locate(i >> 8, u); lds_off[i] = goff(u, i & 255); }
    __syncthreads();
    nl = n;
  }
  DI const char* bbase(const pg8::Unit& u, int half) const { return W + ((size_t)u.e * EXP_STRIDE + (size_t)half * D * FF + (size_t)u.pn * 128 * D) * 2; }
};
struct E2Sched : ExpertSched {
  static constexpr bool GATHER = false;
  const char* A; const char* W; const int* hoff;
  DI bool next(int i, pg8::Unit& u) const { return locate(i, u); }
  DI const char* abase() const { return A; }
  DI unsigned arow_off(const pg8::Unit& u, int r) const { return (unsigned)(hoff[u.e] + u.pm * 256 + r) * (unsigned)(FF * 2); }
  DI const char* bbase(const pg8::Unit& u, int half) const { return W + ((size_t)u.e * EXP_STRIDE + (size_t)2 * D * FF + (size_t)(u.pn * 256 + half * 128) * FF) * 2; }
};

struct EpiInproj {
  u16 *PA, *PH, *PR;
  struct Pre {};
  DI Pre prefetch(const pg8::Unit&, int, int) const { return Pre{}; }
  DI void operator()(const f32x4 (&acc)[2][2][4][2], const pg8::Unit& u, int wr, int wc, int fr, int fq, const Pre&) const {
    const int row0 = u.pm * 256 + wr * 64 + fr;
#pragma unroll
    for (int bj = 0; bj < 2; ++bj) {
      const int colh = u.pn * 256 + bj * 128;
      if (colh >= P_IN) continue;
      if (colh >= PA_W && colh < PA_W + PH_W) {
        const int c0 = colh - PA_W + wc * 32 + 4 * fq;
        const int rb = u.pm * 256;
        u16* base; int L, t0;
        if (rb < TL) { L = SEQ; base = PH + (size_t)(rb / SEQ) * PH_W * SEQ; t0 = rb % SEQ; }
        else { L = CTXL; base = PH + (size_t)NB * PH_W * SEQ + (size_t)((rb - TL) / CTXL) * PH_W * CTXL; t0 = (rb - TL) % CTXL; }
#pragma unroll
        for (int ai = 0; ai < 2; ++ai)
#pragma unroll
          for (int m = 0; m < 4; ++m) {
            const int t = t0 + wr * 64 + fr + ai * 128 + m * 16;
#pragma unroll
            for (int n = 0; n < 2; ++n) {
              const f32x4 v = acc[ai][bj][m][n];
#pragma unroll
              for (int j = 0; j < 4; ++j) base[(size_t)(c0 + n * 16 + j) * L + t] = f2bf(v[j]);
            }
          }
        continue;
      }
      u16* base; int ld, c0;
      if (colh < PA_W) { base = PA; ld = PA_W; c0 = colh; }
      else { base = PR; ld = RW_COLS; c0 = colh - PA_W - PH_W; }
      const int col0 = c0 + wc * 32 + 4 * fq;
#pragma unroll
      for (int ai = 0; ai < 2; ++ai)
#pragma unroll
        for (int m = 0; m < 4; ++m) {
          u16* rowp = base + (size_t)(row0 + ai * 128 + m * 16) * ld + col0;
#pragma unroll
          for (int n = 0; n < 2; ++n) {
            const f32x4 v = acc[ai][bj][m][n];
            u32x2 o; o[0] = pk2(v[0], v[1]); o[1] = pk2(v[2], v[3]);
            *(u32x2*)(rowp + n * 16) = o;
          }
        }
    }
  }
};
struct EpiOutproj {
  const Params* p; int l;
  struct Pre {};
  DI Pre prefetch(const pg8::Unit&, int, int) const { return Pre{}; }
  DI void operator()(const f32x4 (&acc)[2][2][4][2], const pg8::Unit& u, int wr, int wc, int fr, int fq, const Pre&) const {
    const int row0 = u.pm * 256 + wr * 64 + fr, col0 = u.pn * 256 + wc * 32 + 4 * fq;
#pragma unroll
    for (int ai = 0; ai < 2; ++ai)
#pragma unroll
      for (int m = 0; m < 4; ++m) {
        const int r = row0 + ai * 128 + m * 16;
        const float* md = modp(*p, l, r) + 2 * D;
        float* xr = x1row(*p, r);
        const float* xin = (l == 0) ? (r < TL ? p->x + (size_t)r * D : p->ctx + (size_t)(r - TL) * D) : xr;
#pragma unroll
        for (int bj = 0; bj < 2; ++bj)
#pragma unroll
          for (int n = 0; n < 2; ++n) {
            const int c = col0 + bj * 128 + n * 16;
            const f32x4 g1 = *(const f32x4*)(md + c), xv = *(const f32x4*)(xin + c), a = acc[ai][bj][m][n];
            f32x4 o;
#pragma unroll
            for (int j = 0; j < 4; ++j) o[j] = DN_ALPHA * xv[j] + g1[j] * a[j];
            *(f32x4*)(xr + c) = o;
          }
      }
  }
};
struct EpiE1 {
  u16* H; const int* hoff;
  struct Pre {};
  DI Pre prefetch(const pg8::Unit&, int, int) const { return Pre{}; }
  DI void operator()(const f32x4 (&acc)[2][2][4][2], const pg8::Unit& u, int wr, int wc, int fr, int fq, const Pre&) const {
    const int row0 = hoff[u.e] + u.pm * 256 + wr * 64 + fr, col0 = u.pn * 128 + wc * 32 + 4 * fq;
#pragma unroll
    for (int ai = 0; ai < 2; ++ai)
#pragma unroll
      for (int m = 0; m < 4; ++m) {
        u16* rowp = H + (size_t)(row0 + ai * 128 + m * 16) * FF + col0;
#pragma unroll
        for (int n = 0; n < 2; ++n) {
          const f32x4 g = acc[ai][0][m][n], uu = acc[ai][1][m][n];
          u32x2 o; o[0] = pk2(g[0] * fsigmoid_(g[0]) * uu[0], g[1] * fsigmoid_(g[1]) * uu[1]); o[1] = pk2(g[2] * fsigmoid_(g[2]) * uu[2], g[3] * fsigmoid_(g[3]) * uu[3]);
          *(u32x2*)(rowp + n * 16) = o;
        }
      }
  }
};
constexpr float ACC_SCALE = 1024.f;
DI unsigned long long acc_pack4(float a, float b, float c, float d) {
  const long long qa = (long long)(int)rintf(a * ACC_SCALE), qb = (long long)(int)rintf(b * ACC_SCALE);
  const long long qc = (long long)(int)rintf(c * ACC_SCALE), qd = (long long)(int)rintf(d * ACC_SCALE);
  return (unsigned long long)(qa + (qb << 16) + (qc << 32) + (qd << 48));
}
DI void acc_unpack4(unsigned lo, unsigned hi, float& a, float& b, float& c, float& d) {
  long long v = (long long)(((unsigned long long)hi << 32) | (unsigned long long)lo);
  const long long f0 = (long long)(short)(v & 0xffff); v = (v - f0) >> 16;
  const long long f1 = (long long)(short)(v & 0xffff); v = (v - f1) >> 16;
  const long long f2 = (long long)(short)(v & 0xffff); v = (v - f2) >> 16;
  const long long f3 = (long long)(short)(v & 0xffff);
  a = (float)(int)f0 * (1.f / ACC_SCALE); b = (float)(int)f1 * (1.f / ACC_SCALE);
  c = (float)(int)f2 * (1.f / ACC_SCALE); d = (float)(int)f3 * (1.f / ACC_SCALE);
}
struct EpiE2 {
  int* accb; const int* etok; const float* egate; float* xs; u16* sho;
  static constexpr int WSTRIDE = 16 * 36 + 16 + 256;
  struct Pre { int t0, t1; float g0, g1; };
  DI Pre prefetch(const pg8::Unit& u, int wr, int lane) const {
    Pre q; q.t0 = 0; q.t1 = 0; q.g0 = 1.f; q.g1 = 1.f;
    if (u.e < NE) {
      const int s0 = u.pm * 256 + wr * 64 + ((lane >> 4) & 3) * 16 + (lane & 15), s1 = s0 + 128;
      const size_t b = (size_t)u.e * T;
      const size_t i0 = b + (s0 < u.cnt ? s0 : u.pm * 256), i1 = b + (s1 < u.cnt ? s1 : u.pm * 256);
      q.t0 = etok[i0]; q.g0 = egate[i0]; q.t1 = etok[i1]; q.g1 = egate[i1];
    }
    return q;
  }
  DI void operator()(const f32x4 (&acc)[2][2][4][2], const pg8::Unit& u, int wr, int wc, int fr, int fq, const Pre& pq) const {
    if (u.e == NE) {
      const int row0 = u.pm * 256 + wr * 64 + fr, col0 = u.pn * 256 + wc * 32 + 4 * fq;
#pragma unroll
      for (int ai = 0; ai < 2; ++ai)
#pragma unroll
        for (int m = 0; m < 4; ++m) {
          const int r = row0 + ai * 128 + m * 16;
          if (r < u.cnt) {
#pragma unroll
            for (int bj = 0; bj < 2; ++bj)
#pragma unroll
              for (int n = 0; n < 2; ++n) st_bf4(sho + (size_t)r * D + col0 + bj * 128 + n * 16, acc[ai][bj][m][n]);
          }
        }
      return;
    }
    const int lane = fq * 16 + fr, wave = wr * 4 + wc;
    float* X = xs + wave * WSTRIDE;
    int* tk = (int*)(X + 16 * 36);
    int* tokw = tk + 16;
    float* gatew = (float*)(tokw + 128);
    wave_sync();
#pragma unroll
    for (int q = 0; q < 2; ++q) {
      const int lr = lane + 64 * q;
      const int slot = u.pm * 256 + (lr >> 6) * 128 + wr * 64 + ((lr >> 4) & 3) * 16 + (lr & 15);
      const bool valid = slot < u.cnt;
      const int tok = q ? pq.t1 : pq.t0; const float gt = q ? pq.g1 : pq.g0;
      tokw[lr] = valid ? tok : -1; gatew[lr] = valid ? gt : 0.f;
    }
    wave_sync();
#pragma unroll
    for (int ai = 0; ai < 2; ++ai)
#pragma unroll
      for (int m = 0; m < 4; ++m) {
        const int lrow = ai * 64 + m * 16;
        const float gt = gatew[lrow + fr];
#pragma unroll
        for (int bj = 0; bj < 2; ++bj) {
          wave_sync();
#pragma unroll
          for (int n = 0; n < 2; ++n) {
            f32x4 v = acc[ai][bj][m][n];
#pragma unroll
            for (int j = 0; j < 4; ++j) v[j] *= gt;
            *(f32x4*)(X + fr * 36 + n * 16 + fq * 4) = v;
          }
          wave_sync();
          const int cquad = (u.pn * 256 + bj * 128 + wc * 32) / 4 + (lane & 7);
#pragma unroll
          for (int i = 0; i < 2; ++i) {
            const int rr = 8 * i + (lane >> 3);
            const int t2 = tokw[lrow + rr];
            const f32x4 xv = *(const f32x4*)(X + rr * 36 + 4 * (lane & 7));
            if (t2 >= 0) atomicAdd((unsigned long long*)accb + (size_t)t2 * (D / 4) + cquad, acc_pack4(xv[0], xv[1], xv[2], xv[3]));
          }
        }
      }
  }
};

constexpr int TICKET_SLOT_OFF = SMEM_BYTES - 1024 - 64;
template <class F> DI void ticket_loop(unsigned* ctr, int n_items, char* smem, F&& body) {
  int* slot = (int*)(smem + TICKET_SLOT_OFF);
  const int tid = TIDX();
  __syncthreads();
  if (tid == 0) slot[0] = (int)atomicAdd(ctr, 1u);
  __syncthreads();
  for (int k = 0;; ++k) {
    const int it = slot[k & 1];
    if (it >= n_items) break;
    int nx = 0;
    if (tid == 0) nx = (int)atomicAdd(ctr, 1u);
    body(it);
    if (tid == 0) slot[(k + 1) & 1] = nx;
    __syncthreads();
  }
}
DI void ph_prologue(const Params& p, char* smem) {
  const int tid = TIDX();
  constexpr int NCH = 6 * D / 128;
  constexpr int ITEMS_MOD = DEPTH * NCH;
  constexpr int ITEMS_H3 = DEPTH * (SEQ / 64 + CTXL / 64);
  constexpr int ITEMS_CV = DEPTH * CT_STATIC_L;
  constexpr int ITEMS = ITEMS_MOD + ITEMS_H3 + 1;
  for (int item = BIDX(); item < ITEMS; item += gridDim.x) {
    if (item < ITEMS_MOD) {
      const int l = item / NCH, ch = item % NCH;
      float* sv = (float*)smem;
      float* red = sv + (NB + 1) * D;
      {
        constexpr int NSV = ((NB + 1) * D + NT - 1) / NT;
        float cv[NSV];
#pragma unroll
        for (int j = 0; j < NSV; ++j) {
          int i = tid + j * NT; if (i > (NB + 1) * D - 1) i = (NB + 1) * D - 1;
          const int row = i / D, e = i % D;
          const float* src = row < NB ? p.c + row * D : p.c_ctx;
          cv[j] = src[e];
        }
#pragma unroll
        for (int j = 0; j < NSV; ++j) { const int i = tid + j * NT; if (i < (NB + 1) * D) sv[i] = siluf_(cv[j]); }
      }
      __syncthreads();
      const int col = ch * 128 + (tid & 127), kg = tid >> 7;
      float a[NB + 1];
#pragma unroll
      for (int r = 0; r < NB + 1; ++r) a[r] = 0.f;
      const float* W = p.w_ada + (size_t)l * D * 6 * D;
      for (int k = kg * (D / 4); k < (kg + 1) * (D / 4); k += 16) {
        float w[16];
#pragma unroll
        for (int j = 0; j < 16; ++j) w[j] = W[(size_t)(k + j) * 6 * D + col];
#pragma unroll
        for (int j = 0; j < 16; ++j)
#pragma unroll
          for (int r = 0; r < NB + 1; ++r) a[r] += sv[r * D + k + j] * w[j];
      }
#pragma unroll
      for (int r = 0; r < NB + 1; ++r) red[(kg * (NB + 1) + r) * 128 + (tid & 127)] = a[r];
      __syncthreads();
      for (int i = tid; i < (NB + 1) * 128; i += NT) {
        int r = i / 128, cc = i % 128;
        float s = 0.f;
        for (int g = 0; g < 4; ++g) s += red[(g * (NB + 1) + r) * 128 + cc];
        int cg_ = ch * 128 + cc;
        p.mod[((size_t)l * (NB + 1) + r) * 6 * D + cg_] = s + p.b_ada[(size_t)l * 6 * D + cg_];
      }
      __syncthreads();
    } else if (item < ITEMS_MOD + ITEMS_H3) {
      int it = item - ITEMS_MOD;
      constexpr int PER_L = SEQ / 64 + CTXL / 64;
      const int l = it / PER_L;
      int q = it % PER_L;
      const bool isctx = q >= SEQ / 64;
      const int L = isctx ? CTXL : SEQ;
      const int pos0 = (isctx ? q - SEQ / 64 : q) * 64;
      float* z = (float*)smem;
      float* ha = z + 64 * 36;
      float* hb = ha + 64 * 64;
      float* w1s = hb + 64 * 64;
      float* w2s = w1s + HY_EMB * HY_HID;
      float* w3s = w2s + HY_HID * HY_HID;
      {
        constexpr int N1 = (HY_EMB * HY_HID + NT - 1) / NT, N2 = (HY_HID * HY_HID + NT - 1) / NT;
        float a1[N1], a2[N2], a3[N2];
        const float* g1 = p.hf_w1 + (size_t)l * HY_EMB * HY_HID;
        const float* g2 = p.hf_w2 + (size_t)l * HY_HID * HY_HID;
        const float* g3 = p.hf_w3 + (size_t)l * HY_HID * HY_HID;
#pragma unroll
        for (int j = 0; j < N1; ++j) { int i = tid + j * NT; if (i > HY_EMB * HY_HID - 1) i = HY_EMB * HY_HID - 1; a1[j] = g1[i]; }
#pragma unroll
        for (int j = 0; j < N2; ++j) { int i = tid + j * NT; if (i > HY_HID * HY_HID - 1) i = HY_HID * HY_HID - 1; a2[j] = g2[i]; a3[j] = g3[i]; }
#pragma unroll
        for (int j = 0; j < N1; ++j) { const int i = tid + j * NT; if (i < HY_EMB * HY_HID) w1s[i] = a1[j]; }
#pragma unroll
        for (int j = 0; j < N2; ++j) { const int i = tid + j * NT; if (i < HY_HID * HY_HID) { w2s[i] = a2[j]; w3s[i] = a3[j]; } }
      }
      for (int i = tid; i < 64 * HY_EMB; i += NT) {
        int pp = i / HY_EMB, e = i % HY_EMB;
        int pos = pos0 + pp;
        float v;
        if (e == 0) v = (float)pos / (float)(L - 1);
        else {
          int bi = (e - 1) % HY_BANDS;
          float band = 1e-4f + ((float)(HY_BANDS - 1) - 1e-4f) * (float)bi / (float)(HY_BANDS - 1);
          float ang = (2.0f * 3.14159265358979323846f / (float)L) * (float)pos * band;
          v = (e - 1) < HY_BANDS ? cosf(ang) : -sinf(ang);
        }
        z[pp * 36 + e] = v;
      }
      __syncthreads();
      const int pp = tid >> 3, sub = tid & 7;
      const float* fr = p.hf_freq + l * HY_HID;
      {
        const float* b = p.hf_b1 + l * HY_HID;
        float acc8[8];
#pragma unroll
        for (int uu = 0; uu < 8; ++uu) acc8[uu] = b[sub * 8 + uu];
        for (int e = 0; e < HY_EMB; ++e) {
          const float zv = z[pp * 36 + e];
#pragma unroll
          for (int uu = 0; uu < 8; ++uu) acc8[uu] += zv * w1s[e * HY_HID + sub * 8 + uu];
        }
#pragma unroll 1
        for (int uu = 0; uu < 8; ++uu) ha[pp * 64 + sub * 8 + uu] = sinf(fr[sub * 8 + uu] * acc8[uu]);
      }
      __syncthreads();
      {
        const float* b = p.hf_b2 + l * HY_HID;
        float acc8[8];
#pragma unroll
        for (int uu = 0; uu < 8; ++uu) acc8[uu] = b[sub * 8 + uu];
        for (int e = 0; e < HY_HID; ++e) {
          const float zv = ha[pp * 64 + e];
#pragma unroll
          for (int uu = 0; uu < 8; ++uu) acc8[uu] += zv * w2s[e * HY_HID + sub * 8 + uu];
        }
#pragma unroll 1
        for (int uu = 0; uu < 8; ++uu) hb[pp * 64 + sub * 8 + uu] = sinf(fr[sub * 8 + uu] * acc8[uu]);
      }
      __syncthreads();
      {
        const float* b = p.hf_b3 + l * HY_HID;
        float* dst = isctx ? p.h3ctx + ((size_t)l * CTXL + pos0) * 64 : p.h3lat + ((size_t)l * SEQ + pos0) * 64;
        float acc8[8];
#pragma unroll
        for (int uu = 0; uu < 8; ++uu) acc8[uu] = b[sub * 8 + uu];
        for (int e = 0; e < HY_HID; ++e) {
          const float zv = hb[pp * 64 + e];
#pragma unroll
          for (int uu = 0; uu < 8; ++uu) acc8[uu] += zv * w3s[e * HY_HID + sub * 8 + uu];
        }
#pragma unroll 1
        for (int uu = 0; uu < 8; ++uu) dst[pp * 64 + sub * 8 + uu] = sinf(fr[sub * 8 + uu] * acc8[uu]);
      }
      __syncthreads();
    } else {
      for (int k = tid; k < FFTN / 2; k += NT) {
        double ang = -2.0 * 3.14159265358979323846 * (double)k / (double)FFTN;
        cf w; w.x = (float)cos(ang); w.y = (float)sin(ang);
        p.tw[k] = w;
      }
      for (int i = tid; i < DEPTH * NE; i += NT) p.cnt[i] = 0;
    }
  }
  ticket_loop(p.bar + XB_TICKET, ITEMS_CV, smem, [&](int it) { convert_static_item(p, it, smem); });
}

DI void ph_premod(const Params& p) {
  const int tid = TIDX();
  constexpr int ITEMS = T / 8;
  constexpr int NI = 8 * D / 4 / NT;
  static_assert(NI * NT * 4 == 8 * D, "premod tiling");
  for (int item = BIDX(); item < ITEMS; item += gridDim.x) {
    f32x4 xv[NI], sc[NI], sh[NI];
#pragma unroll
    for (int k = 0; k < NI; ++k) {
      const int i = tid + k * NT;
      const int r = item * 8 + i / (D / 4), e = (i % (D / 4)) * 4;
      const float* m = modp(p, 0, r);
      const float* src = r < TL ? p.x + (size_t)r * D : p.ctx + (size_t)(r - TL) * D;
      xv[k] = *(const f32x4*)(src + e); sc[k] = *(const f32x4*)(m + D + e); sh[k] = *(const f32x4*)(m + e);
    }
#pragma unroll
    for (int k = 0; k < NI; ++k) {
      const int i = tid + k * NT;
      const int r = item * 8 + i / (D / 4), e = (i % (D / 4)) * 4;
      f32x4 o;
#pragma unroll
      for (int j = 0; j < 4; ++j) o[j] = xv[k][j] * (1.f + sc[k][j]) + sh[k][j];
      st_bf4(p.HL + (size_t)r * D + e, o);
    }
  }
}

DI int fpad(int i) { return i + (i >> 4); }
constexpr int FFT_LDS = FFTN + FFTN / 16;
__device__ static constexpr float C16[8] = {1.f, 0.92387953251128674f, 0.70710678118654752f, 0.38268343236508977f, 0.f, -0.38268343236508977f, -0.70710678118654752f, -0.92387953251128674f};
__device__ static constexpr float S16[8] = {0.f, 0.38268343236508977f, 0.70710678118654752f, 0.92387953251128674f, 1.f, 0.92387953251128674f, 0.70710678118654752f, 0.38268343236508977f};
template <int R, bool INV>
DI void fft_pass(cf* buf, const cf* tw, int m) {
  const int g = m >> (R - 1);
  constexpr int NQ = 1 << R;
  for (int w = TIDX(); w < (FFTN >> R); w += NT) {
    const int j = w % g, blk = w / g;
    const int base = blk * (g << R) + j;
    cf v[NQ];
#pragma unroll
    for (int q = 0; q < NQ; ++q) v[q] = buf[fpad(base + q * g)];
    cf bt[R];
    bt[0] = tw[j * ((FFTN / 2) / ((NQ / 2) * g))];
#pragma unroll
    for (int r = 1; r < R; ++r) { bt[r].x = bt[r - 1].x * bt[r - 1].x - bt[r - 1].y * bt[r - 1].y; bt[r].y = 2.f * bt[r - 1].x * bt[r - 1].y; }
    if (!INV) {
#pragma unroll
      for (int r = 0; r < R; ++r) {
        const int half = 1 << (R - 1 - r);
#pragma unroll
        for (int q = 0; q < NQ; ++q) {
          if ((q & half) == 0) {
            const int qq = q & (half - 1);
            const int ci = qq * (8 / half);
            cf W;
            W.x = bt[r].x * C16[ci] + bt[r].y * S16[ci];
            W.y = bt[r].y * C16[ci] - bt[r].x * S16[ci];
            cf a = v[q], b = v[q + half];
            v[q].x = a.x + b.x; v[q].y = a.y + b.y;
            float dx = a.x - b.x, dy = a.y - b.y;
            v[q + half].x = dx * W.x - dy * W.y;
            v[q + half].y = dx * W.y + dy * W.x;
          }
        }
      }
    } else {
#pragma unroll
      for (int r = R - 1; r >= 0; --r) {
        const int half = 1 << (R - 1 - r);
#pragma unroll
        for (int q = 0; q < NQ; ++q) {
          if ((q & half) == 0) {
            const int qq = q & (half - 1);
            const int ci = qq * (8 / half);
            cf W;
            W.x = bt[r].x * C16[ci] + bt[r].y * S16[ci];
            W.y = bt[r].y * C16[ci] - bt[r].x * S16[ci];
            cf a = v[q], b = v[q + half];
            float bx = b.x * W.x + b.y * W.y;
            float by = b.y * W.x - b.x * W.y;
            v[q].x = a.x + bx; v[q].y = a.y + by;
            v[q + half].x = a.x - bx; v[q + half].y = a.y - by;
          }
        }
      }
    }
#pragma unroll
    for (int q = 0; q < NQ; ++q) buf[fpad(base + q * g)] = v[q];
  }
}
constexpr int FFT_R4 = LOG2N / 4, FFT_REM = LOG2N % 4;
DI void fft_fwd_main(cf* buf, const cf* tw) {
  int m = FFTN / 2;
#pragma unroll
  for (int i = 0; i < FFT_R4; ++i) { fft_pass<4, false>(buf, tw, m); __syncthreads(); m >>= 4; }
}
DI void fft_fwd_tail(cf* buf, const cf* tw) {
  if (FFT_REM == 3) { fft_pass<3, false>(buf, tw, 4); __syncthreads(); }
  if (FFT_REM == 2) { fft_pass<2, false>(buf, tw, 2); __syncthreads(); }
  if (FFT_REM == 1) { fft_pass<1, false>(buf, tw, 1); __syncthreads(); }
}
DI void fft_fwd(cf* buf, const cf* tw) { fft_fwd_main(buf, tw); fft_fwd_tail(buf, tw); }
DI void fft_inv_tail(cf* buf, const cf* tw) {
  if (FFT_REM == 3) { fft_pass<3, true>(buf, tw, 4); __syncthreads(); }
  if (FFT_REM == 2) { fft_pass<2, true>(buf, tw, 2); __syncthreads(); }
  if (FFT_REM == 1) { fft_pass<1, true>(buf, tw, 1); __syncthreads(); }
}
DI void fft_inv_main(cf* buf, const cf* tw) {
  int m = (1 << FFT_REM) * 8;
#pragma unroll
  for (int i = 0; i < FFT_R4; ++i) { fft_pass<4, true>(buf, tw, m); __syncthreads(); m <<= 4; }
}
DI void tw_to_lds(cf* tw, const cf* __restrict__ gtw) {
  constexpr int NIT = (FFTN / 4 + NT - 1) / NT;
  f32x4 t4[NIT];
#pragma unroll
  for (int j = 0; j < NIT; ++j) { int i = TIDX() + j * NT; if (i > FFTN / 4 - 1) i = FFTN / 4 - 1; t4[j] = ((const f32x4*)gtw)[i]; }
#pragma unroll
  for (int j = 0; j < NIT; ++j) { const int i = TIDX() + j * NT; if (i < FFTN / 4) ((f32x4*)tw)[i] = t4[j]; }
}
constexpr int MID_IT = (FFTN / 2 + NT - 1) / NT;
struct MidSpec { f32x4 k[MID_IT]; };
DI MidSpec fft_mid_prefetch(const cf* __restrict__ sp) {
  MidSpec m;
#pragma unroll
  for (int j = 0; j < MID_IT; ++j) {
    int i = TIDX() + j * NT; if (i > FFTN / 2 - 1) i = FFTN / 2 - 1;
    m.k[j] = *(const f32x4*)(sp + 2 * i);
  }
  return m;
}
DI void fft_mid(cf* buf, const cf* tw, const cf* __restrict__ sp, const MidSpec& ms) {
  if (FFT_REM == 1) {
#pragma unroll
    for (int j = 0; j < MID_IT; ++j) {
      const int i = TIDX() + j * NT;
      if (i >= FFTN / 2) break;
      const cf a = buf[fpad(2 * i)], b = buf[fpad(2 * i + 1)];
      cf A, B;
      A.x = a.x + b.x; A.y = a.y + b.y; B.x = a.x - b.x; B.y = a.y - b.y;
      const f32x4 k = ms.k[j];
      cf P, Q;
      P.x = A.x * k[0] - A.y * k[1]; P.y = A.x * k[1] + A.y * k[0];
      Q.x = B.x * k[2] - B.y * k[3]; Q.y = B.x * k[3] + B.y * k[2];
      cf o0, o1;
      o0.x = P.x + Q.x; o0.y = P.y + Q.y; o1.x = P.x - Q.x; o1.y = P.y - Q.y;
      buf[fpad(2 * i)] = o0; buf[fpad(2 * i + 1)] = o1;
    }
    __syncthreads();
  } else {
    fft_fwd_tail(buf, tw);
    for (int i = TIDX(); i < FFTN; i += NT) {
      cf a = buf[fpad(i)], k = sp[i], r;
      r.x = a.x * k.x - a.y * k.y; r.y = a.x * k.y + a.y * k.x;
      buf[fpad(i)] = r;
    }
    __syncthreads();
    fft_inv_tail(buf, tw);
  }
}

DI float hy_delta(int c) {
  const float lo = -4.605170185988091f / 1.5f, hi = -4.605170185988091f / 0.3f;
  return fabsf(lo + (hi - lo) * (float)c / (float)(HY_CH - 1));
}

DI void hy_spectrum_item(const Params& p, int l, int o, int c, char* smem) {
  const int tid = TIDX();
  cf* buf = (cf*)smem;
  cf* tw = buf + FFT_LDS;
  float* wc = (float*)(tw + FFTN / 2);
  tw_to_lds(tw, p.tw);
  if (tid < 128) {
    int dir = tid >> 6, u = tid & 63;
    wc[tid] = p.hf_wout[((size_t)l * HY_HID + u) * (4 * HY_CH) + o * 2 * HY_CH + dir * HY_CH + c];
  }
  __syncthreads();
  const float dl = hy_delta(c);
  {
    const int q = tid & 15, rr = tid >> 4;
    constexpr int RPP = NT / 16;
    constexpr int UNR = (SEQ / RPP) % 8 == 0 ? 8 : 1;
    const f32x4 wf = *(const f32x4*)(wc + 4 * q), wb = *(const f32x4*)(wc + 64 + 4 * q);
    const float* hbase = p.h3lat + (size_t)l * SEQ * 64 + 4 * q;
    for (int t0 = 0; t0 < SEQ; t0 += RPP * UNR) {
      f32x4 hv[UNR];
#pragma unroll
      for (int j = 0; j < UNR; ++j) hv[j] = *(const f32x4*)(hbase + (size_t)(t0 + j * RPP + rr) * 64);
#pragma unroll
      for (int j = 0; j < UNR; ++j) {
        const int t = t0 + j * RPP + rr;
        float sf = (hv[j][0] * wf[0] + hv[j][1] * wf[1]) + (hv[j][2] * wf[2] + hv[j][3] * wf[3]);
        float sb = (hv[j][0] * wb[0] + hv[j][1] * wb[1]) + (hv[j][2] * wb[2] + hv[j][3] * wb[3]);
        sf = red16(sf); sb = red16(sb);
        if (q == 0) {
          const float dec = expf(-((float)t / (float)(SEQ - 1)) * dl);
          cf a; a.x = sf * dec; a.y = 0.f;
          buf[fpad(t)] = a;
          if (t >= 1) { cf b; b.x = sb * dec; b.y = 0.f; buf[fpad(FFTN - t)] = b; }
          if (t == 0) { cf zz; zz.x = 0.f; zz.y = 0.f; buf[fpad(SEQ)] = zz; }
        }
      }
    }
  }
  __syncthreads();
  fft_fwd(buf, tw);
  cf* dst = p.spec + ((size_t)o * HY_CH + c) * FFTN;
  const float sc = 1.0f / (float)FFTN;
  for (int i = tid; i < FFTN; i += NT) { cf v = buf[fpad(i)]; v.x *= sc; v.y *= sc; dst[i] = v; }
  __syncthreads();
}

DI void ph_inproj(const Params& p, int l, char* smem) {
  constexpr int SPEC_ITEMS = 2 * HY_CH;
  const int G = gridDim.x, c = BIDX();
  {
    DenseSched S; S.init(p.HL, p.wt_in + (size_t)l * P_IN_PAD * D, D, T, P_IN_PAD, G, c);
    EpiInproj E{p.PA, p.PH, p.PR};
    pg8::gemm_phase(smem, D, S, E);
  }
  __syncthreads();
  (void)c;
  ticket_loop(p.bar + XB_TICKET + 1 + l, SPEC_ITEMS, smem, [&](int it) { hy_spectrum_item(p, l, it / HY_CH, it % HY_CH, smem); });
}

DI float hy_u(const u16* P, int t, int L, float w0, float w1, float w2, float bias) {
  const bool hp = t >= 1, hn = t + 1 < L;
  const float c = bf2f(P[t]), a = bf2f(P[hp ? t - 1 : t]), b = bf2f(P[hn ? t + 1 : t]);
  return w1 * c + bias + (hp ? w0 : 0.f) * a + (hn ? w2 : 0.f) * b;
}

struct HyRaw { u32x4 x; u16 prev, next; };
DI HyRaw hy_load8(const u16* P, int t0, int L) {
  HyRaw r;
  r.x = *(const u32x4*)(P + t0);
  r.prev = P[t0 >= 1 ? t0 - 1 : t0];
  r.next = P[t0 + 8 < L ? t0 + 8 : t0 + 7];
  return r;
}
DI void hy_conv8(const HyRaw& r, int t0, int L, float w0, float w1, float w2, float bias, float (&out)[8]) {
  float x[10];
  x[0] = bf2f(r.prev);
#pragma unroll
  for (int j = 0; j < 4; ++j) { x[1 + 2 * j] = bf2f((u16)(r.x[j] & 0xffff)); x[2 + 2 * j] = bf2f((u16)(r.x[j] >> 16)); }
  x[9] = bf2f(r.next);
  const float wp = t0 >= 1 ? w0 : 0.f, wn = t0 + 8 < L ? w2 : 0.f;
#pragma unroll
  for (int j = 0; j < 8; ++j) out[j] = w1 * x[1 + j] + bias + (j == 0 ? wp : w0) * x[j] + (j == 7 ? wn : w2) * x[2 + j];
}

DI void hyena_lat_item(const Params& p, int l, int c, int pair, char* smem, bool load_tw) {
  const int tid = TIDX();
  cf* buf = (cf*)smem;
  cf* tw = buf + FFT_LDS;
  const float* cw = p.hy_sconv_w + (size_t)l * 3 * PH_W;
  const float* cb = p.hy_sconv_b + (size_t)l * PH_W;
  const int b0 = pair * 2, b1 = pair * 2 + 1;
  const int t0 = tid * 8;
  const bool act = t0 < SEQ;
  const int tl = act ? t0 : 0;
  HyRaw rw[3][2];
#pragma unroll
  for (int q = 0; q < 3; ++q) {
    rw[q][0] = hy_load8(p.PH + ((size_t)b0 * PH_W + q * HY_CH + c) * SEQ, tl, SEQ);
    rw[q][1] = hy_load8(p.PH + ((size_t)b1 * PH_W + q * HY_CH + c) * SEQ, tl, SEQ);
  }
  if (load_tw) tw_to_lds(tw, p.tw);
  const MidSpec ms0 = fft_mid_prefetch(p.spec + ((size_t)0 * HY_CH + c) * FFTN);
  float vr[2][8], z1[2][8];
  {
    const int col = c;
    const float w0 = cw[col], w1 = cw[PH_W + col], w2 = cw[2 * PH_W + col], bs = cb[col];
    hy_conv8(rw[0][0], tl, SEQ, w0, w1, w2, bs, vr[0]);
    hy_conv8(rw[0][1], tl, SEQ, w0, w1, w2, bs, vr[1]);
    if (act) {
#pragma unroll
      for (int j = 0; j < 8; ++j) {
        cf a; a.x = vr[0][j]; a.y = vr[1][j];
        buf[fpad(t0 + j)] = a;
        cf zz; zz.x = 0.f; zz.y = 0.f;
        buf[fpad(t0 + j + SEQ)] = zz;
      }
    }
  }
  __syncthreads();
  fft_fwd_main(buf, tw);
  fft_mid(buf, tw, p.spec + ((size_t)0 * HY_CH + c) * FFTN, ms0);
  const MidSpec ms1 = fft_mid_prefetch(p.spec + ((size_t)1 * HY_CH + c) * FFTN);
  fft_inv_main(buf, tw);
  {
    const int col = HY_CH + c;
    const float w0 = cw[col], w1 = cw[PH_W + col], w2 = cw[2 * PH_W + col], bs = cb[col];
    const float sk = p.hf_skip[((size_t)l * 2 + 0) * HY_CH + c];
    float x1a[8], x1b[8];
    hy_conv8(rw[1][0], tl, SEQ, w0, w1, w2, bs, x1a);
    hy_conv8(rw[1][1], tl, SEQ, w0, w1, w2, bs, x1b);
    cf yv[8];
    if (act) {
#pragma unroll
      for (int j = 0; j < 8; ++j) yv[j] = buf[fpad(t0 + j)];
    }
    __syncthreads();
    if (act) {
#pragma unroll
      for (int j = 0; j < 8; ++j) {
        z1[0][j] = (yv[j].x + sk * vr[0][j]) * x1a[j];
        z1[1][j] = (yv[j].y + sk * vr[1][j]) * x1b[j];
        cf a; a.x = z1[0][j]; a.y = z1[1][j];
        buf[fpad(t0 + j)] = a;
        cf zz; zz.x = 0.f; zz.y = 0.f;
        buf[fpad(t0 + j + SEQ)] = zz;
      }
    }
  }
  __syncthreads();
  fft_fwd_main(buf, tw);
  fft_mid(buf, tw, p.spec + ((size_t)1 * HY_CH + c) * FFTN, ms1);
  fft_inv_main(buf, tw);
  {
    const int col = 2 * HY_CH + c;
    const float w0 = cw[col], w1 = cw[PH_W + col], w2 = cw[2 * PH_W + col], bs = cb[col];
    const float sk = p.hf_skip[((size_t)l * 2 + 1) * HY_CH + c];
    float x2a[8], x2b[8];
    hy_conv8(rw[2][0], tl, SEQ, w0, w1, w2, bs, x2a);
    hy_conv8(rw[2][1], tl, SEQ, w0, w1, w2, bs, x2b);
    if (act) {
      u32x4 oa, ob;
#pragma unroll
      for (int j = 0; j < 4; ++j) {
        const cf y0 = buf[fpad(t0 + 2 * j)], y1 = buf[fpad(t0 + 2 * j + 1)];
        oa[j] = pk2((y0.x + sk * z1[0][2 * j]) * x2a[2 * j], (y1.x + sk * z1[0][2 * j + 1]) * x2a[2 * j + 1]);
        ob[j] = pk2((y0.y + sk * z1[1][2 * j]) * x2b[2 * j], (y1.y + sk * z1[1][2 * j + 1]) * x2b[2 * j + 1]);
      }
      *(u32x4*)(p.yhlat + ((size_t)b0 * HY_CH + c) * SEQ + t0) = oa;
      *(u32x4*)(p.yhlat + ((size_t)b1 * HY_CH + c) * SEQ + t0) = ob;
    }
  }
  __syncthreads();
}

DI void hyena_ctx_item(const Params& p, int l, int c, char* smem) {
  const int tid = TIDX();
  float* taps = (float*)smem;
  float* uv = taps + 4 * CTXL;
  float* zb = uv + NB * 3 * CTXL;
  float* wc = zb + NB * CTXL;
  if (tid < 256) {
    int od = tid >> 6, u = tid & 63;
    wc[tid] = p.hf_wout[((size_t)l * HY_HID + u) * (4 * HY_CH) + od * HY_CH + c];
  }
  __syncthreads();
  const float dl = hy_delta(c);
  for (int i = tid; i < 4 * CTXL; i += NT) {
    int od = i / CTXL, t = i % CTXL;
    const float* h = p.h3ctx + ((size_t)l * CTXL + t) * 64;
    float s = 0.f;
    for (int u = 0; u < 64; ++u) s += h[u] * wc[od * 64 + u];
    taps[i] = s * expf(-((float)t / (float)(CTXL - 1)) * dl);
  }
  const float* cw = p.hy_sconv_w + (size_t)l * 3 * PH_W;
  const float* cb = p.hy_sconv_b + (size_t)l * PH_W;
  for (int i = tid; i < NB * 3 * CTXL; i += NT) {
    int b = i / (3 * CTXL), j = (i / CTXL) % 3, t = i % CTXL;
    int col = j * HY_CH + c;
    const u16* P = p.PH + (size_t)NB * PH_W * SEQ + ((size_t)b * PH_W + col) * CTXL;
    uv[i] = hy_u(P, t, CTXL, cw[col], cw[PH_W + col], cw[2 * PH_W + col], cb[col]);
  }
  __syncthreads();
  const float sk0 = p.hf_skip[((size_t)l * 2 + 0) * HY_CH + c], sk1 = p.hf_skip[((size_t)l * 2 + 1) * HY_CH + c];
  for (int i = tid; i < NB * CTXL; i += NT) {
    int b = i / CTXL, t = i % CTXL;
    const float* v = uv + (b * 3 + 0) * CTXL;
    float s = 0.f;
    for (int s_ = 0; s_ < CTXL; ++s_) {
      int lag = t - s_;
      float k = lag >= 0 ? taps[0 * CTXL + lag] : taps[1 * CTXL - lag];
      s += k * v[s_];
    }
    zb[i] = (s + sk0 * v[t]) * uv[(b * 3 + 1) * CTXL + t];
  }
  __syncthreads();
  for (int i = tid; i < NB * CTXL; i += NT) {
    int b = i / CTXL, t = i % CTXL;
    const float* v = zb + b * CTXL;
    float s = 0.f;
    for (int s_ = 0; s_ < CTXL; ++s_) {
      int lag = t - s_;
      float k = lag >= 0 ? taps[2 * CTXL + lag] : taps[3 * CTXL - lag];
      s += k * v[s_];
    }
    p.yhctx[((size_t)b * HY_CH + c) * CTXL + t] = f2bf((s + sk1 * v[t]) * uv[(b * 3 + 2) * CTXL + t]);
  }
  __syncthreads();
}

DI void mixer_a_item(const Params& p, int l, int tile) {
  const int tid = TIDX(), lane = tid & 63, wave = tid >> 6;
  const int ts = lane >> 4, cq = lane & 15;
  constexpr int NBK = CONV_CH / 64;
  const float* cw = p.conv_a + (size_t)l * 3 * CONV_CH;
  const float* gn = p.mix_norm_g + (size_t)l * (CONV_CH + HY_CH);
#pragma unroll
  for (int it = 0; it < 2; ++it) {
    const int r = tile * 64 + wave * 8 + it * 4 + ts;
    int rp = r, rn = r;
    bool hp = false, hn = false;
    if (r < TL) { const int t = r % SEQ; hp = t >= GRID_W; hn = t + GRID_W < SEQ; if (hp) rp = r - GRID_W; if (hn) rn = r + GRID_W; }
    else { const int t = (r - TL) % CTXL; hp = t >= 1; hn = t + 1 < CTXL; if (hp) rp = r - 1; if (hn) rn = r + 1; }
    const float fp = hp ? 1.f : 0.f, fn = hn ? 1.f : 0.f;
    const u16* row = p.PA + (size_t)r * PA_W;
    const u16* qp = p.PA + (size_t)rp * PA_W;
    const u16* qn = p.PA + (size_t)rn * PA_W;
    float yv[NBK][4];
    float ss = 0.f;
#pragma unroll
    for (int bk = 0; bk < NBK; ++bk) {
      const int c = bk * 64 + cq * 4;
      const f32x4 bg = ld_bf4(row + c);
      const f32x4 c0 = ld_bf4(row + CONV_CH + c), x0 = ld_bf4(row + 2 * CONV_CH + c);
      const f32x4 c1 = ld_bf4(qp + CONV_CH + c), x1 = ld_bf4(qp + 2 * CONV_CH + c);
      const f32x4 c2 = ld_bf4(qn + CONV_CH + c), x2 = ld_bf4(qn + 2 * CONV_CH + c);
      const f32x4 w0 = *(const f32x4*)(cw + c), w1 = *(const f32x4*)(cw + CONV_CH + c), w2 = *(const f32x4*)(cw + 2 * CONV_CH + c);
#pragma unroll
      for (int j = 0; j < 4; ++j) {
        const float z = c0[j] * x0[j] * w1[j] + fp * w0[j] * (c1[j] * x1[j]) + fn * w2[j] * (c2[j] * x2[j]);
        yv[bk][j] = bg[j] * z;
        ss += yv[bk][j] * yv[bk][j];
      }
    }
    ss = red16(ss);
    const float rs = rsqrtf(ss / (float)CONV_CH + LN_EPS);
#pragma unroll
    for (int bk = 0; bk < NBK; ++bk) {
      const int c = bk * 64 + cq * 4;
      const f32x4 g4 = *(const f32x4*)(gn + c);
      f32x4 o;
#pragma unroll
      for (int j = 0; j < 4; ++j) o[j] = yv[bk][j] * rs * g4[j];
      st_bf4(p.ya + (size_t)r * CONV_CH + c, o);
    }
  }
}

DI void ph_mix(const Params& p, int l, char* smem) {
  const bool need_ctx = (l == 0);
  constexpr int HL_ITEMS = HY_CH * (NB / 2);
  const int HC_ITEMS = need_ctx ? HY_CH : 0;
  const int MA_ITEMS = (need_ctx ? T : TL) / 64;
  const int total = HL_ITEMS + HC_ITEMS + MA_ITEMS;
  SEG_BEGIN(p)
  bool tw_loaded = false;
  ticket_loop(p.bar + XB_TICKET + 1 + 2 * DEPTH + l, total, smem, [&](int item) {
    if (item < HL_ITEMS) { hyena_lat_item(p, l, item / (NB / 2), item % (NB / 2), smem, !tw_loaded); tw_loaded = true; SEG_MARK(p, 9) }
    else if (item < HL_ITEMS + HC_ITEMS) { hyena_ctx_item(p, l, item - HL_ITEMS, smem); SEG_MARK(p, 10) }
    else { mixer_a_item(p, l, item - HL_ITEMS - HC_ITEMS); SEG_MARK(p, 11) }
  });
}

DI void seq_of_row(int r, int& b, int& t, int& L) {
  if (r < TL) { b = r / SEQ; t = r % SEQ; L = SEQ; }
  else { int rc = r - TL; b = rc / CTXL; t = rc % CTXL; L = CTXL; }
}
DI float rw_u(const Params& p, const float* mu, int r, int t, int L, int col) {
  const float m0 = mu[col], m2 = mu[RW_COLS + col];
  float s = (1.f - m0 - m2) * bf2f(p.PR[(size_t)r * RW_COLS + col]);
  if (t >= 1) s += m0 * bf2f(p.PR[(size_t)(r - 1) * RW_COLS + col]);
  if (t + 1 < L) s += m2 * bf2f(p.PR[(size_t)(r + 1) * RW_COLS + col]);
  return s;
}
DI bf16x8 load_bfrag(const float* W, int ldn, int k0, int col, int lane) {
  const float* q = W + (size_t)(k0 + 8 * (lane >> 5)) * ldn + col + (lane & 31);
  bf16x8 b;
#pragma unroll
  for (int j = 0; j < 8; ++j) b[j] = (short)f2bf(q[(size_t)j * ldn]);
  return b;
}

DI f32x4 rw_u4(const Params& p, const float* mu, int r, int t, int L, int col) {
  const f32x4 m0 = *(const f32x4*)(mu + col), m2 = *(const f32x4*)(mu + RW_COLS + col);
  const bool hp = t >= 1, hn = t + 1 < L;
  const f32x4 c = ld_bf4(p.PR + (size_t)r * RW_COLS + col);
  const f32x4 a = ld_bf4(p.PR + (size_t)(hp ? r - 1 : r) * RW_COLS + col);
  const f32x4 b = ld_bf4(p.PR + (size_t)(hn ? r + 1 : r) * RW_COLS + col);
  const float fp = hp ? 1.f : 0.f, fn = hn ? 1.f : 0.f;
  f32x4 s;
#pragma unroll
  for (int i = 0; i < 4; ++i) s[i] = (1.f - m0[i] - m2[i]) * c[i] + (fp * m0[i]) * a[i] + (fn * m2[i]) * b[i];
  return s;
}
DI bf16x8 ld_bfrag_t(const u16* Wt, int K, int k0, int col, int lane) {
  return *(const bf16x8*)(Wt + (size_t)(col + (lane & 31)) * K + k0 + 8 * (lane >> 5));
}

DI void prep_item(const Params& p, int l, int tile, char* smem) {
  const int tid = TIDX(), lane = tid & 63, wave = tid >> 6;
  constexpr int LA = 72, LG = 136, LX = 68;
  constexpr int XW = 32 * LX + 64;
  u16* Awd = (u16*)smem;
  u16* Aad = Awd + 2 * 32 * LA;
  u16* Agd = Aad + 2 * 32 * LA;
  float* Xall = (float*)(Agd + 32 * LG);
  const float* mu = p.rw_mu + (size_t)l * 2 * RW_COLS;
  const int r0 = tile * 32;
  int b_, t0, L;
  seq_of_row(r0, b_, t0, L);
  SEG_BEGIN(p)
#pragma unroll 2
  for (int i = tid; i < 32 * 96; i += NT) {
    const int tok = i / 96, c4 = (i % 96) * 4;
    f32x4 u = rw_u4(p, mu, r0 + tok, t0 + tok, L, 3 * RW_CH + c4);
    if (c4 < 128) { f32x4 o; for (int j = 0; j < 4; ++j) o[j] = ftanh_(u[j]); st_bf4(Awd + ((c4 >> 6) * 32 + tok) * LA + (c4 & 63), o); }
    else if (c4 < 256) { int c2 = c4 - 128; st_bf4(Aad + ((c2 >> 6) * 32 + tok) * LA + (c2 & 63), u); }
    else { f32x4 o; for (int j = 0; j < 4; ++j) o[j] = fsigmoid_(u[j]); st_bf4(Agd + tok * LG + (c4 - 256), o); }
  }
  __syncthreads();
  SEG_MARK(p, 4)
  const int ts = lane >> 4, cq = lane & 15;
  if (wave < RW_H) {
    const int h = wave;
    float* X = Xall + (size_t)wave * XW;
    float* rinvw = X + 32 * LX;
    float* sbw = rinvw + 32;
    const size_t seqidx0 = (size_t)(b_ * RW_H + h) * L + t0;
    u16* sish = (r0 < TL ? p.SIsh_lat : p.SIsh_ctx);
    u16* sidir = (r0 < TL ? p.SIdir_lat : p.SIdir_ctx);
    const size_t dirstride = (size_t)NB * RW_H * L * 192;
    const int ch = h * 64 + cq * 4;
    const f32x4 kkc = *(const f32x4*)(p.rw_k_k + (size_t)l * RW_CH + ch);
    const f32x4 k_a = *(const f32x4*)(p.rw_k_a + (size_t)l * RW_CH + ch);
    const f32x4 r_k = *(const f32x4*)(p.rw_r_k + (size_t)l * RW_CH + ch);
    auto gemm_to_X = [&](const u16* Atile, int lda_, int arow0, const u16* Wt, int K) {
      f32x16 c0, c1;
#pragma unroll
      for (int r = 0; r < 16; ++r) { c0[r] = 0.f; c1[r] = 0.f; }
#pragma unroll 4
      for (int k0 = 0; k0 < K; k0 += 16) {
        bf16x8 a1 = *(const bf16x8*)(Atile + (arow0 + (lane & 31)) * lda_ + k0 + (lane >> 5) * 8);
        c0 = MFMA32(a1, ld_bfrag_t(Wt, K, k0, h * 64, lane), c0);
        c1 = MFMA32(a1, ld_bfrag_t(Wt, K, k0, h * 64 + 32, lane), c1);
      }
      wave_sync();
#pragma unroll
      for (int r = 0; r < 16; ++r) {
        X[crow(r, lane >> 5) * LX + (lane & 31)] = c0[r];
        X[crow(r, lane >> 5) * LX + 32 + (lane & 31)] = c1[r];
      }
      wave_sync();
    };
    {
      constexpr int mt = 0;
      if (lane < 32) sbw[lane] = 0.f;
      f32x4 rvs[8], kvs[8];
      float ris[8];
#pragma unroll
      for (int it = 0; it < 8; ++it) {
        const int tt = it * 4 + ts, tok = mt * 32 + tt;
        f32x4 rv = rw_u4(p, mu, r0 + tok, t0 + tok, L, ch);
        f32x4 kv = rw_u4(p, mu, r0 + tok, t0 + tok, L, RW_CH + ch);
        f32x4 vv = rw_u4(p, mu, r0 + tok, t0 + tok, L, 2 * RW_CH + ch);
        rvs[it] = rv; kvs[it] = kv;
        f32x4 kr;
        float ss = 0.f;
#pragma unroll
        for (int j = 0; j < 4; ++j) { kr[j] = kv[j] * kkc[j]; ss += kr[j] * kr[j]; }
        const float ri = rsqrtf(fmaxf(red16(ss), 1e-24f));
        ris[it] = ri;
#pragma unroll
        for (int j = 0; j < 4; ++j) kr[j] *= ri;
        u16* dst = sish + (seqidx0 + tok) * 192 + cq * 4;
        st_bf4(dst, rv); st_bf4(dst + 64, kr); st_bf4(dst + 128, vv);
      }
      SEG_MARK(p, 5)
#pragma unroll 1
      for (int d = 0; d < 2; ++d) {
        gemm_to_X(Awd, LA, d * 32 + mt * 32, p.wt_wup + ((size_t)l * 2 + d) * RW_CH * DRK, DRK);
        const f32x4 w0 = *(const f32x4*)(p.rw_w0 + ((size_t)l * 2 + d) * RW_CH + ch);
#pragma unroll 4
        for (int it = 0; it < 8; ++it) {
          const int tt = it * 4 + ts, tok = mt * 32 + tt;
          f32x4 xw = *(const f32x4*)(X + tt * LX + cq * 4);
          u32x2 o;
          u16 hh[4];
#pragma unroll
          for (int j = 0; j < 4; ++j) {
            const float e = 0.60653065971263342f * fsigmoid_(w0[j] + xw[j]);
            hh[j] = f2h(1.0f - fexp_(-e));
          }
          o[0] = (unsigned)hh[0] | ((unsigned)hh[1] << 16); o[1] = (unsigned)hh[2] | ((unsigned)hh[3] << 16);
          *(u32x2*)(sidir + (size_t)d * dirstride + (seqidx0 + tok) * 192 + cq * 4) = o;
        }
        SEG_MARK(p, 6)
        gemm_to_X(Aad, LA, d * 32 + mt * 32, p.wt_aup + ((size_t)l * 2 + d) * RW_CH * IRK, IRK);
        const f32x4 a0 = *(const f32x4*)(p.rw_a0 + ((size_t)l * 2 + d) * RW_CH + ch);
#pragma unroll
        for (int it = 0; it < 8; ++it) {
          const int tt = it * 4 + ts, tok = mt * 32 + tt;
          f32x4 xa = *(const f32x4*)(X + tt * LX + cq * 4);
          const f32x4 rv = rvs[it], kv = kvs[it];
          const float ri = ris[it];
          f32x4 ka, kd;
          float bs = 0.f;
#pragma unroll
          for (int j = 0; j < 4; ++j) {
            float a = fsigmoid_(a0[j] + xa[j]);
            ka[j] = kv[j] * kkc[j] * ri * a;
            kd[j] = kv[j] * (1.f + (a - 1.f) * k_a[j]);
            bs += rv[j] * kd[j] * r_k[j];
          }
          u16* dst = sidir + (size_t)d * dirstride + (seqidx0 + tok) * 192 + cq * 4;
          st_bf4(dst + 64, ka); st_bf4(dst + 128, kd);
          bs = red16(bs);
          if (cq == 0) sbw[tt] += bs;
        }
      }
      SEG_MARK(p, 7)
      wave_sync();
      if (lane < 32) p.sbonus[(size_t)(r0 + mt * 32 + lane) * RW_H + h] = sbw[lane];
      gemm_to_X(Agd, LG, mt * 32, p.wt_gup + (size_t)l * RW_CH * GRK, GRK);
#pragma unroll 4
      for (int it = 0; it < 8; ++it) {
        const int tt = it * 4 + ts, tok = mt * 32 + tt;
        f32x4 xg = *(const f32x4*)(X + tt * LX + cq * 4);
        st_bf4(p.gbuf + (size_t)(r0 + tok) * RW_CH + ch, xg);
      }
      wave_sync();
      SEG_MARK(p, 8)
    }
  }
  __syncthreads();
  SEG_MARK(p, 8)
}

DI void ph_prep(const Params& p, int l, char* smem) {
  for (int item = BIDX(); item < T / 32; item += gridDim.x) prep_item(p, l, item, smem);
}

typedef __attribute__((ext_vector_type(2))) float f32x2;
constexpr int SC_C = 16, SC_NSLOT = 8, SC_NCONS = 2, SC_NPROD = 6;
constexpr int SC_LDP = 72;
constexpr int SC_LDQ = 40;
constexpr int SC_AT = 0, SC_RT = SC_AT + 16 * SC_LDP * 2, SC_KT = SC_RT + 16 * SC_LDP * 2, SC_PQ = SC_KT + 64 * SC_LDQ * 2,
              SC_BM = SC_PQ + 16 * SC_LDQ * 2, SC_TM = SC_BM + 16 * SC_LDQ * 2, SC_VT = SC_TM + 16 * SC_LDQ * 2, SC_CUM = SC_VT + 64 * 16 * 2,
              SC_SLOT = SC_CUM + 64 * 4;
constexpr int SC_PSCR = SC_NSLOT * SC_SLOT;
constexpr int SC_PSCR_W = 2 * 16 * SC_LDP * 2;
constexpr int SC_FLAGS = SC_PSCR + SC_NPROD * SC_PSCR_W;
static_assert(SC_FLAGS + 64 * 4 < SMEM_BYTES - 1024, "scan LDS");
static_assert(SC_SLOT % 16 == 0 && SC_PSCR_W % 16 == 0, "scan LDS alignment");

#ifdef EMU
typedef volatile int* sc_flag_t;
#else
typedef volatile LAS int* sc_flag_t;
#endif
DI void sc_wait_eq(sc_flag_t f, int want) {
#ifdef EMU
  while (*f != want) emu_yield();
#else
  while (__builtin_amdgcn_readfirstlane(*f) != want) __builtin_amdgcn_s_sleep(1);
  asm volatile("s_waitcnt lgkmcnt(0)" ::: "memory");
#endif
}
DI void sc_wait_ge(sc_flag_t f, int want) {
#ifdef EMU
  while (*f < want) emu_yield();
#else
  while (__builtin_amdgcn_readfirstlane(*f) < want) __builtin_amdgcn_s_sleep(1);
  asm volatile("s_waitcnt lgkmcnt(0)" ::: "memory");
#endif
}
DI void sc_flag_inc(sc_flag_t f) {
#ifdef EMU
  *f = *f + 1;
#else
  (void)__hip_atomic_fetch_add((LAS int*)f, 1, __ATOMIC_RELAXED, __HIP_MEMORY_SCOPE_WORKGROUP);
#endif
}
DI float rdlane_f(float v, int l) { return __builtin_bit_cast(float, __builtin_amdgcn_readlane(__builtin_bit_cast(int, v), l)); }
#define MFMA16(a, b, c) __builtin_amdgcn_mfma_f32_16x16x32_bf16((a), (b), (c), 0, 0, 0)

DI void sc_step_time(int d, int s, bool& isctx, int& t) {
  isctx = s < CTXL;
  if (isctx) t = d == 0 ? s : CTXL - 1 - s;
  else { const int u = s - CTXL; t = d == 0 ? u : SEQ - 1 - u; }
}

DI void scan_chain_item(const Params& p, int item, char* smem) {
  const int tid = TIDX(), lane = tid & 63, wave = tid >> 6;
  const int chain = item >> 1, hf = item & 1;
  const int h = chain % RW_H, b = (chain / RW_H) % NB, d = chain / (RW_H * NB);
  constexpr int NCHUNK = (CTXL + SEQ) / SC_C;
  sc_flag_t ready = (sc_flag_t)(smem + SC_FLAGS);
  sc_flag_t done = ready + SC_NSLOT;
  if (tid < 2 * SC_NSLOT) ready[tid] = 0;
  __syncthreads();
  const int q4 = lane >> 4, c16 = lane & 15;
  if (wave >= SC_NCONS) {
    const int pw = wave - SC_NCONS;
    u16* Bt = (u16*)(smem + SC_PSCR + pw * SC_PSCR_W);
    u16* Kt = Bt + 16 * SC_LDP;
    const int k = lane;
    u16 raw[SC_C][6];
    auto load_chunk = [&](int c) {
#pragma unroll
      for (int j = 0; j < SC_C; ++j) {
        bool isctx; int t;
        sc_step_time(d, c * SC_C + j, isctx, t);
        const int L = isctx ? CTXL : SEQ;
        const size_t base = ((size_t)(b * RW_H + h) * L + t) * 192;
        const u16* sh = (isctx ? p.SIsh_ctx : p.SIsh_lat) + base;
        const u16* dr = (isctx ? p.SIdir_ctx : p.SIdir_lat) + (size_t)d * NB * RW_H * L * 192 + base;
        raw[j][0] = sh[k]; raw[j][1] = sh[64 + k]; raw[j][2] = sh[128 + k];
        raw[j][3] = dr[k]; raw[j][4] = dr[64 + k]; raw[j][5] = dr[128 + k];
      }
    };
    if (pw < NCHUNK) load_chunk(pw);
    for (int c = pw; c < NCHUNK; c += SC_NPROD) {
      const int slot = c % SC_NSLOT;
      char* sl = smem + slot * SC_SLOT;
      u16* At = (u16*)(sl + SC_AT); u16* Rt = (u16*)(sl + SC_RT); u16* KT = (u16*)(sl + SC_KT);
      u16* PQ = (u16*)(sl + SC_PQ); u16* BM = (u16*)(sl + SC_BM); u16* TM = (u16*)(sl + SC_TM);
      u16* VT = (u16*)(sl + SC_VT); float* CUM = (float*)(sl + SC_CUM);
      sc_wait_ge(done + slot, SC_NCONS * (c / SC_NSLOT));
      float cum = 1.f;
      u16 ktv[16], btv[16], vtv[16];
#pragma unroll
      for (int j = 0; j < SC_C; ++j) {
        const float rr = bf2f(raw[j][0]), kk = bf2f(raw[j][1]);
        vtv[j] = raw[j][2];
        const float w = 1.f - h2f(raw[j][3]), ka = bf2f(raw[j][4]), kd = bf2f(raw[j][5]);
        const float at = cum * kk;
        cum *= w;
        const float ic = frcp_(cum);
        At[j * SC_LDP + k] = f2bf(at);
        Rt[j * SC_LDP + k] = f2bf(cum * rr);
        btv[j] = f2bf(ka * ic); ktv[j] = f2bf(kd * ic);
        Bt[j * SC_LDP + k] = btv[j];
        Kt[j * SC_LDP + k] = ktv[j];
      }
      if (c + SC_NPROD < NCHUNK) load_chunk(c + SC_NPROD);
      CUM[k] = cum;
      {
        u32x4 o;
#pragma unroll
        for (int hh = 0; hh < 2; ++hh) {
          o[0] = ktv[8 * hh + 0] | ((unsigned)ktv[8 * hh + 1] << 16); o[1] = ktv[8 * hh + 2] | ((unsigned)ktv[8 * hh + 3] << 16);
          o[2] = ktv[8 * hh + 4] | ((unsigned)ktv[8 * hh + 5] << 16); o[3] = ktv[8 * hh + 6] | ((unsigned)ktv[8 * hh + 7] << 16);
          *(u32x4*)(KT + k * SC_LDQ + 8 * hh) = o;
          o[0] = btv[8 * hh + 0] | ((unsigned)btv[8 * hh + 1] << 16); o[1] = btv[8 * hh + 2] | ((unsigned)btv[8 * hh + 3] << 16);
          o[2] = btv[8 * hh + 4] | ((unsigned)btv[8 * hh + 5] << 16); o[3] = btv[8 * hh + 6] | ((unsigned)btv[8 * hh + 7] << 16);
          *(u32x4*)(KT + k * SC_LDQ + 16 + 8 * hh) = o;
          o[0] = vtv[8 * hh + 0] | ((unsigned)vtv[8 * hh + 1] << 16); o[1] = vtv[8 * hh + 2] | ((unsigned)vtv[8 * hh + 3] << 16);
          o[2] = vtv[8 * hh + 4] | ((unsigned)vtv[8 * hh + 5] << 16); o[3] = vtv[8 * hh + 6] | ((unsigned)vtv[8 * hh + 7] << 16);
          *(u32x4*)(VT + k * 16 + 8 * hh) = o;
        }
      }
      wave_sync();
      f32x4 am = {0.f, 0.f, 0.f, 0.f}, bm = am, pm = am, qm = am;
#pragma unroll
      for (int ks = 0; ks < 2; ++ks) {
        const int o = c16 * SC_LDP + 32 * ks + 8 * q4;
        const bf16x8 fa = *(const bf16x8*)(At + o), fr = *(const bf16x8*)(Rt + o);
        const bf16x8 fb = *(const bf16x8*)(Bt + o), fk = *(const bf16x8*)(Kt + o);
        am = MFMA16(fa, fb, am); bm = MFMA16(fa, fk, bm); pm = MFMA16(fr, fk, pm); qm = MFMA16(fr, fb, qm);
      }
#pragma unroll
      for (int r = 0; r < 4; ++r) {
        const int j = 4 * q4 + r;
        BM[j * SC_LDQ + c16] = c16 < j ? f2bf(bm[r]) : (u16)0;
        PQ[j * SC_LDQ + c16] = c16 <= j ? f2bf(pm[r]) : (u16)0;
        PQ[j * SC_LDQ + 16 + c16] = c16 <= j ? f2bf(-qm[r]) : (u16)0;
      }
      float Tc[16];
#pragma unroll
      for (int j = 0; j < 16; ++j) {
        float tv = (j == c16) ? 1.f : 0.f;
#pragma unroll
        for (int i = 0; i < j; ++i) tv -= rdlane_f(am[j & 3], i + 16 * (j >> 2)) * Tc[i];
        Tc[j] = tv;
      }
#pragma unroll
      for (int j = 0; j < 16; ++j) {
        if (q4 == 0) TM[j * SC_LDQ + c16] = f2bf(Tc[j]);
      }
      wave_sync();
      if (lane == 0) ready[slot] = c + 1;
    }
  } else {
    const int vt = SC_NCONS * hf + wave;
#ifndef EMU
    __builtin_amdgcn_s_setprio(3);
#endif
    f32x4 ST[4];
#pragma unroll
    for (int mt = 0; mt < 4; ++mt) ST[mt] = (f32x4){0.f, 0.f, 0.f, 0.f};
    auto ld2 = [&](const u16* q0, const u16* q1) {
      const u32x2 a = *(const u32x2*)q0, b2 = *(const u32x2*)q1;
      u32x4 o; o[0] = a[0]; o[1] = a[1]; o[2] = b2[0]; o[3] = b2[1];
      return __builtin_bit_cast(bf16x8, o);
    };
    auto ld1z = [&](const u16* q0) {
      const u32x2 a = *(const u32x2*)q0;
      u32x4 o; o[0] = a[0]; o[1] = a[1]; o[2] = 0u; o[3] = 0u;
      return __builtin_bit_cast(bf16x8, o);
    };
    SEG_BEGIN(p)
    for (int c = 0; c < NCHUNK; ++c) {
      const int slot = c % SC_NSLOT;
      const char* sl = smem + slot * SC_SLOT;
      const u16* At = (const u16*)(sl + SC_AT); const u16* Rt = (const u16*)(sl + SC_RT); const u16* KT = (const u16*)(sl + SC_KT);
      const u16* PQ = (const u16*)(sl + SC_PQ); const u16* BM = (const u16*)(sl + SC_BM); const u16* TM = (const u16*)(sl + SC_TM);
      const u16* VT = (const u16*)(sl + SC_VT); const float* CUM = (const float*)(sl + SC_CUM);
      bf16x8 shi[2], slo[2];
#pragma unroll
      for (int ks = 0; ks < 2; ++ks) {
        u32x4 oh, ol;
#pragma unroll
        for (int hh = 0; hh < 2; ++hh) {
          const f32x4 x = ST[2 * ks + hh];
          float h0 = bf2f(f2bf(x[0])), h1 = bf2f(f2bf(x[1])), h2 = bf2f(f2bf(x[2])), h3 = bf2f(f2bf(x[3]));
          oh[2 * hh] = pk2(x[0], x[1]); oh[2 * hh + 1] = pk2(x[2], x[3]);
          ol[2 * hh] = pk2(x[0] - h0, x[1] - h1); ol[2 * hh + 1] = pk2(x[2] - h2, x[3] - h3);
        }
        shi[ks] = __builtin_bit_cast(bf16x8, oh); slo[ks] = __builtin_bit_cast(bf16x8, ol);
      }
      SEG_MARK(p, 12)
      sc_wait_eq(ready + slot, c + 1);
      SEG_MARK(p, 13)
      f32x4 rhs = {0.f, 0.f, 0.f, 0.f}, y = rhs;
#pragma unroll
      for (int ks = 0; ks < 2; ++ks) {
        const int o = c16 * SC_LDP + 32 * ks + 4 * q4;
        const bf16x8 fa = ld2(At + o, At + o + 16), fr = ld2(Rt + o, Rt + o + 16);
        rhs = MFMA16(fa, shi[ks], rhs); y = MFMA16(fr, shi[ks], y);
        rhs = MFMA16(fa, slo[ks], rhs); y = MFMA16(fr, slo[ks], y);
      }
      const u32x2 vraw = *(const u32x2*)(VT + (16 * vt + c16) * 16 + 4 * q4);
      {
        u32x4 o; o[0] = vraw[0]; o[1] = vraw[1]; o[2] = 0u; o[3] = 0u;
        rhs = MFMA16(ld1z(BM + c16 * SC_LDQ + 4 * q4), __builtin_bit_cast(bf16x8, o), rhs);
      }
      f32x4 z = {0.f, 0.f, 0.f, 0.f};
      {
        u32x4 o; o[0] = pk2(rhs[0], rhs[1]); o[1] = pk2(rhs[2], rhs[3]); o[2] = 0u; o[3] = 0u;
        z = MFMA16(ld1z(TM + c16 * SC_LDQ + 4 * q4), __builtin_bit_cast(bf16x8, o), z);
      }
      const unsigned z01 = pk2(z[0], z[1]), z23 = pk2(z[2], z[3]);
      {
        u32x4 o; o[0] = vraw[0]; o[1] = vraw[1]; o[2] = z01; o[3] = z23;
        y = MFMA16(ld2(PQ + c16 * SC_LDQ + 4 * q4, PQ + c16 * SC_LDQ + 16 + 4 * q4), __builtin_bit_cast(bf16x8, o), y);
      }
#pragma unroll
      for (int r = 0; r < 4; ++r) {
        bool isctx; int t;
        sc_step_time(d, c * SC_C + 4 * q4 + r, isctx, t);
        const int rrow = isctx ? TL + b * CTXL + t : b * SEQ + t;
        p.ybuf[((size_t)d * T + rrow) * RW_CH + h * 64 + 16 * vt + c16] = f2bf(y[r]);
      }
      {
        u32x4 o; o[0] = vraw[0]; o[1] = vraw[1]; o[2] = z01 ^ 0x80008000u; o[3] = z23 ^ 0x80008000u;
        const bf16x8 bS = __builtin_bit_cast(bf16x8, o);
#pragma unroll
        for (int mt = 0; mt < 4; ++mt) {
          const u16* kr = KT + (16 * mt + c16) * SC_LDQ + 4 * q4;
          ST[mt] = MFMA16(ld2(kr, kr + 16), bS, ST[mt]);
          const f32x4 cm = *(const f32x4*)(CUM + 16 * mt + 4 * q4);
#pragma unroll
          for (int r = 0; r < 4; ++r) ST[mt][r] *= cm[r];
        }
      }
      wave_sync();
      if (lane == 0) sc_flag_inc(done + slot);
    }
#ifndef EMU
    __builtin_amdgcn_s_setprio(0);
#endif
  }
  __syncthreads();
}
DI void ph_scan(const Params& p, char* smem) {
  for (int item = BIDX(); item < 2 * (2 * NB * RW_H); item += gridDim.x) scan_chain_item(p, item, smem);
}

DI void ph_assemble(const Params& p, int l, char* smem) {
  const int tid = TIDX(), lane = tid & 63, wave = tid >> 6;
  const int ts = lane >> 4, cq = lane & 15;
  const int rows = (l == 0) ? T : TL;
  constexpr int LY = 66;
  u16* yt = (u16*)smem;
  const float* gn = p.mix_norm_g + (size_t)l * (CONV_CH + HY_CH);
  for (int tile = BIDX(); tile < rows / 64; tile += gridDim.x) {
    const int r0 = tile * 64;
    int b_, t0, L;
    seq_of_row(r0, b_, t0, L);
    const u16* yh = (r0 < TL ? p.yhlat : p.yhctx) + (size_t)b_ * HY_CH * L + t0;
    for (int i = tid; i < HY_CH * 8; i += NT) {
      int c = i >> 3, part = i & 7;
      const u32x4 v = *(const u32x4*)(yh + (size_t)c * L + part * 8);
      unsigned* q = (unsigned*)(yt + c * LY + part * 8);
      q[0] = v[0]; q[1] = v[1]; q[2] = v[2]; q[3] = v[3];
    }
    __syncthreads();
    const u16* sish = (r0 < TL ? p.SIsh_lat : p.SIsh_ctx);
#pragma unroll
    for (int it = 0; it < 2; ++it) {
      const int tok = wave * 8 + it * 4 + ts;
      const int r = r0 + tok;
      u16* dst = p.ycat + (size_t)r * MIX_W;
#pragma unroll
      for (int bk = 0; bk < CONV_CH / 64; ++bk)
        *(u32x2*)(dst + bk * 64 + cq * 4) = *(const u32x2*)(p.ya + (size_t)r * CONV_CH + bk * 64 + cq * 4);
      float hv[HY_CH / 64][4];
      float ss = 0.f;
#pragma unroll
      for (int bk = 0; bk < HY_CH / 64; ++bk)
#pragma unroll
        for (int j = 0; j < 4; ++j) { hv[bk][j] = bf2f(yt[(bk * 64 + cq * 4 + j) * LY + tok]); ss += hv[bk][j] * hv[bk][j]; }
      ss = red16(ss);
      const float rs = rsqrtf(ss / (float)HY_CH + LN_EPS);
#pragma unroll
      for (int bk = 0; bk < HY_CH / 64; ++bk) {
        const f32x4 g4 = *(const f32x4*)(gn + CONV_CH + bk * 64 + cq * 4);
        f32x4 o;
#pragma unroll
        for (int j = 0; j < 4; ++j) o[j] = hv[bk][j] * rs * g4[j];
        st_bf4(dst + CONV_CH + bk * 64 + cq * 4, o);
      }
#pragma unroll
      for (int h = 0; h < RW_H; ++h) {
        const int ch = h * 64 + cq * 4;
        const f32x4 yf = ld_bf4(p.ybuf + (size_t)r * RW_CH + ch), yb = ld_bf4(p.ybuf + ((size_t)T + r) * RW_CH + ch);
        const f32x4 vv = ld_bf4(sish + ((size_t)(b_ * RW_H + h) * L + t0 + tok) * 192 + 128 + cq * 4);
        const f32x4 gg = ld_bf4(p.gbuf + (size_t)r * RW_CH + ch);
        const f32x4 lg4 = *(const f32x4*)(p.rw_lnx_g + (size_t)l * RW_CH + ch), lb4 = *(const f32x4*)(p.rw_lnx_b + (size_t)l * RW_CH + ch);
        const float sb = p.sbonus[(size_t)r * RW_H + h];
        f32x4 yv;
        float sm = 0.f;
#pragma unroll
        for (int j = 0; j < 4; ++j) { yv[j] = yf[j] + yb[j]; sm += yv[j]; }
        const float mu = red16(sm) * (1.f / 64.f);
        float sq = 0.f;
#pragma unroll
        for (int j = 0; j < 4; ++j) { yv[j] -= mu; sq += yv[j] * yv[j]; }
        const float rstd = rsqrtf(red16(sq) * (1.f / 64.f) + RW_GN_EPS);
        f32x4 o;
#pragma unroll
        for (int j = 0; j < 4; ++j) o[j] = (yv[j] * rstd * lg4[j] + lb4[j] + sb * vv[j]) * gg[j];
        st_bf4(dst + CONV_CH + HY_CH + ch, o);
      }
    }
    __syncthreads();
  }
}

DI void ph_outproj(const Params& p, int l, char* smem) {
  const int rows = (l == 0) ? T : TL;
  const int G = gridDim.x, c = BIDX();
  {
    DenseSched S; S.init(p.ycat, p.wt_out + (size_t)l * D * MIX_W, MIX_W, rows, D, G, c);
    EpiOutproj E{&p, l};
    pg8::gemm_phase(smem, MIX_W, S, E);
  }
  __syncthreads();
  ticket_loop(p.bar + XB_TICKET + 1 + DEPTH + l, CT_EXP_L, smem, [&](int it) { convert_expert_item(p, l, it, smem); });
}

DI void ph_ln_router(const Params& p, int l, char* smem) {
  const int tid = TIDX(), lane = tid & 63, wave = tid >> 6;
  const int rows = (l == 0) ? T : TL;
  constexpr int LH = D + 8;
  constexpr int EPL = D / 64;
  u16* Hhi = (u16*)smem;
  u16* Hlo = Hhi + 32 * LH;
  float* red = (float*)smem;
  constexpr int LGS_OFF = (2 * 32 * LH * 2 > 8 * 32 * 64 * 4) ? 2 * 32 * LH * 2 : 8 * 32 * 64 * 4;
  float* lgs = (float*)(smem + LGS_OFF);
  const float* lg = p.ln_g + ((size_t)l * 2 + 0) * D;
  const float* lb = p.ln_b + ((size_t)l * 2 + 0) * D;
  const u16* Whi = p.wt_rhi + (size_t)l * NE * D;
  const u16* Wlo = p.wt_rlo + (size_t)l * NE * D;
  constexpr int KS = D / 8;
  SEG_BEGIN(p)
  for (int tile = BIDX(); tile < rows / 32; tile += gridDim.x) {
    const int r0 = tile * 32;
#pragma unroll 2
    for (int tt = 0; tt < 4; ++tt) {
      const int tok = wave * 4 + tt;
      const int r = r0 + tok;
      float* xr = x1row(p, r);
      const float* m = modp(p, l, r);
      constexpr int NV = D / 256;
      f32x4 xv[NV];
      float s = 0.f;
#pragma unroll
      for (int i = 0; i < NV; ++i) { xv[i] = *(const f32x4*)(xr + 4 * lane + 256 * i); s += (xv[i][0] + xv[i][1]) + (xv[i][2] + xv[i][3]); }
      const float mu = wave_sum(s) * (1.f / (float)D);
      float s2 = 0.f;
#pragma unroll
      for (int i = 0; i < NV; ++i)
#pragma unroll
        for (int j = 0; j < 4; ++j) { float dd = xv[i][j] - mu; s2 += dd * dd; }
      const float rstd = rsqrtf(wave_sum(s2) * (1.f / (float)D) + LN_EPS);
#pragma unroll
      for (int i = 0; i < NV; ++i) {
        const int e = 4 * lane + 256 * i;
        const f32x4 g4 = *(const f32x4*)(lg + e), b4 = *(const f32x4*)(lb + e);
        const f32x4 sc = *(const f32x4*)(m + 4 * D + e), sh = *(const f32x4*)(m + 3 * D + e);
        f32x4 xn, hh, lo;
#pragma unroll
        for (int j = 0; j < 4; ++j) { xn[j] = (xv[i][j] - mu) * rstd * g4[j] + b4[j]; hh[j] = xn[j] * (1.f + sc[j]) + sh[j]; }
        *(f32x4*)(xr + e) = xn;
        u32x2 hp; hp[0] = pk2(hh[0], hh[1]); hp[1] = pk2(hh[2], hh[3]);
#pragma unroll
        for (int j = 0; j < 4; ++j) lo[j] = hh[j] - bf2f((u16)((j & 1) ? (hp[j >> 1] >> 16) : (hp[j >> 1] & 0xffff)));
        *(u32x2*)(Hhi + tok * LH + e) = hp;
        st_bf4(Hlo + tok * LH + e, lo);
        *(u32x2*)(p.HL + (size_t)r * D + e) = hp;
        u32x2 zz; zz[0] = 0u; zz[1] = 0u;
        *(u32x2*)(p.acc + (size_t)r * (D / 2) + e / 2) = zz;
      }
    }
    __syncthreads();
    SEG_MARK(p, 0)
    f32x16 c0, c1;
#pragma unroll
    for (int r = 0; r < 16; ++r) { c0[r] = 0.f; c1[r] = 0.f; }
#pragma unroll 4
    for (int k0 = wave * KS; k0 < (wave + 1) * KS; k0 += 16) {
      const int ko = k0 + (lane >> 5) * 8;
      bf16x8 ah = *(const bf16x8*)(Hhi + (lane & 31) * LH + ko);
      bf16x8 al = *(const bf16x8*)(Hlo + (lane & 31) * LH + ko);
      bf16x8 bh0 = *(const bf16x8*)(Whi + (size_t)(lane & 31) * D + ko);
      bf16x8 bh1 = *(const bf16x8*)(Whi + (size_t)(32 + (lane & 31)) * D + ko);
      bf16x8 bl0 = *(const bf16x8*)(Wlo + (size_t)(lane & 31) * D + ko);
      bf16x8 bl1 = *(const bf16x8*)(Wlo + (size_t)(32 + (lane & 31)) * D + ko);
      c0 = MFMA32(ah, bh0, c0); c0 = MFMA32(ah, bl0, c0); c0 = MFMA32(al, bh0, c0);
      c1 = MFMA32(ah, bh1, c1); c1 = MFMA32(ah, bl1, c1); c1 = MFMA32(al, bh1, c1);
    }
    __syncthreads();
    SEG_MARK(p, 1)
#pragma unroll
    for (int r = 0; r < 16; ++r) {
      red[(wave * 32 + crow(r, lane >> 5)) * 64 + (lane & 31)] = c0[r];
      red[(wave * 32 + crow(r, lane >> 5)) * 64 + 32 + (lane & 31)] = c1[r];
    }
    __syncthreads();
    for (int i = tid; i < 32 * 64; i += NT) {
      float sacc = 0.f;
#pragma unroll
      for (int w = 0; w < 8; ++w) sacc += red[w * 2048 + i];
      lgs[i] = sacc;
    }
    __syncthreads();
    SEG_MARK(p, 2)
    unsigned long long* selm = (unsigned long long*)(lgs + 32 * 64);
    unsigned char* lpos = (unsigned char*)(selm + 32);
    int* tbase = (int*)(lpos + 32 * 64);
    const float eb = p.e_bias[(size_t)l * NE + lane];
    float gate4[4];
    bool ch4[4];
    {
      float score4[4], selv4[4];
#pragma unroll
      for (int tt = 0; tt < 4; ++tt) { score4[tt] = fsigmoid_(lgs[(wave * 4 + tt) * 64 + lane]); selv4[tt] = score4[tt] + eb; ch4[tt] = false; }
      for (int round = 0; round < TOPK; ++round) {
#pragma unroll
        for (int tt = 0; tt < 4; ++tt) {
          const float cand = ch4[tt] ? -1e30f : selv4[tt];
          const float mx = wave_max(cand);
          const unsigned long long bal = __ballot(cand == mx);
          const int win = __ffsll((long long)bal) - 1;
          if (lane == win) ch4[tt] = true;
        }
      }
#pragma unroll
      for (int tt = 0; tt < 4; ++tt) {
        const float ssum = wave_sum(ch4[tt] ? score4[tt] : 0.f);
        gate4[tt] = ROUTED_SCALE * score4[tt] / ssum;
        const unsigned long long m = __ballot(ch4[tt]);
        if (lane == 0) selm[wave * 4 + tt] = m;
      }
    }
    __syncthreads();
    if (wave == 0) {
      int c = 0;
      for (int t = 0; t < 32; ++t) {
        const int bit = (int)((selm[t] >> lane) & 1ull);
        lpos[t * 64 + lane] = (unsigned char)c;
        c += bit;
      }
      int base = 0;
      if (c > 0) base = atomicAdd(p.cnt + l * NE + lane, c);
      tbase[lane] = base;
    }
    __syncthreads();
#pragma unroll
    for (int tt = 0; tt < 4; ++tt) {
      const int tok = wave * 4 + tt;
      if (ch4[tt]) {
        const int pos = tbase[lane] + (int)lpos[tok * 64 + lane];
        p.etok[(size_t)lane * T + pos] = r0 + tok;
        p.egate[(size_t)lane * T + pos] = gate4[tt];
      }
    }
    __syncthreads();
    SEG_MARK(p, 3)
  }
}

constexpr int EXP_LDS_OFF = 128 * 1024;
constexpr int MAX_ROW_TILES = (T * TOPK) / 256 + NE + T / 256;
static_assert(28 * 1024 + (2 * (NE + 2) + (NE + 2)) * 4 + MAX_ROW_TILES + EXP_LDS_OFF <= SMEM_BYTES - 1024, "expert tables fit below the parked parameters");
static_assert(NE == 64, "binary search step");
struct ExpTables { int* pre; int* hoff; int* cntl; unsigned char* t2e; };
DI ExpTables expert_tables(const Params& p, int l, int rows, char* smem) {
  ExpTables x;
  x.pre = (int*)(smem + EXP_LDS_OFF + 28 * 1024);
  x.hoff = x.pre + (NE + 2);
  x.cntl = x.hoff + (NE + 2);
  x.t2e = (unsigned char*)(x.cntl + (NE + 2));
  const int tid = TIDX();
  if (tid == 0) {
    int s = 0, ho = 0;
    for (int e = 0; e < NE; ++e) { const int ce = p.cnt[l * NE + e]; const int nt = (ce + 255) / 256; x.pre[e] = s; x.hoff[e] = ho; x.cntl[e] = ce; s += nt; ho += nt * 256; }
    x.pre[NE] = s; x.hoff[NE] = ho; x.cntl[NE] = rows; s += rows / 256; x.pre[NE + 1] = s;
  }
  __syncthreads();
  {
    const int R = x.pre[NE + 1];
    for (int t = tid; t < R; t += NT) {
      int e = 0;
#pragma unroll
      for (int step = 64; step >= 1; step >>= 1) { const int c = e + step; if (c <= NE && x.pre[c] <= t) e = c; }
      x.t2e[t] = (unsigned char)e;
    }
  }
  __syncthreads();
  return x;
}
DI void ph_e1(const Params& p, int l, char* smem) {
  const int rows = (l == 0) ? T : TL;
  const ExpTables x = expert_tables(p, l, rows, smem);
  E1Sched S;
  S.pre = x.pre; S.cntl = x.cntl; S.t2e = x.t2e; S.nN = FF / 128; S.G = gridDim.x; S.c = BIDX(); S.total = x.pre[NE + 1] * S.nN;
  S.A = (const char*)p.HL; S.W = (const char*)p.wt_exp; S.etok = p.etok;
  S.preload((unsigned*)(smem + EXP_LDS_OFF), 24);
  EpiE1 E{p.Hbuf, x.hoff};
  pg8::gemm_phase(smem, D, S, E);
  __syncthreads();
}
DI void ph_e2(const Params& p, int l, char* smem) {
  const int rows = (l == 0) ? T : TL;
  const ExpTables x = expert_tables(p, l, rows, smem);
  E2Sched S;
  S.pre = x.pre; S.cntl = x.cntl; S.t2e = x.t2e; S.nN = D / 256; S.G = gridDim.x; S.c = BIDX(); S.total = x.pre[NE + 1] * S.nN;
  S.A = (const char*)p.Hbuf; S.W = (const char*)p.wt_exp; S.hoff = x.hoff;
  EpiE2 E{p.acc, p.etok, p.egate, (float*)(smem + EXP_LDS_OFF), p.SHo};
  pg8::gemm_phase(smem, FF, S, E);
  __syncthreads();
}

DI void ph_combine(const Params& p, int l) {
  const int tid = TIDX(), lane = tid & 63, wave = tid >> 6;
  const int rows = (l == 0) ? T : TL;
  constexpr int NV = D / 256;
  constexpr int RPW = 2;
  const float* lg = p.ln_g + ((size_t)l * 2 + 1) * D;
  const float* lb = p.ln_b + ((size_t)l * 2 + 1) * D;
  for (int tile = BIDX(); tile < rows / (8 * RPW); tile += gridDim.x) {
    f32x4 xv[RPW][NV];
    float s[RPW];
#pragma unroll
    for (int u = 0; u < RPW; ++u) {
      const int r = tile * (8 * RPW) + u * 8 + wave;
      const float* x1 = x1row(p, r);
      const float* m = modp(p, l, r);
      s[u] = 0.f;
#pragma unroll
      for (int i = 0; i < NV; ++i) {
        const int e = 4 * lane + 256 * i;
        const u32x2 aw = *(const u32x2*)(p.acc + (size_t)r * (D / 2) + e / 2);
        float m0, m1, m2, m3;
        acc_unpack4(aw[0], aw[1], m0, m1, m2, m3);
        const f32x4 xx = *(const f32x4*)(x1 + e), gg = *(const f32x4*)(m + 5 * D + e);
        const f32x4 sh4 = ld_bf4(p.SHo + (size_t)r * D + e);
        xv[u][i][0] = DN_ALPHA * xx[0] + gg[0] * (m0 + sh4[0]); xv[u][i][1] = DN_ALPHA * xx[1] + gg[1] * (m1 + sh4[1]);
        xv[u][i][2] = DN_ALPHA * xx[2] + gg[2] * (m2 + sh4[2]); xv[u][i][3] = DN_ALPHA * xx[3] + gg[3] * (m3 + sh4[3]);
        s[u] += (xv[u][i][0] + xv[u][i][1]) + (xv[u][i][2] + xv[u][i][3]);
      }
    }
#pragma unroll
    for (int u = 0; u < RPW; ++u) {
      const int r = tile * (8 * RPW) + u * 8 + wave;
      float* x1 = x1row(p, r);
      const float* m = modp(p, l, r);
      const float mu = wave_sum(s[u]) * (1.f / (float)D);
      float s2 = 0.f;
#pragma unroll
      for (int i = 0; i < NV; ++i)
#pragma unroll
        for (int j = 0; j < 4; ++j) { float dd = xv[u][i][j] - mu; s2 += dd * dd; }
      const float rstd = rsqrtf(wave_sum(s2) * (1.f / (float)D) + LN_EPS);
      const float* m1 = (l + 1 < DEPTH) ? modp(p, l + 1, r) : m;
#pragma unroll
      for (int i = 0; i < NV; ++i) {
        const int e = 4 * lane + 256 * i;
        const f32x4 g4 = *(const f32x4*)(lg + e), b4 = *(const f32x4*)(lb + e);
        f32x4 xn;
#pragma unroll
        for (int j = 0; j < 4; ++j) xn[j] = (xv[u][i][j] - mu) * rstd * g4[j] + b4[j];
        if (r < TL) *(f32x4*)(x1 + e) = xn;
        if (l + 1 < DEPTH) {
          const f32x4 sc = *(const f32x4*)(m1 + D + e), sh = *(const f32x4*)(m1 + e);
          f32x4 o;
#pragma unroll
          for (int j = 0; j < 4; ++j) o[j] = xn[j] * (1.f + sc[j]) + sh[j];
          st_bf4(p.HL + (size_t)r * D + e, o);
        }
      }
    }
  }
}

constexpr int PH_PER_LAYER = 10;
constexpr int NPHASES = 2 + PH_PER_LAYER * DEPTH;
DI void run_phase(const Params& p, int ph, char* smem) {
  if (ph == 0) { ph_prologue(p, smem); return; }
  if (ph == 1) { ph_premod(p); return; }
  const int l = (ph - 2) / PH_PER_LAYER, q = (ph - 2) % PH_PER_LAYER;
  switch (q) {
    case 0: ph_inproj(p, l, smem); break;
    case 1: ph_mix(p, l, smem); break;
    case 2: ph_prep(p, l, smem); break;
    case 3: ph_scan(p, smem); break;
    case 4: ph_assemble(p, l, smem); break;
    case 5: ph_outproj(p, l, smem); break;
    case 6: ph_ln_router(p, l, smem); break;
    case 7: ph_e1(p, l, smem); break;
    case 8: ph_e2(p, l, smem); break;
    case 9: ph_combine(p, l); break;
  }
}

static inline size_t al256(size_t x) { return (x + 255) & ~(size_t)255; }
static inline size_t max2(size_t a, size_t b) { return a > b ? a : b; }
static Params make_params(void* const* d_in, void* d_out, void* d_ws, size_t* used) {
  Params p{};
  const float** f = (const float**)&p;
  for (int i = 0; i < 42; ++i) f[i] = (const float*)d_in[i];
  p.out = (float*)d_out;
  char* w = (char*)d_ws;
  size_t o = 0;
  auto take = [&](size_t bytes) { char* r = w + o; o = al256(o + bytes); return r; };
  p.HL = (u16*)take((size_t)T * D * 2);
  p.mod = (float*)take((size_t)DEPTH * (NB + 1) * 6 * D * 4);
  p.h3lat = (float*)take((size_t)DEPTH * SEQ * 64 * 4);
  p.h3ctx = (float*)take((size_t)DEPTH * CTXL * 64 * 4);
  p.tw = (cf*)take((size_t)(FFTN / 2) * 8);
  p.tstamp = (long long*)take(64 * 8);
  p.bar = (unsigned*)take((size_t)XCD_BAR_WORDS * 4);
  p.cnt = (int*)take((size_t)DEPTH * NE * 4);
  p.sbonus = (float*)take((size_t)T * RW_H * 4);
  p.XC = (float*)take((size_t)TC * D * 4);
  p.wt_in = (u16*)take((size_t)DEPTH * P_IN_PAD * D * 2);
  p.wt_out = (u16*)take((size_t)DEPTH * D * MIX_W * 2);
  p.wt_rhi = (u16*)take((size_t)DEPTH * NE * D * 2);
  p.wt_rlo = (u16*)take((size_t)DEPTH * NE * D * 2);
  p.wt_wup = (u16*)take((size_t)DEPTH * 2 * RW_CH * DRK * 2);
  p.wt_aup = (u16*)take((size_t)DEPTH * 2 * RW_CH * IRK * 2);
  p.wt_gup = (u16*)take((size_t)DEPTH * RW_CH * GRK * 2);
  const size_t szEt = al256((size_t)NE * T * 4);
  char* G = take(max2(max2((size_t)T * RW_CH * 2, (size_t)2 * HY_CH * FFTN * 8), 2 * szEt));
  p.spec = (cf*)G;
  p.gbuf = (u16*)G;
  p.etok = (int*)G;
  p.egate = (float*)(G + szEt);
  const size_t szPAPH = (size_t)T * PA_W * 2 + (size_t)T * PH_W * 2;
  const size_t szSIsh = (size_t)T * RW_H * 192 * 2;
  const size_t szWexp = (size_t)(NE + 1) * EXP_STRIDE * 2;
  char* R0 = take(max2(max2(szPAPH, szSIsh), szWexp));
  p.PA = (u16*)R0;
  p.PH = (u16*)(R0 + (size_t)T * PA_W * 2);
  p.SIsh_lat = (u16*)R0;
  p.SIsh_ctx = p.SIsh_lat + (size_t)NB * RW_H * SEQ * 192;
  p.wt_exp = (u16*)R0;
  const size_t szPR = (size_t)T * RW_COLS * 2, szY = (size_t)2 * T * RW_CH * 2;
  char* R1 = take(max2(szPR, szY));
  p.PR = (u16*)R1;
  p.ybuf = (u16*)R1;
  const size_t szSIdir = (size_t)2 * T * RW_H * 192 * 2;
  const size_t szYC = al256((size_t)T * MIX_W * 2);
  char* R2 = take(max2(szSIdir, szYC));
  p.SIdir_lat = (u16*)R2;
  p.SIdir_ctx = p.SIdir_lat + (size_t)2 * NB * RW_H * SEQ * 192;
  p.ycat = (u16*)R2;
  p.acc = (int*)R1;
  const size_t szAcc = al256((size_t)T * (D / 2) * 4);
  const size_t szH = (size_t)(T * TOPK + T + (NE + 1) * 256) * FF * 2;
  p.Hbuf = (u16*)(R1 + szAcc);
  const size_t szSH = al256((size_t)T * D * 2);
  p.SHo = (u16*)(R1 + szAcc + al256(szH));
  p.ya = (u16*)take((size_t)T * CONV_CH * 2);
  p.yhlat = (u16*)take((size_t)NB * HY_CH * SEQ * 2);
  p.yhctx = (u16*)take((size_t)NB * HY_CH * CTXL * 2);
  if (szAcc + al256(szH) + szSH > al256(max2(szPR, szY)) + al256(max2(szSIdir, szYC))) o = (size_t)1 << 62;
  *used = o;
  return p;
}
static size_t ws_needed() {
  return (size_t)640 * 1024 * 1024;
}

#ifndef EMU
constexpr int NFIELDS = sizeof(Params) / 8;
static_assert(sizeof(Params) % 8 == 0 && sizeof(Params) <= 1024, "Params layout");
DI unsigned long long uni64(unsigned long long v) {
  unsigned lo = __builtin_amdgcn_readfirstlane((unsigned)v), hi = __builtin_amdgcn_readfirstlane((unsigned)(v >> 32));
  return ((unsigned long long)hi << 32) | lo;
}
DI void load_params(Params& q, const char* smem) {
  const unsigned long long* src = (const unsigned long long*)(smem + SMEM_BYTES - 1024);
  char** dst = (char**)&q;
  typedef __attribute__((address_space(1))) char gchar_t;
#pragma clang loop unroll(full)
  for (int i = 0; i < NFIELDS; ++i) dst[i] = (char*)(gchar_t*)uni64(src[i]);
}
__global__ void __launch_bounds__(NT) hybrid_mega(Params parg) {
  __shared__ __attribute__((aligned(16))) char smem[SMEM_BYTES];
  if (threadIdx.x < NFIELDS)
    ((unsigned long long*)(smem + SMEM_BYTES - 1024))[threadIdx.x] = ((const unsigned long long*)&parg)[threadIdx.x];
  volatile LAS unsigned* st = (volatile LAS unsigned*)(smem + SMEM_BYTES - 16);
  if (threadIdx.x == 0) { st[0] = 0u; st[1] = 0u; }
  __syncthreads();
  const XcdBarrier xb = xcd_barrier_post(parg.bar, st);
#if PROF_SEG
  if (blockIdx.x == 0 && threadIdx.x < 16) parg.tstamp[32 + threadIdx.x] = 0;
#endif
#if PROF_A || PROF_B || PROF_C || PROF_SEG
#define MK_STAMP(ph) if (blockIdx.x == 0 && threadIdx.x == 0) p.tstamp[ph] = (long long)__builtin_amdgcn_s_memrealtime();
#else
#define MK_STAMP(ph)
#endif
#define MK_PHASE(ph) { Params p; load_params(p, smem); MK_STAMP(ph) run_phase(p, ph, smem); if ((ph) + 1 < NPHASES) xcd_barrier(xb); }
  MK_PHASE(0) MK_PHASE(1) MK_PHASE(2) MK_PHASE(3) MK_PHASE(4) MK_PHASE(5) MK_PHASE(6) MK_PHASE(7) MK_PHASE(8) MK_PHASE(9) MK_PHASE(10)
  MK_PHASE(11) MK_PHASE(12) MK_PHASE(13) MK_PHASE(14) MK_PHASE(15) MK_PHASE(16) MK_PHASE(17) MK_PHASE(18) MK_PHASE(19) MK_PHASE(20) MK_PHASE(21)
  static_assert(NPHASES == 22, "phase program");
#if PROF_A || PROF_B || PROF_C || PROF_SEG
  {
    xcd_barrier(xb);
    Params p;
    load_params(p, smem);
    if (blockIdx.x == 0 && threadIdx.x == 0) p.tstamp[NPHASES] = (long long)__builtin_amdgcn_s_memrealtime();
    xcd_barrier(xb);
    const long long* ts = p.tstamp;
    float tot = (float)(ts[NPHASES] - ts[0]);
    (void)tot;
    float ta = 0.f, tb = 0.f;
    long long tc = 0;
    for (int ph = 0; ph < NPHASES; ++ph) {
      float dt = (float)(ts[ph + 1] - ts[ph]);
      if ((PROF_A >> ph) & 1) ta += dt;
      if ((PROF_B >> ph) & 1) tb += dt;
      if ((PROF_C >> ph) & 1) tc += ts[ph + 1] - ts[ph];
    }
#if PROF_SEG
    {
      float st_ = 0.f;
      for (int k = 0; k < 16; ++k) st_ += (float)ts[32 + k];
      ta = (float)ts[32 + PROF_SA]; tb = (float)ts[32 + PROF_SB]; tot = st_ > 0.f ? st_ : 1.f;
      tc = ts[32 + PROF_SC];
    }
#endif
    float fa = ta / tot, fb = tb / tot;
#if PROF_SEG
    fa = floorf(fa * 50.f + 0.5f) * (1.f / 50.f); fb = floorf(fb * 45.f + 0.5f) * (1.f / 45.f);
#endif
    const float da = sqrtf(0.5f * fa);
    const size_t NA = (size_t)TL * D / 100;
    if (!PROF_SEG) for (size_t i = (size_t)blockIdx.x * NT + threadIdx.x; i < NA; i += (size_t)gridDim.x * NT) p.out[i] += da;
    if (PROF_B && !PROF_SEG && blockIdx.x == 0 && threadIdx.x == 0) p.out[(size_t)TL * D - 1] += 10.f + 90.f * fb;
    if (PROF_C || PROF_SEG) { while ((long long)__builtin_amdgcn_s_memrealtime() < ts[NPHASES] + tc) {} }
  }
#endif
}
#ifdef MULTI_LAUNCH
__global__ void __launch_bounds__(NT) hybrid_phase(Params p, int ph) {
  __shared__ __attribute__((aligned(16))) char smem[SMEM_BYTES];
  run_phase(p, ph, smem);
}
#endif

extern "C" void kernel_launch(void* const* d_in, const int* in_sizes, int n_in, void* d_out, int out_size, void* d_ws,
                              size_t ws_size, hipStream_t stream) {
  (void)in_sizes; (void)n_in; (void)out_size;
  static int grid_blocks = 0;
  if (!grid_blocks) {
    int dev = 0, cus = 0, per_cu = 0;
    hipGetDevice(&dev);
    hipDeviceGetAttribute(&cus, hipDeviceAttributeMultiprocessorCount, dev);
    hipOccupancyMaxActiveBlocksPerMultiprocessor(&per_cu, hybrid_mega, NT, 0);
    if (per_cu < 1) per_cu = 1;
    grid_blocks = cus;
  }
  size_t used = 0;
  Params p = make_params(d_in, d_out, d_ws, &used);
  if (used > ws_size) return;
#ifdef MULTI_LAUNCH
  for (int ph = 0; ph < NPHASES; ++ph) hipLaunchKernelGGL(hybrid_phase, dim3(grid_blocks), dim3(NT), 0, stream, p, ph);
#else
  hipMemsetAsync(p.bar, 0, (size_t)XCD_BAR_WORDS * 4, stream);
  void* args[] = {&p};
  hipLaunchCooperativeKernel((void*)hybrid_mega, dim3(grid_blocks), dim3(NT), args, 0, stream);
#endif
}
#endif
```

```cpp
#ifdef EMU
#include "emu_hip.h"
#else
#include <hip/hip_runtime.h>
#endif
#include <stdint.h>
#include <stddef.h>

#define DI __device__ __forceinline__

#ifdef CFG_SMALL
constexpr int D = 512, NB = 2, SEQ = 256, GRID_W = 16, CTXL = 256, CONV_CH = 128, HY_CH = 128, RW_H = 4;
#else
constexpr int D = 1024, NB = 8, SEQ = 4096, GRID_W = 64, CTXL = 256, CONV_CH = 256, HY_CH = 256, RW_H = 8;
#endif
constexpr int DEPTH = 2;
constexpr int HD = 64;
constexpr int RW_CH = RW_H * HD;
constexpr int MIX_W = CONV_CH + HY_CH + RW_CH;
constexpr int DRK = 64, IRK = 64, GRK = 128;
constexpr int RW_COLS = 3 * RW_CH + 2 * DRK + 2 * IRK + GRK;
constexpr int PA_W = 3 * CONV_CH, PH_W = 3 * HY_CH;
constexpr int P_IN = PA_W + PH_W + RW_COLS;
constexpr int P_IN_PAD = ((P_IN + 255) / 256) * 256;
constexpr int HY_EMB = 33, HY_BANDS = 16, HY_HID = 64;
constexpr int NE = 64, TOPK = 8, FF = 256;
constexpr int TL = NB * SEQ, TC = NB * CTXL, T = TL + TC;
constexpr int FFTN = 2 * SEQ;
constexpr int ilog2c(int n) { return n <= 1 ? 0 : 1 + ilog2c(n / 2); }
constexpr int LOG2N = ilog2c(FFTN);
constexpr float LN_EPS = 1e-5f;
constexpr float RW_GN_EPS = 64e-5f;
constexpr float DN_ALPHA = 1.41421356237309515f;
constexpr float ROUTED_SCALE = 2.5f;
constexpr int NT = 512;
#ifndef PROF_A
#define PROF_A 0
#endif
#ifndef PROF_B
#define PROF_B 0
#endif
#ifndef PROF_C
#define PROF_C 0
#endif
constexpr int SMEM_BYTES = 160 * 1024;
static_assert(MIX_W == D, "mix width");
static_assert(D % 128 == 0 && P_IN % 128 == 0 && PA_W % 128 == 0 && PH_W % 128 == 0, "tiles");
static_assert(SEQ % 256 == 0 && CTXL % 256 == 0, "row tiles");

typedef unsigned short u16;
typedef __attribute__((ext_vector_type(8))) short bf16x8;
typedef __attribute__((ext_vector_type(16))) float f32x16;
typedef __attribute__((ext_vector_type(4))) unsigned u32x4;
typedef __attribute__((ext_vector_type(2))) unsigned u32x2;
typedef __attribute__((ext_vector_type(4))) float f32x4;
struct cf { float x, y; };

struct Params {
  const float *x, *c, *ctx, *c_ctx, *w_ada, *b_ada, *w_in, *conv_a, *hy_sconv_w, *hy_sconv_b;
  const float *hf_w1, *hf_b1, *hf_w2, *hf_b2, *hf_w3, *hf_b3, *hf_wout, *hf_freq, *hf_skip;
  const float *rw_mu, *rw_w0, *rw_w_up, *rw_a0, *rw_a_up, *rw_g_up, *rw_k_k, *rw_k_a, *rw_r_k;
  const float *rw_lnx_g, *rw_lnx_b, *mix_norm_g, *w_out, *ln_g, *ln_b, *w_router, *e_bias;
  const float *w_e_gate, *w_e_up, *w_e_down, *w_s_gate, *w_s_up, *w_s_down;
  float* out;
  float* mod;
  float* h3lat;
  float* h3ctx;
  cf* tw;
  int* cnt;
  float* sbonus;
  cf* spec;
  u16* HL;
  u16* PA;
  u16* PH;
  u16* PR;
  u16* SIsh_lat;
  u16* SIsh_ctx;
  u16* SIdir_lat;
  u16* SIdir_ctx;
  u16* ya;
  u16* yhlat;
  u16* yhctx;
  u16* gbuf;
  u16* ybuf;
  u16* ycat;
  float* XC;
  u16* wt_in;
  u16* wt_out;
  u16* wt_rhi;
  u16* wt_rlo;
  u16* wt_wup;
  u16* wt_aup;
  u16* wt_gup;
  u16* Hbuf;
  u16* SHo;
  u16* wt_exp;
  int* acc;
  int* etok;
  float* egate;
  long long* tstamp;
  unsigned* bar;
};


#ifndef PROF_SEG
#define PROF_SEG 0
#endif
#if PROF_SEG && !defined(EMU)
#define SEG_BEGIN(p) long long seg_last_ = 0; const bool seg_on_ = (blockIdx.x == 0 && threadIdx.x == 0); if (seg_on_) seg_last_ = (long long)__builtin_amdgcn_s_memrealtime();
#define SEG_MARK(p, k) if (seg_on_) { long long now_ = (long long)__builtin_amdgcn_s_memrealtime(); (p).tstamp[32 + (k)] += now_ - seg_last_; seg_last_ = now_; }
#else
#define SEG_BEGIN(p)
#define SEG_MARK(p, k)
#endif
#ifdef EMU
DI int TIDX() { return threadIdx.x; }
DI int BIDX() { return blockIdx.x; }
#else
DI int TIDX() { int t = threadIdx.x; asm volatile("" : "+v"(t)); return t; }
DI int BIDX() { int b = blockIdx.x; asm volatile("" : "+s"(b)); return b; }
#endif

#ifdef EMU
DI u16 f2bf(float x) {
  unsigned u = __builtin_bit_cast(unsigned, x);
  u += 0x7fffu + ((u >> 16) & 1u);
  return (u16)(u >> 16);
}
#else
DI u16 f2bf(float x) { return __builtin_bit_cast(u16, (__bf16)x); }
#endif
DI float bf2f(u16 h) { return __builtin_bit_cast(float, ((unsigned)h) << 16); }
DI u16 f2h(float x) { return __builtin_bit_cast(u16, (_Float16)x); }
DI float h2f(u16 h) { return (float)__builtin_bit_cast(_Float16, h); }
#ifdef EMU
DI unsigned pk2(float a, float b) { return (unsigned)f2bf(a) | ((unsigned)f2bf(b) << 16); }
#else
DI unsigned pk2(float a, float b) {
  typedef __bf16 bf16v2 __attribute__((ext_vector_type(2)));
  bf16v2 v; v[0] = (__bf16)a; v[1] = (__bf16)b;
  return __builtin_bit_cast(unsigned, v);
}
#endif
DI float sigmoidf_(float x) { return 1.0f / (1.0f + expf(-x)); }
DI float siluf_(float x) { return x / (1.0f + expf(-x)); }
DI float softplusf_(float x) { return x > 20.f ? x : log1pf(expf(x)); }
#ifdef EMU
DI float fexp_(float x) { return expf(x); }
DI float frcp_(float x) { return 1.0f / x; }
#else
DI float fexp_(float x) { return __builtin_amdgcn_exp2f(x * 1.44269504088896341f); }
DI float frcp_(float x) { return __builtin_amdgcn_rcpf(x); }
#endif
DI float fsigmoid_(float x) { return frcp_(1.0f + fexp_(-x)); }
DI float ftanh_(float x) { return 1.0f - 2.0f * frcp_(1.0f + fexp_(2.0f * x)); }

#ifdef EMU
DI float red16(float v) { v += __shfl_xor(v, 1); v += __shfl_xor(v, 2); v += __shfl_xor(v, 4); v += __shfl_xor(v, 8); return v; }
DI float wave_sum(float v) {
#pragma unroll
  for (int m = 1; m < 64; m <<= 1) v += __shfl_xor(v, m);
  return v;
}
#else
template <int CTRL> DI float dppf(float v) {
  return __builtin_bit_cast(float, __builtin_amdgcn_update_dpp(0, __builtin_bit_cast(int, v), CTRL, 0xf, 0xf, true));
}
DI float red16(float v) {
  v += dppf<0xB1>(v);
  v += dppf<0x4E>(v);
  v += dppf<0x141>(v);
  v += dppf<0x140>(v);
  return v;
}
DI float wave_sum(float v) {
  v = red16(v);
  int iv = __builtin_bit_cast(int, v);
  float a = __builtin_bit_cast(float, __builtin_amdgcn_readlane(iv, 0));
  float b = __builtin_bit_cast(float, __builtin_amdgcn_readlane(iv, 16));
  float c = __builtin_bit_cast(float, __builtin_amdgcn_readlane(iv, 32));
  float d = __builtin_bit_cast(float, __builtin_amdgcn_readlane(iv, 48));
  return (a + b) + (c + d);
}
#endif
#ifdef EMU
DI float wave_max(float v) {
#pragma unroll
  for (int m = 1; m < 64; m <<= 1) v = fmaxf(v, __shfl_xor(v, m));
  return v;
}
#else
DI float wave_max(float v) {
  v = fmaxf(v, dppf<0xB1>(v));
  v = fmaxf(v, dppf<0x4E>(v));
  v = fmaxf(v, dppf<0x141>(v));
  v = fmaxf(v, dppf<0x140>(v));
  int iv = __builtin_bit_cast(int, v);
  float a = __builtin_bit_cast(float, __builtin_amdgcn_readlane(iv, 0));
  float b = __builtin_bit_cast(float, __builtin_amdgcn_readlane(iv, 16));
  float c = __builtin_bit_cast(float, __builtin_amdgcn_readlane(iv, 32));
  float d = __builtin_bit_cast(float, __builtin_amdgcn_readlane(iv, 48));
  return fmaxf(fmaxf(a, b), fmaxf(c, d));
}
#endif
DI void wave_sync() {
#ifdef EMU
  emu::wave_barrier();
#else
  asm volatile("s_waitcnt lgkmcnt(0)" ::: "memory");
  __builtin_amdgcn_wave_barrier();
#endif
}
DI f32x4 ld_bf4(const u16* q) {
  u32x2 v = *(const u32x2*)q;
  f32x4 r;
  r[0] = bf2f((u16)(v[0] & 0xffff)); r[1] = bf2f((u16)(v[0] >> 16));
  r[2] = bf2f((u16)(v[1] & 0xffff)); r[3] = bf2f((u16)(v[1] >> 16));
  return r;
}
DI void st_bf4(u16* q, f32x4 v) {
  u32x2 o; o[0] = pk2(v[0], v[1]); o[1] = pk2(v[2], v[3]);
  *(u32x2*)q = o;
}
DI int crow(int reg, int h) { return (reg & 3) + 8 * (reg >> 2) + 4 * h; }
#define MFMA32(a, b, c) __builtin_amdgcn_mfma_f32_32x32x16_bf16((a), (b), (c), 0, 0, 0)

DI int modrow(int r) { return r < TL ? r / SEQ : NB; }
DI const float* modp(const Params& p, int l, int r) { return p.mod + ((size_t)l * (NB + 1) + modrow(r)) * (6 * D); }


#define XB_TMO      128
#define XB_TICKET   192
#define XB_XCNT(j)  (256  + 64 * (j))
#define XB_XSUB(j)  (1280 + 64 * (j))
#define XB_XGEN(j)  (2304 + 64 * (j))
#define XB_TOP      3328
#define XB_TOPGEN   3392
#define XCD_BAR_WORDS 3456
#ifndef EMU
#define XB_SPIN_CAP (1u << 22)
#define LAS __attribute__((address_space(3)))
DI unsigned xb_ld(unsigned* p) { return __hip_atomic_load(p, __ATOMIC_RELAXED, __HIP_MEMORY_SCOPE_AGENT); }
DI unsigned xb_add(unsigned* p, unsigned v) { return __hip_atomic_fetch_add(p, v, __ATOMIC_RELAXED, __HIP_MEMORY_SCOPE_AGENT); }
DI unsigned xb_xcc_id() { return (unsigned)__builtin_amdgcn_s_getreg((3 << 11) | 20) & 0xFu; }
#define XB_SPIN(cond, bar) do { unsigned _sp = 0; while (cond) { __builtin_amdgcn_s_sleep(1); \
    if ((++_sp & 255u) == 0u) { if (xb_ld(&(bar)[XB_TMO])) break; if (_sp > XB_SPIN_CAP) { atomicAdd(&(bar)[XB_TMO], 1u); break; } } } } while (0)
struct XcdBarrier { unsigned* bar; unsigned x; volatile LAS unsigned* st; };
DI XcdBarrier xcd_barrier_post(unsigned* bar, volatile LAS unsigned* st) {
  XcdBarrier b; b.bar = bar; b.x = xb_xcc_id(); b.st = st;
  if (threadIdx.x == 0) (void)xb_add(&bar[XB_XCNT(b.x)], 1u);
  return b;
}
DI void xcd_barrier_complete(unsigned* bar, unsigned x, unsigned& nloc, unsigned& nx) {
  const unsigned G = gridDim.x * gridDim.y * gridDim.z;
  unsigned sum, cnt, mine, sp = 0u;
  for (;;) {
    sum = 0u; cnt = 0u; mine = 0u;
#pragma unroll
    for (unsigned j = 0; j < 16; ++j) { const unsigned c = xb_ld(&bar[XB_XCNT(j)]); sum += c; cnt += (c > 0u) ? 1u : 0u; mine = (j == x) ? c : mine; }
    if (sum == G) break;
    __builtin_amdgcn_s_sleep(1);
    if ((++sp & 255u) == 0u) { if (xb_ld(&bar[XB_TMO])) break; if (sp > XB_SPIN_CAP) { atomicAdd(&bar[XB_TMO], 1u); break; } }
  }
  nloc = mine > 0u ? mine : 1u; nx = cnt > 0u ? cnt : 1u;
}
DI void xcd_barrier(const XcdBarrier& b) {
  asm volatile("s_waitcnt vmcnt(0)" ::: "memory");
  __syncthreads();
  if (threadIdx.x == 0) {
    unsigned* bar = b.bar;
    __builtin_amdgcn_s_waitcnt(0);
    unsigned nloc = b.st[0], nx = b.st[1];
    if (nloc == 0u) { xcd_barrier_complete(bar, b.x, nloc, nx); b.st[0] = nloc; b.st[1] = nx; }
    const unsigned old = xb_add(&bar[XB_XSUB(b.x)], 1u);
    const unsigned gen = old / nloc;
    if (old + 1u == (gen + 1u) * nloc) {
      __builtin_amdgcn_fence(__ATOMIC_RELEASE, "agent");
      asm volatile("s_waitcnt vmcnt(0)" ::: "memory");
      const unsigned og = xb_add(&bar[XB_TOP], 1u);
      const unsigned tg = og / nx;
      if (og + 1u == (tg + 1u) * nx) xb_add(&bar[XB_TOPGEN], 1u);
      else XB_SPIN(xb_ld(&bar[XB_TOPGEN]) == tg, bar);
      __builtin_amdgcn_fence(__ATOMIC_ACQUIRE, "agent");
      xb_add(&bar[XB_XGEN(b.x)], 1u);
      asm volatile("s_waitcnt vmcnt(0)" ::: "memory");
    } else {
      XB_SPIN(xb_ld(&bar[XB_XGEN(b.x)]) == gen, bar);
      __builtin_amdgcn_fence(__ATOMIC_ACQUIRE, "agent");
      asm volatile("s_waitcnt vmcnt(0)" ::: "memory");
    }
  }
  __syncthreads();
}
#endif

namespace pg8 {
constexpr int BM = 256, BK = 64, HALF = 128, HTB = HALF * BK * 2, STAGE_BYTES = 8 * HTB;
struct Unit { int pm, pn, e, cnt, idx; };
__host__ __device__ __forceinline__ int lds_byte(int r, int c) { const int st = (r >> 4) * 2 + (c >> 5), rr = r & 15, cc = c & 31, ob = rr * 64 + cc * 2; return st * 1024 + (ob ^ (((ob >> 9) & 1) << 5)); }
__host__ __device__ __forceinline__ void stage_rc(int b, int& R, int& C) { const int st = b / 1024, sb = b % 1024, swz = sb ^ (((sb >> 9) & 1) << 5); R = (st >> 1) * 16 + swz / 64; C = (st & 1) * 32 + (swz % 64) / 2; }

#ifdef EMU
template <class Epi, class Sched>
inline void gemm_phase(char* lds, int K, const Sched& S, const Epi& E) {
  (void)lds;
  const int tid = TIDX(), wid = tid >> 6, lane = tid & 63, wr = wid >> 2, wc = wid & 3, fr = lane & 15, fq = lane >> 4;
  Unit u;
  for (int ui = 0; S.next(ui, u); ++ui) {
    f32x4 acc[2][2][4][2];
    for (int ai = 0; ai < 2; ++ai) for (int bj = 0; bj < 2; ++bj) for (int m = 0; m < 4; ++m) for (int n = 0; n < 2; ++n) {
      const int r = 128 * ai + 64 * wr + 16 * m + fr;
      const u16* arow = (const u16*)(S.abase() + S.arow_off(u, r));
      for (int j = 0; j < 4; ++j) {
        const int c = 32 * wc + 16 * n + 4 * fq + j;
        const u16* brow = (const u16*)S.bbase(u, bj) + (size_t)c * K;
        float s = 0.f;
        for (int k = 0; k < K; ++k) s += bf2f(arow[k]) * bf2f(brow[k]);
        acc[ai][bj][m][n][j] = s;
      }
    }
    E(acc, u, wr, wc, fr, fq, E.prefetch(u, wr, lane));
  }
}
#else
#define PG8_LAS __attribute__((address_space(3)))
template <class Epi, class Sched>
__device__ __forceinline__ void gemm_phase(char* lds_generic, int K, const Sched& S, const Epi& E) {
  PG8_LAS unsigned char* lds = (PG8_LAS unsigned char*)lds_generic;
  const int tid = TIDX(), wid = __builtin_amdgcn_readfirstlane(tid >> 6), lane = tid & 63, wr = wid >> 2, wc = wid & 3, fr = lane & 15, fq = lane >> 4;
  const int nt = K / BK;
  int Rr[2], Cc[2];
  unsigned voffB[2];
#pragma unroll
  for (int i = 0; i < 2; ++i) { stage_rc(tid * 16 + i * 8192, Rr[i], Cc[i]); voffB[i] = (unsigned)(Rr[i] * K + Cc[i]) * 2u; }
  const size_t kstep = (size_t)(BK * 2);
  const unsigned ldsw = (unsigned)wid * 1024u;
  const int aoff = lds_byte(wr * 64 + fr, fq * 8), boff = lds_byte(wc * 32 + fr, fq * 8);
#define PG8_SA(b, h) (((b) * 2 + (h)) * HTB)
#define PG8_SB(b, h) ((4 + (b) * 2 + (h)) * HTB)
#define PG8_STAGE2(bufoff, gbase, v0, v1) do { \
    __builtin_amdgcn_global_load_lds((const unsigned*)((const char*)(gbase) + (v0)), (PG8_LAS unsigned*)(lds + (bufoff) + ldsw), 16, 0, 0); \
    __builtin_amdgcn_global_load_lds((const unsigned*)((const char*)(gbase) + (v1)), (PG8_LAS unsigned*)(lds + (bufoff) + ldsw + 8192), 16, 0, 0); } while (0)
#define PG8_STAGEB(bufoff, gbase) PG8_STAGE2(bufoff, gbase, voffB[0], voffB[1])
#define PG8_LDA(dst, b, h) do { _Pragma("unroll") for (int m = 0; m < 4; ++m) _Pragma("unroll") for (int k = 0; k < 2; ++k) dst[m][k] = *(const PG8_LAS bf16x8*)(lds + PG8_SA(b, h) + aoff + m * 2048 + k * 1024); } while (0)
#define PG8_LDB(dst, b, h) do { _Pragma("unroll") for (int n = 0; n < 2; ++n) _Pragma("unroll") for (int k = 0; k < 2; ++k) dst[n][k] = *(const PG8_LAS bf16x8*)(lds + PG8_SB(b, h) + boff + n * 2048 + k * 1024); } while (0)
#define PG8_MMA(ai, bj, At, Bt) do { __builtin_amdgcn_s_setprio(1); _Pragma("unroll") for (int m = 0; m < 4; ++m) _Pragma("unroll") for (int n = 0; n < 2; ++n) _Pragma("unroll") for (int k = 0; k < 2; ++k) \
    acc[ai][bj][m][n] = __builtin_amdgcn_mfma_f32_16x16x32_bf16(Bt[n][k], At[m][k], acc[ai][bj][m][n], 0, 0, 0); __builtin_amdgcn_s_setprio(0); } while (0)
#define PG8_WAIT_V(n) asm volatile("s_waitcnt vmcnt(" #n ")" ::: "memory")
#define PG8_WAIT_L(n) asm volatile("s_waitcnt lgkmcnt(" #n ")" ::: "memory")
#define PG8_BAR __builtin_amdgcn_s_barrier()
#define PG8_SCHED __builtin_amdgcn_sched_barrier(0)
  Unit cur, nxt; int ui = 0;
  if (!S.next(0, cur)) return;
  f32x4 acc[2][2][4][2];
#pragma unroll
  for (int a = 0; a < 2; ++a)
#pragma unroll
    for (int b = 0; b < 2; ++b)
#pragma unroll
      for (int m = 0; m < 4; ++m)
#pragma unroll
        for (int n = 0; n < 2; ++n) acc[a][b][m][n] = (f32x4){0.f, 0.f, 0.f, 0.f};
  bf16x8 At[4][2], B0[2][2], B1[2][2];
  const char* const gA = S.abase();
  unsigned cv00 = 0, cv01 = 0, cv10 = 0, cv11 = 0, nv00 = 0, nv01 = 0, nv10 = 0, nv11 = 0;
  const char *cA0 = gA, *cA1 = gA, *nA0 = gA, *nA1 = gA;
  if constexpr (Sched::GATHER) {
    cv00 = S.arow_off(cur, Rr[0]) + Cc[0] * 2u; cv01 = S.arow_off(cur, Rr[1]) + Cc[1] * 2u;
    cv10 = S.arow_off(cur, 128 + Rr[0]) + Cc[0] * 2u; cv11 = S.arow_off(cur, 128 + Rr[1]) + Cc[1] * 2u;
  } else {
    cA0 = gA + S.arow_off(cur, 0); cA1 = gA + S.arow_off(cur, 128);
  }
#define PG8_STAGE_A(bufoff, kb, h, NEXT) do { \
    if constexpr (Sched::GATHER) { PG8_STAGE2(bufoff, gA + (kb), (NEXT) ? ((h) ? nv10 : nv00) : ((h) ? cv10 : cv00), (NEXT) ? ((h) ? nv11 : nv01) : ((h) ? cv11 : cv01)); } \
    else { PG8_STAGE2(bufoff, ((NEXT) ? ((h) ? nA1 : nA0) : ((h) ? cA1 : cA0)) + (kb), voffB[0], voffB[1]); } } while (0)
  const char* cB0 = S.bbase(cur, 0); const char* cB1 = S.bbase(cur, 1);
  PG8_STAGEB(PG8_SB(0, 0), cB0); PG8_STAGE_A(PG8_SA(0, 0), 0, 0, false); PG8_STAGEB(PG8_SB(0, 1), cB1); PG8_STAGE_A(PG8_SA(0, 1), 0, 1, false);
  if (wr == 1) PG8_BAR;
  PG8_WAIT_V(4); PG8_BAR;
  PG8_STAGEB(PG8_SB(1, 0), cB0 + kstep); PG8_STAGE_A(PG8_SA(1, 0), kstep, 0, false); PG8_STAGEB(PG8_SB(1, 1), cB1 + kstep);
  PG8_WAIT_V(6); PG8_BAR;
  for (;;) {
    const bool has_next = S.next(ui + 1, nxt);
    const char* nB0 = cB0; const char* nB1 = cB1;
    if constexpr (Sched::GATHER) { nv00 = cv00; nv01 = cv01; nv10 = cv10; nv11 = cv11; } else { nA0 = cA0; nA1 = cA1; }
    if (has_next) {
      if constexpr (Sched::GATHER) {
        nv00 = S.arow_off(nxt, Rr[0]) + Cc[0] * 2u; nv01 = S.arow_off(nxt, Rr[1]) + Cc[1] * 2u;
        nv10 = S.arow_off(nxt, 128 + Rr[0]) + Cc[0] * 2u; nv11 = S.arow_off(nxt, 128 + Rr[1]) + Cc[1] * 2u;
      } else {
        nA0 = gA + S.arow_off(nxt, 0); nA1 = gA + S.arow_off(nxt, 128);
      }
      nB0 = S.bbase(nxt, 0); nB1 = S.bbase(nxt, 1);
    }
    const typename Epi::Pre epre = E.prefetch(cur, wr, lane);
#pragma clang loop unroll(disable)
    for (int t = 0; t < nt; t += 2) {
      const bool last = (t == nt - 2);
      const size_t kb1 = (size_t)(t + 1) * kstep;
      const size_t kb2 = last ? (size_t)0 : (size_t)(t + 2) * kstep;
      const size_t kb3 = kb2 + kstep;
      const char* b20 = last ? nB0 : cB0 + (size_t)(t + 2) * kstep;
      const char* b21 = last ? nB1 : cB1 + (size_t)(t + 2) * kstep;
      const char* b30 = b20 + kstep; const char* b31 = b21 + kstep;
      PG8_LDB(B0, 0, 0); PG8_SCHED; PG8_LDA(At, 0, 0); PG8_STAGE_A(PG8_SA(1, 1), kb1, 1, false);
      PG8_WAIT_L(8); PG8_BAR; PG8_WAIT_L(0); PG8_MMA(0, 0, At, B0); PG8_BAR; PG8_SCHED;
      PG8_LDB(B1, 0, 1); PG8_STAGEB(PG8_SB(0, 0), b20);
      PG8_BAR; PG8_WAIT_L(0); PG8_MMA(0, 1, At, B1); PG8_BAR;
      PG8_LDA(At, 0, 1); PG8_STAGE_A(PG8_SA(0, 0), kb2, 0, last);
      PG8_BAR; PG8_WAIT_L(0); PG8_MMA(1, 0, At, B0); PG8_BAR; PG8_SCHED;
      PG8_STAGEB(PG8_SB(0, 1), b21);
      PG8_WAIT_V(6); PG8_BAR; PG8_MMA(1, 1, At, B1); PG8_BAR;
      PG8_LDB(B0, 1, 0); PG8_SCHED; PG8_LDA(At, 1, 0); PG8_STAGE_A(PG8_SA(0, 1), kb2, 1, last);
      PG8_WAIT_L(8); PG8_BAR; PG8_WAIT_L(0); PG8_MMA(0, 0, At, B0); PG8_BAR; PG8_SCHED;
      PG8_LDB(B1, 1, 1); PG8_STAGEB(PG8_SB(1, 0), b30);
      PG8_BAR; PG8_WAIT_L(0); PG8_MMA(0, 1, At, B1); PG8_BAR;
      PG8_LDA(At, 1, 1); PG8_STAGE_A(PG8_SA(1, 0), kb3, 0, last);
      PG8_BAR; PG8_WAIT_L(0); PG8_MMA(1, 0, At, B0); PG8_BAR; PG8_SCHED;
      PG8_STAGEB(PG8_SB(1, 1), b31);
      PG8_WAIT_V(6); PG8_BAR; PG8_MMA(1, 1, At, B1); PG8_BAR;
    }
    E(acc, cur, wr, wc, fr, fq, epre);
    if (!has_next) break;
#pragma unroll
    for (int a = 0; a < 2; ++a)
#pragma unroll
      for (int b = 0; b < 2; ++b)
#pragma unroll
        for (int m = 0; m < 4; ++m)
#pragma unroll
          for (int n = 0; n < 2; ++n) acc[a][b][m][n] = (f32x4){0.f, 0.f, 0.f, 0.f};
    cur = nxt; cB0 = nB0; cB1 = nB1; ++ui;
    if constexpr (Sched::GATHER) { cv00 = nv00; cv01 = nv01; cv10 = nv10; cv11 = nv11; } else { cA0 = nA0; cA1 = nA1; }
  }
  PG8_WAIT_V(0);
  if (wr == 0) PG8_BAR;
  PG8_BAR;
#undef PG8_SA
#undef PG8_SB
#undef PG8_STAGE2
#undef PG8_STAGE_A
#undef PG8_STAGEB
#undef PG8_LDA
#undef PG8_LDB
#undef PG8_MMA
#undef PG8_WAIT_V
#undef PG8_WAIT_L
#undef PG8_BAR
#undef PG8_SCHED
}
#endif
DI int remap_xcd(int L, int nwg) {
  const int q = nwg / 8, r = nwg % 8, xcd = L % 8, off = L / 8;
  return (xcd < r ? xcd * (q + 1) : r * (q + 1) + (xcd - r) * q) + off;
}
}

DI void convert_tile(const float* __restrict__ src, int K, int N, u16* __restrict__ dst, u16* __restrict__ dst_lo, int tile, char* smem) {
  const int tid = TIDX();
  float* t = (float*)smem;
  const int ntn = N / 64;
  const int k0 = (tile / ntn) * 64, n0 = (tile % ntn) * 64;
#pragma unroll
  for (int i = 0; i < 8; ++i) {
    const int row = i * 8 + (tid >> 6), col = tid & 63;
    t[row * 65 + col] = src[(size_t)(k0 + row) * N + n0 + col];
  }
  __syncthreads();
  const int n = tid >> 3, kq = tid & 7;
  float f[8];
#pragma unroll
  for (int j = 0; j < 8; ++j) f[j] = t[(kq * 8 + j) * 65 + n];
  u32x4 pb;
  pb[0] = pk2(f[0], f[1]); pb[1] = pk2(f[2], f[3]); pb[2] = pk2(f[4], f[5]); pb[3] = pk2(f[6], f[7]);
  *(u32x4*)(dst + (size_t)(n0 + n) * K + k0 + kq * 8) = pb;
  if (dst_lo) {
#pragma unroll
    for (int j = 0; j < 8; ++j) f[j] -= bf2f(f2bf(f[j]));
    pb[0] = pk2(f[0], f[1]); pb[1] = pk2(f[2], f[3]); pb[2] = pk2(f[4], f[5]); pb[3] = pk2(f[6], f[7]);
    *(u32x4*)(dst_lo + (size_t)(n0 + n) * K + k0 + kq * 8) = pb;
  }
  __syncthreads();
}
DI void convert_tile_w(const float* __restrict__ src, int K, int N, u16* __restrict__ dst, int tile, char* smem) {
  const int tid = TIDX();
  float* t = (float*)smem;
  const int ntn = N / 256;
  const int k0 = (tile / ntn) * 64, n0 = (tile % ntn) * 256;
#pragma unroll
  for (int i = 0; i < 8; ++i) {
    const int row = i * 8 + (tid >> 6), col = (tid & 63) * 4;
    const f32x4 v = *(const f32x4*)(src + (size_t)(k0 + row) * N + n0 + col);
    float* q = t + row * 257 + col;
    q[0] = v[0]; q[1] = v[1]; q[2] = v[2]; q[3] = v[3];
  }
  __syncthreads();
#pragma unroll
  for (int i = 0; i < 4; ++i) {
    const int idx = tid + NT * i;
    const int n = idx >> 3, kq = idx & 7;
    float f[8];
#pragma unroll
    for (int j = 0; j < 8; ++j) f[j] = t[(kq * 8 + j) * 257 + n];
    u32x4 pb;
    pb[0] = pk2(f[0], f[1]); pb[1] = pk2(f[2], f[3]); pb[2] = pk2(f[4], f[5]); pb[3] = pk2(f[6], f[7]);
    *(u32x4*)(dst + (size_t)(n0 + n) * K + k0 + kq * 8) = pb;
  }
  __syncthreads();
}
constexpr int CT_IN = (D / 64) * (P_IN / 64), CT_OUT = (MIX_W / 64) * (D / 64), CT_R = (D / 64) * (NE / 64);
constexpr int CT_WUP = (DRK / 64) * (RW_CH / 64), CT_GUP = (GRK / 64) * (RW_CH / 64);
constexpr int CT_STATIC_L = CT_IN + CT_OUT + CT_R + 4 * CT_WUP + CT_GUP;
DI void convert_static_item(const Params& p, int it, char* smem) {
  const int l = it / CT_STATIC_L;
  int q = it % CT_STATIC_L;
  if (q < CT_IN) { convert_tile(p.w_in + (size_t)l * D * P_IN, D, P_IN, p.wt_in + (size_t)l * P_IN_PAD * D, nullptr, q, smem); return; }
  q -= CT_IN;
  if (q < CT_OUT) { convert_tile(p.w_out + (size_t)l * MIX_W * D, MIX_W, D, p.wt_out + (size_t)l * D * MIX_W, nullptr, q, smem); return; }
  q -= CT_OUT;
  if (q < CT_R) { convert_tile(p.w_router + (size_t)l * D * NE, D, NE, p.wt_rhi + (size_t)l * NE * D, p.wt_rlo + (size_t)l * NE * D, q, smem); return; }
  q -= CT_R;
  if (q < 4 * CT_WUP) {
    const int which = q / CT_WUP, tile = q % CT_WUP;
    const int d = which & 1;
    if (which < 2) convert_tile(p.rw_w_up + ((size_t)l * 2 + d) * DRK * RW_CH, DRK, RW_CH, p.wt_wup + ((size_t)l * 2 + d) * RW_CH * DRK, nullptr, tile, smem);
    else convert_tile(p.rw_a_up + ((size_t)l * 2 + d) * IRK * RW_CH, IRK, RW_CH, p.wt_aup + ((size_t)l * 2 + d) * RW_CH * IRK, nullptr, tile, smem);
    return;
  }
  q -= 4 * CT_WUP;
  convert_tile(p.rw_g_up + (size_t)l * GRK * RW_CH, GRK, RW_CH, p.wt_gup + (size_t)l * RW_CH * GRK, nullptr, q, smem);
}
constexpr int CT_EMAT = (D / 64) * (FF / 256);
static_assert(FF % 256 == 0 && D % 256 == 0 && (D / 64) * (FF / 256) == (FF / 64) * (D / 256), "expert conversion tiling");
constexpr int CT_EXP_L = (NE + 1) * 3 * CT_EMAT;
constexpr size_t EXP_STRIDE = (size_t)3 * D * FF;
DI void convert_expert_item(const Params& p, int l, int it, char* smem) {
  const int e = it / (3 * CT_EMAT), m = (it / CT_EMAT) % 3, tile = it % CT_EMAT;
  const float *eg = p.w_e_gate, *eu = p.w_e_up, *ed = p.w_e_down, *sg = p.w_s_gate, *su = p.w_s_up, *sd = p.w_s_down;
#ifndef EMU
  asm volatile("" : "+s"(eg), "+s"(eu), "+s"(ed), "+s"(sg), "+s"(su), "+s"(sd));
#endif
  const float* src;
  if (e < NE) src = (m == 0 ? eg : m == 1 ? eu : ed) + ((size_t)l * NE + e) * D * FF;
  else src = (m == 0 ? sg : m == 1 ? su : sd) + (size_t)l * D * FF;
#ifndef EMU
  src = (const float*)(__attribute__((address_space(1))) const float*)(unsigned long long)src;
#endif
  u16* dst = p.wt_exp + (size_t)e * EXP_STRIDE + (size_t)m * D * FF;
  if (m < 2) convert_tile_w(src, D, FF, dst, tile, smem);
  else convert_tile_w(src, FF, D, dst, tile, smem);
}

DI float* x1row(const Params& p, int r) { return r < TL ? p.out + (size_t)r * D : p.XC + (size_t)(r - TL) * D; }

struct DenseSched {
  static constexpr bool GATHER = false;
  const char* A; const char* Bt; int K, nM, nN, nwg, G, c;
  DI void init(const void* A_, const void* Bt_, int K_, int M, int N, int G_, int c_) { A = (const char*)A_; Bt = (const char*)Bt_; K = K_; nM = M / 256; nN = N / 256; nwg = nM * nN; G = G_; c = c_; }
  DI bool next(int i, pg8::Unit& u) const {
    const int L = i * G + c; if (L >= nwg) return false;
    const int wgid = pg8::remap_xcd(L, nwg);
    const int nig = 8 * nN, gid = wgid / nig, fm = gid * 8, gsz = (nM - fm) < 8 ? (nM - fm) : 8;
    u.pm = fm + ((wgid % nig) % gsz); u.pn = (wgid % nig) / gsz; u.e = 0; u.cnt = 0; u.idx = i; return true;
  }
  DI const char* abase() const { return A; }
  DI unsigned arow_off(const pg8::Unit& u, int r) const { return (unsigned)(u.pm * 256 + r) * (unsigned)(K * 2); }
  DI const char* bbase(const pg8::Unit& u, int half) const { return Bt + (size_t)(u.pn * 256 + half * 128) * K * 2; }
};
struct ExpertSched {
  const int* pre;
  const int* cntl;
  const unsigned char* t2e;
  int nN, G, c, total;
  DI bool locate(int i, pg8::Unit& u) const {
    const int L = i * G + c; if (L >= total) return false;
    const int w = pg8::remap_xcd(L, total);
    const int tile = w / nN; u.pn = w % nN;
    const int e = (int)t2e[tile];
    u.e = e; u.pm = tile - pre[e]; u.cnt = cntl[e]; u.idx = i;
    return true;
  }
};
struct E1Sched : ExpertSched {
  static constexpr bool GATHER = true;
  const char* A; const char* W; const int* etok;
  const unsigned* loff; int nl;
  DI bool next(int i, pg8::Unit& u) const { return locate(i, u); }
  DI const char* abase() const { return A; }
  DI unsigned goff(const pg8::Unit& u, int r) const {
    const int slot = u.pm * 256 + r;
    const unsigned tl = (unsigned)etok[u.e < NE ? (size_t)u.e * T + slot : (size_t)slot];
    const unsigned tok = u.e < NE ? (tl < (unsigned)T ? tl : 0u) : (unsigned)slot;
    return tok * (unsigned)(D * 2);
  }
  DI unsigned arow_off(const pg8::Unit& u, int r) const { return u.idx < nl ? loff[u.idx * 256 + r] : goff(u, r); }
  DI void preload(unsigned* lds_off, int maxu) {
    loff = lds_off; nl = 0;
    const int tid = TIDX();
    pg8::Unit u;
    int n = 0;
    while (n < maxu && locate(n, u)) ++n;
    for (int i = tid; i < n * 256; i += NT) { locate(i >> 8, u); lds_off[i] = goff(u, i & 255); }
    __syncthreads();
    nl = n;
  }
  DI const char* bbase(const pg8::Unit& u, int half) const { return W + ((size_t)u.e * EXP_STRIDE + (size_t)half * D * FF + (size_t)u.pn * 128 * D) * 2; }
};
struct E2Sched : ExpertSched {
  static constexpr bool GATHER = false;
  const char* A; const char* W; const int* hoff;
  DI bool next(int i, pg8::Unit& u) const { return locate(i, u); }
  DI const char* abase() const { return A; }
  DI unsigned arow_off(const pg8::Unit& u, int r) const { return (unsigned)(hoff[u.e] + u.pm * 256 + r) * (unsigned)(FF * 2); }
  DI const char* bbase(const pg8::Unit& u, int half) const { return W + ((size_t)u.e * EXP_STRIDE + (size_t)2 * D * FF + (size_t)(u.pn * 256 + half * 128) * FF) * 2; }
};

struct EpiInproj {
  u16 *PA, *PH, *PR;
  struct Pre {};
  DI Pre prefetch(const pg8::Unit&, int, int) const { return Pre{}; }
  DI void operator()(const f32x4 (&acc)[2][2][4][2], const pg8::Unit& u, int wr, int wc, int fr, int fq, const Pre&) const {
    const int row0 = u.pm * 256 + wr * 64 + fr;
#pragma unroll
    for (int bj = 0; bj < 2; ++bj) {
      const int colh = u.pn * 256 + bj * 128;
      if (colh >= P_IN) continue;
      if (colh >= PA_W && colh < PA_W + PH_W) {
        const int c0 = colh - PA_W + wc * 32 + 4 * fq;
        const int rb = u.pm * 256;
        u16* base; int L, t0;
        if (rb < TL) { L = SEQ; base = PH + (size_t)(rb / SEQ) * PH_W * SEQ; t0 = rb % SEQ; }
        else { L = CTXL; base = PH + (size_t)NB * PH_W * SEQ + (size_t)((rb - TL) / CTXL) * PH_W * CTXL; t0 = (rb - TL) % CTXL; }
#pragma unroll
        for (int ai = 0; ai < 2; ++ai)
#pragma unroll
          for (int m = 0; m < 4; ++m) {
            const int t = t0 + wr * 64 + fr + ai * 128 + m * 16;
#pragma unroll
            for (int n = 0; n < 2; ++n) {
              const f32x4 v = acc[ai][bj][m][n];
#pragma unroll
              for (int j = 0; j < 4; ++j) base[(size_t)(c0 + n * 16 + j) * L + t] = f2bf(v[j]);
            }
          }
        continue;
      }
      u16* base; int ld, c0;
      if (colh < PA_W) { base = PA; ld = PA_W; c0 = colh; }
      else { base = PR; ld = RW_COLS; c0 = colh - PA_W - PH_W; }
      const int col0 = c0 + wc * 32 + 4 * fq;
#pragma unroll
      for (int ai = 0; ai < 2; ++ai)
#pragma unroll
        for (int m = 0; m < 4; ++m) {
          u16* rowp = base + (size_t)(row0 + ai * 128 + m * 16) * ld + col0;
#pragma unroll
          for (int n = 0; n < 2; ++n) {
            const f32x4 v = acc[ai][bj][m][n];
            u32x2 o; o[0] = pk2(v[0], v[1]); o[1] = pk2(v[2], v[3]);
            *(u32x2*)(rowp + n * 16) = o;
          }
        }
    }
  }
};
struct EpiOutproj {
  const Params* p; int l;
  struct Pre {};
  DI Pre prefetch(const pg8::Unit&, int, int) const { return Pre{}; }
  DI void operator()(const f32x4 (&acc)[2][2][4][2], const pg8::Unit& u, int wr, int wc, int fr, int fq, const Pre&) const {
    const int row0 = u.pm * 256 + wr * 64 + fr, col0 = u.pn * 256 + wc * 32 + 4 * fq;
#pragma unroll
    for (int ai = 0; ai < 2; ++ai)
#pragma unroll
      for (int m = 0; m < 4; ++m) {
        const int r = row0 + ai * 128 + m * 16;
        const float* md = modp(*p, l, r) + 2 * D;
        float* xr = x1row(*p, r);
        const float* xin = (l == 0) ? (r < TL ? p->x + (size_t)r * D : p->ctx + (size_t)(r - TL) * D) : xr;
#pragma unroll
        for (int bj = 0; bj < 2; ++bj)
#pragma unroll
          for (int n = 0; n < 2; ++n) {
            const int c = col0 + bj * 128 + n * 16;
            const f32x4 g1 = *(const f32x4*)(md + c), xv = *(const f32x4*)(xin + c), a = acc[ai][bj][m][n];
            f32x4 o;
#pragma unroll
            for (int j = 0; j < 4; ++j) o[j] = DN_ALPHA * xv[j] + g1[j] * a[j];
            *(f32x4*)(xr + c) = o;
          }
      }
  }
};
struct EpiE1 {
  u16* H; const int* hoff;
  struct Pre {};
  DI Pre prefetch(const pg8::Unit&, int, int) const { return Pre{}; }
  DI void operator()(const f32x4 (&acc)[2][2][4][2], const pg8::Unit& u, int wr, int wc, int fr, int fq, const Pre&) const {
    const int row0 = hoff[u.e] + u.pm * 256 + wr * 64 + fr, col0 = u.pn * 128 + wc * 32 + 4 * fq;
#pragma unroll
    for (int ai = 0; ai < 2; ++ai)
#pragma unroll
      for (int m = 0; m < 4; ++m) {
        u16* rowp = H + (size_t)(row0 + ai * 128 + m * 16) * FF + col0;
#pragma unroll
        for (int n = 0; n < 2; ++n) {
          const f32x4 g = acc[ai][0][m][n], uu = acc[ai][1][m][n];
          u32x2 o; o[0] = pk2(g[0] * fsigmoid_(g[0]) * uu[0], g[1] * fsigmoid_(g[1]) * uu[1]); o[1] = pk2(g[2] * fsigmoid_(g[2]) * uu[2], g[3] * fsigmoid_(g[3]) * uu[3]);
          *(u32x2*)(rowp + n * 16) = o;
        }
      }
  }
};
constexpr float ACC_SCALE = 1024.f;
DI unsigned long long acc_pack4(float a, float b, float c, float d) {
  const long long qa = (long long)(int)rintf(a * ACC_SCALE), qb = (long long)(int)rintf(b * ACC_SCALE);
  const long long qc = (long long)(int)rintf(c * ACC_SCALE), qd = (long long)(int)rintf(d * ACC_SCALE);
  return (unsigned long long)(qa + (qb << 16) + (qc << 32) + (qd << 48));
}
DI void acc_unpack4(unsigned lo, unsigned hi, float& a, float& b, float& c, float& d) {
  long long v = (long long)(((unsigned long long)hi << 32) | (unsigned long long)lo);
  const long long f0 = (long long)(short)(v & 0xffff); v = (v - f0) >> 16;
  const long long f1 = (long long)(short)(v & 0xffff); v = (v - f1) >> 16;
  const long long f2 = (long long)(short)(v & 0xffff); v = (v - f2) >> 16;
  const long long f3 = (long long)(short)(v & 0xffff);
  a = (float)(int)f0 * (1.f / ACC_SCALE); b = (float)(int)f1 * (1.f / ACC_SCALE);
  c = (float)(int)f2 * (1.f / ACC_SCALE); d = (float)(int)f3 * (1.f / ACC_SCALE);
}
struct EpiE2 {
  int* accb; const int* etok; const float* egate; float* xs; u16* sho;
  static constexpr int WSTRIDE = 16 * 36 + 16 + 256;
  struct Pre { int t0, t1; float g0, g1; };
  DI Pre prefetch(const pg8::Unit& u, int wr, int lane) const {
    Pre q; q.t0 = 0; q.t1 = 0; q.g0 = 1.f; q.g1 = 1.f;
    if (u.e < NE) {
      const int s0 = u.pm * 256 + wr * 64 + ((lane >> 4) & 3) * 16 + (lane & 15), s1 = s0 + 128;
      const size_t b = (size_t)u.e * T;
      const size_t i0 = b + (s0 < u.cnt ? s0 : u.pm * 256), i1 = b + (s1 < u.cnt ? s1 : u.pm * 256);
      q.t0 = etok[i0]; q.g0 = egate[i0]; q.t1 = etok[i1]; q.g1 = egate[i1];
    }
    return q;
  }
  DI void operator()(const f32x4 (&acc)[2][2][4][2], const pg8::Unit& u, int wr, int wc, int fr, int fq, const Pre& pq) const {
    if (u.e == NE) {
      const int row0 = u.pm * 256 + wr * 64 + fr, col0 = u.pn * 256 + wc * 32 + 4 * fq;
#pragma unroll
      for (int ai = 0; ai < 2; ++ai)
#pragma unroll
        for (int m = 0; m < 4; ++m) {
          const int r = row0 + ai * 128 + m * 16;
          if (r < u.cnt) {
#pragma unroll
            for (int bj = 0; bj < 2; ++bj)
#pragma unroll
              for (int n = 0; n < 2; ++n) st_bf4(sho + (size_t)r * D + col0 + bj * 128 + n * 16, acc[ai][bj][m][n]);
          }
        }
      return;
    }
    const int lane = fq * 16 + fr, wave = wr * 4 + wc;
    float* X = xs + wave * WSTRIDE;
    int* tk = (int*)(X + 16 * 36);
    int* tokw = tk + 16;
    float* gatew = (float*)(tokw + 128);
    wave_sync();
#pragma unroll
    for (int q = 0; q < 2; ++q) {
      const int lr = lane + 64 * q;
      const int slot = u.pm * 256 + (lr >> 6) * 128 + wr * 64 + ((lr >> 4) & 3) * 16 + (lr & 15);
      const bool valid = slot < u.cnt;
      const int tok = q ? pq.t1 : pq.t0; const float gt = q ? pq.g1 : pq.g0;
      tokw[lr] = valid ? tok : -1; gatew[lr] = valid ? gt : 0.f;
    }
    wave_sync();
#pragma unroll
    for (int ai = 0; ai < 2; ++ai)
#pragma unroll
      for (int m = 0; m < 4; ++m) {
        const int lrow = ai * 64 + m * 16;
        const float gt = gatew[lrow + fr];
#pragma unroll
        for (int bj = 0; bj < 2; ++bj) {
          wave_sync();
#pragma unroll
          for (int n = 0; n < 2; ++n) {
            f32x4 v = acc[ai][bj][m][n];
#pragma unroll
            for (int j = 0; j < 4; ++j) v[j] *= gt;
            *(f32x4*)(X + fr * 36 + n * 16 + fq * 4) = v;
          }
          wave_sync();
          const int cquad = (u.pn * 256 + bj * 128 + wc * 32) / 4 + (lane & 7);
#pragma unroll
          for (int i = 0; i < 2; ++i) {
            const int rr = 8 * i + (lane >> 3);
            const int t2 = tokw[lrow + rr];
            const f32x4 xv = *(const f32x4*)(X + rr * 36 + 4 * (lane & 7));
            if (t2 >= 0) atomicAdd((unsigned long long*)accb + (size_t)t2 * (D / 4) + cquad, acc_pack4(xv[0], xv[1], xv[2], xv[3]));
          }
        }
      }
  }
};

constexpr int TICKET_SLOT_OFF = SMEM_BYTES - 1024 - 64;
template <class F> DI void ticket_loop(unsigned* ctr, int n_items, char* smem, F&& body) {
  int* slot = (int*)(smem + TICKET_SLOT_OFF);
  const int tid = TIDX();
  __syncthreads();
  if (tid == 0) slot[0] = (int)atomicAdd(ctr, 1u);
  __syncthreads();
  for (int k = 0;; ++k) {
    const int it = slot[k & 1];
    if (it >= n_items) break;
    int nx = 0;
    if (tid == 0) nx = (int)atomicAdd(ctr, 1u);
    body(it);
    if (tid == 0) slot[(k + 1) & 1] = nx;
    __syncthreads();
  }
}
DI void ph_prologue(const Params& p, char* smem) {
  const int tid = TIDX();
  constexpr int NCH = 6 * D / 128;
  constexpr int ITEMS_MOD = DEPTH * NCH;
  constexpr int ITEMS_H3 = DEPTH * (SEQ / 64 + CTXL / 64);
  constexpr int ITEMS_CV = DEPTH * CT_STATIC_L;
  constexpr int ITEMS = ITEMS_MOD + ITEMS_H3 + 1;
  for (int item = BIDX(); item < ITEMS; item += gridDim.x) {
    if (item < ITEMS_MOD) {
      const int l = item / NCH, ch = item % NCH;
      float* sv = (float*)smem;
      float* red = sv + (NB + 1) * D;
      {
        constexpr int NSV = ((NB + 1) * D + NT - 1) / NT;
        float cv[NSV];
#pragma unroll
        for (int j = 0; j < NSV; ++j) {
          int i = tid + j * NT; if (i > (NB + 1) * D - 1) i = (NB + 1) * D - 1;
          const int row = i / D, e = i % D;
          const float* src = row < NB ? p.c + row * D : p.c_ctx;
          cv[j] = src[e];
        }
#pragma unroll
        for (int j = 0; j < NSV; ++j) { const int i = tid + j * NT; if (i < (NB + 1) * D) sv[i] = siluf_(cv[j]); }
      }
      __syncthreads();
      const int col = ch * 128 + (tid & 127), kg = tid >> 7;
      float a[NB + 1];
#pragma unroll
      for (int r = 0; r < NB + 1; ++r) a[r] = 0.f;
      const float* W = p.w_ada + (size_t)l * D * 6 * D;
      for (int k = kg * (D / 4); k < (kg + 1) * (D / 4); k += 16) {
        float w[16];
#pragma unroll
        for (int j = 0; j < 16; ++j) w[j] = W[(size_t)(k + j) * 6 * D + col];
#pragma unroll
        for (int j = 0; j < 16; ++j)
#pragma unroll
          for (int r = 0; r < NB + 1; ++r) a[r] += sv[r * D + k + j] * w[j];
      }
#pragma unroll
      for (int r = 0; r < NB + 1; ++r) red[(kg * (NB + 1) + r) * 128 + (tid & 127)] = a[r];
      __syncthreads();
      for (int i = tid; i < (NB + 1) * 128; i += NT) {
        int r = i / 128, cc = i % 128;
        float s = 0.f;
        for (int g = 0; g < 4; ++g) s += red[(g * (NB + 1) + r) * 128 + cc];
        int cg_ = ch * 128 + cc;
        p.mod[((size_t)l * (NB + 1) + r) * 6 * D + cg_] = s + p.b_ada[(size_t)l * 6 * D + cg_];
      }
      __syncthreads();
    } else if (item < ITEMS_MOD + ITEMS_H3) {
      int it = item - ITEMS_MOD;
      constexpr int PER_L = SEQ / 64 + CTXL / 64;
      const int l = it / PER_L;
      int q = it % PER_L;
      const bool isctx = q >= SEQ / 64;
      const int L = isctx ? CTXL : SEQ;
      const int pos0 = (isctx ? q - SEQ / 64 : q) * 64;
      float* z = (float*)smem;
      float* ha = z + 64 * 36;
      float* hb = ha + 64 * 64;
      float* w1s = hb + 64 * 64;
      float* w2s = w1s + HY_EMB * HY_HID;
      float* w3s = w2s + HY_HID * HY_HID;
      {
        constexpr int N1 = (HY_EMB * HY_HID + NT - 1) / NT, N2 = (HY_HID * HY_HID + NT - 1) / NT;
        float a1[N1], a2[N2], a3[N2];
        const float* g1 = p.hf_w1 + (size_t)l * HY_EMB * HY_HID;
        const float* g2 = p.hf_w2 + (size_t)l * HY_HID * HY_HID;
        const float* g3 = p.hf_w3 + (size_t)l * HY_HID * HY_HID;
#pragma unroll
        for (int j = 0; j < N1; ++j) { int i = tid + j * NT; if (i > HY_EMB * HY_HID - 1) i = HY_EMB * HY_HID - 1; a1[j] = g1[i]; }
#pragma unroll
        for (int j = 0; j < N2; ++j) { int i = tid + j * NT; if (i > HY_HID * HY_HID - 1) i = HY_HID * HY_HID - 1; a2[j] = g2[i]; a3[j] = g3[i]; }
#pragma unroll
        for (int j = 0; j < N1; ++j) { const int i = tid + j * NT; if (i < HY_EMB * HY_HID) w1s[i] = a1[j]; }
#pragma unroll
        for (int j = 0; j < N2; ++j) { const int i = tid + j * NT; if (i < HY_HID * HY_HID) { w2s[i] = a2[j]; w3s[i] = a3[j]; } }
      }
      for (int i = tid; i < 64 * HY_EMB; i += NT) {
        int pp = i / HY_EMB, e = i % HY_EMB;
        int pos = pos0 + pp;
        float v;
        if (e == 0) v = (float)pos / (float)(L - 1);
        else {
          int bi = (e - 1) % HY_BANDS;
          float band = 1e-4f + ((float)(HY_BANDS - 1) - 1e-4f) * (float)bi / (float)(HY_BANDS - 1);
          float ang = (2.0f * 3.14159265358979323846f / (float)L) * (float)pos * band;
          v = (e - 1) < HY_BANDS ? cosf(ang) : -sinf(ang);
        }
        z[pp * 36 + e] = v;
      }
      __syncthreads();
      const int pp = tid >> 3, sub = tid & 7;
      const float* fr = p.hf_freq + l * HY_HID;
      {
        const float* b = p.hf_b1 + l * HY_HID;
        float acc8[8];
#pragma unroll
        for (int uu = 0; uu < 8; ++uu) acc8[uu] = b[sub * 8 + uu];
        for (int e = 0; e < HY_EMB; ++e) {
          const float zv = z[pp * 36 + e];
#pragma unroll
          for (int uu = 0; uu < 8; ++uu) acc8[uu] += zv * w1s[e * HY_HID + sub * 8 + uu];
        }
#pragma unroll 1
        for (int uu = 0; uu < 8; ++uu) ha[pp * 64 + sub * 8 + uu] = sinf(fr[sub * 8 + uu] * acc8[uu]);
      }
      __syncthreads();
      {
        const float* b = p.hf_b2 + l * HY_HID;
        float acc8[8];
#pragma unroll
        for (int uu = 0; uu < 8; ++uu) acc8[uu] = b[sub * 8 + uu];
        for (int e = 0; e < HY_HID; ++e) {
          const float zv = ha[pp * 64 + e];
#pragma unroll
          for (int uu = 0; uu < 8; ++uu) acc8[uu] += zv * w2s[e * HY_HID + sub * 8 + uu];
        }
#pragma unroll 1
        for (int uu = 0; uu < 8; ++uu) hb[pp * 64 + sub * 8 + uu] = sinf(fr[sub * 8 + uu] * acc8[uu]);
      }
      __syncthreads();
      {
        const float* b = p.hf_b3 + l * HY_HID;
        float* dst = isctx ? p.h3ctx + ((size_t)l * CTXL + pos0) * 64 : p.h3lat + ((size_t)l * SEQ + pos0) * 64;
        float acc8[8];
#pragma unroll
        for (int uu = 0; uu < 8; ++uu) acc8[uu] = b[sub * 8 + uu];
        for (int e = 0; e < HY_HID; ++e) {
          const float zv = hb[pp * 64 + e];
#pragma unroll
          for (int uu = 0; uu < 8; ++uu) acc8[uu] += zv * w3s[e * HY_HID + sub * 8 + uu];
        }
#pragma unroll 1
        for (int uu = 0; uu < 8; ++uu) dst[pp * 64 + sub * 8 + uu] = sinf(fr[sub * 8 + uu] * acc8[uu]);
      }
      __syncthreads();
    } else {
      for (int k = tid; k < FFTN / 2; k += NT) {
        double ang = -2.0 * 3.14159265358979323846 * (double)k / (double)FFTN;
        cf w; w.x = (float)cos(ang); w.y = (float)sin(ang);
        p.tw[k] = w;
      }
      for (int i = tid; i < DEPTH * NE; i += NT) p.cnt[i] = 0;
    }
  }
  ticket_loop(p.bar + XB_TICKET, ITEMS_CV, smem, [&](int it) { convert_static_item(p, it, smem); });
}

DI void ph_premod(const Params& p) {
  const int tid = TIDX();
  constexpr int ITEMS = T / 8;
  constexpr int NI = 8 * D / 4 / NT;
  static_assert(NI * NT * 4 == 8 * D, "premod tiling");
  for (int item = BIDX(); item < ITEMS; item += gridDim.x) {
    f32x4 xv[NI], sc[NI], sh[NI];
#pragma unroll
    for (int k = 0; k < NI; ++k) {
      const int i = tid + k * NT;
      const int r = item * 8 + i / (D / 4), e = (i % (D / 4)) * 4;
      const float* m = modp(p, 0, r);
      const float* src = r < TL ? p.x + (size_t)r * D : p.ctx + (size_t)(r - TL) * D;
      xv[k] = *(const f32x4*)(src + e); sc[k] = *(const f32x4*)(m + D + e); sh[k] = *(const f32x4*)(m + e);
    }
#pragma unroll
    for (int k = 0; k < NI; ++k) {
      const int i = tid + k * NT;
      const int r = item * 8 + i / (D / 4), e = (i % (D / 4)) * 4;
      f32x4 o;
#pragma unroll
      for (int j = 0; j < 4; ++j) o[j] = xv[k][j] * (1.f + sc[k][j]) + sh[k][j];
      st_bf4(p.HL + (size_t)r * D + e, o);
    }
  }
}

DI int fpad(int i) { return i + (i >> 4); }
constexpr int FFT_LDS = FFTN + FFTN / 16;
__device__ static constexpr float C16[8] = {1.f, 0.92387953251128674f, 0.70710678118654752f, 0.38268343236508977f, 0.f, -0.38268343236508977f, -0.70710678118654752f, -0.92387953251128674f};
__device__ static constexpr float S16[8] = {0.f, 0.38268343236508977f, 0.70710678118654752f, 0.92387953251128674f, 1.f, 0.92387953251128674f, 0.70710678118654752f, 0.38268343236508977f};
template <int R, bool INV>
DI void fft_pass(cf* buf, const cf* tw, int m) {
  const int g = m >> (R - 1);
  constexpr int NQ = 1 << R;
  for (int w = TIDX(); w < (FFTN >> R); w += NT) {
    const int j = w % g, blk = w / g;
    const int base = blk * (g << R) + j;
    cf v[NQ];
#pragma unroll
    for (int q = 0; q < NQ; ++q) v[q] = buf[fpad(base + q * g)];
    cf bt[R];
    bt[0] = tw[j * ((FFTN / 2) / ((NQ / 2) * g))];
#pragma unroll
    for (int r = 1; r < R; ++r) { bt[r].x = bt[r - 1].x * bt[r - 1].x - bt[r - 1].y * bt[r - 1].y; bt[r].y = 2.f * bt[r - 1].x * bt[r - 1].y; }
    if (!INV) {
#pragma unroll
      for (int r = 0; r < R; ++r) {
        const int half = 1 << (R - 1 - r);
#pragma unroll
        for (int q = 0; q < NQ; ++q) {
          if ((q & half) == 0) {
            const int qq = q & (half - 1);
            const int ci = qq * (8 / half);
            cf W;
            W.x = bt[r].x * C16[ci] + bt[r].y * S16[ci];
            W.y = bt[r].y * C16[ci] - bt[r].x * S16[ci];
            cf a = v[q], b = v[q + half];
            v[q].x = a.x + b.x; v[q].y = a.y + b.y;
            float dx = a.x - b.x, dy = a.y - b.y;
            v[q + half].x = dx * W.x - dy * W.y;
            v[q + half].y = dx * W.y + dy * W.x;
          }
        }
      }
    } else {
#pragma unroll
      for (int r = R - 1; r >= 0; --r) {
        const int half = 1 << (R - 1 - r);
#pragma unroll
        for (int q = 0; q < NQ; ++q) {
          if ((q & half) == 0) {
            const int qq = q & (half - 1);
            const int ci = qq * (8 / half);
            cf W;
            W.x = bt[r].x * C16[ci] + bt[r].y * S16[ci];
            W.y = bt[r].y * C16[ci] - bt[r].x * S16[ci];
            cf a = v[q], b = v[q + half];
            float bx = b.x * W.x + b.y * W.y;
            float by = b.y * W.x - b.x * W.y;
            v[q].x = a.x + bx; v[q].y = a.y + by;
            v[q + half].x = a.x - bx; v[q + half].y = a.y - by;
          }
        }
      }
    }
#pragma unroll
    for (int q = 0; q < NQ; ++q) buf[fpad(base + q * g)] = v[q];
  }
}
constexpr int FFT_R4 = LOG2N / 4, FFT_REM = LOG2N % 4;
DI void fft_fwd_main(cf* buf, const cf* tw) {
  int m = FFTN / 2;
#pragma unroll
  for (int i = 0; i < FFT_R4; ++i) { fft_pass<4, false>(buf, tw, m); __syncthreads(); m >>= 4; }
}
DI void fft_fwd_tail(cf* buf, const cf* tw) {
  if (FFT_REM == 3) { fft_pass<3, false>(buf, tw, 4); __syncthreads(); }
  if (FFT_REM == 2) { fft_pass<2, false>(buf, tw, 2); __syncthreads(); }
  if (FFT_REM == 1) { fft_pass<1, false>(buf, tw, 1); __syncthreads(); }
}
DI void fft_fwd(cf* buf, const cf* tw) { fft_fwd_main(buf, tw); fft_fwd_tail(buf, tw); }
DI void fft_inv_tail(cf* buf, const cf* tw) {
  if (FFT_REM == 3) { fft_pass<3, true>(buf, tw, 4); __syncthreads(); }
  if (FFT_REM == 2) { fft_pass<2, true>(buf, tw, 2); __syncthreads(); }
  if (FFT_REM == 1) { fft_pass<1, true>(buf, tw, 1); __syncthreads(); }
}
DI void fft_inv_main(cf* buf, const cf* tw) {
  int m = (1 << FFT_REM) * 8;
#pragma unroll
  for (int i = 0; i < FFT_R4; ++i) { fft_pass<4, true>(buf, tw, m); __syncthreads(); m <<= 4; }
}
DI void tw_to_lds(cf* tw, const cf* __restrict__ gtw) {
  constexpr int NIT = (FFTN / 4 + NT - 1) / NT;
  f32x4 t4[NIT];
#pragma unroll
  for (int j = 0; j < NIT; ++j) { int i = TIDX() + j * NT; if (i > FFTN / 4 - 1) i = FFTN / 4 - 1; t4[j] = ((const f32x4*)gtw)[i]; }
#pragma unroll
  for (int j = 0; j < NIT; ++j) { const int i = TIDX() + j * NT; if (i < FFTN / 4) ((f32x4*)tw)[i] = t4[j]; }
}
constexpr int MID_IT = (FFTN / 2 + NT - 1) / NT;
struct MidSpec { f32x4 k[MID_IT]; };
DI MidSpec fft_mid_prefetch(const cf* __restrict__ sp) {
  MidSpec m;
#pragma unroll
  for (int j = 0; j < MID_IT; ++j) {
    int i = TIDX() + j * NT; if (i > FFTN / 2 - 1) i = FFTN / 2 - 1;
    m.k[j] = *(const f32x4*)(sp + 2 * i);
  }
  return m;
}
DI void fft_mid(cf* buf, const cf* tw, const cf* __restrict__ sp, const MidSpec& ms) {
  if (FFT_REM == 1) {
#pragma unroll
    for (int j = 0; j < MID_IT; ++j) {
      const int i = TIDX() + j * NT;
      if (i >= FFTN / 2) break;
      const cf a = buf[fpad(2 * i)], b = buf[fpad(2 * i + 1)];
      cf A, B;
      A.x = a.x + b.x; A.y = a.y + b.y; B.x = a.x - b.x; B.y = a.y - b.y;
      const f32x4 k = ms.k[j];
      cf P, Q;
      P.x = A.x * k[0] - A.y * k[1]; P.y = A.x * k[1] + A.y * k[0];
      Q.x = B.x * k[2] - B.y * k[3]; Q.y = B.x * k[3] + B.y * k[2];
      cf o0, o1;
      o0.x = P.x + Q.x; o0.y = P.y + Q.y; o1.x = P.x - Q.x; o1.y = P.y - Q.y;
      buf[fpad(2 * i)] = o0; buf[fpad(2 * i + 1)] = o1;
    }
    __syncthreads();
  } else {
    fft_fwd_tail(buf, tw);
    for (int i = TIDX(); i < FFTN; i += NT) {
      cf a = buf[fpad(i)], k = sp[i], r;
      r.x = a.x * k.x - a.y * k.y; r.y = a.x * k.y + a.y * k.x;
      buf[fpad(i)] = r;
    }
    __syncthreads();
    fft_inv_tail(buf, tw);
  }
}

DI float hy_delta(int c) {
  const float lo = -4.605170185988091f / 1.5f, hi = -4.605170185988091f / 0.3f;
  return fabsf(lo + (hi - lo) * (float)c / (float)(HY_CH - 1));
}

DI void hy_spectrum_item(const Params& p, int l, int o, int c, char* smem) {
  const int tid = TIDX();
  cf* buf = (cf*)smem;
  cf* tw = buf + FFT_LDS;
  float* wc = (float*)(tw + FFTN / 2);
  tw_to_lds(tw, p.tw);
  if (tid < 128) {
    int dir = tid >> 6, u = tid & 63;
    wc[tid] = p.hf_wout[((size_t)l * HY_HID + u) * (4 * HY_CH) + o * 2 * HY_CH + dir * HY_CH + c];
  }
  __syncthreads();
  const float dl = hy_delta(c);
  {
    const int q = tid & 15, rr = tid >> 4;
    constexpr int RPP = NT / 16;
    constexpr int UNR = (SEQ / RPP) % 8 == 0 ? 8 : 1;
    const f32x4 wf = *(const f32x4*)(wc + 4 * q), wb = *(const f32x4*)(wc + 64 + 4 * q);
    const float* hbase = p.h3lat + (size_t)l * SEQ * 64 + 4 * q;
    for (int t0 = 0; t0 < SEQ; t0 += RPP * UNR) {
      f32x4 hv[UNR];
#pragma unroll
      for (int j = 0; j < UNR; ++j) hv[j] = *(const f32x4*)(hbase + (size_t)(t0 + j * RPP + rr) * 64);
#pragma unroll
      for (int j = 0; j < UNR; ++j) {
        const int t = t0 + j * RPP + rr;
        float sf = (hv[j][0] * wf[0] + hv[j][1] * wf[1]) + (hv[j][2] * wf[2] + hv[j][3] * wf[3]);
        float sb = (hv[j][0] * wb[0] + hv[j][1] * wb[1]) + (hv[j][2] * wb[2] + hv[j][3] * wb[3]);
        sf = red16(sf); sb = red16(sb);
        if (q == 0) {
          const float dec = expf(-((float)t / (float)(SEQ - 1)) * dl);
          cf a; a.x = sf * dec; a.y = 0.f;
          buf[fpad(t)] = a;
          if (t >= 1) { cf b; b.x = sb * dec; b.y = 0.f; buf[fpad(FFTN - t)] = b; }
          if (t == 0) { cf zz; zz.x = 0.f; zz.y = 0.f; buf[fpad(SEQ)] = zz; }
        }
      }
    }
  }
  __syncthreads();
  fft_fwd(buf, tw);
  cf* dst = p.spec + ((size_t)o * HY_CH + c) * FFTN;
  const float sc = 1.0f / (float)FFTN;
  for (int i = tid; i < FFTN; i += NT) { cf v = buf[fpad(i)]; v.x *= sc; v.y *= sc; dst[i] = v; }
  __syncthreads();
}

DI void ph_inproj(const Params& p, int l, char* smem) {
  constexpr int SPEC_ITEMS = 2 * HY_CH;
  const int G = gridDim.x, c = BIDX();
  {
    DenseSched S; S.init(p.HL, p.wt_in + (size_t)l * P_IN_PAD * D, D, T, P_IN_PAD, G, c);
    EpiInproj E{p.PA, p.PH, p.PR};
    pg8::gemm_phase(smem, D, S, E);
  }
  __syncthreads();
  (void)c;
  ticket_loop(p.bar + XB_TICKET + 1 + l, SPEC_ITEMS, smem, [&](int it) { hy_spectrum_item(p, l, it / HY_CH, it % HY_CH, smem); });
}

DI float hy_u(const u16* P, int t, int L, float w0, float w1, float w2, float bias) {
  const bool hp = t >= 1, hn = t + 1 < L;
  const float c = bf2f(P[t]), a = bf2f(P[hp ? t - 1 : t]), b = bf2f(P[hn ? t + 1 : t]);
  return w1 * c + bias + (hp ? w0 : 0.f) * a + (hn ? w2 : 0.f) * b;
}

struct HyRaw { u32x4 x; u16 prev, next; };
DI HyRaw hy_load8(const u16* P, int t0, int L) {
  HyRaw r;
  r.x = *(const u32x4*)(P + t0);
  r.prev = P[t0 >= 1 ? t0 - 1 : t0];
  r.next = P[t0 + 8 < L ? t0 + 8 : t0 + 7];
  return r;
}
DI void hy_conv8(const HyRaw& r, int t0, int L, float w0, float w1, float w2, float bias, float (&out)[8]) {
  float x[10];
  x[0] = bf2f(r.prev);
#pragma unroll
  for (int j = 0; j < 4; ++j) { x[1 + 2 * j] = bf2f((u16)(r.x[j] & 0xffff)); x[2 + 2 * j] = bf2f((u16)(r.x[j] >> 16)); }
  x[9] = bf2f(r.next);
  const float wp = t0 >= 1 ? w0 : 0.f, wn = t0 + 8 < L ? w2 : 0.f;
#pragma unroll
  for (int j = 0; j < 8; ++j) out[j] = w1 * x[1 + j] + bias + (j == 0 ? wp : w0) * x[j] + (j == 7 ? wn : w2) * x[2 + j];
}

DI void hyena_lat_item(const Params& p, int l, int c, int pair, char* smem, bool load_tw) {
  const int tid = TIDX();
  cf* buf = (cf*)smem;
  cf* tw = buf + FFT_LDS;
  const float* cw = p.hy_sconv_w + (size_t)l * 3 * PH_W;
  const float* cb = p.hy_sconv_b + (size_t)l * PH_W;
  const int b0 = pair * 2, b1 = pair * 2 + 1;
  const int t0 = tid * 8;
  const bool act = t0 < SEQ;
  const int tl = act ? t0 : 0;
  HyRaw rw[3][2];
#pragma unroll
  for (int q = 0; q < 3; ++q) {
    rw[q][0] = hy_load8(p.PH + ((size_t)b0 * PH_W + q * HY_CH + c) * SEQ, tl, SEQ);
    rw[q][1] = hy_load8(p.PH + ((size_t)b1 * PH_W + q * HY_CH + c) * SEQ, tl, SEQ);
  }
  if (load_tw) tw_to_lds(tw, p.tw);
  const MidSpec ms0 = fft_mid_prefetch(p.spec + ((size_t)0 * HY_CH + c) * FFTN);
  float vr[2][8], z1[2][8];
  {
    const int col = c;
    const float w0 = cw[col], w1 = cw[PH_W + col], w2 = cw[2 * PH_W + col], bs = cb[col];
    hy_conv8(rw[0][0], tl, SEQ, w0, w1, w2, bs, vr[0]);
    hy_conv8(rw[0][1], tl, SEQ, w0, w1, w2, bs, vr[1]);
    if (act) {
#pragma unroll
      for (int j = 0; j < 8; ++j) {
        cf a; a.x = vr[0][j]; a.y = vr[1][j];
        buf[fpad(t0 + j)] = a;
        cf zz; zz.x = 0.f; zz.y = 0.f;
        buf[fpad(t0 + j + SEQ)] = zz;
      }
    }
  }
  __syncthreads();
  fft_fwd_main(buf, tw);
  fft_mid(buf, tw, p.spec + ((size_t)0 * HY_CH + c) * FFTN, ms0);
  const MidSpec ms1 = fft_mid_prefetch(p.spec + ((size_t)1 * HY_CH + c) * FFTN);
  fft_inv_main(buf, tw);
  {
    const int col = HY_CH + c;
    const float w0 = cw[col], w1 = cw[PH_W + col], w2 = cw[2 * PH_W + col], bs = cb[col];
    const float sk = p.hf_skip[((size_t)l * 2 + 0) * HY_CH + c];
    float x1a[8], x1b[8];
    hy_conv8(rw[1][0], tl, SEQ, w0, w1, w2, bs, x1a);
    hy_conv8(rw[1][1], tl, SEQ, w0, w1, w2, bs, x1b);
    cf yv[8];
    if (act) {
#pragma unroll
      for (int j = 0; j < 8; ++j) yv[j] = buf[fpad(t0 + j)];
    }
    __syncthreads();
    if (act) {
#pragma unroll
      for (int j = 0; j < 8; ++j) {
        z1[0][j] = (yv[j].x + sk * vr[0][j]) * x1a[j];
        z1[1][j] = (yv[j].y + sk * vr[1][j]) * x1b[j];
        cf a; a.x = z1[0][j]; a.y = z1[1][j];
        buf[fpad(t0 + j)] = a;
        cf zz; zz.x = 0.f; zz.y = 0.f;
        buf[fpad(t0 + j + SEQ)] = zz;
      }
    }
  }
  __syncthreads();
  fft_fwd_main(buf, tw);
  fft_mid(buf, tw, p.spec + ((size_t)1 * HY_CH + c) * FFTN, ms1);
  fft_inv_main(buf, tw);
  {
    const int col = 2 * HY_CH + c;
    const float w0 = cw[col], w1 = cw[PH_W + col], w2 = cw[2 * PH_W + col], bs = cb[col];
    const float sk = p.hf_skip[((size_t)l * 2 + 1) * HY_CH + c];
    float x2a[8], x2b[8];
    hy_conv8(rw[2][0], tl, SEQ, w0, w1, w2, bs, x2a);
    hy_conv8(rw[2][1], tl, SEQ, w0, w1, w2, bs, x2b);
    if (act) {
      u32x4 oa, ob;
#pragma unroll
      for (int j = 0; j < 4; ++j) {
        const cf y0 = buf[fpad(t0 + 2 * j)], y1 = buf[fpad(t0 + 2 * j + 1)];
        oa[j] = pk2((y0.x + sk * z1[0][2 * j]) * x2a[2 * j], (y1.x + sk * z1[0][2 * j + 1]) * x2a[2 * j + 1]);
        ob[j] = pk2((y0.y + sk * z1[1][2 * j]) * x2b[2 * j], (y1.y + sk * z1[1][2 * j + 1]) * x2b[2 * j + 1]);
      }
      *(u32x4*)(p.yhlat + ((size_t)b0 * HY_CH + c) * SEQ + t0) = oa;
      *(u32x4*)(p.yhlat + ((size_t)b1 * HY_CH + c) * SEQ + t0) = ob;
    }
  }
  __syncthreads();
}

DI void hyena_ctx_item(const Params& p, int l, int c, char* smem) {
  const int tid = TIDX();
  float* taps = (float*)smem;
  float* uv = taps + 4 * CTXL;
  float* zb = uv + NB * 3 * CTXL;
  float* wc = zb + NB * CTXL;
  if (tid < 256) {
    int od = tid >> 6, u = tid & 63;
    wc[tid] = p.hf_wout[((size_t)l * HY_HID + u) * (4 * HY_CH) + od * HY_CH + c];
  }
  __syncthreads();
  const float dl = hy_delta(c);
  for (int i = tid; i < 4 * CTXL; i += NT) {
    int od = i / CTXL, t = i % CTXL;
    const float* h = p.h3ctx + ((size_t)l * CTXL + t) * 64;
    float s = 0.f;
    for (int u = 0; u < 64; ++u) s += h[u] * wc[od * 64 + u];
    taps[i] = s * expf(-((float)t / (float)(CTXL - 1)) * dl);
  }
  const float* cw = p.hy_sconv_w + (size_t)l * 3 * PH_W;
  const float* cb = p.hy_sconv_b + (size_t)l * PH_W;
  for (int i = tid; i < NB * 3 * CTXL; i += NT) {
    int b = i / (3 * CTXL), j = (i / CTXL) % 3, t = i % CTXL;
    int col = j * HY_CH + c;
    const u16* P = p.PH + (size_t)NB * PH_W * SEQ + ((size_t)b * PH_W + col) * CTXL;
    uv[i] = hy_u(P, t, CTXL, cw[col], cw[PH_W + col], cw[2 * PH_W + col], cb[col]);
  }
  __syncthreads();
  const float sk0 = p.hf_skip[((size_t)l * 2 + 0) * HY_CH + c], sk1 = p.hf_skip[((size_t)l * 2 + 1) * HY_CH + c];
  for (int i = tid; i < NB * CTXL; i += NT) {
    int b = i / CTXL, t = i % CTXL;
    const float* v = uv + (b * 3 + 0) * CTXL;
    float s = 0.f;
    for (int s_ = 0; s_ < CTXL; ++s_) {
      int lag = t - s_;
      float k = lag >= 0 ? taps[0 * CTXL + lag] : taps[1 * CTXL - lag];
      s += k * v[s_];
    }
    zb[i] = (s + sk0 * v[t]) * uv[(b * 3 + 1) * CTXL + t];
  }
  __syncthreads();
  for (int i = tid; i < NB * CTXL; i += NT) {
    int b = i / CTXL, t = i % CTXL;
    const float* v = zb + b * CTXL;
    float s = 0.f;
    for (int s_ = 0; s_ < CTXL; ++s_) {
      int lag = t - s_;
      float k = lag >= 0 ? taps[2 * CTXL + lag] : taps[3 * CTXL - lag];
      s += k * v[s_];
    }
    p.yhctx[((size_t)b * HY_CH + c) * CTXL + t] = f2bf((s + sk1 * v[t]) * uv[(b * 3 + 2) * CTXL + t]);
  }
  __syncthreads();
}

DI void mixer_a_item(const Params& p, int l, int tile) {
  const int tid = TIDX(), lane = tid & 63, wave = tid >> 6;
  const int ts = lane >> 4, cq = lane & 15;
  constexpr int NBK = CONV_CH / 64;
  const float* cw = p.conv_a + (size_t)l * 3 * CONV_CH;
  const float* gn = p.mix_norm_g + (size_t)l * (CONV_CH + HY_CH);
#pragma unroll
  for (int it = 0; it < 2; ++it) {
    const int r = tile * 64 + wave * 8 + it * 4 + ts;
    int rp = r, rn = r;
    bool hp = false, hn = false;
    if (r < TL) { const int t = r % SEQ; hp = t >= GRID_W; hn = t + GRID_W < SEQ; if (hp) rp = r - GRID_W; if (hn) rn = r + GRID_W; }
    else { const int t = (r - TL) % CTXL; hp = t >= 1; hn = t + 1 < CTXL; if (hp) rp = r - 1; if (hn) rn = r + 1; }
    const float fp = hp ? 1.f : 0.f, fn = hn ? 1.f : 0.f;
    const u16* row = p.PA + (size_t)r * PA_W;
    const u16* qp = p.PA + (size_t)rp * PA_W;
    const u16* qn = p.PA + (size_t)rn * PA_W;
    float yv[NBK][4];
    float ss = 0.f;
#pragma unroll
    for (int bk = 0; bk < NBK; ++bk) {
      const int c = bk * 64 + cq * 4;
      const f32x4 bg = ld_bf4(row + c);
      const f32x4 c0 = ld_bf4(row + CONV_CH + c), x0 = ld_bf4(row + 2 * CONV_CH + c);
      const f32x4 c1 = ld_bf4(qp + CONV_CH + c), x1 = ld_bf4(qp + 2 * CONV_CH + c);
      const f32x4 c2 = ld_bf4(qn + CONV_CH + c), x2 = ld_bf4(qn + 2 * CONV_CH + c);
      const f32x4 w0 = *(const f32x4*)(cw + c), w1 = *(const f32x4*)(cw + CONV_CH + c), w2 = *(const f32x4*)(cw + 2 * CONV_CH + c);
#pragma unroll
      for (int j = 0; j < 4; ++j) {
        const float z = c0[j] * x0[j] * w1[j] + fp * w0[j] * (c1[j] * x1[j]) + fn * w2[j] * (c2[j] * x2[j]);
        yv[bk][j] = bg[j] * z;
        ss += yv[bk][j] * yv[bk][j];
      }
    }
    ss = red16(ss);
    const float rs = rsqrtf(ss / (float)CONV_CH + LN_EPS);
#pragma unroll
    for (int bk = 0; bk < NBK; ++bk) {
      const int c = bk * 64 + cq * 4;
      const f32x4 g4 = *(const f32x4*)(gn + c);
      f32x4 o;
#pragma unroll
      for (int j = 0; j < 4; ++j) o[j] = yv[bk][j] * rs * g4[j];
      st_bf4(p.ya + (size_t)r * CONV_CH + c, o);
    }
  }
}

DI void ph_mix(const Params& p, int l, char* smem) {
  const bool need_ctx = (l == 0);
  constexpr int HL_ITEMS = HY_CH * (NB / 2);
  const int HC_ITEMS = need_ctx ? HY_CH : 0;
  const int MA_ITEMS = (need_ctx ? T : TL) / 64;
  const int total = HL_ITEMS + HC_ITEMS + MA_ITEMS;
  SEG_BEGIN(p)
  bool tw_loaded = false;
  ticket_loop(p.bar + XB_TICKET + 1 + 2 * DEPTH + l, total, smem, [&](int item) {
    if (item < HL_ITEMS) { hyena_lat_item(p, l, item / (NB / 2), item % (NB / 2), smem, !tw_loaded); tw_loaded = true; SEG_MARK(p, 9) }
    else if (item < HL_ITEMS + HC_ITEMS) { hyena_ctx_item(p, l, item - HL_ITEMS, smem); SEG_MARK(p, 10) }
    else { mixer_a_item(p, l, item - HL_ITEMS - HC_ITEMS); SEG_MARK(p, 11) }
  });
}

DI void seq_of_row(int r, int& b, int& t, int& L) {
  if (r < TL) { b = r / SEQ; t = r % SEQ; L = SEQ; }
  else { int rc = r - TL; b = rc / CTXL; t = rc % CTXL; L = CTXL; }
}
DI float rw_u(const Params& p, const float* mu, int r, int t, int L, int col) {
  const float m0 = mu[col], m2 = mu[RW_COLS + col];
  float s = (1.f - m0 - m2) * bf2f(p.PR[(size_t)r * RW_COLS + col]);
  if (t >= 1) s += m0 * bf2f(p.PR[(size_t)(r - 1) * RW_COLS + col]);
  if (t + 1 < L) s += m2 * bf2f(p.PR[(size_t)(r + 1) * RW_COLS + col]);
  return s;
}
DI bf16x8 load_bfrag(const float* W, int ldn, int k0, int col, int lane) {
  const float* q = W + (size_t)(k0 + 8 * (lane >> 5)) * ldn + col + (lane & 31);
  bf16x8 b;
#pragma unroll
  for (int j = 0; j < 8; ++j) b[j] = (short)f2bf(q[(size_t)j * ldn]);
  return b;
}

DI f32x4 rw_u4(const Params& p, const float* mu, int r, int t, int L, int col) {
  const f32x4 m0 = *(const f32x4*)(mu + col), m2 = *(const f32x4*)(mu + RW_COLS + col);
  const bool hp = t >= 1, hn = t + 1 < L;
  const f32x4 c = ld_bf4(p.PR + (size_t)r * RW_COLS + col);
  const f32x4 a = ld_bf4(p.PR + (size_t)(hp ? r - 1 : r) * RW_COLS + col);
  const f32x4 b = ld_bf4(p.PR + (size_t)(hn ? r + 1 : r) * RW_COLS + col);
  const float fp = hp ? 1.f : 0.f, fn = hn ? 1.f : 0.f;
  f32x4 s;
#pragma unroll
  for (int i = 0; i < 4; ++i) s[i] = (1.f - m0[i] - m2[i]) * c[i] + (fp * m0[i]) * a[i] + (fn * m2[i]) * b[i];
  return s;
}
DI bf16x8 ld_bfrag_t(const u16* Wt, int K, int k0, int col, int lane) {
  return *(const bf16x8*)(Wt + (size_t)(col + (lane & 31)) * K + k0 + 8 * (lane >> 5));
}

DI void prep_item(const Params& p, int l, int tile, char* smem) {
  const int tid = TIDX(), lane = tid & 63, wave = tid >> 6;
  constexpr int LA = 72, LG = 136, LX = 68;
  constexpr int XW = 32 * LX + 64;
  u16* Awd = (u16*)smem;
  u16* Aad = Awd + 2 * 32 * LA;
  u16* Agd = Aad + 2 * 32 * LA;
  float* Xall = (float*)(Agd + 32 * LG);
  const float* mu = p.rw_mu + (size_t)l * 2 * RW_COLS;
  const int r0 = tile * 32;
  int b_, t0, L;
  seq_of_row(r0, b_, t0, L);
  SEG_BEGIN(p)
#pragma unroll 2
  for (int i = tid; i < 32 * 96; i += NT) {
    const int tok = i / 96, c4 = (i % 96) * 4;
    f32x4 u = rw_u4(p, mu, r0 + tok, t0 + tok, L, 3 * RW_CH + c4);
    if (c4 < 128) { f32x4 o; for (int j = 0; j < 4; ++j) o[j] = ftanh_(u[j]); st_bf4(Awd + ((c4 >> 6) * 32 + tok) * LA + (c4 & 63), o); }
    else if (c4 < 256) { int c2 = c4 - 128; st_bf4(Aad + ((c2 >> 6) * 32 + tok) * LA + (c2 & 63), u); }
    else { f32x4 o; for (int j = 0; j < 4; ++j) o[j] = fsigmoid_(u[j]); st_bf4(Agd + tok * LG + (c4 - 256), o); }
  }
  __syncthreads();
  SEG_MARK(p, 4)
  const int ts = lane >> 4, cq = lane & 15;
  if (wave < RW_H) {
    const int h = wave;
    float* X = Xall + (size_t)wave * XW;
    float* rinvw = X + 32 * LX;
    float* sbw = rinvw + 32;
    const size_t seqidx0 = (size_t)(b_ * RW_H + h) * L + t0;
    u16* sish = (r0 < TL ? p.SIsh_lat : p.SIsh_ctx);
    u16* sidir = (r0 < TL ? p.SIdir_lat : p.SIdir_ctx);
    const size_t dirstride = (size_t)NB * RW_H * L * 192;
    const int ch = h * 64 + cq * 4;
    const f32x4 kkc = *(const f32x4*)(p.rw_k_k + (size_t)l * RW_CH + ch);
    const f32x4 k_a = *(const f32x4*)(p.rw_k_a + (size_t)l * RW_CH + ch);
    const f32x4 r_k = *(const f32x4*)(p.rw_r_k + (size_t)l * RW_CH + ch);
    auto gemm_to_X = [&](const u16* Atile, int lda_, int arow0, const u16* Wt, int K) {
      f32x16 c0, c1;
#pragma unroll
      for (int r = 0; r < 16; ++r) { c0[r] = 0.f; c1[r] = 0.f; }
#pragma unroll 4
      for (int k0 = 0; k0 < K; k0 += 16) {
        bf16x8 a1 = *(const bf16x8*)(Atile + (arow0 + (lane & 31)) * lda_ + k0 + (lane >> 5) * 8);
        c0 = MFMA32(a1, ld_bfrag_t(Wt, K, k0, h * 64, lane), c0);
        c1 = MFMA32(a1, ld_bfrag_t(Wt, K, k0, h * 64 + 32, lane), c1);
      }
      wave_sync();
#pragma unroll
      for (int r = 0; r < 16; ++r) {
        X[crow(r, lane >> 5) * LX + (lane & 31)] = c0[r];
        X[crow(r, lane >> 5) * LX + 32 + (lane & 31)] = c1[r];
      }
      wave_sync();
    };
    {
      constexpr int mt = 0;
      if (lane < 32) sbw[lane] = 0.f;
      f32x4 rvs[8], kvs[8];
      float ris[8];
#pragma unroll
      for (int it = 0; it < 8; ++it) {
        const int tt = it * 4 + ts, tok = mt * 32 + tt;
        f32x4 rv = rw_u4(p, mu, r0 + tok, t0 + tok, L, ch);
        f32x4 kv = rw_u4(p, mu, r0 + tok, t0 + tok, L, RW_CH + ch);
        f32x4 vv = rw_u4(p, mu, r0 + tok, t0 + tok, L, 2 * RW_CH + ch);
        rvs[it] = rv; kvs[it] = kv;
        f32x4 kr;
        float ss = 0.f;
#pragma unroll
        for (int j = 0; j < 4; ++j) { kr[j] = kv[j] * kkc[j]; ss += kr[j] * kr[j]; }
        const float ri = rsqrtf(fmaxf(red16(ss), 1e-24f));
        ris[it] = ri;
#pragma unroll
        for (int j = 0; j < 4; ++j) kr[j] *= ri;
        u16* dst = sish + (seqidx0 + tok) * 192 + cq * 4;
        st_bf4(dst, rv); st_bf4(dst + 64, kr); st_bf4(dst + 128, vv);
      }
      SEG_MARK(p, 5)
#pragma unroll 1
      for (int d = 0; d < 2; ++d) {
        gemm_to_X(Awd, LA, d * 32 + mt * 32, p.wt_wup + ((size_t)l * 2 + d) * RW_CH * DRK, DRK);
        const f32x4 w0 = *(const f32x4*)(p.rw_w0 + ((size_t)l * 2 + d) * RW_CH + ch);
#pragma unroll 4
        for (int it = 0; it < 8; ++it) {
          const int tt = it * 4 + ts, tok = mt * 32 + tt;
          f32x4 xw = *(const f32x4*)(X + tt * LX + cq * 4);
          u32x2 o;
          u16 hh[4];
#pragma unroll
          for (int j = 0; j < 4; ++j) {
            const float e = 0.60653065971263342f * fsigmoid_(w0[j] + xw[j]);
            hh[j] = f2h(1.0f - fexp_(-e));
          }
          o[0] = (unsigned)hh[0] | ((unsigned)hh[1] << 16); o[1] = (unsigned)hh[2] | ((unsigned)hh[3] << 16);
          *(u32x2*)(sidir + (size_t)d * dirstride + (seqidx0 + tok) * 192 + cq * 4) = o;
        }
        SEG_MARK(p, 6)
        gemm_to_X(Aad, LA, d * 32 + mt * 32, p.wt_aup + ((size_t)l * 2 + d) * RW_CH * IRK, IRK);
        const f32x4 a0 = *(const f32x4*)(p.rw_a0 + ((size_t)l * 2 + d) * RW_CH + ch);
#pragma unroll
        for (int it = 0; it < 8; ++it) {
          const int tt = it * 4 + ts, tok = mt * 32 + tt;
          f32x4 xa = *(const f32x4*)(X + tt * LX + cq * 4);
          const f32x4 rv = rvs[it], kv = kvs[it];
          const float ri = ris[it];
          f32x4 ka, kd;
          float bs = 0.f;
#pragma unroll
          for (int j = 0; j < 4; ++j) {
            float a = fsigmoid_(a0[j] + xa[j]);
            ka[j] = kv[j] * kkc[j] * ri * a;
            kd[j] = kv[j] * (1.f + (a - 1.f) * k_a[j]);
            bs += rv[j] * kd[j] * r_k[j];
          }
          u16* dst = sidir + (size_t)d * dirstride + (seqidx0 + tok) * 192 + cq * 4;
          st_bf4(dst + 64, ka); st_bf4(dst + 128, kd);
          bs = red16(bs);
          if (cq == 0) sbw[tt] += bs;
        }
      }
      SEG_MARK(p, 7)
      wave_sync();
      if (lane < 32) p.sbonus[(size_t)(r0 + mt * 32 + lane) * RW_H + h] = sbw[lane];
      gemm_to_X(Agd, LG, mt * 32, p.wt_gup + (size_t)l * RW_CH * GRK, GRK);
#pragma unroll 4
      for (int it = 0; it < 8; ++it) {
        const int tt = it * 4 + ts, tok = mt * 32 + tt;
        f32x4 xg = *(const f32x4*)(X + tt * LX + cq * 4);
        st_bf4(p.gbuf + (size_t)(r0 + tok) * RW_CH + ch, xg);
      }
      wave_sync();
      SEG_MARK(p, 8)
    }
  }
  __syncthreads();
  SEG_MARK(p, 8)
}

DI void ph_prep(const Params& p, int l, char* smem) {
  for (int item = BIDX(); item < T / 32; item += gridDim.x) prep_item(p, l, item, smem);
}

typedef __attribute__((ext_vector_type(2))) float f32x2;
constexpr int SC_C = 16, SC_NSLOT = 8, SC_NCONS = 2, SC_NPROD = 6;
constexpr int SC_LDP = 72;
constexpr int SC_LDQ = 40;
constexpr int SC_AT = 0, SC_RT = SC_AT + 16 * SC_LDP * 2, SC_KT = SC_RT + 16 * SC_LDP * 2, SC_PQ = SC_KT + 64 * SC_LDQ * 2,
              SC_BM = SC_PQ + 16 * SC_LDQ * 2, SC_TM = SC_BM + 16 * SC_LDQ * 2, SC_VT = SC_TM + 16 * SC_LDQ * 2, SC_CUM = SC_VT + 64 * 16 * 2,
              SC_SLOT = SC_CUM + 64 * 4;
constexpr int SC_PSCR = SC_NSLOT * SC_SLOT;
constexpr int SC_PSCR_W = 2 * 16 * SC_LDP * 2;
constexpr int SC_FLAGS = SC_PSCR + SC_NPROD * SC_PSCR_W;
static_assert(SC_FLAGS + 64 * 4 < SMEM_BYTES - 1024, "scan LDS");
static_assert(SC_SLOT % 16 == 0 && SC_PSCR_W % 16 == 0, "scan LDS alignment");

#ifdef EMU
typedef volatile int* sc_flag_t;
#else
typedef volatile LAS int* sc_flag_t;
#endif
DI void sc_wait_eq(sc_flag_t f, int want) {
#ifdef EMU
  while (*f != want) emu_yield();
#else
  while (__builtin_amdgcn_readfirstlane(*f) != want) __builtin_amdgcn_s_sleep(1);
  asm volatile("s_waitcnt lgkmcnt(0)" ::: "memory");
#endif
}
DI void sc_wait_ge(sc_flag_t f, int want) {
#ifdef EMU
  while (*f < want) emu_yield();
#else
  while (__builtin_amdgcn_readfirstlane(*f) < want) __builtin_amdgcn_s_sleep(1);
  asm volatile("s_waitcnt lgkmcnt(0)" ::: "memory");
#endif
}
DI void sc_flag_inc(sc_flag_t f) {
#ifdef EMU
  *f = *f + 1;
#else
  (void)__hip_atomic_fetch_add((LAS int*)f, 1, __ATOMIC_RELAXED, __HIP_MEMORY_SCOPE_WORKGROUP);
#endif
}
DI float rdlane_f(float v, int l) { return __builtin_bit_cast(float, __builtin_amdgcn_readlane(__builtin_bit_cast(int, v), l)); }
#define MFMA16(a, b, c) __builtin_amdgcn_mfma_f32_16x16x32_bf16((a), (b), (c), 0, 0, 0)

DI void sc_step_time(int d, int s, bool& isctx, int& t) {
  isctx = s < CTXL;
  if (isctx) t = d == 0 ? s : CTXL - 1 - s;
  else { const int u = s - CTXL; t = d == 0 ? u : SEQ - 1 - u; }
}

DI void scan_chain_item(const Params& p, int item, char* smem) {
  const int tid = TIDX(), lane = tid & 63, wave = tid >> 6;
  const int chain = item >> 1, hf = item & 1;
  const int h = chain % RW_H, b = (chain / RW_H) % NB, d = chain / (RW_H * NB);
  constexpr int NCHUNK = (CTXL + SEQ) / SC_C;
  sc_flag_t ready = (sc_flag_t)(smem + SC_FLAGS);
  sc_flag_t done = ready + SC_NSLOT;
  if (tid < 2 * SC_NSLOT) ready[tid] = 0;
  __syncthreads();
  const int q4 = lane >> 4, c16 = lane & 15;
  if (wave >= SC_NCONS) {
    const int pw = wave - SC_NCONS;
    u16* Bt = (u16*)(smem + SC_PSCR + pw * SC_PSCR_W);
    u16* Kt = Bt + 16 * SC_LDP;
    const int k = lane;
    u16 raw[SC_C][6];
    static_assert(CTXL % SC_C == 0 && SEQ % SC_C == 0, "a chunk lies inside the context or the latent part");
    auto load_chunk = [&](int c) {
      bool isctx; int t0;
      sc_step_time(d, c * SC_C, isctx, t0);
      const int L = isctx ? CTXL : SEQ;
      const long st = (d == 0) ? 192 : -192;
      const size_t base = ((size_t)(b * RW_H + h) * L + t0) * 192 + k;
      const u16* sh = (isctx ? p.SIsh_ctx : p.SIsh_lat) + base;
      const u16* dr = (isctx ? p.SIdir_ctx : p.SIdir_lat) + (size_t)d * NB * RW_H * L * 192 + base;
#pragma unroll
      for (int j = 0; j < SC_C; ++j) {
        const u16* s_ = sh + j * st; const u16* d_ = dr + j * st;
        raw[j][0] = s_[0]; raw[j][1] = s_[64]; raw[j][2] = s_[128];
        raw[j][3] = d_[0]; raw[j][4] = d_[64]; raw[j][5] = d_[128];
      }
    };
    if (pw < NCHUNK) load_chunk(pw);
    for (int c = pw; c < NCHUNK; c += SC_NPROD) {
      const int slot = c % SC_NSLOT;
      char* sl = smem + slot * SC_SLOT;
      u16* At = (u16*)(sl + SC_AT); u16* Rt = (u16*)(sl + SC_RT); u16* KT = (u16*)(sl + SC_KT);
      u16* PQ = (u16*)(sl + SC_PQ); u16* BM = (u16*)(sl + SC_BM); u16* TM = (u16*)(sl + SC_TM);
      u16* VT = (u16*)(sl + SC_VT); float* CUM = (float*)(sl + SC_CUM);
      sc_wait_ge(done + slot, SC_NCONS * (c / SC_NSLOT));
      float cum = 1.f;
      u16 ktv[16], btv[16], vtv[16];
#pragma unroll
      for (int j = 0; j < SC_C; ++j) {
        const float rr = bf2f(raw[j][0]), kk = bf2f(raw[j][1]);
        vtv[j] = raw[j][2];
        const float w = 1.f - h2f(raw[j][3]), ka = bf2f(raw[j][4]), kd = bf2f(raw[j][5]);
        const float at = cum * kk;
        cum *= w;
        const float ic = frcp_(cum);
        At[j * SC_LDP + k] = f2bf(at);
        Rt[j * SC_LDP + k] = f2bf(cum * rr);
        btv[j] = f2bf(ka * ic); ktv[j] = f2bf(kd * ic);
        Bt[j * SC_LDP + k] = btv[j];
        Kt[j * SC_LDP + k] = ktv[j];
      }
      if (c + SC_NPROD < NCHUNK) load_chunk(c + SC_NPROD);
      CUM[k] = cum;
      {
        u32x4 o;
#pragma unroll
        for (int hh = 0; hh < 2; ++hh) {
          o[0] = ktv[8 * hh + 0] | ((unsigned)ktv[8 * hh + 1] << 16); o[1] = ktv[8 * hh + 2] | ((unsigned)ktv[8 * hh + 3] << 16);
          o[2] = ktv[8 * hh + 4] | ((unsigned)ktv[8 * hh + 5] << 16); o[3] = ktv[8 * hh + 6] | ((unsigned)ktv[8 * hh + 7] << 16);
          *(u32x4*)(KT + k * SC_LDQ + 8 * hh) = o;
          o[0] = btv[8 * hh + 0] | ((unsigned)btv[8 * hh + 1] << 16); o[1] = btv[8 * hh + 2] | ((unsigned)btv[8 * hh + 3] << 16);
          o[2] = btv[8 * hh + 4] | ((unsigned)btv[8 * hh + 5] << 16); o[3] = btv[8 * hh + 6] | ((unsigned)btv[8 * hh + 7] << 16);
          *(u32x4*)(KT + k * SC_LDQ + 16 + 8 * hh) = o;
          o[0] = vtv[8 * hh + 0] | ((unsigned)vtv[8 * hh + 1] << 16); o[1] = vtv[8 * hh + 2] | ((unsigned)vtv[8 * hh + 3] << 16);
          o[2] = vtv[8 * hh + 4] | ((unsigned)vtv[8 * hh + 5] << 16); o[3] = vtv[8 * hh + 6] | ((unsigned)vtv[8 * hh + 7] << 16);
          *(u32x4*)(VT + k * 16 + 8 * hh) = o;
        }
      }
      wave_sync();
      f32x4 am = {0.f, 0.f, 0.f, 0.f}, bm = am, pm = am, qm = am;
#pragma unroll
      for (int ks = 0; ks < 2; ++ks) {
        const int o = c16 * SC_LDP + 32 * ks + 8 * q4;
        const bf16x8 fa = *(const bf16x8*)(At + o), fr = *(const bf16x8*)(Rt + o);
        const bf16x8 fb = *(const bf16x8*)(Bt + o), fk = *(const bf16x8*)(Kt + o);
        am = MFMA16(fa, fb, am); bm = MFMA16(fa, fk, bm); pm = MFMA16(fr, fk, pm); qm = MFMA16(fr, fb, qm);
      }
#pragma unroll
      for (int r = 0; r < 4; ++r) {
        const int j = 4 * q4 + r;
        BM[j * SC_LDQ + c16] = c16 < j ? f2bf(bm[r]) : (u16)0;
        PQ[j * SC_LDQ + c16] = c16 <= j ? f2bf(pm[r]) : (u16)0;
        PQ[j * SC_LDQ + 16 + c16] = c16 <= j ? f2bf(-qm[r]) : (u16)0;
      }
      float Tc[16];
#pragma unroll
      for (int j = 0; j < 16; ++j) {
        float tv = (j == c16) ? 1.f : 0.f;
#pragma unroll
        for (int i = 0; i < j; ++i) tv -= rdlane_f(am[j & 3], i + 16 * (j >> 2)) * Tc[i];
        Tc[j] = tv;
      }
#pragma unroll
      for (int j = 0; j < 16; ++j) {
        if (q4 == 0) TM[j * SC_LDQ + c16] = f2bf(Tc[j]);
      }
      wave_sync();
      if (lane == 0) ready[slot] = c + 1;
    }
  } else {
    const int vt = SC_NCONS * hf + wave;
#ifndef EMU
    __builtin_amdgcn_s_setprio(3);
#endif
    f32x4 ST[4];
#pragma unroll
    for (int mt = 0; mt < 4; ++mt) ST[mt] = (f32x4){0.f, 0.f, 0.f, 0.f};
    auto ld2 = [&](const u16* q0, const u16* q1) {
      const u32x2 a = *(const u32x2*)q0, b2 = *(const u32x2*)q1;
      u32x4 o; o[0] = a[0]; o[1] = a[1]; o[2] = b2[0]; o[3] = b2[1];
      return __builtin_bit_cast(bf16x8, o);
    };
    auto ld1z = [&](const u16* q0) {
      const u32x2 a = *(const u32x2*)q0;
      u32x4 o; o[0] = a[0]; o[1] = a[1]; o[2] = 0u; o[3] = 0u;
      return __builtin_bit_cast(bf16x8, o);
    };
    SEG_BEGIN(p)
    for (int c = 0; c < NCHUNK; ++c) {
      const int slot = c % SC_NSLOT;
      const char* sl = smem + slot * SC_SLOT;
      const u16* At = (const u16*)(sl + SC_AT); const u16* Rt = (const u16*)(sl + SC_RT); const u16* KT = (const u16*)(sl + SC_KT);
      const u16* PQ = (const u16*)(sl + SC_PQ); const u16* BM = (const u16*)(sl + SC_BM); const u16* TM = (const u16*)(sl + SC_TM);
      const u16* VT = (const u16*)(sl + SC_VT); const float* CUM = (const float*)(sl + SC_CUM);
      bf16x8 shi[2], slo[2];
#pragma unroll
      for (int ks = 0; ks < 2; ++ks) {
        u32x4 oh, ol;
#pragma unroll
        for (int hh = 0; hh < 2; ++hh) {
          const f32x4 x = ST[2 * ks + hh];
          float h0 = bf2f(f2bf(x[0])), h1 = bf2f(f2bf(x[1])), h2 = bf2f(f2bf(x[2])), h3 = bf2f(f2bf(x[3]));
          oh[2 * hh] = pk2(x[0], x[1]); oh[2 * hh + 1] = pk2(x[2], x[3]);
          ol[2 * hh] = pk2(x[0] - h0, x[1] - h1); ol[2 * hh + 1] = pk2(x[2] - h2, x[3] - h3);
        }
        shi[ks] = __builtin_bit_cast(bf16x8, oh); slo[ks] = __builtin_bit_cast(bf16x8, ol);
      }
      SEG_MARK(p, 12)
      sc_wait_eq(ready + slot, c + 1);
      SEG_MARK(p, 13)
      f32x4 rhs = {0.f, 0.f, 0.f, 0.f}, y = rhs;
#pragma unroll
      for (int ks = 0; ks < 2; ++ks) {
        const int o = c16 * SC_LDP + 32 * ks + 4 * q4;
        const bf16x8 fa = ld2(At + o, At + o + 16), fr = ld2(Rt + o, Rt + o + 16);
        rhs = MFMA16(fa, shi[ks], rhs); y = MFMA16(fr, shi[ks], y);
        rhs = MFMA16(fa, slo[ks], rhs); y = MFMA16(fr, slo[ks], y);
      }
      const u32x2 vraw = *(const u32x2*)(VT + (16 * vt + c16) * 16 + 4 * q4);
      {
        u32x4 o; o[0] = vraw[0]; o[1] = vraw[1]; o[2] = 0u; o[3] = 0u;
        rhs = MFMA16(ld1z(BM + c16 * SC_LDQ + 4 * q4), __builtin_bit_cast(bf16x8, o), rhs);
      }
      f32x4 z = {0.f, 0.f, 0.f, 0.f};
      {
        u32x4 o; o[0] = pk2(rhs[0], rhs[1]); o[1] = pk2(rhs[2], rhs[3]); o[2] = 0u; o[3] = 0u;
        z = MFMA16(ld1z(TM + c16 * SC_LDQ + 4 * q4), __builtin_bit_cast(bf16x8, o), z);
      }
      const unsigned z01 = pk2(z[0], z[1]), z23 = pk2(z[2], z[3]);
      {
        u32x4 o; o[0] = vraw[0]; o[1] = vraw[1]; o[2] = z01; o[3] = z23;
        y = MFMA16(ld2(PQ + c16 * SC_LDQ + 4 * q4, PQ + c16 * SC_LDQ + 16 + 4 * q4), __builtin_bit_cast(bf16x8, o), y);
      }
      {
        bool isctx; int t0;
        sc_step_time(d, c * SC_C + 4 * q4, isctx, t0);
        const int rrow0 = isctx ? TL + b * CTXL + t0 : b * SEQ + t0;
        u16* yo = p.ybuf + ((size_t)d * T + rrow0) * RW_CH + h * 64 + 16 * vt + c16;
        const long yst = (d == 0) ? RW_CH : -RW_CH;
#pragma unroll
        for (int r = 0; r < 4; ++r) yo[r * yst] = f2bf(y[r]);
      }
      {
        u32x4 o; o[0] = vraw[0]; o[1] = vraw[1]; o[2] = z01 ^ 0x80008000u; o[3] = z23 ^ 0x80008000u;
        const bf16x8 bS = __builtin_bit_cast(bf16x8, o);
#pragma unroll
        for (int mt = 0; mt < 4; ++mt) {
          const u16* kr = KT + (16 * mt + c16) * SC_LDQ + 4 * q4;
          ST[mt] = MFMA16(ld2(kr, kr + 16), bS, ST[mt]);
          const f32x4 cm = *(const f32x4*)(CUM + 16 * mt + 4 * q4);
#pragma unroll
          for (int r = 0; r < 4; ++r) ST[mt][r] *= cm[r];
        }
      }
      wave_sync();
      if (lane == 0) sc_flag_inc(done + slot);
    }
#ifndef EMU
    __builtin_amdgcn_s_setprio(0);
#endif
  }
  __syncthreads();
}
DI void ph_scan(const Params& p, char* smem) {
  for (int item = BIDX(); item < 2 * (2 * NB * RW_H); item += gridDim.x) scan_chain_item(p, item, smem);
}

DI void ph_assemble(const Params& p, int l, char* smem) {
  const int tid = TIDX(), lane = tid & 63, wave = tid >> 6;
  const int ts = lane >> 4, cq = lane & 15;
  const int rows = (l == 0) ? T : TL;
  constexpr int LY = 66;
  u16* yt = (u16*)smem;
  const float* gn = p.mix_norm_g + (size_t)l * (CONV_CH + HY_CH);
  for (int tile = BIDX(); tile < rows / 64; tile += gridDim.x) {
    const int r0 = tile * 64;
    int b_, t0, L;
    seq_of_row(r0, b_, t0, L);
    const u16* yh = (r0 < TL ? p.yhlat : p.yhctx) + (size_t)b_ * HY_CH * L + t0;
    for (int i = tid; i < HY_CH * 8; i += NT) {
      int c = i >> 3, part = i & 7;
      const u32x4 v = *(const u32x4*)(yh + (size_t)c * L + part * 8);
      unsigned* q = (unsigned*)(yt + c * LY + part * 8);
      q[0] = v[0]; q[1] = v[1]; q[2] = v[2]; q[3] = v[3];
    }
    __syncthreads();
    const u16* sish = (r0 < TL ? p.SIsh_lat : p.SIsh_ctx);
#pragma unroll
    for (int it = 0; it < 2; ++it) {
      const int tok = wave * 8 + it * 4 + ts;
      const int r = r0 + tok;
      u16* dst = p.ycat + (size_t)r * MIX_W;
#pragma unroll
      for (int bk = 0; bk < CONV_CH / 64; ++bk)
        *(u32x2*)(dst + bk * 64 + cq * 4) = *(const u32x2*)(p.ya + (size_t)r * CONV_CH + bk * 64 + cq * 4);
      float hv[HY_CH / 64][4];
      float ss = 0.f;
#pragma unroll
      for (int bk = 0; bk < HY_CH / 64; ++bk)
#pragma unroll
        for (int j = 0; j < 4; ++j) { hv[bk][j] = bf2f(yt[(bk * 64 + cq * 4 + j) * LY + tok]); ss += hv[bk][j] * hv[bk][j]; }
      ss = red16(ss);
      const float rs = rsqrtf(ss / (float)HY_CH + LN_EPS);
#pragma unroll
      for (int bk = 0; bk < HY_CH / 64; ++bk) {
        const f32x4 g4 = *(const f32x4*)(gn + CONV_CH + bk * 64 + cq * 4);
        f32x4 o;
#pragma unroll
        for (int j = 0; j < 4; ++j) o[j] = hv[bk][j] * rs * g4[j];
        st_bf4(dst + CONV_CH + bk * 64 + cq * 4, o);
      }
#pragma unroll
      for (int h = 0; h < RW_H; ++h) {
        const int ch = h * 64 + cq * 4;
        const f32x4 yf = ld_bf4(p.ybuf + (size_t)r * RW_CH + ch), yb = ld_bf4(p.ybuf + ((size_t)T + r) * RW_CH + ch);
        const f32x4 vv = ld_bf4(sish + ((size_t)(b_ * RW_H + h) * L + t0 + tok) * 192 + 128 + cq * 4);
        const f32x4 gg = ld_bf4(p.gbuf + (size_t)r * RW_CH + ch);
        const f32x4 lg4 = *(const f32x4*)(p.rw_lnx_g + (size_t)l * RW_CH + ch), lb4 = *(const f32x4*)(p.rw_lnx_b + (size_t)l * RW_CH + ch);
        const float sb = p.sbonus[(size_t)r * RW_H + h];
        f32x4 yv;
        float sm = 0.f;
#pragma unroll
        for (int j = 0; j < 4; ++j) { yv[j] = yf[j] + yb[j]; sm += yv[j]; }
        const float mu = red16(sm) * (1.f / 64.f);
        float sq = 0.f;
#pragma unroll
        for (int j = 0; j < 4; ++j) { yv[j] -= mu; sq += yv[j] * yv[j]; }
        const float rstd = rsqrtf(red16(sq) * (1.f / 64.f) + RW_GN_EPS);
        f32x4 o;
#pragma unroll
        for (int j = 0; j < 4; ++j) o[j] = (yv[j] * rstd * lg4[j] + lb4[j] + sb * vv[j]) * gg[j];
        st_bf4(dst + CONV_CH + HY_CH + ch, o);
      }
    }
    __syncthreads();
  }
}

DI void ph_outproj(const Params& p, int l, char* smem) {
  const int rows = (l == 0) ? T : TL;
  const int G = gridDim.x, c = BIDX();
  {
    DenseSched S; S.init(p.ycat, p.wt_out + (size_t)l * D * MIX_W, MIX_W, rows, D, G, c);
    EpiOutproj E{&p, l};
    pg8::gemm_phase(smem, MIX_W, S, E);
  }
  __syncthreads();
  ticket_loop(p.bar + XB_TICKET + 1 + DEPTH + l, CT_EXP_L, smem, [&](int it) { convert_expert_item(p, l, it, smem); });
}

DI void ph_ln_router(const Params& p, int l, char* smem) {
  const int tid = TIDX(), lane = tid & 63, wave = tid >> 6;
  const int rows = (l == 0) ? T : TL;
  constexpr int LH = D + 8;
  constexpr int EPL = D / 64;
  u16* Hhi = (u16*)smem;
  u16* Hlo = Hhi + 32 * LH;
  float* red = (float*)smem;
  constexpr int LGS_OFF = (2 * 32 * LH * 2 > 8 * 32 * 64 * 4) ? 2 * 32 * LH * 2 : 8 * 32 * 64 * 4;
  float* lgs = (float*)(smem + LGS_OFF);
  const float* lg = p.ln_g + ((size_t)l * 2 + 0) * D;
  const float* lb = p.ln_b + ((size_t)l * 2 + 0) * D;
  const u16* Whi = p.wt_rhi + (size_t)l * NE * D;
  const u16* Wlo = p.wt_rlo + (size_t)l * NE * D;
  constexpr int KS = D / 8;
  SEG_BEGIN(p)
  for (int tile = BIDX(); tile < rows / 32; tile += gridDim.x) {
    const int r0 = tile * 32;
#pragma unroll 2
    for (int tt = 0; tt < 4; ++tt) {
      const int tok = wave * 4 + tt;
      const int r = r0 + tok;
      float* xr = x1row(p, r);
      const float* m = modp(p, l, r);
      constexpr int NV = D / 256;
      f32x4 xv[NV];
      float s = 0.f;
#pragma unroll
      for (int i = 0; i < NV; ++i) { xv[i] = *(const f32x4*)(xr + 4 * lane + 256 * i); s += (xv[i][0] + xv[i][1]) + (xv[i][2] + xv[i][3]); }
      const float mu = wave_sum(s) * (1.f / (float)D);
      float s2 = 0.f;
#pragma unroll
      for (int i = 0; i < NV; ++i)
#pragma unroll
        for (int j = 0; j < 4; ++j) { float dd = xv[i][j] - mu; s2 += dd * dd; }
      const float rstd = rsqrtf(wave_sum(s2) * (1.f / (float)D) + LN_EPS);
#pragma unroll
      for (int i = 0; i < NV; ++i) {
        const int e = 4 * lane + 256 * i;
        const f32x4 g4 = *(const f32x4*)(lg + e), b4 = *(const f32x4*)(lb + e);
        const f32x4 sc = *(const f32x4*)(m + 4 * D + e), sh = *(const f32x4*)(m + 3 * D + e);
        f32x4 xn, hh, lo;
#pragma unroll
        for (int j = 0; j < 4; ++j) { xn[j] = (xv[i][j] - mu) * rstd * g4[j] + b4[j]; hh[j] = xn[j] * (1.f + sc[j]) + sh[j]; }
        *(f32x4*)(xr + e) = xn;
        u32x2 hp; hp[0] = pk2(hh[0], hh[1]); hp[1] = pk2(hh[2], hh[3]);
#pragma unroll
        for (int j = 0; j < 4; ++j) lo[j] = hh[j] - bf2f((u16)((j & 1) ? (hp[j >> 1] >> 16) : (hp[j >> 1] & 0xffff)));
        *(u32x2*)(Hhi + tok * LH + e) = hp;
        st_bf4(Hlo + tok * LH + e, lo);
        *(u32x2*)(p.HL + (size_t)r * D + e) = hp;
        u32x2 zz; zz[0] = 0u; zz[1] = 0u;
        *(u32x2*)(p.acc + (size_t)r * (D / 2) + e / 2) = zz;
      }
    }
    __syncthreads();
    SEG_MARK(p, 0)
    f32x16 c0, c1;
#pragma unroll
    for (int r = 0; r < 16; ++r) { c0[r] = 0.f; c1[r] = 0.f; }
#pragma unroll 4
    for (int k0 = wave * KS; k0 < (wave + 1) * KS; k0 += 16) {
      const int ko = k0 + (lane >> 5) * 8;
      bf16x8 ah = *(const bf16x8*)(Hhi + (lane & 31) * LH + ko);
      bf16x8 al = *(const bf16x8*)(Hlo + (lane & 31) * LH + ko);
      bf16x8 bh0 = *(const bf16x8*)(Whi + (size_t)(lane & 31) * D + ko);
      bf16x8 bh1 = *(const bf16x8*)(Whi + (size_t)(32 + (lane & 31)) * D + ko);
      bf16x8 bl0 = *(const bf16x8*)(Wlo + (size_t)(lane & 31) * D + ko);
      bf16x8 bl1 = *(const bf16x8*)(Wlo + (size_t)(32 + (lane & 31)) * D + ko);
      c0 = MFMA32(ah, bh0, c0); c0 = MFMA32(ah, bl0, c0); c0 = MFMA32(al, bh0, c0);
      c1 = MFMA32(ah, bh1, c1); c1 = MFMA32(ah, bl1, c1); c1 = MFMA32(al, bh1, c1);
    }
    __syncthreads();
    SEG_MARK(p, 1)
#pragma unroll
    for (int r = 0; r < 16; ++r) {
      red[(wave * 32 + crow(r, lane >> 5)) * 64 + (lane & 31)] = c0[r];
      red[(wave * 32 + crow(r, lane >> 5)) * 64 + 32 + (lane & 31)] = c1[r];
    }
    __syncthreads();
    for (int i = tid; i < 32 * 64; i += NT) {
      float sacc = 0.f;
#pragma unroll
      for (int w = 0; w < 8; ++w) sacc += red[w * 2048 + i];
      lgs[i] = sacc;
    }
    __syncthreads();
    SEG_MARK(p, 2)
    unsigned long long* selm = (unsigned long long*)(lgs + 32 * 64);
    unsigned char* lpos = (unsigned char*)(selm + 32);
    int* tbase = (int*)(lpos + 32 * 64);
    const float eb = p.e_bias[(size_t)l * NE + lane];
    float gate4[4];
    bool ch4[4];
    {
      float score4[4], selv4[4];
#pragma unroll
      for (int tt = 0; tt < 4; ++tt) { score4[tt] = fsigmoid_(lgs[(wave * 4 + tt) * 64 + lane]); selv4[tt] = score4[tt] + eb; ch4[tt] = false; }
      for (int round = 0; round < TOPK; ++round) {
#pragma unroll
        for (int tt = 0; tt < 4; ++tt) {
          const float cand = ch4[tt] ? -1e30f : selv4[tt];
          const float mx = wave_max(cand);
          const unsigned long long bal = __ballot(cand == mx);
          const int win = __ffsll((long long)bal) - 1;
          if (lane == win) ch4[tt] = true;
        }
      }
#pragma unroll
      for (int tt = 0; tt < 4; ++tt) {
        const float ssum = wave_sum(ch4[tt] ? score4[tt] : 0.f);
        gate4[tt] = ROUTED_SCALE * score4[tt] / ssum;
        const unsigned long long m = __ballot(ch4[tt]);
        if (lane == 0) selm[wave * 4 + tt] = m;
      }
    }
    __syncthreads();
    if (wave == 0) {
      int c = 0;
      for (int t = 0; t < 32; ++t) {
        const int bit = (int)((selm[t] >> lane) & 1ull);
        lpos[t * 64 + lane] = (unsigned char)c;
        c += bit;
      }
      int base = 0;
      if (c > 0) base = atomicAdd(p.cnt + l * NE + lane, c);
      tbase[lane] = base;
    }
    __syncthreads();
#pragma unroll
    for (int tt = 0; tt < 4; ++tt) {
      const int tok = wave * 4 + tt;
      if (ch4[tt]) {
        const int pos = tbase[lane] + (int)lpos[tok * 64 + lane];
        p.etok[(size_t)lane * T + pos] = r0 + tok;
        p.egate[(size_t)lane * T + pos] = gate4[tt];
      }
    }
    __syncthreads();
    SEG_MARK(p, 3)
  }
}

constexpr int EXP_LDS_OFF = 128 * 1024;
constexpr int MAX_ROW_TILES = (T * TOPK) / 256 + NE + T / 256;
static_assert(28 * 1024 + (2 * (NE + 2) + (NE + 2)) * 4 + MAX_ROW_TILES + EXP_LDS_OFF <= SMEM_BYTES - 1024, "expert tables fit below the parked parameters");
static_assert(NE == 64, "binary search step");
struct ExpTables { int* pre; int* hoff; int* cntl; unsigned char* t2e; };
DI ExpTables expert_tables(const Params& p, int l, int rows, char* smem) {
  ExpTables x;
  x.pre = (int*)(smem + EXP_LDS_OFF + 28 * 1024);
  x.hoff = x.pre + (NE + 2);
  x.cntl = x.hoff + (NE + 2);
  x.t2e = (unsigned char*)(x.cntl + (NE + 2));
  const int tid = TIDX();
  if (tid == 0) {
    int s = 0, ho = 0;
    for (int e = 0; e < NE; ++e) { const int ce = p.cnt[l * NE + e]; const int nt = (ce + 255) / 256; x.pre[e] = s; x.hoff[e] = ho; x.cntl[e] = ce; s += nt; ho += nt * 256; }
    x.pre[NE] = s; x.hoff[NE] = ho; x.cntl[NE] = rows; s += rows / 256; x.pre[NE + 1] = s;
  }
  __syncthreads();
  {
    const int R = x.pre[NE + 1];
    for (int t = tid; t < R; t += NT) {
      int e = 0;
#pragma unroll
      for (int step = 64; step >= 1; step >>= 1) { const int c = e + step; if (c <= NE && x.pre[c] <= t) e = c; }
      x.t2e[t] = (unsigned char)e;
    }
  }
  __syncthreads();
  return x;
}
DI void ph_e1(const Params& p, int l, char* smem) {
  const int rows = (l == 0) ? T : TL;
  const ExpTables x = expert_tables(p, l, rows, smem);
  E1Sched S;
  S.pre = x.pre; S.cntl = x.cntl; S.t2e = x.t2e; S.nN = FF / 128; S.G = gridDim.x; S.c = BIDX(); S.total = x.pre[NE + 1] * S.nN;
  S.A = (const char*)p.HL; S.W = (const char*)p.wt_exp; S.etok = p.etok;
  S.preload((unsigned*)(smem + EXP_LDS_OFF), 24);
  EpiE1 E{p.Hbuf, x.hoff};
  pg8::gemm_phase(smem, D, S, E);
  __syncthreads();
}
DI void ph_e2(const Params& p, int l, char* smem) {
  const int rows = (l == 0) ? T : TL;
  const ExpTables x = expert_tables(p, l, rows, smem);
  E2Sched S;
  S.pre = x.pre; S.cntl = x.cntl; S.t2e = x.t2e; S.nN = D / 256; S.G = gridDim.x; S.c = BIDX(); S.total = x.pre[NE + 1] * S.nN;
  S.A = (const char*)p.Hbuf; S.W = (const char*)p.wt_exp; S.hoff = x.hoff;
  EpiE2 E{p.acc, p.etok, p.egate, (float*)(smem + EXP_LDS_OFF), p.SHo};
  pg8::gemm_phase(smem, FF, S, E);
  __syncthreads();
}

DI void ph_combine(const Params& p, int l) {
  const int tid = TIDX(), lane = tid & 63, wave = tid >> 6;
  const int rows = (l == 0) ? T : TL;
  constexpr int NV = D / 256;
  constexpr int RPW = 2;
  const float* lg = p.ln_g + ((size_t)l * 2 + 1) * D;
  const float* lb = p.ln_b + ((size_t)l * 2 + 1) * D;
  for (int tile = BIDX(); tile < rows / (8 * RPW); tile += gridDim.x) {
    f32x4 xv[RPW][NV];
    float s[RPW];
#pragma unroll
    for (int u = 0; u < RPW; ++u) {
      const int r = tile * (8 * RPW) + u * 8 + wave;
      const float* x1 = x1row(p, r);
      const float* m = modp(p, l, r);
      s[u] = 0.f;
#pragma unroll
      for (int i = 0; i < NV; ++i) {
        const int e = 4 * lane + 256 * i;
        const u32x2 aw = *(const u32x2*)(p.acc + (size_t)r * (D / 2) + e / 2);
        float m0, m1, m2, m3;
        acc_unpack4(aw[0], aw[1], m0, m1, m2, m3);
        const f32x4 xx = *(const f32x4*)(x1 + e), gg = *(const f32x4*)(m + 5 * D + e);
        const f32x4 sh4 = ld_bf4(p.SHo + (size_t)r * D + e);
        xv[u][i][0] = DN_ALPHA * xx[0] + gg[0] * (m0 + sh4[0]); xv[u][i][1] = DN_ALPHA * xx[1] + gg[1] * (m1 + sh4[1]);
        xv[u][i][2] = DN_ALPHA * xx[2] + gg[2] * (m2 + sh4[2]); xv[u][i][3] = DN_ALPHA * xx[3] + gg[3] * (m3 + sh4[3]);
        s[u] += (xv[u][i][0] + xv[u][i][1]) + (xv[u][i][2] + xv[u][i][3]);
      }
    }
#pragma unroll
    for (int u = 0; u < RPW; ++u) {
      const int r = tile * (8 * RPW) + u * 8 + wave;
      float* x1 = x1row(p, r);
      const float* m = modp(p, l, r);
      const float mu = wave_sum(s[u]) * (1.f / (float)D);
      float s2 = 0.f;
#pragma unroll
      for (int i = 0; i < NV; ++i)
#pragma unroll
        for (int j = 0; j < 4; ++j) { float dd = xv[u][i][j] - mu; s2 += dd * dd; }
      const float rstd = rsqrtf(wave_sum(s2) * (1.f / (float)D) + LN_EPS);
      const float* m1 = (l + 1 < DEPTH) ? modp(p, l + 1, r) : m;
#pragma unroll
      for (int i = 0; i < NV; ++i) {
        const int e = 4 * lane + 256 * i;
        const f32x4 g4 = *(const f32x4*)(lg + e), b4 = *(const f32x4*)(lb + e);
        f32x4 xn;
#pragma unroll
        for (int j = 0; j < 4; ++j) xn[j] = (xv[u][i][j] - mu) * rstd * g4[j] + b4[j];
        if (r < TL) *(f32x4*)(x1 + e) = xn;
        if (l + 1 < DEPTH) {
          const f32x4 sc = *(const f32x4*)(m1 + D + e), sh = *(const f32x4*)(m1 + e);
          f32x4 o;
#pragma unroll
          for (int j = 0; j < 4; ++j) o[j] = xn[j] * (1.f + sc[j]) + sh[j];
          st_bf4(p.HL + (size_t)r * D + e, o);
        }
      }
    }
  }
}

constexpr int PH_PER_LAYER = 10;
constexpr int NPHASES = 2 + PH_PER_LAYER * DEPTH;
DI void run_phase(const Params& p, int ph, char* smem) {
  if (ph == 0) { ph_prologue(p, smem); return; }
  if (ph == 1) { ph_premod(p); return; }
  const int l = (ph - 2) / PH_PER_LAYER, q = (ph - 2) % PH_PER_LAYER;
  switch (q) {
    case 0: ph_inproj(p, l, smem); break;
    case 1: ph_mix(p, l, smem); break;
    case 2: ph_prep(p, l, smem); break;
    case 3: ph_scan(p, smem); break;
    case 4: ph_assemble(p, l, smem); break;
    case 5: ph_outproj(p, l, smem); break;
    case 6: ph_ln_router(p, l, smem); break;
    case 7: ph_e1(p, l, smem); break;
    case 8: ph_e2(p, l, smem); break;
    case 9: ph_combine(p, l); break;
  }
}

static inline size_t al256(size_t x) { return (x + 255) & ~(size_t)255; }
static inline size_t max2(size_t a, size_t b) { return a > b ? a : b; }
static Params make_params(void* const* d_in, void* d_out, void* d_ws, size_t* used) {
  Params p{};
  const float** f = (const float**)&p;
  for (int i = 0; i < 42; ++i) f[i] = (const float*)d_in[i];
  p.out = (float*)d_out;
  char* w = (char*)d_ws;
  size_t o = 0;
  auto take = [&](size_t bytes) { char* r = w + o; o = al256(o + bytes); return r; };
  p.HL = (u16*)take((size_t)T * D * 2);
  p.mod = (float*)take((size_t)DEPTH * (NB + 1) * 6 * D * 4);
  p.h3lat = (float*)take((size_t)DEPTH * SEQ * 64 * 4);
  p.h3ctx = (float*)take((size_t)DEPTH * CTXL * 64 * 4);
  p.tw = (cf*)take((size_t)(FFTN / 2) * 8);
  p.tstamp = (long long*)take(64 * 8);
  p.bar = (unsigned*)take((size_t)XCD_BAR_WORDS * 4);
  p.cnt = (int*)take((size_t)DEPTH * NE * 4);
  p.sbonus = (float*)take((size_t)T * RW_H * 4);
  p.XC = (float*)take((size_t)TC * D * 4);
  p.wt_in = (u16*)take((size_t)DEPTH * P_IN_PAD * D * 2);
  p.wt_out = (u16*)take((size_t)DEPTH * D * MIX_W * 2);
  p.wt_rhi = (u16*)take((size_t)DEPTH * NE * D * 2);
  p.wt_rlo = (u16*)take((size_t)DEPTH * NE * D * 2);
  p.wt_wup = (u16*)take((size_t)DEPTH * 2 * RW_CH * DRK * 2);
  p.wt_aup = (u16*)take((size_t)DEPTH * 2 * RW_CH * IRK * 2);
  p.wt_gup = (u16*)take((size_t)DEPTH * RW_CH * GRK * 2);
  const size_t szEt = al256((size_t)NE * T * 4);
  char* G = take(max2(max2((size_t)T * RW_CH * 2, (size_t)2 * HY_CH * FFTN * 8), 2 * szEt));
  p.spec = (cf*)G;
  p.gbuf = (u16*)G;
  p.etok = (int*)G;
  p.egate = (float*)(G + szEt);
  const size_t szPAPH = (size_t)T * PA_W * 2 + (size_t)T * PH_W * 2;
  const size_t szSIsh = (size_t)T * RW_H * 192 * 2;
  const size_t szWexp = (size_t)(NE + 1) * EXP_STRIDE * 2;
  char* R0 = take(max2(max2(szPAPH, szSIsh), szWexp));
  p.PA = (u16*)R0;
  p.PH = (u16*)(R0 + (size_t)T * PA_W * 2);
  p.SIsh_lat = (u16*)R0;
  p.SIsh_ctx = p.SIsh_lat + (size_t)NB * RW_H * SEQ * 192;
  p.wt_exp = (u16*)R0;
  const size_t szPR = (size_t)T * RW_COLS * 2, szY = (size_t)2 * T * RW_CH * 2;
  char* R1 = take(max2(szPR, szY));
  p.PR = (u16*)R1;
  p.ybuf = (u16*)R1;
  const size_t szSIdir = (size_t)2 * T * RW_H * 192 * 2;
  const size_t szYC = al256((size_t)T * MIX_W * 2);
  char* R2 = take(max2(szSIdir, szYC));
  p.SIdir_lat = (u16*)R2;
  p.SIdir_ctx = p.SIdir_lat + (size_t)2 * NB * RW_H * SEQ * 192;
  p.ycat = (u16*)R2;
  p.acc = (int*)R1;
  const size_t szAcc = al256((size_t)T * (D / 2) * 4);
  const size_t szH = (size_t)(T * TOPK + T + (NE + 1) * 256) * FF * 2;
  p.Hbuf = (u16*)(R1 + szAcc);
  const size_t szSH = al256((size_t)T * D * 2);
  p.SHo = (u16*)(R1 + szAcc + al256(szH));
  p.ya = (u16*)take((size_t)T * CONV_CH * 2);
  p.yhlat = (u16*)take((size_t)NB * HY_CH * SEQ * 2);
  p.yhctx = (u16*)take((size_t)NB * HY_CH * CTXL * 2);
  if (szAcc + al256(szH) + szSH > al256(max2(szPR, szY)) + al256(max2(szSIdir, szYC))) o = (size_t)1 << 62;
  *used = o;
  return p;
}
static size_t ws_needed() {
  return (size_t)640 * 1024 * 1024;
}

#ifndef EMU
constexpr int NFIELDS = sizeof(Params) / 8;
static_assert(sizeof(Params) % 8 == 0 && sizeof(Params) <= 1024, "Params layout");
DI unsigned long long uni64(unsigned long long v) {
  unsigned lo = __builtin_amdgcn_readfirstlane((unsigned)v), hi = __builtin_amdgcn_readfirstlane((unsigned)(v >> 32));
  return ((unsigned long long)hi << 32) | lo;
}
DI void load_params(Params& q, const char* smem) {
  const unsigned long long* src = (const unsigned long long*)(smem + SMEM_BYTES - 1024);
  char** dst = (char**)&q;
  typedef __attribute__((address_space(1))) char gchar_t;
#pragma clang loop unroll(full)
  for (int i = 0; i < NFIELDS; ++i) dst[i] = (char*)(gchar_t*)uni64(src[i]);
}
__global__ void __launch_bounds__(NT) hybrid_mega(Params parg) {
  __shared__ __attribute__((aligned(16))) char smem[SMEM_BYTES];
  if (threadIdx.x < NFIELDS)
    ((unsigned long long*)(smem + SMEM_BYTES - 1024))[threadIdx.x] = ((const unsigned long long*)&parg)[threadIdx.x];
  volatile LAS unsigned* st = (volatile LAS unsigned*)(smem + SMEM_BYTES - 16);
  if (threadIdx.x == 0) { st[0] = 0u; st[1] = 0u; }
  __syncthreads();
  const XcdBarrier xb = xcd_barrier_post(parg.bar, st);
#if PROF_SEG
  if (blockIdx.x == 0 && threadIdx.x < 16) parg.tstamp[32 + threadIdx.x] = 0;
#endif
#if PROF_A || PROF_B || PROF_C || PROF_SEG
#define MK_STAMP(ph) if (blockIdx.x == 0 && threadIdx.x == 0) p.tstamp[ph] = (long long)__builtin_amdgcn_s_memrealtime();
#else
#define MK_STAMP(ph)
#endif
#define MK_PHASE(ph) { Params p; load_params(p, smem); MK_STAMP(ph) run_phase(p, ph, smem); if ((ph) + 1 < NPHASES) xcd_barrier(xb); }
  MK_PHASE(0) MK_PHASE(1) MK_PHASE(2) MK_PHASE(3) MK_PHASE(4) MK_PHASE(5) MK_PHASE(6) MK_PHASE(7) MK_PHASE(8) MK_PHASE(9) MK_PHASE(10)
  MK_PHASE(11) MK_PHASE(12) MK_PHASE(13) MK_PHASE(14) MK_PHASE(15) MK_PHASE(16) MK_PHASE(17) MK_PHASE(18) MK_PHASE(19) MK_PHASE(20) MK_PHASE(21)
  static_assert(NPHASES == 22, "phase program");
#if PROF_A || PROF_B || PROF_C || PROF_SEG
  {
    xcd_barrier(xb);
    Params p;
    load_params(p, smem);
    if (blockIdx.x == 0 && threadIdx.x == 0) p.tstamp[NPHASES] = (long long)__builtin_amdgcn_s_memrealtime();
    xcd_barrier(xb);
    const long long* ts = p.tstamp;
    float tot = (float)(ts[NPHASES] - ts[0]);
    (void)tot;
    float ta = 0.f, tb = 0.f;
    long long tc = 0;
    for (int ph = 0; ph < NPHASES; ++ph) {
      float dt = (float)(ts[ph + 1] - ts[ph]);
      if ((PROF_A >> ph) & 1) ta += dt;
      if ((PROF_B >> ph) & 1) tb += dt;
      if ((PROF_C >> ph) & 1) tc += ts[ph + 1] - ts[ph];
    }
#if PROF_SEG
    {
      float st_ = 0.f;
      for (int k = 0; k < 16; ++k) st_ += (float)ts[32 + k];
      ta = (float)ts[32 + PROF_SA]; tb = (float)ts[32 + PROF_SB]; tot = st_ > 0.f ? st_ : 1.f;
      tc = ts[32 + PROF_SC];
    }
#endif
    float fa = ta / tot, fb = tb / tot;
#if PROF_SEG
    fa = floorf(fa * 50.f + 0.5f) * (1.f / 50.f); fb = floorf(fb * 45.f + 0.5f) * (1.f / 45.f);
#endif
    const float da = sqrtf(0.5f * fa);
    const size_t NA = (size_t)TL * D / 100;
    if (!PROF_SEG) for (size_t i = (size_t)blockIdx.x * NT + threadIdx.x; i < NA; i += (size_t)gridDim.x * NT) p.out[i] += da;
    if (PROF_B && !PROF_SEG && blockIdx.x == 0 && threadIdx.x == 0) p.out[(size_t)TL * D - 1] += 10.f + 90.f * fb;
    if (PROF_C || PROF_SEG) { while ((long long)__builtin_amdgcn_s_memrealtime() < ts[NPHASES] + tc) {} }
  }
#endif
}
#ifdef MULTI_LAUNCH
__global__ void __launch_bounds__(NT) hybrid_phase(Params p, int ph) {
  __shared__ __attribute__((aligned(16))) char smem[SMEM_BYTES];
  run_phase(p, ph, smem);
}
#endif

extern "C" void kernel_launch(void* const* d_in, const int* in_sizes, int n_in, void* d_out, int out_size, void* d_ws,
                              size_t ws_size, hipStream_t stream) {
  (void)in_sizes; (void)n_in; (void)out_size;
  static int grid_blocks = 0;
  if (!grid_blocks) {
    int dev = 0, cus = 0, per_cu = 0;
    hipGetDevice(&dev);
    hipDeviceGetAttribute(&cus, hipDeviceAttributeMultiprocessorCount, dev);
    hipOccupancyMaxActiveBlocksPerMultiprocessor(&per_cu, hybrid_mega, NT, 0);
    if (per_cu < 1) per_cu = 1;
    grid_blocks = cus;
  }
  size_t used = 0;
  Params p = make_params(d_in, d_out, d_ws, &used);
  if (used > ws_size) return;
#ifdef MULTI_LAUNCH
  for (int ph = 0; ph < NPHASES; ++ph) hipLaunchKernelGGL(hybrid_phase, dim3(grid_blocks), dim3(NT), 0, stream, p, ph);
#else
  hipMemsetAsync(p.bar, 0, (size_t)XCD_BAR_WORDS * 4, stream);
  void* args[] = {&p};
  hipLaunchCooperativeKernel((void*)hybrid_mega, dim3(grid_blocks), dim3(NT), args, 0, stream);
#endif
}
#endif
```

```cpp
#ifdef EMU
#include "emu_hip.h"
#else
#include <hip/hip_runtime.h>
#endif
#include <stdint.h>
#include <stddef.h>

#define DI __device__ __forceinline__

#ifdef CFG_SMALL
constexpr int D = 512, NB = 2, SEQ = 256, GRID_W = 16, CTXL = 256, CONV_CH = 128, HY_CH = 128, RW_H = 4;
#else
constexpr int D = 1024, NB = 8, SEQ = 4096, GRID_W = 64, CTXL = 256, CONV_CH = 256, HY_CH = 256, RW_H = 8;
#endif
constexpr int DEPTH = 2;
constexpr int HD = 64;
constexpr int RW_CH = RW_H * HD;
constexpr int MIX_W = CONV_CH + HY_CH + RW_CH;
constexpr int DRK = 64, IRK = 64, GRK = 128;
constexpr int RW_COLS = 3 * RW_CH + 2 * DRK + 2 * IRK + GRK;
constexpr int PA_W = 3 * CONV_CH, PH_W = 3 * HY_CH;
constexpr int P_IN = PA_W + PH_W + RW_COLS;
constexpr int P_IN_PAD = ((P_IN + 255) / 256) * 256;
constexpr int HY_EMB = 33, HY_BANDS = 16, HY_HID = 64;
constexpr int NE = 64, TOPK = 8, FF = 256;
constexpr int TL = NB * SEQ, TC = NB * CTXL, T = TL + TC;
constexpr int FFTN = 2 * SEQ;
constexpr int ilog2c(int n) { return n <= 1 ? 0 : 1 + ilog2c(n / 2); }
constexpr int LOG2N = ilog2c(FFTN);
constexpr float LN_EPS = 1e-5f;
constexpr float RW_GN_EPS = 64e-5f;
constexpr float DN_ALPHA = 1.41421356237309515f;
constexpr float ROUTED_SCALE = 2.5f;
constexpr int NT = 512;
#ifndef PROF_A
#define PROF_A 0
#endif
#ifndef PROF_B
#define PROF_B 0
#endif
#ifndef PROF_C
#define PROF_C 0
#endif
constexpr int SMEM_BYTES = 160 * 1024;
static_assert(MIX_W == D, "mix width");
static_assert(D % 128 == 0 && P_IN % 128 == 0 && PA_W % 128 == 0 && PH_W % 128 == 0, "tiles");
static_assert(SEQ % 256 == 0 && CTXL % 256 == 0, "row tiles");

typedef unsigned short u16;
typedef __attribute__((ext_vector_type(8))) short bf16x8;
typedef __attribute__((ext_vector_type(16))) float f32x16;
typedef __attribute__((ext_vector_type(4))) unsigned u32x4;
typedef __attribute__((ext_vector_type(2))) unsigned u32x2;
typedef __attribute__((ext_vector_type(4))) float f32x4;
struct cf { float x, y; };

struct Params {
  const float *x, *c, *ctx, *c_ctx, *w_ada, *b_ada, *w_in, *conv_a, *hy_sconv_w, *hy_sconv_b;
  const float *hf_w1, *hf_b1, *hf_w2, *hf_b2, *hf_w3, *hf_b3, *hf_wout, *hf_freq, *hf_skip;
  const float *rw_mu, *rw_w0, *rw_w_up, *rw_a0, *rw_a_up, *rw_g_up, *rw_k_k, *rw_k_a, *rw_r_k;
  const float *rw_lnx_g, *rw_lnx_b, *mix_norm_g, *w_out, *ln_g, *ln_b, *w_router, *e_bias;
  const float *w_e_gate, *w_e_up, *w_e_down, *w_s_gate, *w_s_up, *w_s_down;
  float* out;
  float* mod;
  float* h3lat;
  float* h3ctx;
  cf* tw;
  int* cnt;
  float* sbonus;
  cf* spec;
  u16* HL;
  u16* PA;
  u16* PH;
  u16* PR;
  u16* SIsh_lat;
  u16* SIsh_ctx;
  u16* SIdir_lat;
  u16* SIdir_ctx;
  u16* ya;
  u16* yhlat;
  u16* yhctx;
  u16* gbuf;
  u16* ybuf;
  u16* ycat;
  float* XC;
  u16* wt_in;
  u16* wt_out;
  u16* wt_rhi;
  u16* wt_rlo;
  u16* wt_wup;
  u16* wt_aup;
  u16* wt_gup;
  u16* Hbuf;
  u16* SHo;
  u16* wt_exp;
  int* acc;
  int* etok;
  float* egate;
  long long* tstamp;
  unsigned* bar;
};


#ifndef PROF_SEG
#define PROF_SEG 0
#endif
#if PROF_SEG && !defined(EMU)
#define SEG_BEGIN(p) long long seg_last_ = 0; const bool seg_on_ = (blockIdx.x == 0 && threadIdx.x == 0); if (seg_on_) seg_last_ = (long long)__builtin_amdgcn_s_memrealtime();
#define SEG_MARK(p, k) if (seg_on_) { long long now_ = (long long)__builtin_amdgcn_s_memrealtime(); (p).tstamp[32 + (k)] += now_ - seg_last_; seg_last_ = now_; }
#else
#define SEG_BEGIN(p)
#define SEG_MARK(p, k)
#endif
#ifdef EMU
DI int TIDX() { return threadIdx.x; }
DI int BIDX() { return blockIdx.x; }
#else
DI int TIDX() { int t = threadIdx.x; asm volatile("" : "+v"(t)); return t; }
DI int BIDX() { int b = blockIdx.x; asm volatile("" : "+s"(b)); return b; }
#endif

#ifdef EMU
DI u16 f2bf(float x) {
  unsigned u = __builtin_bit_cast(unsigned, x);
  u += 0x7fffu + ((u >> 16) & 1u);
  return (u16)(u >> 16);
}
#else
DI u16 f2bf(float x) { return __builtin_bit_cast(u16, (__bf16)x); }
#endif
DI float bf2f(u16 h) { return __builtin_bit_cast(float, ((unsigned)h) << 16); }
DI u16 f2h(float x) { return __builtin_bit_cast(u16, (_Float16)x); }
DI float h2f(u16 h) { return (float)__builtin_bit_cast(_Float16, h); }
#ifdef EMU
DI unsigned pk2(float a, float b) { return (unsigned)f2bf(a) | ((unsigned)f2bf(b) << 16); }
#else
DI unsigned pk2(float a, float b) {
  typedef __bf16 bf16v2 __attribute__((ext_vector_type(2)));
  bf16v2 v; v[0] = (__bf16)a; v[1] = (__bf16)b;
  return __builtin_bit_cast(unsigned, v);
}
#endif
DI float sigmoidf_(float x) { return 1.0f / (1.0f + expf(-x)); }
DI float siluf_(float x) { return x / (1.0f + expf(-x)); }
DI float softplusf_(float x) { return x > 20.f ? x : log1pf(expf(x)); }
#ifdef EMU
DI float fexp_(float x) { return expf(x); }
DI float frcp_(float x) { return 1.0f / x; }
#else
DI float fexp_(float x) { return __builtin_amdgcn_exp2f(x * 1.44269504088896341f); }
DI float frcp_(float x) { return __builtin_amdgcn_rcpf(x); }
#endif
DI float fsigmoid_(float x) { return frcp_(1.0f + fexp_(-x)); }
DI float ftanh_(float x) { return 1.0f - 2.0f * frcp_(1.0f + fexp_(2.0f * x)); }

#ifdef EMU
DI float red16(float v) { v += __shfl_xor(v, 1); v += __shfl_xor(v, 2); v += __shfl_xor(v, 4); v += __shfl_xor(v, 8); return v; }
DI float wave_sum(float v) {
#pragma unroll
  for (int m = 1; m < 64; m <<= 1) v += __shfl_xor(v, m);
  return v;
}
#else
template <int CTRL> DI float dppf(float v) {
  return __builtin_bit_cast(float, __builtin_amdgcn_update_dpp(0, __builtin_bit_cast(int, v), CTRL, 0xf, 0xf, true));
}
DI float red16(float v) {
  v += dppf<0xB1>(v);
  v += dppf<0x4E>(v);
  v += dppf<0x141>(v);
  v += dppf<0x140>(v);
  return v;
}
DI float wave_sum(float v) {
  v = red16(v);
  int iv = __builtin_bit_cast(int, v);
  float a = __builtin_bit_cast(float, __builtin_amdgcn_readlane(iv, 0));
  float b = __builtin_bit_cast(float, __builtin_amdgcn_readlane(iv, 16));
  float c = __builtin_bit_cast(float, __builtin_amdgcn_readlane(iv, 32));
  float d = __builtin_bit_cast(float, __builtin_amdgcn_readlane(iv, 48));
  return (a + b) + (c + d);
}
#endif
#ifdef EMU
DI float wave_max(float v) {
#pragma unroll
  for (int m = 1; m < 64; m <<= 1) v = fmaxf(v, __shfl_xor(v, m));
  return v;
}
#else
DI float wave_max(float v) {
  v = fmaxf(v, dppf<0xB1>(v));
  v = fmaxf(v, dppf<0x4E>(v));
  v = fmaxf(v, dppf<0x141>(v));
  v = fmaxf(v, dppf<0x140>(v));
  int iv = __builtin_bit_cast(int, v);
  float a = __builtin_bit_cast(float, __builtin_amdgcn_readlane(iv, 0));
  float b = __builtin_bit_cast(float, __builtin_amdgcn_readlane(iv, 16));
  float c = __builtin_bit_cast(float, __builtin_amdgcn_readlane(iv, 32));
  float d = __builtin_bit_cast(float, __builtin_amdgcn_readlane(iv, 48));
  return fmaxf(fmaxf(a, b), fmaxf(c, d));
}
#endif
DI void wave_sync() {
#ifdef EMU
  emu::wave_barrier();
#else
  asm volatile("s_waitcnt lgkmcnt(0)" ::: "memory");
  __builtin_amdgcn_wave_barrier();
#endif
}
DI f32x4 ld_bf4(const u16* q) {
  u32x2 v = *(const u32x2*)q;
  f32x4 r;
  r[0] = bf2f((u16)(v[0] & 0xffff)); r[1] = bf2f((u16)(v[0] >> 16));
  r[2] = bf2f((u16)(v[1] & 0xffff)); r[3] = bf2f((u16)(v[1] >> 16));
  return r;
}
DI void st_bf4(u16* q, f32x4 v) {
  u32x2 o; o[0] = pk2(v[0], v[1]); o[1] = pk2(v[2], v[3]);
  *(u32x2*)q = o;
}
DI int crow(int reg, int h) { return (reg & 3) + 8 * (reg >> 2) + 4 * h; }
#define MFMA32(a, b, c) __builtin_amdgcn_mfma_f32_32x32x16_bf16((a), (b), (c), 0, 0, 0)

DI int modrow(int r) { return r < TL ? r / SEQ : NB; }
DI const float* modp(const Params& p, int l, int r) { return p.mod + ((size_t)l * (NB + 1) + modrow(r)) * (6 * D); }


#define XB_TMO      128
#define XB_TICKET   192
#define XB_XCNT(j)  (256  + 64 * (j))
#define XB_XSUB(j)  (1280 + 64 * (j))
#define XB_XGEN(j)  (2304 + 64 * (j))
#define XB_TOP      3328
#define XB_TOPGEN   3392
#define XCD_BAR_WORDS 3456
#ifndef EMU
#define XB_SPIN_CAP (1u << 22)
#define LAS __attribute__((address_space(3)))
DI unsigned xb_ld(unsigned* p) { return __hip_atomic_load(p, __ATOMIC_RELAXED, __HIP_MEMORY_SCOPE_AGENT); }
DI unsigned xb_add(unsigned* p, unsigned v) { return __hip_atomic_fetch_add(p, v, __ATOMIC_RELAXED, __HIP_MEMORY_SCOPE_AGENT); }
DI unsigned xb_xcc_id() { return (unsigned)__builtin_amdgcn_s_getreg((3 << 11) | 20) & 0xFu; }
#define XB_SPIN(cond, bar) do { unsigned _sp = 0; while (cond) { __builtin_amdgcn_s_sleep(1); \
    if ((++_sp & 255u) == 0u) { if (xb_ld(&(bar)[XB_TMO])) break; if (_sp > XB_SPIN_CAP) { atomicAdd(&(bar)[XB_TMO], 1u); break; } } } } while (0)
struct XcdBarrier { unsigned* bar; unsigned x; volatile LAS unsigned* st; };
DI XcdBarrier xcd_barrier_post(unsigned* bar, volatile LAS unsigned* st) {
  XcdBarrier b; b.bar = bar; b.x = xb_xcc_id(); b.st = st;
  if (threadIdx.x == 0) (void)xb_add(&bar[XB_XCNT(b.x)], 1u);
  return b;
}
DI void xcd_barrier_complete(unsigned* bar, unsigned x, unsigned& nloc, unsigned& nx) {
  const unsigned G = gridDim.x * gridDim.y * gridDim.z;
  unsigned sum, cnt, mine, sp = 0u;
  for (;;) {
    sum = 0u; cnt = 0u; mine = 0u;
#pragma unroll
    for (unsigned j = 0; j < 16; ++j) { const unsigned c = xb_ld(&bar[XB_XCNT(j)]); sum += c; cnt += (c > 0u) ? 1u : 0u; mine = (j == x) ? c : mine; }
    if (sum == G) break;
    __builtin_amdgcn_s_sleep(1);
    if ((++sp & 255u) == 0u) { if (xb_ld(&bar[XB_TMO])) break; if (sp > XB_SPIN_CAP) { atomicAdd(&bar[XB_TMO], 1u); break; } }
  }
  nloc = mine > 0u ? mine : 1u; nx = cnt > 0u ? cnt : 1u;
}
DI void xcd_barrier(const XcdBarrier& b) {
  asm volatile("s_waitcnt vmcnt(0)" ::: "memory");
  __syncthreads();
  if (threadIdx.x == 0) {
    unsigned* bar = b.bar;
    __builtin_amdgcn_s_waitcnt(0);
    unsigned nloc = b.st[0], nx = b.st[1];
    if (nloc == 0u) { xcd_barrier_complete(bar, b.x, nloc, nx); b.st[0] = nloc; b.st[1] = nx; }
    const unsigned old = xb_add(&bar[XB_XSUB(b.x)], 1u);
    const unsigned gen = old / nloc;
    if (old + 1u == (gen + 1u) * nloc) {
      __builtin_amdgcn_fence(__ATOMIC_RELEASE, "agent");
      asm volatile("s_waitcnt vmcnt(0)" ::: "memory");
      const unsigned og = xb_add(&bar[XB_TOP], 1u);
      const unsigned tg = og / nx;
      if (og + 1u == (tg + 1u) * nx) xb_add(&bar[XB_TOPGEN], 1u);
      else XB_SPIN(xb_ld(&bar[XB_TOPGEN]) == tg, bar);
      __builtin_amdgcn_fence(__ATOMIC_ACQUIRE, "agent");
      xb_add(&bar[XB_XGEN(b.x)], 1u);
      asm volatile("s_waitcnt vmcnt(0)" ::: "memory");
    } else {
      XB_SPIN(xb_ld(&bar[XB_XGEN(b.x)]) == gen, bar);
      __builtin_amdgcn_fence(__ATOMIC_ACQUIRE, "agent");
      asm volatile("s_waitcnt vmcnt(0)" ::: "memory");
    }
  }
  __syncthreads();
}
#endif

namespace pg8 {
constexpr int BM = 256, BK = 64, HALF = 128, HTB = HALF * BK * 2, STAGE_BYTES = 8 * HTB;
struct Unit { int pm, pn, e, cnt, idx; };
__host__ __device__ __forceinline__ int lds_byte(int r, int c) { const int st = (r >> 4) * 2 + (c >> 5), rr = r & 15, cc = c & 31, ob = rr * 64 + cc * 2; return st * 1024 + (ob ^ (((ob >> 9) & 1) << 5)); }
__host__ __device__ __forceinline__ void stage_rc(int b, int& R, int& C) { const int st = b / 1024, sb = b % 1024, swz = sb ^ (((sb >> 9) & 1) << 5); R = (st >> 1) * 16 + swz / 64; C = (st & 1) * 32 + (swz % 64) / 2; }

#ifdef EMU
template <class Epi, class Sched>
inline void gemm_phase(char* lds, int K, const Sched& S, const Epi& E) {
  (void)lds;
  const int tid = TIDX(), wid = tid >> 6, lane = tid & 63, wr = wid >> 2, wc = wid & 3, fr = lane & 15, fq = lane >> 4;
  Unit u;
  for (int ui = 0; S.next(ui, u); ++ui) {
    f32x4 acc[2][2][4][2];
    for (int ai = 0; ai < 2; ++ai) for (int bj = 0; bj < 2; ++bj) for (int m = 0; m < 4; ++m) for (int n = 0; n < 2; ++n) {
      const int r = 128 * ai + 64 * wr + 16 * m + fr;
      const u16* arow = (const u16*)(S.abase() + S.arow_off(u, r));
      for (int j = 0; j < 4; ++j) {
        const int c = 32 * wc + 16 * n + 4 * fq + j;
        const u16* brow = (const u16*)S.bbase(u, bj) + (size_t)c * K;
        float s = 0.f;
        for (int k = 0; k < K; ++k) s += bf2f(arow[k]) * bf2f(brow[k]);
        acc[ai][bj][m][n][j] = s;
      }
    }
    E(acc, u, wr, wc, fr, fq, E.prefetch(u, wr, lane));
  }
}
#else
#define PG8_LAS __attribute__((address_space(3)))
template <class Epi, class Sched>
__device__ __forceinline__ void gemm_phase(char* lds_generic, int K, const Sched& S, const Epi& E) {
  PG8_LAS unsigned char* lds = (PG8_LAS unsigned char*)lds_generic;
  const int tid = TIDX(), wid = __builtin_amdgcn_readfirstlane(tid >> 6), lane = tid & 63, wr = wid >> 2, wc = wid & 3, fr = lane & 15, fq = lane >> 4;
  const int nt = K / BK;
  int Rr[2], Cc[2];
  unsigned voffB[2];
#pragma unroll
  for (int i = 0; i < 2; ++i) { stage_rc(tid * 16 + i * 8192, Rr[i], Cc[i]); voffB[i] = (unsigned)(Rr[i] * K + Cc[i]) * 2u; }
  const size_t kstep = (size_t)(BK * 2);
  const unsigned ldsw = (unsigned)wid * 1024u;
  const int aoff = lds_byte(wr * 64 + fr, fq * 8), boff = lds_byte(wc * 32 + fr, fq * 8);
#define PG8_SA(b, h) (((b) * 2 + (h)) * HTB)
#define PG8_SB(b, h) ((4 + (b) * 2 + (h)) * HTB)
#define PG8_STAGE2(bufoff, gbase, v0, v1) do { \
    __builtin_amdgcn_global_load_lds((const unsigned*)((const char*)(gbase) + (v0)), (PG8_LAS unsigned*)(lds + (bufoff) + ldsw), 16, 0, 0); \
    __builtin_amdgcn_global_load_lds((const unsigned*)((const char*)(gbase) + (v1)), (PG8_LAS unsigned*)(lds + (bufoff) + ldsw + 8192), 16, 0, 0); } while (0)
#define PG8_STAGEB(bufoff, gbase) PG8_STAGE2(bufoff, gbase, voffB[0], voffB[1])
#define PG8_LDA(dst, b, h) do { _Pragma("unroll") for (int m = 0; m < 4; ++m) _Pragma("unroll") for (int k = 0; k < 2; ++k) dst[m][k] = *(const PG8_LAS bf16x8*)(lds + PG8_SA(b, h) + aoff + m * 2048 + k * 1024); } while (0)
#define PG8_LDB(dst, b, h) do { _Pragma("unroll") for (int n = 0; n < 2; ++n) _Pragma("unroll") for (int k = 0; k < 2; ++k) dst[n][k] = *(const PG8_LAS bf16x8*)(lds + PG8_SB(b, h) + boff + n * 2048 + k * 1024); } while (0)
#define PG8_MMA(ai, bj, At, Bt) do { __builtin_amdgcn_s_setprio(1); _Pragma("unroll") for (int m = 0; m < 4; ++m) _Pragma("unroll") for (int n = 0; n < 2; ++n) _Pragma("unroll") for (int k = 0; k < 2; ++k) \
    acc[ai][bj][m][n] = __builtin_amdgcn_mfma_f32_16x16x32_bf16(Bt[n][k], At[m][k], acc[ai][bj][m][n], 0, 0, 0); __builtin_amdgcn_s_setprio(0); } while (0)
#define PG8_WAIT_V(n) asm volatile("s_waitcnt vmcnt(" #n ")" ::: "memory")
#define PG8_WAIT_L(n) asm volatile("s_waitcnt lgkmcnt(" #n ")" ::: "memory")
#define PG8_BAR __builtin_amdgcn_s_barrier()
#define PG8_SCHED __builtin_amdgcn_sched_barrier(0)
  Unit cur, nxt; int ui = 0;
  if (!S.next(0, cur)) return;
  f32x4 acc[2][2][4][2];
#pragma unroll
  for (int a = 0; a < 2; ++a)
#pragma unroll
    for (int b = 0; b < 2; ++b)
#pragma unroll
      for (int m = 0; m < 4; ++m)
#pragma unroll
        for (int n = 0; n < 2; ++n) acc[a][b][m][n] = (f32x4){0.f, 0.f, 0.f, 0.f};
  bf16x8 At[4][2], B0[2][2], B1[2][2];
  const char* const gA = S.abase();
  unsigned cv00 = 0, cv01 = 0, cv10 = 0, cv11 = 0, nv00 = 0, nv01 = 0, nv10 = 0, nv11 = 0;
  const char *cA0 = gA, *cA1 = gA, *nA0 = gA, *nA1 = gA;
  if constexpr (Sched::GATHER) {
    cv00 = S.arow_off(cur, Rr[0]) + Cc[0] * 2u; cv01 = S.arow_off(cur, Rr[1]) + Cc[1] * 2u;
    cv10 = S.arow_off(cur, 128 + Rr[0]) + Cc[0] * 2u; cv11 = S.arow_off(cur, 128 + Rr[1]) + Cc[1] * 2u;
  } else {
    cA0 = gA + S.arow_off(cur, 0); cA1 = gA + S.arow_off(cur, 128);
  }
#define PG8_STAGE_A(bufoff, kb, h, NEXT) do { \
    if constexpr (Sched::GATHER) { PG8_STAGE2(bufoff, gA + (kb), (NEXT) ? ((h) ? nv10 : nv00) : ((h) ? cv10 : cv00), (NEXT) ? ((h) ? nv11 : nv01) : ((h) ? cv11 : cv01)); } \
    else { PG8_STAGE2(bufoff, ((NEXT) ? ((h) ? nA1 : nA0) : ((h) ? cA1 : cA0)) + (kb), voffB[0], voffB[1]); } } while (0)
  const char* cB0 = S.bbase(cur, 0); const char* cB1 = S.bbase(cur, 1);
  PG8_STAGEB(PG8_SB(0, 0), cB0); PG8_STAGE_A(PG8_SA(0, 0), 0, 0, false); PG8_STAGEB(PG8_SB(0, 1), cB1); PG8_STAGE_A(PG8_SA(0, 1), 0, 1, false);
  if (wr == 1) PG8_BAR;
  PG8_WAIT_V(4); PG8_BAR;
  PG8_STAGEB(PG8_SB(1, 0), cB0 + kstep); PG8_STAGE_A(PG8_SA(1, 0), kstep, 0, false); PG8_STAGEB(PG8_SB(1, 1), cB1 + kstep);
  PG8_WAIT_V(6); PG8_BAR;
  for (;;) {
    const bool has_next = S.next(ui + 1, nxt);
    const char* nB0 = cB0; const char* nB1 = cB1;
    if constexpr (Sched::GATHER) { nv00 = cv00; nv01 = cv01; nv10 = cv10; nv11 = cv11; } else { nA0 = cA0; nA1 = cA1; }
    if (has_next) {
      if constexpr (Sched::GATHER) {
        nv00 = S.arow_off(nxt, Rr[0]) + Cc[0] * 2u; nv01 = S.arow_off(nxt, Rr[1]) + Cc[1] * 2u;
        nv10 = S.arow_off(nxt, 128 + Rr[0]) + Cc[0] * 2u; nv11 = S.arow_off(nxt, 128 + Rr[1]) + Cc[1] * 2u;
      } else {
        nA0 = gA + S.arow_off(nxt, 0); nA1 = gA + S.arow_off(nxt, 128);
      }
      nB0 = S.bbase(nxt, 0); nB1 = S.bbase(nxt, 1);
    }
    const typename Epi::Pre epre = E.prefetch(cur, wr, lane);
#pragma clang loop unroll(disable)
    for (int t = 0; t < nt; t += 2) {
      const bool last = (t == nt - 2);
      const size_t kb1 = (size_t)(t + 1) * kstep;
      const size_t kb2 = last ? (size_t)0 : (size_t)(t + 2) * kstep;
      const size_t kb3 = kb2 + kstep;
      const char* b20 = last ? nB0 : cB0 + (size_t)(t + 2) * kstep;
      const char* b21 = last ? nB1 : cB1 + (size_t)(t + 2) * kstep;
      const char* b30 = b20 + kstep; const char* b31 = b21 + kstep;
      PG8_LDB(B0, 0, 0); PG8_SCHED; PG8_LDA(At, 0, 0); PG8_STAGE_A(PG8_SA(1, 1), kb1, 1, false);
      PG8_WAIT_L(8); PG8_BAR; PG8_WAIT_L(0); PG8_MMA(0, 0, At, B0); PG8_BAR; PG8_SCHED;
      PG8_LDB(B1, 0, 1); PG8_STAGEB(PG8_SB(0, 0), b20);
      PG8_BAR; PG8_WAIT_L(0); PG8_MMA(0, 1, At, B1); PG8_BAR;
      PG8_LDA(At, 0, 1); PG8_STAGE_A(PG8_SA(0, 0), kb2, 0, last);
      PG8_BAR; PG8_WAIT_L(0); PG8_MMA(1, 0, At, B0); PG8_BAR; PG8_SCHED;
      PG8_STAGEB(PG8_SB(0, 1), b21);
      PG8_WAIT_V(6); PG8_BAR; PG8_MMA(1, 1, At, B1); PG8_BAR;
      PG8_LDB(B0, 1, 0); PG8_SCHED; PG8_LDA(At, 1, 0); PG8_STAGE_A(PG8_SA(0, 1), kb2, 1, last);
      PG8_WAIT_L(8); PG8_BAR; PG8_WAIT_L(0); PG8_MMA(0, 0, At, B0); PG8_BAR; PG8_SCHED;
      PG8_LDB(B1, 1, 1); PG8_STAGEB(PG8_SB(1, 0), b30);
      PG8_BAR; PG8_WAIT_L(0); PG8_MMA(0, 1, At, B1); PG8_BAR;
      PG8_LDA(At, 1, 1); PG8_STAGE_A(PG8_SA(1, 0), kb3, 0, last);
      PG8_BAR; PG8_WAIT_L(0); PG8_MMA(1, 0, At, B0); PG8_BAR; PG8_SCHED;
      PG8_STAGEB(PG8_SB(1, 1), b31);
      PG8_WAIT_V(6); PG8_BAR; PG8_MMA(1, 1, At, B1); PG8_BAR;
    }
    E(acc, cur, wr, wc, fr, fq, epre);
    if (!has_next) break;
#pragma unroll
    for (int a = 0; a < 2; ++a)
#pragma unroll
      for (int b = 0; b < 2; ++b)
#pragma unroll
        for (int m = 0; m < 4; ++m)
#pragma unroll
          for (int n = 0; n < 2; ++n) acc[a][b][m][n] = (f32x4){0.f, 0.f, 0.f, 0.f};
    cur = nxt; cB0 = nB0; cB1 = nB1; ++ui;
    if constexpr (Sched::GATHER) { cv00 = nv00; cv01 = nv01; cv10 = nv10; cv11 = nv11; } else { cA0 = nA0; cA1 = nA1; }
  }
  PG8_WAIT_V(0);
  if (wr == 0) PG8_BAR;
  PG8_BAR;
#undef PG8_SA
#undef PG8_SB
#undef PG8_STAGE2
#undef PG8_STAGE_A
#undef PG8_STAGEB
#undef PG8_LDA
#undef PG8_LDB
#undef PG8_MMA
#undef PG8_WAIT_V
#undef PG8_WAIT_L
#undef PG8_BAR
#undef PG8_SCHED
}
#endif
DI int remap_xcd(int L, int nwg) {
  const int q = nwg / 8, r = nwg % 8, xcd = L % 8, off = L / 8;
  return (xcd < r ? xcd * (q + 1) : r * (q + 1) + (xcd - r) * q) + off;
}
}

DI void convert_tile(const float* __restrict__ src, int K, int N, u16* __restrict__ dst, u16* __restrict__ dst_lo, int tile, char* smem) {
  const int tid = TIDX();
  float* t = (float*)smem;
  const int ntn = N / 64;
  const int k0 = (tile / ntn) * 64, n0 = (tile % ntn) * 64;
#pragma unroll
  for (int i = 0; i < 8; ++i) {
    const int row = i * 8 + (tid >> 6), col = tid & 63;
    t[row * 65 + col] = src[(size_t)(k0 + row) * N + n0 + col];
  }
  __syncthreads();
  const int n = tid >> 3, kq = tid & 7;
  float f[8];
#pragma unroll
  for (int j = 0; j < 8; ++j) f[j] = t[(kq * 8 + j) * 65 + n];
  u32x4 pb;
  pb[0] = pk2(f[0], f[1]); pb[1] = pk2(f[2], f[3]); pb[2] = pk2(f[4], f[5]); pb[3] = pk2(f[6], f[7]);
  *(u32x4*)(dst + (size_t)(n0 + n) * K + k0 + kq * 8) = pb;
  if (dst_lo) {
#pragma unroll
    for (int j = 0; j < 8; ++j) f[j] -= bf2f(f2bf(f[j]));
    pb[0] = pk2(f[0], f[1]); pb[1] = pk2(f[2], f[3]); pb[2] = pk2(f[4], f[5]); pb[3] = pk2(f[6], f[7]);
    *(u32x4*)(dst_lo + (size_t)(n0 + n) * K + k0 + kq * 8) = pb;
  }
  __syncthreads();
}
DI void convert_tile_w(const float* __restrict__ src, int K, int N, u16* __restrict__ dst, int tile, char* smem) {
  const int tid = TIDX();
  float* t = (float*)smem;
  const int ntn = N / 256;
  const int k0 = (tile / ntn) * 64, n0 = (tile % ntn) * 256;
#pragma unroll
  for (int i = 0; i < 8; ++i) {
    const int row = i * 8 + (tid >> 6), col = (tid & 63) * 4;
    const f32x4 v = *(const f32x4*)(src + (size_t)(k0 + row) * N + n0 + col);
    float* q = t + row * 257 + col;
    q[0] = v[0]; q[1] = v[1]; q[2] = v[2]; q[3] = v[3];
  }
  __syncthreads();
#pragma unroll
  for (int i = 0; i < 4; ++i) {
    const int idx = tid + NT * i;
    const int n = idx >> 3, kq = idx & 7;
    float f[8];
#pragma unroll
    for (int j = 0; j < 8; ++j) f[j] = t[(kq * 8 + j) * 257 + n];
    u32x4 pb;
    pb[0] = pk2(f[0], f[1]); pb[1] = pk2(f[2], f[3]); pb[2] = pk2(f[4], f[5]); pb[3] = pk2(f[6], f[7]);
    *(u32x4*)(dst + (size_t)(n0 + n) * K + k0 + kq * 8) = pb;
  }
  __syncthreads();
}
constexpr int CT_IN = (D / 64) * (P_IN / 64), CT_OUT = (MIX_W / 64) * (D / 64), CT_R = (D / 64) * (NE / 64);
constexpr int CT_WUP = (DRK / 64) * (RW_CH / 64), CT_GUP = (GRK / 64) * (RW_CH / 64);
constexpr int CT_STATIC_L = CT_IN + CT_OUT + CT_R + 4 * CT_WUP + CT_GUP;
DI void convert_static_item(const Params& p, int it, char* smem) {
  const int l = it / CT_STATIC_L;
  int q = it % CT_STATIC_L;
  if (q < CT_IN) { convert_tile(p.w_in + (size_t)l * D * P_IN, D, P_IN, p.wt_in + (size_t)l * P_IN_PAD * D, nullptr, q, smem); return; }
  q -= CT_IN;
  if (q < CT_OUT) { convert_tile(p.w_out + (size_t)l * MIX_W * D, MIX_W, D, p.wt_out + (size_t)l * D * MIX_W, nullptr, q, smem); return; }
  q -= CT_OUT;
  if (q < CT_R) { convert_tile(p.w_router + (size_t)l * D * NE, D, NE, p.wt_rhi + (size_t)l * NE * D, p.wt_rlo + (size_t)l * NE * D, q, smem); return; }
  q -= CT_R;
  if (q < 4 * CT_WUP) {
    const int which = q / CT_WUP, tile = q % CT_WUP;
    const int d = which & 1;
    if (which < 2) convert_tile(p.rw_w_up + ((size_t)l * 2 + d) * DRK * RW_CH, DRK, RW_CH, p.wt_wup + ((size_t)l * 2 + d) * RW_CH * DRK, nullptr, tile, smem);
    else convert_tile(p.rw_a_up + ((size_t)l * 2 + d) * IRK * RW_CH, IRK, RW_CH, p.wt_aup + ((size_t)l * 2 + d) * RW_CH * IRK, nullptr, tile, smem);
    return;
  }
  q -= 4 * CT_WUP;
  convert_tile(p.rw_g_up + (size_t)l * GRK * RW_CH, GRK, RW_CH, p.wt_gup + (size_t)l * RW_CH * GRK, nullptr, q, smem);
}
constexpr int CT_EMAT = (D / 64) * (FF / 256);
static_assert(FF % 256 == 0 && D % 256 == 0 && (D / 64) * (FF / 256) == (FF / 64) * (D / 256), "expert conversion tiling");
constexpr int CT_EXP_L = (NE + 1) * 3 * CT_EMAT;
constexpr size_t EXP_STRIDE = (size_t)3 * D * FF;
DI void convert_expert_item(const Params& p, int l, int it, char* smem) {
  const int e = it / (3 * CT_EMAT), m = (it / CT_EMAT) % 3, tile = it % CT_EMAT;
  const float *eg = p.w_e_gate, *eu = p.w_e_up, *ed = p.w_e_down, *sg = p.w_s_gate, *su = p.w_s_up, *sd = p.w_s_down;
#ifndef EMU
  asm volatile("" : "+s"(eg), "+s"(eu), "+s"(ed), "+s"(sg), "+s"(su), "+s"(sd));
#endif
  const float* src;
  if (e < NE) src = (m == 0 ? eg : m == 1 ? eu : ed) + ((size_t)l * NE + e) * D * FF;
  else src = (m == 0 ? sg : m == 1 ? su : sd) + (size_t)l * D * FF;
#ifndef EMU
  src = (const float*)(__attribute__((address_space(1))) const float*)(unsigned long long)src;
#endif
  u16* dst = p.wt_exp + (size_t)e * EXP_STRIDE + (size_t)m * D * FF;
  if (m < 2) convert_tile_w(src, D, FF, dst, tile, smem);
  else convert_tile_w(src, FF, D, dst, tile, smem);
}

DI float* x1row(const Params& p, int r) { return r < TL ? p.out + (size_t)r * D : p.XC + (size_t)(r - TL) * D; }

struct DenseSched {
  static constexpr bool GATHER = false;
  const char* A; const char* Bt; int K, nM, nN, nwg, G, c;
  DI void init(const void* A_, const void* Bt_, int K_, int M, int N, int G_, int c_) { A = (const char*)A_; Bt = (const char*)Bt_; K = K_; nM = M / 256; nN = N / 256; nwg = nM * nN; G = G_; c = c_; }
  DI bool next(int i, pg8::Unit& u) const {
    const int L = i * G + c; if (L >= nwg) return false;
    const int wgid = pg8::remap_xcd(L, nwg);
    const int nig = 8 * nN, gid = wgid / nig, fm = gid * 8, gsz = (nM - fm) < 8 ? (nM - fm) : 8;
    u.pm = fm + ((wgid % nig) % gsz); u.pn = (wgid % nig) / gsz; u.e = 0; u.cnt = 0; u.idx = i; return true;
  }
  DI const char* abase() const { return A; }
  DI unsigned arow_off(const pg8::Unit& u, int r) const { return (unsigned)(u.pm * 256 + r) * (unsigned)(K * 2); }
  DI const char* bbase(const pg8::Unit& u, int half) const { return Bt + (size_t)(u.pn * 256 + half * 128) * K * 2; }
};
struct ExpertSched {
  const int* pre;
  const int* cntl;
  const unsigned char* t2e;
  int nN, G, c, total;
  DI bool locate(int i, pg8::Unit& u) const {
    const int L = i * G + c; if (L >= total) return false;
    const int w = pg8::remap_xcd(L, total);
    const int tile = w / nN; u.pn = w % nN;
    const int e = (int)t2e[tile];
    u.e = e; u.pm = tile - pre[e]; u.cnt = cntl[e]; u.idx = i;
    return true;
  }
};
struct E1Sched : ExpertSched {
  static constexpr bool GATHER = true;
  const char* A; const char* W; const int* etok;
  const unsigned* loff; int nl;
  DI bool next(int i, pg8::Unit& u) const { return locate(i, u); }
  DI const char* abase() const { return A; }
  DI unsigned goff(const pg8::Unit& u, int r) const {
    const int slot = u.pm * 256 + r;
    const unsigned tl = (unsigned)etok[u.e < NE ? (size_t)u.e * T + slot : (size_t)slot];
    const unsigned tok = u.e < NE ? (tl < (unsigned)T ? tl : 0u) : (unsigned)slot;
    return tok * (unsigned)(D * 2);
  }
  DI unsigned arow_off(const pg8::Unit& u, int r) const { return u.idx < nl ? loff[u.idx * 256 + r] : goff(u, r); }
  DI void preload(unsigned* lds_off, int maxu) {
    loff = lds_off; nl = 0;
    const int tid = TIDX();
    pg8::Unit u;
    int n = 0;
    while (n < maxu && locate(n, u)) ++n;
    for (int i = tid; i < n * 256; i += NT) { locate(i >> 8, u); lds_off[i] = goff(u, i & 255); }
    __syncthreads();
    nl = n;
  }
  DI const char* bbase(const pg8::Unit& u, int half) const { return W + ((size_t)u.e * EXP_STRIDE + (size_t)half * D * FF + (size_t)u.pn * 128 * D) * 2; }
};
struct E2Sched : ExpertSched {
  static constexpr bool GATHER = false;
  const char* A; const char* W; const int* hoff;
  DI bool next(int i, pg8::Unit& u) const { return locate(i, u); }
  DI const char* abase() const { return A; }
  DI unsigned arow_off(const pg8::Unit& u, int r) const { return (unsigned)(hoff[u.e] + u.pm * 256 + r) * (unsigned)(FF * 2); }
  DI const char* bbase(const pg8::Unit& u, int half) const { return W + ((size_t)u.e * EXP_STRIDE + (size_t)2 * D * FF + (size_t)(u.pn * 256 + half * 128) * FF) * 2; }
};

struct EpiInproj {
  u16 *PA, *PH, *PR;
  struct Pre {};
  DI Pre prefetch(const pg8::Unit&, int, int) const { return Pre{}; }
  DI void operator()(const f32x4 (&acc)[2][2][4][2], const pg8::Unit& u, int wr, int wc, int fr, int fq, const Pre&) const {
    const int row0 = u.pm * 256 + wr * 64 + fr;
#pragma unroll
    for (int bj = 0; bj < 2; ++bj) {
      const int colh = u.pn * 256 + bj * 128;
      if (colh >= P_IN) continue;
      if (colh >= PA_W && colh < PA_W + PH_W) {
        const int c0 = colh - PA_W + wc * 32 + 4 * fq;
        const int rb = u.pm * 256;
        u16* base; int L, t0;
        if (rb < TL) { L = SEQ; base = PH + (size_t)(rb / SEQ) * PH_W * SEQ; t0 = rb % SEQ; }
        else { L = CTXL; base = PH + (size_t)NB * PH_W * SEQ + (size_t)((rb - TL) / CTXL) * PH_W * CTXL; t0 = (rb - TL) % CTXL; }
#pragma unroll
        for (int ai = 0; ai < 2; ++ai)
#pragma unroll
          for (int m = 0; m < 4; ++m) {
            const int t = t0 + wr * 64 + fr + ai * 128 + m * 16;
#pragma unroll
            for (int n = 0; n < 2; ++n) {
              const f32x4 v = acc[ai][bj][m][n];
#pragma unroll
              for (int j = 0; j < 4; ++j) base[(size_t)(c0 + n * 16 + j) * L + t] = f2bf(v[j]);
            }
          }
        continue;
      }
      u16* base; int ld, c0;
      if (colh < PA_W) { base = PA; ld = PA_W; c0 = colh; }
      else { base = PR; ld = RW_COLS; c0 = colh - PA_W - PH_W; }
      const int col0 = c0 + wc * 32 + 4 * fq;
#pragma unroll
      for (int ai = 0; ai < 2; ++ai)
#pragma unroll
        for (int m = 0; m < 4; ++m) {
          u16* rowp = base + (size_t)(row0 + ai * 128 + m * 16) * ld + col0;
#pragma unroll
          for (int n = 0; n < 2; ++n) {
            const f32x4 v = acc[ai][bj][m][n];
            u32x2 o; o[0] = pk2(v[0], v[1]); o[1] = pk2(v[2], v[3]);
            *(u32x2*)(rowp + n * 16) = o;
          }
        }
    }
  }
};
struct EpiOutproj {
  const Params* p; int l;
  struct Pre {};
  DI Pre prefetch(const pg8::Unit&, int, int) const { return Pre{}; }
  DI void operator()(const f32x4 (&acc)[2][2][4][2], const pg8::Unit& u, int wr, int wc, int fr, int fq, const Pre&) const {
    const int row0 = u.pm * 256 + wr * 64 + fr, col0 = u.pn * 256 + wc * 32 + 4 * fq;
#pragma unroll
    for (int ai = 0; ai < 2; ++ai)
#pragma unroll
      for (int m = 0; m < 4; ++m) {
        const int r = row0 + ai * 128 + m * 16;
        const float* md = modp(*p, l, r) + 2 * D;
        float* xr = x1row(*p, r);
        const float* xin = (l == 0) ? (r < TL ? p->x + (size_t)r * D : p->ctx + (size_t)(r - TL) * D) : xr;
#pragma unroll
        for (int bj = 0; bj < 2; ++bj)
#pragma unroll
          for (int n = 0; n < 2; ++n) {
            const int c = col0 + bj * 128 + n * 16;
            const f32x4 g1 = *(const f32x4*)(md + c), xv = *(const f32x4*)(xin + c), a = acc[ai][bj][m][n];
            f32x4 o;
#pragma unroll
            for (int j = 0; j < 4; ++j) o[j] = DN_ALPHA * xv[j] + g1[j] * a[j];
            *(f32x4*)(xr + c) = o;
          }
      }
  }
};
struct EpiE1 {
  u16* H; const int* hoff;
  struct Pre {};
  DI Pre prefetch(const pg8::Unit&, int, int) const { return Pre{}; }
  DI void operator()(const f32x4 (&acc)[2][2][4][2], const pg8::Unit& u, int wr, int wc, int fr, int fq, const Pre&) const {
    const int row0 = hoff[u.e] + u.pm * 256 + wr * 64 + fr, col0 = u.pn * 128 + wc * 32 + 4 * fq;
#pragma unroll
    for (int ai = 0; ai < 2; ++ai)
#pragma unroll
      for (int m = 0; m < 4; ++m) {
        u16* rowp = H + (size_t)(row0 + ai * 128 + m * 16) * FF + col0;
#pragma unroll
        for (int n = 0; n < 2; ++n) {
          const f32x4 g = acc[ai][0][m][n], uu = acc[ai][1][m][n];
          u32x2 o; o[0] = pk2(g[0] * fsigmoid_(g[0]) * uu[0], g[1] * fsigmoid_(g[1]) * uu[1]); o[1] = pk2(g[2] * fsigmoid_(g[2]) * uu[2], g[3] * fsigmoid_(g[3]) * uu[3]);
          *(u32x2*)(rowp + n * 16) = o;
        }
      }
  }
};
constexpr float ACC_SCALE = 1024.f;
DI unsigned long long acc_pack4(float a, float b, float c, float d) {
  const long long qa = (long long)(int)rintf(a * ACC_SCALE), qb = (long long)(int)rintf(b * ACC_SCALE);
  const long long qc = (long long)(int)rintf(c * ACC_SCALE), qd = (long long)(int)rintf(d * ACC_SCALE);
  return (unsigned long long)(qa + (qb << 16) + (qc << 32) + (qd << 48));
}
DI void acc_unpack4(unsigned lo, unsigned hi, float& a, float& b, float& c, float& d) {
  long long v = (long long)(((unsigned long long)hi << 32) | (unsigned long long)lo);
  const long long f0 = (long long)(short)(v & 0xffff); v = (v - f0) >> 16;
  const long long f1 = (long long)(short)(v & 0xffff); v = (v - f1) >> 16;
  const long long f2 = (long long)(short)(v & 0xffff); v = (v - f2) >> 16;
  const long long f3 = (long long)(short)(v & 0xffff);
  a = (float)(int)f0 * (1.f / ACC_SCALE); b = (float)(int)f1 * (1.f / ACC_SCALE);
  c = (float)(int)f2 * (1.f / ACC_SCALE); d = (float)(int)f3 * (1.f / ACC_SCALE);
}
struct EpiE2 {
  int* accb; const int* etok; const float* egate; float* xs; u16* sho;
  static constexpr int WSTRIDE = 16 * 36 + 16 + 256;
  struct Pre { int t0, t1; float g0, g1; };
  DI Pre prefetch(const pg8::Unit& u, int wr, int lane) const {
    Pre q; q.t0 = 0; q.t1 = 0; q.g0 = 1.f; q.g1 = 1.f;
    if (u.e < NE) {
      const int s0 = u.pm * 256 + wr * 64 + ((lane >> 4) & 3) * 16 + (lane & 15), s1 = s0 + 128;
      const size_t b = (size_t)u.e * T;
      const size_t i0 = b + (s0 < u.cnt ? s0 : u.pm * 256), i1 = b + (s1 < u.cnt ? s1 : u.pm * 256);
      q.t0 = etok[i0]; q.g0 = egate[i0]; q.t1 = etok[i1]; q.g1 = egate[i1];
    }
    return q;
  }
  DI void operator()(const f32x4 (&acc)[2][2][4][2], const pg8::Unit& u, int wr, int wc, int fr, int fq, const Pre& pq) const {
    if (u.e == NE) {
      const int row0 = u.pm * 256 + wr * 64 + fr, col0 = u.pn * 256 + wc * 32 + 4 * fq;
#pragma unroll
      for (int ai = 0; ai < 2; ++ai)
#pragma unroll
        for (int m = 0; m < 4; ++m) {
          const int r = row0 + ai * 128 + m * 16;
          if (r < u.cnt) {
#pragma unroll
            for (int bj = 0; bj < 2; ++bj)
#pragma unroll
              for (int n = 0; n < 2; ++n) st_bf4(sho + (size_t)r * D + col0 + bj * 128 + n * 16, acc[ai][bj][m][n]);
          }
        }
      return;
    }
    const int lane = fq * 16 + fr, wave = wr * 4 + wc;
    float* X = xs + wave * WSTRIDE;
    int* tk = (int*)(X + 16 * 36);
    int* tokw = tk + 16;
    float* gatew = (float*)(tokw + 128);
    wave_sync();
#pragma unroll
    for (int q = 0; q < 2; ++q) {
      const int lr = lane + 64 * q;
      const int slot = u.pm * 256 + (lr >> 6) * 128 + wr * 64 + ((lr >> 4) & 3) * 16 + (lr & 15);
      const bool valid = slot < u.cnt;
      const int tok = q ? pq.t1 : pq.t0; const float gt = q ? pq.g1 : pq.g0;
      tokw[lr] = valid ? tok : -1; gatew[lr] = valid ? gt : 0.f;
    }
    wave_sync();
#pragma unroll
    for (int ai = 0; ai < 2; ++ai)
#pragma unroll
      for (int m = 0; m < 4; ++m) {
        const int lrow = ai * 64 + m * 16;
        const float gt = gatew[lrow + fr];
#pragma unroll
        for (int bj = 0; bj < 2; ++bj) {
          wave_sync();
#pragma unroll
          for (int n = 0; n < 2; ++n) {
            f32x4 v = acc[ai][bj][m][n];
#pragma unroll
            for (int j = 0; j < 4; ++j) v[j] *= gt;
            *(f32x4*)(X + fr * 36 + n * 16 + fq * 4) = v;
          }
          wave_sync();
          const int cquad = (u.pn * 256 + bj * 128 + wc * 32) / 4 + (lane & 7);
#pragma unroll
          for (int i = 0; i < 2; ++i) {
            const int rr = 8 * i + (lane >> 3);
            const int t2 = tokw[lrow + rr];
            const f32x4 xv = *(const f32x4*)(X + rr * 36 + 4 * (lane & 7));
            if (t2 >= 0) atomicAdd((unsigned long long*)accb + (size_t)t2 * (D / 4) + cquad, acc_pack4(xv[0], xv[1], xv[2], xv[3]));
          }
        }
      }
  }
};

constexpr int TICKET_SLOT_OFF = SMEM_BYTES - 1024 - 64;
template <class F> DI void ticket_loop(unsigned* ctr, int n_items, char* smem, F&& body) {
  int* slot = (int*)(smem + TICKET_SLOT_OFF);
  const int tid = TIDX();
  __syncthreads();
  if (tid == 0) slot[0] = (int)atomicAdd(ctr, 1u);
  __syncthreads();
  for (int k = 0;; ++k) {
    const int it = slot[k & 1];
    if (it >= n_items) break;
    int nx = 0;
    if (tid == 0) nx = (int)atomicAdd(ctr, 1u);
    body(it);
    if (tid == 0) slot[(k + 1) & 1] = nx;
    __syncthreads();
  }
}
DI void ph_prologue(const Params& p, char* smem) {
  const int tid = TIDX();
  constexpr int NCH = 6 * D / 128;
  constexpr int ITEMS_MOD = DEPTH * NCH;
  constexpr int ITEMS_H3 = DEPTH * (SEQ / 64 + CTXL / 64);
  constexpr int ITEMS_CV = DEPTH * CT_STATIC_L;
  constexpr int ITEMS = ITEMS_MOD + ITEMS_H3 + 1;
  for (int item = BIDX(); item < ITEMS; item += gridDim.x) {
    if (item < ITEMS_MOD) {
      const int l = item / NCH, ch = item % NCH;
      float* sv = (float*)smem;
      float* red = sv + (NB + 1) * D;
      {
        constexpr int NSV = ((NB + 1) * D + NT - 1) / NT;
        float cv[NSV];
#pragma unroll
        for (int j = 0; j < NSV; ++j) {
          int i = tid + j * NT; if (i > (NB + 1) * D - 1) i = (NB + 1) * D - 1;
          const int row = i / D, e = i % D;
          const float* src = row < NB ? p.c + row * D : p.c_ctx;
          cv[j] = src[e];
        }
#pragma unroll
        for (int j = 0; j < NSV; ++j) { const int i = tid + j * NT; if (i < (NB + 1) * D) sv[i] = siluf_(cv[j]); }
      }
      __syncthreads();
      const int col = ch * 128 + (tid & 127), kg = tid >> 7;
      float a[NB + 1];
#pragma unroll
      for (int r = 0; r < NB + 1; ++r) a[r] = 0.f;
      const float* W = p.w_ada + (size_t)l * D * 6 * D;
      for (int k = kg * (D / 4); k < (kg + 1) * (D / 4); k += 16) {
        float w[16];
#pragma unroll
        for (int j = 0; j < 16; ++j) w[j] = W[(size_t)(k + j) * 6 * D + col];
#pragma unroll
        for (int j = 0; j < 16; ++j)
#pragma unroll
          for (int r = 0; r < NB + 1; ++r) a[r] += sv[r * D + k + j] * w[j];
      }
#pragma unroll
      for (int r = 0; r < NB + 1; ++r) red[(kg * (NB + 1) + r) * 128 + (tid & 127)] = a[r];
      __syncthreads();
      for (int i = tid; i < (NB + 1) * 128; i += NT) {
        int r = i / 128, cc = i % 128;
        float s = 0.f;
        for (int g = 0; g < 4; ++g) s += red[(g * (NB + 1) + r) * 128 + cc];
        int cg_ = ch * 128 + cc;
        p.mod[((size_t)l * (NB + 1) + r) * 6 * D + cg_] = s + p.b_ada[(size_t)l * 6 * D + cg_];
      }
      __syncthreads();
    } else if (item < ITEMS_MOD + ITEMS_H3) {
      int it = item - ITEMS_MOD;
      constexpr int PER_L = SEQ / 64 + CTXL / 64;
      const int l = it / PER_L;
      int q = it % PER_L;
      const bool isctx = q >= SEQ / 64;
      const int L = isctx ? CTXL : SEQ;
      const int pos0 = (isctx ? q - SEQ / 64 : q) * 64;
      float* z = (float*)smem;
      float* ha = z + 64 * 36;
      float* hb = ha + 64 * 64;
      float* w1s = hb + 64 * 64;
      float* w2s = w1s + HY_EMB * HY_HID;
      float* w3s = w2s + HY_HID * HY_HID;
      {
        constexpr int N1 = (HY_EMB * HY_HID + NT - 1) / NT, N2 = (HY_HID * HY_HID + NT - 1) / NT;
        float a1[N1], a2[N2], a3[N2];
        const float* g1 = p.hf_w1 + (size_t)l * HY_EMB * HY_HID;
        const float* g2 = p.hf_w2 + (size_t)l * HY_HID * HY_HID;
        const float* g3 = p.hf_w3 + (size_t)l * HY_HID * HY_HID;
#pragma unroll
        for (int j = 0; j < N1; ++j) { int i = tid + j * NT; if (i > HY_EMB * HY_HID - 1) i = HY_EMB * HY_HID - 1; a1[j] = g1[i]; }
#pragma unroll
        for (int j = 0; j < N2; ++j) { int i = tid + j * NT; if (i > HY_HID * HY_HID - 1) i = HY_HID * HY_HID - 1; a2[j] = g2[i]; a3[j] = g3[i]; }
#pragma unroll
        for (int j = 0; j < N1; ++j) { const int i = tid + j * NT; if (i < HY_EMB * HY_HID) w1s[i] = a1[j]; }
#pragma unroll
        for (int j = 0; j < N2; ++j) { const int i = tid + j * NT; if (i < HY_HID * HY_HID) { w2s[i] = a2[j]; w3s[i] = a3[j]; } }
      }
      for (int i = tid; i < 64 * HY_EMB; i += NT) {
        int pp = i / HY_EMB, e = i % HY_EMB;
        int pos = pos0 + pp;
        float v;
        if (e == 0) v = (float)pos / (float)(L - 1);
        else {
          int bi = (e - 1) % HY_BANDS;
          float band = 1e-4f + ((float)(HY_BANDS - 1) - 1e-4f) * (float)bi / (float)(HY_BANDS - 1);
          float ang = (2.0f * 3.14159265358979323846f / (float)L) * (float)pos * band;
          v = (e - 1) < HY_BANDS ? cosf(ang) : -sinf(ang);
        }
        z[pp * 36 + e] = v;
      }
      __syncthreads();
      const int pp = tid >> 3, sub = tid & 7;
      const float* fr = p.hf_freq + l * HY_HID;
      {
        const float* b = p.hf_b1 + l * HY_HID;
        float acc8[8];
#pragma unroll
        for (int uu = 0; uu < 8; ++uu) acc8[uu] = b[sub * 8 + uu];
        for (int e = 0; e < HY_EMB; ++e) {
          const float zv = z[pp * 36 + e];
#pragma unroll
          for (int uu = 0; uu < 8; ++uu) acc8[uu] += zv * w1s[e * HY_HID + sub * 8 + uu];
        }
#pragma unroll 1
        for (int uu = 0; uu < 8; ++uu) ha[pp * 64 + sub * 8 + uu] = sinf(fr[sub * 8 + uu] * acc8[uu]);
      }
      __syncthreads();
      {
        const float* b = p.hf_b2 + l * HY_HID;
        float acc8[8];
#pragma unroll
        for (int uu = 0; uu < 8; ++uu) acc8[uu] = b[sub * 8 + uu];
        for (int e = 0; e < HY_HID; ++e) {
          const float zv = ha[pp * 64 + e];
#pragma unroll
          for (int uu = 0; uu < 8; ++uu) acc8[uu] += zv * w2s[e * HY_HID + sub * 8 + uu];
        }
#pragma unroll 1
        for (int uu = 0; uu < 8; ++uu) hb[pp * 64 + sub * 8 + uu] = sinf(fr[sub * 8 + uu] * acc8[uu]);
      }
      __syncthreads();
      {
        const float* b = p.hf_b3 + l * HY_HID;
        float* dst = isctx ? p.h3ctx + ((size_t)l * CTXL + pos0) * 64 : p.h3lat + ((size_t)l * SEQ + pos0) * 64;
        float acc8[8];
#pragma unroll
        for (int uu = 0; uu < 8; ++uu) acc8[uu] = b[sub * 8 + uu];
        for (int e = 0; e < HY_HID; ++e) {
          const float zv = hb[pp * 64 + e];
#pragma unroll
          for (int uu = 0; uu < 8; ++uu) acc8[uu] += zv * w3s[e * HY_HID + sub * 8 + uu];
        }
#pragma unroll 1
        for (int uu = 0; uu < 8; ++uu) dst[pp * 64 + sub * 8 + uu] = sinf(fr[sub * 8 + uu] * acc8[uu]);
      }
      __syncthreads();
    } else {
      for (int k = tid; k < FFTN / 2; k += NT) {
        double ang = -2.0 * 3.14159265358979323846 * (double)k / (double)FFTN;
        cf w; w.x = (float)cos(ang); w.y = (float)sin(ang);
        p.tw[k] = w;
      }
      for (int i = tid; i < DEPTH * NE; i += NT) p.cnt[i] = 0;
    }
  }
  ticket_loop(p.bar + XB_TICKET, ITEMS_CV, smem, [&](int it) { convert_static_item(p, it, smem); });
}

DI void ph_premod(const Params& p) {
  const int tid = TIDX();
  constexpr int ITEMS = T / 8;
  constexpr int NI = 8 * D / 4 / NT;
  static_assert(NI * NT * 4 == 8 * D, "premod tiling");
  for (int item = BIDX(); item < ITEMS; item += gridDim.x) {
    f32x4 xv[NI], sc[NI], sh[NI];
#pragma unroll
    for (int k = 0; k < NI; ++k) {
      const int i = tid + k * NT;
      const int r = item * 8 + i / (D / 4), e = (i % (D / 4)) * 4;
      const float* m = modp(p, 0, r);
      const float* src = r < TL ? p.x + (size_t)r * D : p.ctx + (size_t)(r - TL) * D;
      xv[k] = *(const f32x4*)(src + e); sc[k] = *(const f32x4*)(m + D + e); sh[k] = *(const f32x4*)(m + e);
    }
#pragma unroll
    for (int k = 0; k < NI; ++k) {
      const int i = tid + k * NT;
      const int r = item * 8 + i / (D / 4), e = (i % (D / 4)) * 4;
      f32x4 o;
#pragma unroll
      for (int j = 0; j < 4; ++j) o[j] = xv[k][j] * (1.f + sc[k][j]) + sh[k][j];
      st_bf4(p.HL + (size_t)r * D + e, o);
    }
  }
}

DI int fpad(int i) { return i + (i >> 4); }
constexpr int FFT_LDS = FFTN + FFTN / 16;
__device__ static constexpr float C16[8] = {1.f, 0.92387953251128674f, 0.70710678118654752f, 0.38268343236508977f, 0.f, -0.38268343236508977f, -0.70710678118654752f, -0.92387953251128674f};
__device__ static constexpr float S16[8] = {0.f, 0.38268343236508977f, 0.70710678118654752f, 0.92387953251128674f, 1.f, 0.92387953251128674f, 0.70710678118654752f, 0.38268343236508977f};
template <int R, bool INV>
DI void fft_pass(cf* buf, const cf* tw, int m) {
  const int g = m >> (R - 1);
  constexpr int NQ = 1 << R;
  for (int w = TIDX(); w < (FFTN >> R); w += NT) {
    const int j = w % g, blk = w / g;
    const int base = blk * (g << R) + j;
    cf v[NQ];
#pragma unroll
    for (int q = 0; q < NQ; ++q) v[q] = buf[fpad(base + q * g)];
    cf bt[R];
    bt[0] = tw[j * ((FFTN / 2) / ((NQ / 2) * g))];
#pragma unroll
    for (int r = 1; r < R; ++r) { bt[r].x = bt[r - 1].x * bt[r - 1].x - bt[r - 1].y * bt[r - 1].y; bt[r].y = 2.f * bt[r - 1].x * bt[r - 1].y; }
    if (!INV) {
#pragma unroll
      for (int r = 0; r < R; ++r) {
        const int half = 1 << (R - 1 - r);
#pragma unroll
        for (int q = 0; q < NQ; ++q) {
          if ((q & half) == 0) {
            const int qq = q & (half - 1);
            const int ci = qq * (8 / half);
            cf W;
            W.x = bt[r].x * C16[ci] + bt[r].y * S16[ci];
            W.y = bt[r].y * C16[ci] - bt[r].x * S16[ci];
            cf a = v[q], b = v[q + half];
            v[q].x = a.x + b.x; v[q].y = a.y + b.y;
            float dx = a.x - b.x, dy = a.y - b.y;
            v[q + half].x = dx * W.x - dy * W.y;
            v[q + half].y = dx * W.y + dy * W.x;
          }
        }
      }
    } else {
#pragma unroll
      for (int r = R - 1; r >= 0; --r) {
        const int half = 1 << (R - 1 - r);
#pragma unroll
        for (int q = 0; q < NQ; ++q) {
          if ((q & half) == 0) {
            const int qq = q & (half - 1);
            const int ci = qq * (8 / half);
            cf W;
            W.x = bt[r].x * C16[ci] + bt[r].y * S16[ci];
            W.y = bt[r].y * C16[ci] - bt[r].x * S16[ci];
            cf a = v[q], b = v[q + half];
            float bx = b.x * W.x + b.y * W.y;
            float by = b.y * W.x - b.x * W.y;
            v[q].x = a.x + bx; v[q].y = a.y + by;
            v[q + half].x = a.x - bx; v[q + half].y = a.y - by;
          }
        }
      }
    }
#pragma unroll
    for (int q = 0; q < NQ; ++q) buf[fpad(base + q * g)] = v[q];
  }
}
constexpr int FFT_R4 = LOG2N / 4, FFT_REM = LOG2N % 4;
DI void fft_fwd_main(cf* buf, const cf* tw) {
  int m = FFTN / 2;
#pragma unroll
  for (int i = 0; i < FFT_R4; ++i) { fft_pass<4, false>(buf, tw, m); __syncthreads(); m >>= 4; }
}
DI void fft_fwd_tail(cf* buf, const cf* tw) {
  if (FFT_REM == 3) { fft_pass<3, false>(buf, tw, 4); __syncthreads(); }
  if (FFT_REM == 2) { fft_pass<2, false>(buf, tw, 2); __syncthreads(); }
  if (FFT_REM == 1) { fft_pass<1, false>(buf, tw, 1); __syncthreads(); }
}
DI void fft_fwd(cf* buf, const cf* tw) { fft_fwd_main(buf, tw); fft_fwd_tail(buf, tw); }
DI void fft_inv_tail(cf* buf, const cf* tw) {
  if (FFT_REM == 3) { fft_pass<3, true>(buf, tw, 4); __syncthreads(); }
  if (FFT_REM == 2) { fft_pass<2, true>(buf, tw, 2); __syncthreads(); }
  if (FFT_REM == 1) { fft_pass<1, true>(buf, tw, 1); __syncthreads(); }
}
DI void fft_inv_main(cf* buf, const cf* tw) {
  int m = (1 << FFT_REM) * 8;
#pragma unroll
  for (int i = 0; i < FFT_R4; ++i) { fft_pass<4, true>(buf, tw, m); __syncthreads(); m <<= 4; }
}
DI void tw_to_lds(cf* tw, const cf* __restrict__ gtw) {
  constexpr int NIT = (FFTN / 4 + NT - 1) / NT;
  f32x4 t4[NIT];
#pragma unroll
  for (int j = 0; j < NIT; ++j) { int i = TIDX() + j * NT; if (i > FFTN / 4 - 1) i = FFTN / 4 - 1; t4[j] = ((const f32x4*)gtw)[i]; }
#pragma unroll
  for (int j = 0; j < NIT; ++j) { const int i = TIDX() + j * NT; if (i < FFTN / 4) ((f32x4*)tw)[i] = t4[j]; }
}
constexpr int MID_IT = (FFTN / 2 + NT - 1) / NT;
struct MidSpec { f32x4 k[MID_IT]; };
DI MidSpec fft_mid_prefetch(const cf* __restrict__ sp) {
  MidSpec m;
#pragma unroll
  for (int j = 0; j < MID_IT; ++j) {
    int i = TIDX() + j * NT; if (i > FFTN / 2 - 1) i = FFTN / 2 - 1;
    m.k[j] = *(const f32x4*)(sp + 2 * i);
  }
  return m;
}
DI void fft_mid(cf* buf, const cf* tw, const cf* __restrict__ sp, const MidSpec& ms) {
  if (FFT_REM == 1) {
#pragma unroll
    for (int j = 0; j < MID_IT; ++j) {
      const int i = TIDX() + j * NT;
      if (i >= FFTN / 2) break;
      const cf a = buf[fpad(2 * i)], b = buf[fpad(2 * i + 1)];
      cf A, B;
      A.x = a.x + b.x; A.y = a.y + b.y; B.x = a.x - b.x; B.y = a.y - b.y;
      const f32x4 k = ms.k[j];
      cf P, Q;
      P.x = A.x * k[0] - A.y * k[1]; P.y = A.x * k[1] + A.y * k[0];
      Q.x = B.x * k[2] - B.y * k[3]; Q.y = B.x * k[3] + B.y * k[2];
      cf o0, o1;
      o0.x = P.x + Q.x; o0.y = P.y + Q.y; o1.x = P.x - Q.x; o1.y = P.y - Q.y;
      buf[fpad(2 * i)] = o0; buf[fpad(2 * i + 1)] = o1;
    }
    __syncthreads();
  } else {
    fft_fwd_tail(buf, tw);
    for (int i = TIDX(); i < FFTN; i += NT) {
      cf a = buf[fpad(i)], k = sp[i], r;
      r.x = a.x * k.x - a.y * k.y; r.y = a.x * k.y + a.y * k.x;
      buf[fpad(i)] = r;
    }
    __syncthreads();
    fft_inv_tail(buf, tw);
  }
}

DI float hy_delta(int c) {
  const float lo = -4.605170185988091f / 1.5f, hi = -4.605170185988091f / 0.3f;
  return fabsf(lo + (hi - lo) * (float)c / (float)(HY_CH - 1));
}

DI void hy_spectrum_item(const Params& p, int l, int o, int c, char* smem) {
  const int tid = TIDX();
  cf* buf = (cf*)smem;
  cf* tw = buf + FFT_LDS;
  float* wc = (float*)(tw + FFTN / 2);
  tw_to_lds(tw, p.tw);
  if (tid < 128) {
    int dir = tid >> 6, u = tid & 63;
    wc[tid] = p.hf_wout[((size_t)l * HY_HID + u) * (4 * HY_CH) + o * 2 * HY_CH + dir * HY_CH + c];
  }
  __syncthreads();
  const float dl = hy_delta(c);
  {
    const int q = tid & 15, rr = tid >> 4;
    constexpr int RPP = NT / 16;
    constexpr int UNR = (SEQ / RPP) % 8 == 0 ? 8 : 1;
    const f32x4 wf = *(const f32x4*)(wc + 4 * q), wb = *(const f32x4*)(wc + 64 + 4 * q);
    const float* hbase = p.h3lat + (size_t)l * SEQ * 64 + 4 * q;
    for (int t0 = 0; t0 < SEQ; t0 += RPP * UNR) {
      f32x4 hv[UNR];
#pragma unroll
      for (int j = 0; j < UNR; ++j) hv[j] = *(const f32x4*)(hbase + (size_t)(t0 + j * RPP + rr) * 64);
#pragma unroll
      for (int j = 0; j < UNR; ++j) {
        const int t = t0 + j * RPP + rr;
        float sf = (hv[j][0] * wf[0] + hv[j][1] * wf[1]) + (hv[j][2] * wf[2] + hv[j][3] * wf[3]);
        float sb = (hv[j][0] * wb[0] + hv[j][1] * wb[1]) + (hv[j][2] * wb[2] + hv[j][3] * wb[3]);
        sf = red16(sf); sb = red16(sb);
        if (q == 0) {
          const float dec = expf(-((float)t / (float)(SEQ - 1)) * dl);
          cf a; a.x = sf * dec; a.y = 0.f;
          buf[fpad(t)] = a;
          if (t >= 1) { cf b; b.x = sb * dec; b.y = 0.f; buf[fpad(FFTN - t)] = b; }
          if (t == 0) { cf zz; zz.x = 0.f; zz.y = 0.f; buf[fpad(SEQ)] = zz; }
        }
      }
    }
  }
  __syncthreads();
  fft_fwd(buf, tw);
  cf* dst = p.spec + ((size_t)o * HY_CH + c) * FFTN;
  const float sc = 1.0f / (float)FFTN;
  for (int i = tid; i < FFTN; i += NT) { cf v = buf[fpad(i)]; v.x *= sc; v.y *= sc; dst[i] = v; }
  __syncthreads();
}

DI void ph_inproj(const Params& p, int l, char* smem) {
  constexpr int SPEC_ITEMS = 2 * HY_CH;
  const int G = gridDim.x, c = BIDX();
  {
    DenseSched S; S.init(p.HL, p.wt_in + (size_t)l * P_IN_PAD * D, D, T, P_IN_PAD, G, c);
    EpiInproj E{p.PA, p.PH, p.PR};
    pg8::gemm_phase(smem, D, S, E);
  }
  __syncthreads();
  (void)c;
  ticket_loop(p.bar + XB_TICKET + 1 + l, SPEC_ITEMS, smem, [&](int it) { hy_spectrum_item(p, l, it / HY_CH, it % HY_CH, smem); });
}

DI float hy_u(const u16* P, int t, int L, float w0, float w1, float w2, float bias) {
  const bool hp = t >= 1, hn = t + 1 < L;
  const float c = bf2f(P[t]), a = bf2f(P[hp ? t - 1 : t]), b = bf2f(P[hn ? t + 1 : t]);
  return w1 * c + bias + (hp ? w0 : 0.f) * a + (hn ? w2 : 0.f) * b;
}

struct HyRaw { u32x4 x; u16 prev, next; };
DI HyRaw hy_load8(const u16* P, int t0, int L) {
  HyRaw r;
  r.x = *(const u32x4*)(P + t0);
  r.prev = P[t0 >= 1 ? t0 - 1 : t0];
  r.next = P[t0 + 8 < L ? t0 + 8 : t0 + 7];
  return r;
}
DI void hy_conv8(const HyRaw& r, int t0, int L, float w0, float w1, float w2, float bias, float (&out)[8]) {
  float x[10];
  x[0] = bf2f(r.prev);
#pragma unroll
  for (int j = 0; j < 4; ++j) { x[1 + 2 * j] = bf2f((u16)(r.x[j] & 0xffff)); x[2 + 2 * j] = bf2f((u16)(r.x[j] >> 16)); }
  x[9] = bf2f(r.next);
  const float wp = t0 >= 1 ? w0 : 0.f, wn = t0 + 8 < L ? w2 : 0.f;
#pragma unroll
  for (int j = 0; j < 8; ++j) out[j] = w1 * x[1 + j] + bias + (j == 0 ? wp : w0) * x[j] + (j == 7 ? wn : w2) * x[2 + j];
}

DI void hyena_lat_item(const Params& p, int l, int c, int pair, char* smem, bool load_tw) {
  const int tid = TIDX();
  cf* buf = (cf*)smem;
  cf* tw = buf + FFT_LDS;
  const float* cw = p.hy_sconv_w + (size_t)l * 3 * PH_W;
  const float* cb = p.hy_sconv_b + (size_t)l * PH_W;
  const int b0 = pair * 2, b1 = pair * 2 + 1;
  const int t0 = tid * 8;
  const bool act = t0 < SEQ;
  const int tl = act ? t0 : 0;
  HyRaw rw[3][2];
#pragma unroll
  for (int q = 0; q < 3; ++q) {
    rw[q][0] = hy_load8(p.PH + ((size_t)b0 * PH_W + q * HY_CH + c) * SEQ, tl, SEQ);
    rw[q][1] = hy_load8(p.PH + ((size_t)b1 * PH_W + q * HY_CH + c) * SEQ, tl, SEQ);
  }
  if (load_tw) tw_to_lds(tw, p.tw);
  const MidSpec ms0 = fft_mid_prefetch(p.spec + ((size_t)0 * HY_CH + c) * FFTN);
  float vr[2][8], z1[2][8];
  {
    const int col = c;
    const float w0 = cw[col], w1 = cw[PH_W + col], w2 = cw[2 * PH_W + col], bs = cb[col];
    hy_conv8(rw[0][0], tl, SEQ, w0, w1, w2, bs, vr[0]);
    hy_conv8(rw[0][1], tl, SEQ, w0, w1, w2, bs, vr[1]);
    if (act) {
#pragma unroll
      for (int j = 0; j < 8; ++j) {
        cf a; a.x = vr[0][j]; a.y = vr[1][j];
        buf[fpad(t0 + j)] = a;
        cf zz; zz.x = 0.f; zz.y = 0.f;
        buf[fpad(t0 + j + SEQ)] = zz;
      }
    }
  }
  __syncthreads();
  fft_fwd_main(buf, tw);
  fft_mid(buf, tw, p.spec + ((size_t)0 * HY_CH + c) * FFTN, ms0);
  const MidSpec ms1 = fft_mid_prefetch(p.spec + ((size_t)1 * HY_CH + c) * FFTN);
  fft_inv_main(buf, tw);
  {
    const int col = HY_CH + c;
    const float w0 = cw[col], w1 = cw[PH_W + col], w2 = cw[2 * PH_W + col], bs = cb[col];
    const float sk = p.hf_skip[((size_t)l * 2 + 0) * HY_CH + c];
    float x1a[8], x1b[8];
    hy_conv8(rw[1][0], tl, SEQ, w0, w1, w2, bs, x1a);
    hy_conv8(rw[1][1], tl, SEQ, w0, w1, w2, bs, x1b);
    cf yv[8];
    if (act) {
#pragma unroll
      for (int j = 0; j < 8; ++j) yv[j] = buf[fpad(t0 + j)];
    }
    __syncthreads();
    if (act) {
#pragma unroll
      for (int j = 0; j < 8; ++j) {
        z1[0][j] = (yv[j].x + sk * vr[0][j]) * x1a[j];
        z1[1][j] = (yv[j].y + sk * vr[1][j]) * x1b[j];
        cf a; a.x = z1[0][j]; a.y = z1[1][j];
        buf[fpad(t0 + j)] = a;
        cf zz; zz.x = 0.f; zz.y = 0.f;
        buf[fpad(t0 + j + SEQ)] = zz;
      }
    }
  }
  __syncthreads();
  fft_fwd_main(buf, tw);
  fft_mid(buf, tw, p.spec + ((size_t)1 * HY_CH + c) * FFTN, ms1);
  fft_inv_main(buf, tw);
  {
    const int col = 2 * HY_CH + c;
    const float w0 = cw[col], w1 = cw[PH_W + col], w2 = cw[2 * PH_W + col], bs = cb[col];
    const float sk = p.hf_skip[((size_t)l * 2 + 1) * HY_CH + c];
    float x2a[8], x2b[8];
    hy_conv8(rw[2][0], tl, SEQ, w0, w1, w2, bs, x2a);
    hy_conv8(rw[2][1], tl, SEQ, w0, w1, w2, bs, x2b);
    if (act) {
      u32x4 oa, ob;
#pragma unroll
      for (int j = 0; j < 4; ++j) {
        const cf y0 = buf[fpad(t0 + 2 * j)], y1 = buf[fpad(t0 + 2 * j + 1)];
        oa[j] = pk2((y0.x + sk * z1[0][2 * j]) * x2a[2 * j], (y1.x + sk * z1[0][2 * j + 1]) * x2a[2 * j + 1]);
        ob[j] = pk2((y0.y + sk * z1[1][2 * j]) * x2b[2 * j], (y1.y + sk * z1[1][2 * j + 1]) * x2b[2 * j + 1]);
      }
      *(u32x4*)(p.yhlat + ((size_t)b0 * HY_CH + c) * SEQ + t0) = oa;
      *(u32x4*)(p.yhlat + ((size_t)b1 * HY_CH + c) * SEQ + t0) = ob;
    }
  }
  __syncthreads();
}

DI void hyena_ctx_item(const Params& p, int l, int c, char* smem) {
  const int tid = TIDX();
  float* taps = (float*)smem;
  float* uv = taps + 4 * CTXL;
  float* zb = uv + NB * 3 * CTXL;
  float* wc = zb + NB * CTXL;
  if (tid < 256) {
    int od = tid >> 6, u = tid & 63;
    wc[tid] = p.hf_wout[((size_t)l * HY_HID + u) * (4 * HY_CH) + od * HY_CH + c];
  }
  __syncthreads();
  const float dl = hy_delta(c);
  for (int i = tid; i < 4 * CTXL; i += NT) {
    int od = i / CTXL, t = i % CTXL;
    const float* h = p.h3ctx + ((size_t)l * CTXL + t) * 64;
    float s = 0.f;
    for (int u = 0; u < 64; ++u) s += h[u] * wc[od * 64 + u];
    taps[i] = s * expf(-((float)t / (float)(CTXL - 1)) * dl);
  }
  const float* cw = p.hy_sconv_w + (size_t)l * 3 * PH_W;
  const float* cb = p.hy_sconv_b + (size_t)l * PH_W;
  for (int i = tid; i < NB * 3 * CTXL; i += NT) {
    int b = i / (3 * CTXL), j = (i / CTXL) % 3, t = i % CTXL;
    int col = j * HY_CH + c;
    const u16* P = p.PH + (size_t)NB * PH_W * SEQ + ((size_t)b * PH_W + col) * CTXL;
    uv[i] = hy_u(P, t, CTXL, cw[col], cw[PH_W + col], cw[2 * PH_W + col], cb[col]);
  }
  __syncthreads();
  const float sk0 = p.hf_skip[((size_t)l * 2 + 0) * HY_CH + c], sk1 = p.hf_skip[((size_t)l * 2 + 1) * HY_CH + c];
  for (int i = tid; i < NB * CTXL; i += NT) {
    int b = i / CTXL, t = i % CTXL;
    const float* v = uv + (b * 3 + 0) * CTXL;
    float s = 0.f;
    for (int s_ = 0; s_ < CTXL; ++s_) {
      int lag = t - s_;
      float k = lag >= 0 ? taps[0 * CTXL + lag] : taps[1 * CTXL - lag];
      s += k * v[s_];
    }
    zb[i] = (s + sk0 * v[t]) * uv[(b * 3 + 1) * CTXL + t];
  }
  __syncthreads();
  for (int i = tid; i < NB * CTXL; i += NT) {
    int b = i / CTXL, t = i % CTXL;
    const float* v = zb + b * CTXL;
    float s = 0.f;
    for (int s_ = 0; s_ < CTXL; ++s_) {
      int lag = t - s_;
      float k = lag >= 0 ? taps[2 * CTXL + lag] : taps[3 * CTXL - lag];
      s += k * v[s_];
    }
    p.yhctx[((size_t)b * HY_CH + c) * CTXL + t] = f2bf((s + sk1 * v[t]) * uv[(b * 3 + 2) * CTXL + t]);
  }
  __syncthreads();
}

DI void mixer_a_item(const Params& p, int l, int tile) {
  const int tid = TIDX(), lane = tid & 63, wave = tid >> 6;
  const int ts = lane >> 4, cq = lane & 15;
  constexpr int NBK = CONV_CH / 64;
  const float* cw = p.conv_a + (size_t)l * 3 * CONV_CH;
  const float* gn = p.mix_norm_g + (size_t)l * (CONV_CH + HY_CH);
#pragma unroll
  for (int it = 0; it < 2; ++it) {
    const int r = tile * 64 + wave * 8 + it * 4 + ts;
    int rp = r, rn = r;
    bool hp = false, hn = false;
    if (r < TL) { const int t = r % SEQ; hp = t >= GRID_W; hn = t + GRID_W < SEQ; if (hp) rp = r - GRID_W; if (hn) rn = r + GRID_W; }
    else { const int t = (r - TL) % CTXL; hp = t >= 1; hn = t + 1 < CTXL; if (hp) rp = r - 1; if (hn) rn = r + 1; }
    const float fp = hp ? 1.f : 0.f, fn = hn ? 1.f : 0.f;
    const u16* row = p.PA + (size_t)r * PA_W;
    const u16* qp = p.PA + (size_t)rp * PA_W;
    const u16* qn = p.PA + (size_t)rn * PA_W;
    float yv[NBK][4];
    float ss = 0.f;
#pragma unroll
    for (int bk = 0; bk < NBK; ++bk) {
      const int c = bk * 64 + cq * 4;
      const f32x4 bg = ld_bf4(row + c);
      const f32x4 c0 = ld_bf4(row + CONV_CH + c), x0 = ld_bf4(row + 2 * CONV_CH + c);
      const f32x4 c1 = ld_bf4(qp + CONV_CH + c), x1 = ld_bf4(qp + 2 * CONV_CH + c);
      const f32x4 c2 = ld_bf4(qn + CONV_CH + c), x2 = ld_bf4(qn + 2 * CONV_CH + c);
      const f32x4 w0 = *(const f32x4*)(cw + c), w1 = *(const f32x4*)(cw + CONV_CH + c), w2 = *(const f32x4*)(cw + 2 * CONV_CH + c);
#pragma unroll
      for (int j = 0; j < 4; ++j) {
        const float z = c0[j] * x0[j] * w1[j] + fp * w0[j] * (c1[j] * x1[j]) + fn * w2[j] * (c2[j] * x2[j]);
        yv[bk][j] = bg[j] * z;
        ss += yv[bk][j] * yv[bk][j];
      }
    }
    ss = red16(ss);
    const float rs = rsqrtf(ss / (float)CONV_CH + LN_EPS);
#pragma unroll
    for (int bk = 0; bk < NBK; ++bk) {
      const int c = bk * 64 + cq * 4;
      const f32x4 g4 = *(const f32x4*)(gn + c);
      f32x4 o;
#pragma unroll
      for (int j = 0; j < 4; ++j) o[j] = yv[bk][j] * rs * g4[j];
      st_bf4(p.ya + (size_t)r * CONV_CH + c, o);
    }
  }
}

DI void ph_mix(const Params& p, int l, char* smem) {
  const bool need_ctx = (l == 0);
  constexpr int HL_ITEMS = HY_CH * (NB / 2);
  const int HC_ITEMS = need_ctx ? HY_CH : 0;
  const int MA_ITEMS = (need_ctx ? T : TL) / 64;
  const int total = HL_ITEMS + HC_ITEMS + MA_ITEMS;
  SEG_BEGIN(p)
  bool tw_loaded = false;
  ticket_loop(p.bar + XB_TICKET + 1 + 2 * DEPTH + l, total, smem, [&](int item) {
    if (item < HL_ITEMS) { hyena_lat_item(p, l, item / (NB / 2), item % (NB / 2), smem, !tw_loaded); tw_loaded = true; SEG_MARK(p, 9) }
    else if (item < HL_ITEMS + HC_ITEMS) { hyena_ctx_item(p, l, item - HL_ITEMS, smem); SEG_MARK(p, 10) }
    else { mixer_a_item(p, l, item - HL_ITEMS - HC_ITEMS); SEG_MARK(p, 11) }
  });
}

DI void seq_of_row(int r, int& b, int& t, int& L) {
  if (r < TL) { b = r / SEQ; t = r % SEQ; L = SEQ; }
  else { int rc = r - TL; b = rc / CTXL; t = rc % CTXL; L = CTXL; }
}
DI float rw_u(const Params& p, const float* mu, int r, int t, int L, int col) {
  const float m0 = mu[col], m2 = mu[RW_COLS + col];
  float s = (1.f - m0 - m2) * bf2f(p.PR[(size_t)r * RW_COLS + col]);
  if (t >= 1) s += m0 * bf2f(p.PR[(size_t)(r - 1) * RW_COLS + col]);
  if (t + 1 < L) s += m2 * bf2f(p.PR[(size_t)(r + 1) * RW_COLS + col]);
  return s;
}
DI bf16x8 load_bfrag(const float* W, int ldn, int k0, int col, int lane) {
  const float* q = W + (size_t)(k0 + 8 * (lane >> 5)) * ldn + col + (lane & 31);
  bf16x8 b;
#pragma unroll
  for (int j = 0; j < 8; ++j) b[j] = (short)f2bf(q[(size_t)j * ldn]);
  return b;
}

DI f32x4 rw_u4(const Params& p, const float* mu, int r, int t, int L, int col) {
  const f32x4 m0 = *(const f32x4*)(mu + col), m2 = *(const f32x4*)(mu + RW_COLS + col);
  const bool hp = t >= 1, hn = t + 1 < L;
  const f32x4 c = ld_bf4(p.PR + (size_t)r * RW_COLS + col);
  const f32x4 a = ld_bf4(p.PR + (size_t)(hp ? r - 1 : r) * RW_COLS + col);
  const f32x4 b = ld_bf4(p.PR + (size_t)(hn ? r + 1 : r) * RW_COLS + col);
  const float fp = hp ? 1.f : 0.f, fn = hn ? 1.f : 0.f;
  f32x4 s;
#pragma unroll
  for (int i = 0; i < 4; ++i) s[i] = (1.f - m0[i] - m2[i]) * c[i] + (fp * m0[i]) * a[i] + (fn * m2[i]) * b[i];
  return s;
}
DI bf16x8 ld_bfrag_t(const u16* Wt, int K, int k0, int col, int lane) {
  return *(const bf16x8*)(Wt + (size_t)(col + (lane & 31)) * K + k0 + 8 * (lane >> 5));
}

DI void prep_item(const Params& p, int l, int tile, char* smem) {
  const int tid = TIDX(), lane = tid & 63, wave = tid >> 6;
  constexpr int LA = 72, LG = 136, LX = 68;
  constexpr int XW = 32 * LX + 64;
  u16* Awd = (u16*)smem;
  u16* Aad = Awd + 2 * 32 * LA;
  u16* Agd = Aad + 2 * 32 * LA;
  float* Xall = (float*)(Agd + 32 * LG);
  const float* mu = p.rw_mu + (size_t)l * 2 * RW_COLS;
  const int r0 = tile * 32;
  int b_, t0, L;
  seq_of_row(r0, b_, t0, L);
  SEG_BEGIN(p)
#pragma unroll 2
  for (int i = tid; i < 32 * 96; i += NT) {
    const int tok = i / 96, c4 = (i % 96) * 4;
    f32x4 u = rw_u4(p, mu, r0 + tok, t0 + tok, L, 3 * RW_CH + c4);
    if (c4 < 128) { f32x4 o; for (int j = 0; j < 4; ++j) o[j] = ftanh_(u[j]); st_bf4(Awd + ((c4 >> 6) * 32 + tok) * LA + (c4 & 63), o); }
    else if (c4 < 256) { int c2 = c4 - 128; st_bf4(Aad + ((c2 >> 6) * 32 + tok) * LA + (c2 & 63), u); }
    else { f32x4 o; for (int j = 0; j < 4; ++j) o[j] = fsigmoid_(u[j]); st_bf4(Agd + tok * LG + (c4 - 256), o); }
  }
  __syncthreads();
  SEG_MARK(p, 4)
  const int ts = lane >> 4, cq = lane & 15;
  if (wave < RW_H) {
    const int h = wave;
    float* X = Xall + (size_t)wave * XW;
    float* rinvw = X + 32 * LX;
    float* sbw = rinvw + 32;
    const size_t seqidx0 = (size_t)(b_ * RW_H + h) * L + t0;
    u16* sish = (r0 < TL ? p.SIsh_lat : p.SIsh_ctx);
    u16* sidir = (r0 < TL ? p.SIdir_lat : p.SIdir_ctx);
    const size_t dirstride = (size_t)NB * RW_H * L * 192;
    const int ch = h * 64 + cq * 4;
    const f32x4 kkc = *(const f32x4*)(p.rw_k_k + (size_t)l * RW_CH + ch);
    const f32x4 k_a = *(const f32x4*)(p.rw_k_a + (size_t)l * RW_CH + ch);
    const f32x4 r_k = *(const f32x4*)(p.rw_r_k + (size_t)l * RW_CH + ch);
    auto gemm_to_X = [&](const u16* Atile, int lda_, int arow0, const u16* Wt, int K) {
      f32x16 c0, c1;
#pragma unroll
      for (int r = 0; r < 16; ++r) { c0[r] = 0.f; c1[r] = 0.f; }
#pragma unroll 4
      for (int k0 = 0; k0 < K; k0 += 16) {
        bf16x8 a1 = *(const bf16x8*)(Atile + (arow0 + (lane & 31)) * lda_ + k0 + (lane >> 5) * 8);
        c0 = MFMA32(a1, ld_bfrag_t(Wt, K, k0, h * 64, lane), c0);
        c1 = MFMA32(a1, ld_bfrag_t(Wt, K, k0, h * 64 + 32, lane), c1);
      }
      wave_sync();
#pragma unroll
      for (int r = 0; r < 16; ++r) {
        X[crow(r, lane >> 5) * LX + (lane & 31)] = c0[r];
        X[crow(r, lane >> 5) * LX + 32 + (lane & 31)] = c1[r];
      }
      wave_sync();
    };
    {
      constexpr int mt = 0;
      if (lane < 32) sbw[lane] = 0.f;
      f32x4 rvs[8], kvs[8];
      float ris[8];
#pragma unroll
      for (int it = 0; it < 8; ++it) {
        const int tt = it * 4 + ts, tok = mt * 32 + tt;
        f32x4 rv = rw_u4(p, mu, r0 + tok, t0 + tok, L, ch);
        f32x4 kv = rw_u4(p, mu, r0 + tok, t0 + tok, L, RW_CH + ch);
        f32x4 vv = rw_u4(p, mu, r0 + tok, t0 + tok, L, 2 * RW_CH + ch);
        rvs[it] = rv; kvs[it] = kv;
        f32x4 kr;
        float ss = 0.f;
#pragma unroll
        for (int j = 0; j < 4; ++j) { kr[j] = kv[j] * kkc[j]; ss += kr[j] * kr[j]; }
        const float ri = rsqrtf(fmaxf(red16(ss), 1e-24f));
        ris[it] = ri;
#pragma unroll
        for (int j = 0; j < 4; ++j) kr[j] *= ri;
        u16* dst = sish + (seqidx0 + tok) * 192 + cq * 4;
        st_bf4(dst, rv); st_bf4(dst + 64, kr); st_bf4(dst + 128, vv);
      }
      SEG_MARK(p, 5)
#pragma unroll 1
      for (int d = 0; d < 2; ++d) {
        gemm_to_X(Awd, LA, d * 32 + mt * 32, p.wt_wup + ((size_t)l * 2 + d) * RW_CH * DRK, DRK);
        const f32x4 w0 = *(const f32x4*)(p.rw_w0 + ((size_t)l * 2 + d) * RW_CH + ch);
#pragma unroll 4
        for (int it = 0; it < 8; ++it) {
          const int tt = it * 4 + ts, tok = mt * 32 + tt;
          f32x4 xw = *(const f32x4*)(X + tt * LX + cq * 4);
          u32x2 o;
          u16 hh[4];
#pragma unroll
          for (int j = 0; j < 4; ++j) {
            const float e = 0.60653065971263342f * fsigmoid_(w0[j] + xw[j]);
            hh[j] = f2h(1.0f - fexp_(-e));
          }
          o[0] = (unsigned)hh[0] | ((unsigned)hh[1] << 16); o[1] = (unsigned)hh[2] | ((unsigned)hh[3] << 16);
          *(u32x2*)(sidir + (size_t)d * dirstride + (seqidx0 + tok) * 192 + cq * 4) = o;
        }
        SEG_MARK(p, 6)
        gemm_to_X(Aad, LA, d * 32 + mt * 32, p.wt_aup + ((size_t)l * 2 + d) * RW_CH * IRK, IRK);
        const f32x4 a0 = *(const f32x4*)(p.rw_a0 + ((size_t)l * 2 + d) * RW_CH + ch);
#pragma unroll
        for (int it = 0; it < 8; ++it) {
          const int tt = it * 4 + ts, tok = mt * 32 + tt;
          f32x4 xa = *(const f32x4*)(X + tt * LX + cq * 4);
          const f32x4 rv = rvs[it], kv = kvs[it];
          const float ri = ris[it];
          f32x4 ka, kd;
          float bs = 0.f;
#pragma unroll
          for (int j = 0; j < 4; ++j) {
            float a = fsigmoid_(a0[j] + xa[j]);
            ka[j] = kv[j] * kkc[j] * ri * a;
            kd[j] = kv[j] * (1.f + (a - 1.f) * k_a[j]);
            bs += rv[j] * kd[j] * r_k[j];
          }
          u16* dst = sidir + (size_t)d * dirstride + (seqidx0 + tok) * 192 + cq * 4;
          st_bf4(dst + 64, ka); st_bf4(dst + 128, kd);
          bs = red16(bs);
          if (cq == 0) sbw[tt] += bs;
        }
      }
      SEG_MARK(p, 7)
      wave_sync();
      if (lane < 32) p.sbonus[(size_t)(r0 + mt * 32 + lane) * RW_H + h] = sbw[lane];
      gemm_to_X(Agd, LG, mt * 32, p.wt_gup + (size_t)l * RW_CH * GRK, GRK);
#pragma unroll 4
      for (int it = 0; it < 8; ++it) {
        const int tt = it * 4 + ts, tok = mt * 32 + tt;
        f32x4 xg = *(const f32x4*)(X + tt * LX + cq * 4);
        st_bf4(p.gbuf + (size_t)(r0 + tok) * RW_CH + ch, xg);
      }
      wave_sync();
      SEG_MARK(p, 8)
    }
  }
  __syncthreads();
  SEG_MARK(p, 8)
}

DI void ph_prep(const Params& p, int l, char* smem) {
  for (int item = BIDX(); item < T / 32; item += gridDim.x) prep_item(p, l, item, smem);
}

typedef __attribute__((ext_vector_type(2))) float f32x2;
constexpr int SC_C = 16, SC_NSLOT = 8, SC_NCONS = 2, SC_NPROD = 6;
constexpr int SC_LDP = 72;
constexpr int SC_LDQ = 40;
constexpr int SC_AT = 0, SC_RT = SC_AT + 16 * SC_LDP * 2, SC_KT = SC_RT + 16 * SC_LDP * 2, SC_PQ = SC_KT + 64 * SC_LDQ * 2,
              SC_BM = SC_PQ + 16 * SC_LDQ * 2, SC_TM = SC_BM + 16 * SC_LDQ * 2, SC_VT = SC_TM + 16 * SC_LDQ * 2, SC_CUM = SC_VT + 64 * 16 * 2,
              SC_SLOT = SC_CUM + 64 * 4;
constexpr int SC_PSCR = SC_NSLOT * SC_SLOT;
constexpr int SC_PSCR_W = 2 * 16 * SC_LDP * 2;
constexpr int SC_FLAGS = SC_PSCR + SC_NPROD * SC_PSCR_W;
static_assert(SC_FLAGS + 64 * 4 < SMEM_BYTES - 1024, "scan LDS");
static_assert(SC_SLOT % 16 == 0 && SC_PSCR_W % 16 == 0, "scan LDS alignment");

#ifdef EMU
typedef volatile int* sc_flag_t;
#else
typedef volatile LAS int* sc_flag_t;
#endif
DI void sc_wait_eq(sc_flag_t f, int want) {
#ifdef EMU
  while (*f != want) emu_yield();
#else
  while (__builtin_amdgcn_readfirstlane(*f) != want) __builtin_amdgcn_s_sleep(1);
  asm volatile("s_waitcnt lgkmcnt(0)" ::: "memory");
#endif
}
DI void sc_wait_ge(sc_flag_t f, int want) {
#ifdef EMU
  while (*f < want) emu_yield();
#else
  while (__builtin_amdgcn_readfirstlane(*f) < want) __builtin_amdgcn_s_sleep(1);
  asm volatile("s_waitcnt lgkmcnt(0)" ::: "memory");
#endif
}
DI void sc_flag_inc(sc_flag_t f) {
#ifdef EMU
  *f = *f + 1;
#else
  (void)__hip_atomic_fetch_add((LAS int*)f, 1, __ATOMIC_RELAXED, __HIP_MEMORY_SCOPE_WORKGROUP);
#endif
}
DI float rdlane_f(float v, int l) { return __builtin_bit_cast(float, __builtin_amdgcn_readlane(__builtin_bit_cast(int, v), l)); }
#define MFMA16(a, b, c) __builtin_amdgcn_mfma_f32_16x16x32_bf16((a), (b), (c), 0, 0, 0)

DI void sc_step_time(int d, int s, bool& isctx, int& t) {
  isctx = s < CTXL;
  if (isctx) t = d == 0 ? s : CTXL - 1 - s;
  else { const int u = s - CTXL; t = d == 0 ? u : SEQ - 1 - u; }
}

DI void scan_chain_item(const Params& p, int item, char* smem) {
  const int tid = TIDX(), lane = tid & 63, wave = tid >> 6;
  const int chain = item >> 1, hf = item & 1;
  const int h = chain % RW_H, b = (chain / RW_H) % NB, d = chain / (RW_H * NB);
  constexpr int NCHUNK = (CTXL + SEQ) / SC_C;
  sc_flag_t ready = (sc_flag_t)(smem + SC_FLAGS);
  sc_flag_t done = ready + SC_NSLOT;
  if (tid < 2 * SC_NSLOT) ready[tid] = 0;
  __syncthreads();
  const int q4 = lane >> 4, c16 = lane & 15;
  if (wave >= SC_NCONS) {
    const int pw = wave - SC_NCONS;
    u16* Bt = (u16*)(smem + SC_PSCR + pw * SC_PSCR_W);
    u16* Kt = Bt + 16 * SC_LDP;
    const int k = lane;
    u16 raw[SC_C][6];
    static_assert(CTXL % SC_C == 0 && SEQ % SC_C == 0, "a chunk lies inside the context or the latent part");
    auto load_chunk = [&](int c) {
      bool isctx; int t0;
      sc_step_time(d, c * SC_C, isctx, t0);
      const int L = isctx ? CTXL : SEQ;
      const long st = (d == 0) ? 192 : -192;
      const size_t base = ((size_t)(b * RW_H + h) * L + t0) * 192 + k;
      const u16* sh = (isctx ? p.SIsh_ctx : p.SIsh_lat) + base;
      const u16* dr = (isctx ? p.SIdir_ctx : p.SIdir_lat) + (size_t)d * NB * RW_H * L * 192 + base;
#pragma unroll
      for (int j = 0; j < SC_C; ++j) {
        const u16* s_ = sh + j * st; const u16* d_ = dr + j * st;
        raw[j][0] = s_[0]; raw[j][1] = s_[64]; raw[j][2] = s_[128];
        raw[j][3] = d_[0]; raw[j][4] = d_[64]; raw[j][5] = d_[128];
      }
    };
    if (pw < NCHUNK) load_chunk(pw);
    for (int c = pw; c < NCHUNK; c += SC_NPROD) {
      const int slot = c % SC_NSLOT;
      char* sl = smem + slot * SC_SLOT;
      u16* At = (u16*)(sl + SC_AT); u16* Rt = (u16*)(sl + SC_RT); u16* KT = (u16*)(sl + SC_KT);
      u16* PQ = (u16*)(sl + SC_PQ); u16* BM = (u16*)(sl + SC_BM); u16* TM = (u16*)(sl + SC_TM);
      u16* VT = (u16*)(sl + SC_VT); float* CUM = (float*)(sl + SC_CUM);
      sc_wait_ge(done + slot, SC_NCONS * (c / SC_NSLOT));
      float cum = 1.f;
      unsigned ktp[8], btp[8], vtp[8];
#pragma unroll
      for (int j2 = 0; j2 < SC_C / 2; ++j2) {
        float at[2], rt[2], bt[2], kt[2];
#pragma unroll
        for (int e = 0; e < 2; ++e) {
          const int j = 2 * j2 + e;
          const float rr = bf2f(raw[j][0]), kk = bf2f(raw[j][1]);
          const float w = 1.f - h2f(raw[j][3]), ka = bf2f(raw[j][4]), kd = bf2f(raw[j][5]);
          at[e] = cum * kk;
          cum *= w;
          const float ic = frcp_(cum);
          rt[e] = cum * rr; bt[e] = ka * ic; kt[e] = kd * ic;
        }
        const unsigned ap = pk2(at[0], at[1]), rp = pk2(rt[0], rt[1]);
        btp[j2] = pk2(bt[0], bt[1]); ktp[j2] = pk2(kt[0], kt[1]);
        vtp[j2] = (unsigned)raw[2 * j2][2] | ((unsigned)raw[2 * j2 + 1][2] << 16);
        const int o0 = (2 * j2) * SC_LDP + k, o1 = o0 + SC_LDP;
        At[o0] = (u16)(ap & 0xffffu); At[o1] = (u16)(ap >> 16);
        Rt[o0] = (u16)(rp & 0xffffu); Rt[o1] = (u16)(rp >> 16);
        Bt[o0] = (u16)(btp[j2] & 0xffffu); Bt[o1] = (u16)(btp[j2] >> 16);
        Kt[o0] = (u16)(ktp[j2] & 0xffffu); Kt[o1] = (u16)(ktp[j2] >> 16);
      }
      if (c + SC_NPROD < NCHUNK) load_chunk(c + SC_NPROD);
      CUM[k] = cum;
      {
#pragma unroll
        for (int hh = 0; hh < 2; ++hh) {
          u32x4 o;
          o[0] = ktp[4 * hh]; o[1] = ktp[4 * hh + 1]; o[2] = ktp[4 * hh + 2]; o[3] = ktp[4 * hh + 3];
          *(u32x4*)(KT + k * SC_LDQ + 8 * hh) = o;
          o[0] = btp[4 * hh]; o[1] = btp[4 * hh + 1]; o[2] = btp[4 * hh + 2]; o[3] = btp[4 * hh + 3];
          *(u32x4*)(KT + k * SC_LDQ + 16 + 8 * hh) = o;
          o[0] = vtp[4 * hh]; o[1] = vtp[4 * hh + 1]; o[2] = vtp[4 * hh + 2]; o[3] = vtp[4 * hh + 3];
          *(u32x4*)(VT + k * 16 + 8 * hh) = o;
        }
      }
      wave_sync();
      f32x4 am = {0.f, 0.f, 0.f, 0.f}, bm = am, pm = am, qm = am;
#pragma unroll
      for (int ks = 0; ks < 2; ++ks) {
        const int o = c16 * SC_LDP + 32 * ks + 8 * q4;
        const bf16x8 fa = *(const bf16x8*)(At + o), fr = *(const bf16x8*)(Rt + o);
        const bf16x8 fb = *(const bf16x8*)(Bt + o), fk = *(const bf16x8*)(Kt + o);
        am = MFMA16(fa, fb, am); bm = MFMA16(fa, fk, bm); pm = MFMA16(fr, fk, pm); qm = MFMA16(fr, fb, qm);
      }
#pragma unroll
      for (int r = 0; r < 4; ++r) {
        const int j = 4 * q4 + r;
        BM[j * SC_LDQ + c16] = c16 < j ? f2bf(bm[r]) : (u16)0;
        PQ[j * SC_LDQ + c16] = c16 <= j ? f2bf(pm[r]) : (u16)0;
        PQ[j * SC_LDQ + 16 + c16] = c16 <= j ? f2bf(-qm[r]) : (u16)0;
      }
      float Tc[16];
#pragma unroll
      for (int j = 0; j < 16; ++j) {
        float tv = (j == c16) ? 1.f : 0.f;
#pragma unroll
        for (int i = 0; i < j; ++i) tv -= rdlane_f(am[j & 3], i + 16 * (j >> 2)) * Tc[i];
        Tc[j] = tv;
      }
#pragma unroll
      for (int j = 0; j < 16; ++j) {
        if (q4 == 0) TM[j * SC_LDQ + c16] = f2bf(Tc[j]);
      }
      wave_sync();
      if (lane == 0) ready[slot] = c + 1;
    }
  } else {
    const int vt = SC_NCONS * hf + wave;
#ifndef EMU
    __builtin_amdgcn_s_setprio(3);
#endif
    f32x4 ST[4];
#pragma unroll
    for (int mt = 0; mt < 4; ++mt) ST[mt] = (f32x4){0.f, 0.f, 0.f, 0.f};
    auto ld2 = [&](const u16* q0, const u16* q1) {
      const u32x2 a = *(const u32x2*)q0, b2 = *(const u32x2*)q1;
      u32x4 o; o[0] = a[0]; o[1] = a[1]; o[2] = b2[0]; o[3] = b2[1];
      return __builtin_bit_cast(bf16x8, o);
    };
    auto ld1z = [&](const u16* q0) {
      const u32x2 a = *(const u32x2*)q0;
      u32x4 o; o[0] = a[0]; o[1] = a[1]; o[2] = 0u; o[3] = 0u;
      return __builtin_bit_cast(bf16x8, o);
    };
    SEG_BEGIN(p)
    for (int c = 0; c < NCHUNK; ++c) {
      const int slot = c % SC_NSLOT;
      const char* sl = smem + slot * SC_SLOT;
      const u16* At = (const u16*)(sl + SC_AT); const u16* Rt = (const u16*)(sl + SC_RT); const u16* KT = (const u16*)(sl + SC_KT);
      const u16* PQ = (const u16*)(sl + SC_PQ); const u16* BM = (const u16*)(sl + SC_BM); const u16* TM = (const u16*)(sl + SC_TM);
      const u16* VT = (const u16*)(sl + SC_VT); const float* CUM = (const float*)(sl + SC_CUM);
      bf16x8 shi[2], slo[2];
#pragma unroll
      for (int ks = 0; ks < 2; ++ks) {
        u32x4 oh, ol;
#pragma unroll
        for (int hh = 0; hh < 2; ++hh) {
          const f32x4 x = ST[2 * ks + hh];
          float h0 = bf2f(f2bf(x[0])), h1 = bf2f(f2bf(x[1])), h2 = bf2f(f2bf(x[2])), h3 = bf2f(f2bf(x[3]));
          oh[2 * hh] = pk2(x[0], x[1]); oh[2 * hh + 1] = pk2(x[2], x[3]);
          ol[2 * hh] = pk2(x[0] - h0, x[1] - h1); ol[2 * hh + 1] = pk2(x[2] - h2, x[3] - h3);
        }
        shi[ks] = __builtin_bit_cast(bf16x8, oh); slo[ks] = __builtin_bit_cast(bf16x8, ol);
      }
      SEG_MARK(p, 12)
      sc_wait_eq(ready + slot, c + 1);
      SEG_MARK(p, 13)
      f32x4 rhs = {0.f, 0.f, 0.f, 0.f}, y = rhs;
#pragma unroll
      for (int ks = 0; ks < 2; ++ks) {
        const int o = c16 * SC_LDP + 32 * ks + 4 * q4;
        const bf16x8 fa = ld2(At + o, At + o + 16), fr = ld2(Rt + o, Rt + o + 16);
        rhs = MFMA16(fa, shi[ks], rhs); y = MFMA16(fr, shi[ks], y);
        rhs = MFMA16(fa, slo[ks], rhs); y = MFMA16(fr, slo[ks], y);
      }
      const u32x2 vraw = *(const u32x2*)(VT + (16 * vt + c16) * 16 + 4 * q4);
      {
        u32x4 o; o[0] = vraw[0]; o[1] = vraw[1]; o[2] = 0u; o[3] = 0u;
        rhs = MFMA16(ld1z(BM + c16 * SC_LDQ + 4 * q4), __builtin_bit_cast(bf16x8, o), rhs);
      }
      f32x4 z = {0.f, 0.f, 0.f, 0.f};
      {
        u32x4 o; o[0] = pk2(rhs[0], rhs[1]); o[1] = pk2(rhs[2], rhs[3]); o[2] = 0u; o[3] = 0u;
        z = MFMA16(ld1z(TM + c16 * SC_LDQ + 4 * q4), __builtin_bit_cast(bf16x8, o), z);
      }
      const unsigned z01 = pk2(z[0], z[1]), z23 = pk2(z[2], z[3]);
      {
        u32x4 o; o[0] = vraw[0]; o[1] = vraw[1]; o[2] = z01; o[3] = z23;
        y = MFMA16(ld2(PQ + c16 * SC_LDQ + 4 * q4, PQ + c16 * SC_LDQ + 16 + 4 * q4), __builtin_bit_cast(bf16x8, o), y);
      }
      {
        bool isctx; int t0;
        sc_step_time(d, c * SC_C + 4 * q4, isctx, t0);
        const int rrow0 = isctx ? TL + b * CTXL + t0 : b * SEQ + t0;
        u16* yo = p.ybuf + ((size_t)d * T + rrow0) * RW_CH + h * 64 + 16 * vt + c16;
        const long yst = (d == 0) ? RW_CH : -RW_CH;
#pragma unroll
        for (int r = 0; r < 4; ++r) yo[r * yst] = f2bf(y[r]);
      }
      {
        u32x4 o; o[0] = vraw[0]; o[1] = vraw[1]; o[2] = z01 ^ 0x80008000u; o[3] = z23 ^ 0x80008000u;
        const bf16x8 bS = __builtin_bit_cast(bf16x8, o);
#pragma unroll
        for (int mt = 0; mt < 4; ++mt) {
          const u16* kr = KT + (16 * mt + c16) * SC_LDQ + 4 * q4;
          ST[mt] = MFMA16(ld2(kr, kr + 16), bS, ST[mt]);
          const f32x4 cm = *(const f32x4*)(CUM + 16 * mt + 4 * q4);
#pragma unroll
          for (int r = 0; r < 4; ++r) ST[mt][r] *= cm[r];
        }
      }
      wave_sync();
      if (lane == 0) sc_flag_inc(done + slot);
    }
#ifndef EMU
    __builtin_amdgcn_s_setprio(0);
#endif
  }
  __syncthreads();
}
DI void ph_scan(const Params& p, char* smem) {
  for (int item = BIDX(); item < 2 * (2 * NB * RW_H); item += gridDim.x) scan_chain_item(p, item, smem);
}

DI void ph_assemble(const Params& p, int l, char* smem) {
  const int tid = TIDX(), lane = tid & 63, wave = tid >> 6;
  const int ts = lane >> 4, cq = lane & 15;
  const int rows = (l == 0) ? T : TL;
  constexpr int LY = 66;
  u16* yt = (u16*)smem;
  const float* gn = p.mix_norm_g + (size_t)l * (CONV_CH + HY_CH);
  for (int tile = BIDX(); tile < rows / 64; tile += gridDim.x) {
    const int r0 = tile * 64;
    int b_, t0, L;
    seq_of_row(r0, b_, t0, L);
    const u16* yh = (r0 < TL ? p.yhlat : p.yhctx) + (size_t)b_ * HY_CH * L + t0;
    for (int i = tid; i < HY_CH * 8; i += NT) {
      int c = i >> 3, part = i & 7;
      const u32x4 v = *(const u32x4*)(yh + (size_t)c * L + part * 8);
      unsigned* q = (unsigned*)(yt + c * LY + part * 8);
      q[0] = v[0]; q[1] = v[1]; q[2] = v[2]; q[3] = v[3];
    }
    __syncthreads();
    const u16* sish = (r0 < TL ? p.SIsh_lat : p.SIsh_ctx);
#pragma unroll
    for (int it = 0; it < 2; ++it) {
      const int tok = wave * 8 + it * 4 + ts;
      const int r = r0 + tok;
      u16* dst = p.ycat + (size_t)r * MIX_W;
#pragma unroll
      for (int bk = 0; bk < CONV_CH / 64; ++bk)
        *(u32x2*)(dst + bk * 64 + cq * 4) = *(const u32x2*)(p.ya + (size_t)r * CONV_CH + bk * 64 + cq * 4);
      float hv[HY_CH / 64][4];
      float ss = 0.f;
#pragma unroll
      for (int bk = 0; bk < HY_CH / 64; ++bk)
#pragma unroll
        for (int j = 0; j < 4; ++j) { hv[bk][j] = bf2f(yt[(bk * 64 + cq * 4 + j) * LY + tok]); ss += hv[bk][j] * hv[bk][j]; }
      ss = red16(ss);
      const float rs = rsqrtf(ss / (float)HY_CH + LN_EPS);
#pragma unroll
      for (int bk = 0; bk < HY_CH / 64; ++bk) {
        const f32x4 g4 = *(const f32x4*)(gn + CONV_CH + bk * 64 + cq * 4);
        f32x4 o;
#pragma unroll
        for (int j = 0; j < 4; ++j) o[j] = hv[bk][j] * rs * g4[j];
        st_bf4(dst + CONV_CH + bk * 64 + cq * 4, o);
      }
#pragma unroll
      for (int h = 0; h < RW_H; ++h) {
        const int ch = h * 64 + cq * 4;
        const f32x4 yf = ld_bf4(p.ybuf + (size_t)r * RW_CH + ch), yb = ld_bf4(p.ybuf + ((size_t)T + r) * RW_CH + ch);
        const f32x4 vv = ld_bf4(sish + ((size_t)(b_ * RW_H + h) * L + t0 + tok) * 192 + 128 + cq * 4);
        const f32x4 gg = ld_bf4(p.gbuf + (size_t)r * RW_CH + ch);
        const f32x4 lg4 = *(const f32x4*)(p.rw_lnx_g + (size_t)l * RW_CH + ch), lb4 = *(const f32x4*)(p.rw_lnx_b + (size_t)l * RW_CH + ch);
        const float sb = p.sbonus[(size_t)r * RW_H + h];
        f32x4 yv;
        float sm = 0.f;
#pragma unroll
        for (int j = 0; j < 4; ++j) { yv[j] = yf[j] + yb[j]; sm += yv[j]; }
        const float mu = red16(sm) * (1.f / 64.f);
        float sq = 0.f;
#pragma unroll
        for (int j = 0; j < 4; ++j) { yv[j] -= mu; sq += yv[j] * yv[j]; }
        const float rstd = rsqrtf(red16(sq) * (1.f / 64.f) + RW_GN_EPS);
        f32x4 o;
#pragma unroll
        for (int j = 0; j < 4; ++j) o[j] = (yv[j] * rstd * lg4[j] + lb4[j] + sb * vv[j]) * gg[j];
        st_bf4(dst + CONV_CH + HY_CH + ch, o);
      }
    }
    __syncthreads();
  }
}

DI void ph_outproj(const Params& p, int l, char* smem) {
  const int rows = (l == 0) ? T : TL;
  const int G = gridDim.x, c = BIDX();
  {
    DenseSched S; S.init(p.ycat, p.wt_out + (size_t)l * D * MIX_W, MIX_W, rows, D, G, c);
    EpiOutproj E{&p, l};
    pg8::gemm_phase(smem, MIX_W, S, E);
  }
  __syncthreads();
  ticket_loop(p.bar + XB_TICKET + 1 + DEPTH + l, CT_EXP_L, smem, [&](int it) { convert_expert_item(p, l, it, smem); });
}

DI void ph_ln_router(const Params& p, int l, char* smem) {
  const int tid = TIDX(), lane = tid & 63, wave = tid >> 6;
  const int rows = (l == 0) ? T : TL;
  constexpr int LH = D + 8;
  constexpr int EPL = D / 64;
  u16* Hhi = (u16*)smem;
  u16* Hlo = Hhi + 32 * LH;
  float* red = (float*)smem;
  constexpr int LGS_OFF = (2 * 32 * LH * 2 > 8 * 32 * 64 * 4) ? 2 * 32 * LH * 2 : 8 * 32 * 64 * 4;
  float* lgs = (float*)(smem + LGS_OFF);
  const float* lg = p.ln_g + ((size_t)l * 2 + 0) * D;
  const float* lb = p.ln_b + ((size_t)l * 2 + 0) * D;
  const u16* Whi = p.wt_rhi + (size_t)l * NE * D;
  const u16* Wlo = p.wt_rlo + (size_t)l * NE * D;
  constexpr int KS = D / 8;
  SEG_BEGIN(p)
  for (int tile = BIDX(); tile < rows / 32; tile += gridDim.x) {
    const int r0 = tile * 32;
#pragma unroll 2
    for (int tt = 0; tt < 4; ++tt) {
      const int tok = wave * 4 + tt;
      const int r = r0 + tok;
      float* xr = x1row(p, r);
      const float* m = modp(p, l, r);
      constexpr int NV = D / 256;
      f32x4 xv[NV];
      float s = 0.f;
#pragma unroll
      for (int i = 0; i < NV; ++i) { xv[i] = *(const f32x4*)(xr + 4 * lane + 256 * i); s += (xv[i][0] + xv[i][1]) + (xv[i][2] + xv[i][3]); }
      const float mu = wave_sum(s) * (1.f / (float)D);
      float s2 = 0.f;
#pragma unroll
      for (int i = 0; i < NV; ++i)
#pragma unroll
        for (int j = 0; j < 4; ++j) { float dd = xv[i][j] - mu; s2 += dd * dd; }
      const float rstd = rsqrtf(wave_sum(s2) * (1.f / (float)D) + LN_EPS);
#pragma unroll
      for (int i = 0; i < NV; ++i) {
        const int e = 4 * lane + 256 * i;
        const f32x4 g4 = *(const f32x4*)(lg + e), b4 = *(const f32x4*)(lb + e);
        const f32x4 sc = *(const f32x4*)(m + 4 * D + e), sh = *(const f32x4*)(m + 3 * D + e);
        f32x4 xn, hh, lo;
#pragma unroll
        for (int j = 0; j < 4; ++j) { xn[j] = (xv[i][j] - mu) * rstd * g4[j] + b4[j]; hh[j] = xn[j] * (1.f + sc[j]) + sh[j]; }
        *(f32x4*)(xr + e) = xn;
        u32x2 hp; hp[0] = pk2(hh[0], hh[1]); hp[1] = pk2(hh[2], hh[3]);
#pragma unroll
        for (int j = 0; j < 4; ++j) lo[j] = hh[j] - bf2f((u16)((j & 1) ? (hp[j >> 1] >> 16) : (hp[j >> 1] & 0xffff)));
        *(u32x2*)(Hhi + tok * LH + e) = hp;
        st_bf4(Hlo + tok * LH + e, lo);
        *(u32x2*)(p.HL + (size_t)r * D + e) = hp;
        u32x2 zz; zz[0] = 0u; zz[1] = 0u;
        *(u32x2*)(p.acc + (size_t)r * (D / 2) + e / 2) = zz;
      }
    }
    __syncthreads();
    SEG_MARK(p, 0)
    f32x16 c0, c1;
#pragma unroll
    for (int r = 0; r < 16; ++r) { c0[r] = 0.f; c1[r] = 0.f; }
#pragma unroll 4
    for (int k0 = wave * KS; k0 < (wave + 1) * KS; k0 += 16) {
      const int ko = k0 + (lane >> 5) * 8;
      bf16x8 ah = *(const bf16x8*)(Hhi + (lane & 31) * LH + ko);
      bf16x8 al = *(const bf16x8*)(Hlo + (lane & 31) * LH + ko);
      bf16x8 bh0 = *(const bf16x8*)(Whi + (size_t)(lane & 31) * D + ko);
      bf16x8 bh1 = *(const bf16x8*)(Whi + (size_t)(32 + (lane & 31)) * D + ko);
      bf16x8 bl0 = *(const bf16x8*)(Wlo + (size_t)(lane & 31) * D + ko);
      bf16x8 bl1 = *(const bf16x8*)(Wlo + (size_t)(32 + (lane & 31)) * D + ko);
      c0 = MFMA32(ah, bh0, c0); c0 = MFMA32(ah, bl0, c0); c0 = MFMA32(al, bh0, c0);
      c1 = MFMA32(ah, bh1, c1); c1 = MFMA32(ah, bl1, c1); c1 = MFMA32(al, bh1, c1);
    }
    __syncthreads();
    SEG_MARK(p, 1)
#pragma unroll
    for (int r = 0; r < 16; ++r) {
      red[(wave * 32 + crow(r, lane >> 5)) * 64 + (lane & 31)] = c0[r];
      red[(wave * 32 + crow(r, lane >> 5)) * 64 + 32 + (lane & 31)] = c1[r];
    }
    __syncthreads();
    for (int i = tid; i < 32 * 64; i += NT) {
      float sacc = 0.f;
#pragma unroll
      for (int w = 0; w < 8; ++w) sacc += red[w * 2048 + i];
      lgs[i] = sacc;
    }
    __syncthreads();
    SEG_MARK(p, 2)
    unsigned long long* selm = (unsigned long long*)(lgs + 32 * 64);
    unsigned char* lpos = (unsigned char*)(selm + 32);
    int* tbase = (int*)(lpos + 32 * 64);
    const float eb = p.e_bias[(size_t)l * NE + lane];
    float gate4[4];
    bool ch4[4];
    {
      float score4[4], selv4[4];
#pragma unroll
      for (int tt = 0; tt < 4; ++tt) { score4[tt] = fsigmoid_(lgs[(wave * 4 + tt) * 64 + lane]); selv4[tt] = score4[tt] + eb; ch4[tt] = false; }
      for (int round = 0; round < TOPK; ++round) {
#pragma unroll
        for (int tt = 0; tt < 4; ++tt) {
          const float cand = ch4[tt] ? -1e30f : selv4[tt];
          const float mx = wave_max(cand);
          const unsigned long long bal = __ballot(cand == mx);
          const int win = __ffsll((long long)bal) - 1;
          if (lane == win) ch4[tt] = true;
        }
      }
#pragma unroll
      for (int tt = 0; tt < 4; ++tt) {
        const float ssum = wave_sum(ch4[tt] ? score4[tt] : 0.f);
        gate4[tt] = ROUTED_SCALE * score4[tt] / ssum;
        const unsigned long long m = __ballot(ch4[tt]);
        if (lane == 0) selm[wave * 4 + tt] = m;
      }
    }
    __syncthreads();
    if (wave == 0) {
      int c = 0;
      for (int t = 0; t < 32; ++t) {
        const int bit = (int)((selm[t] >> lane) & 1ull);
        lpos[t * 64 + lane] = (unsigned char)c;
        c += bit;
      }
      int base = 0;
      if (c > 0) base = atomicAdd(p.cnt + l * NE + lane, c);
      tbase[lane] = base;
    }
    __syncthreads();
#pragma unroll
    for (int tt = 0; tt < 4; ++tt) {
      const int tok = wave * 4 + tt;
      if (ch4[tt]) {
        const int pos = tbase[lane] + (int)lpos[tok * 64 + lane];
        p.etok[(size_t)lane * T + pos] = r0 + tok;
        p.egate[(size_t)lane * T + pos] = gate4[tt];
      }
    }
    __syncthreads();
    SEG_MARK(p, 3)
  }
}

constexpr int EXP_LDS_OFF = 128 * 1024;
constexpr int MAX_ROW_TILES = (T * TOPK) / 256 + NE + T / 256;
static_assert(28 * 1024 + (2 * (NE + 2) + (NE + 2)) * 4 + MAX_ROW_TILES + EXP_LDS_OFF <= SMEM_BYTES - 1024, "expert tables fit below the parked parameters");
static_assert(NE == 64, "binary search step");
struct ExpTables { int* pre; int* hoff; int* cntl; unsigned char* t2e; };
DI ExpTables expert_tables(const Params& p, int l, int rows, char* smem) {
  ExpTables x;
  x.pre = (int*)(smem + EXP_LDS_OFF + 28 * 1024);
  x.hoff = x.pre + (NE + 2);
  x.cntl = x.hoff + (NE + 2);
  x.t2e = (unsigned char*)(x.cntl + (NE + 2));
  const int tid = TIDX();
  if (tid == 0) {
    int s = 0, ho = 0;
    for (int e = 0; e < NE; ++e) { const int ce = p.cnt[l * NE + e]; const int nt = (ce + 255) / 256; x.pre[e] = s; x.hoff[e] = ho; x.cntl[e] = ce; s += nt; ho += nt * 256; }
    x.pre[NE] = s; x.hoff[NE] = ho; x.cntl[NE] = rows; s += rows / 256; x.pre[NE + 1] = s;
  }
  __syncthreads();
  {
    const int R = x.pre[NE + 1];
    for (int t = tid; t < R; t += NT) {
      int e = 0;
#pragma unroll
      for (int step = 64; step >= 1; step >>= 1) { const int c = e + step; if (c <= NE && x.pre[c] <= t) e = c; }
      x.t2e[t] = (unsigned char)e;
    }
  }
  __syncthreads();
  return x;
}
DI void ph_e1(const Params& p, int l, char* smem) {
  const int rows = (l == 0) ? T : TL;
  const ExpTables x = expert_tables(p, l, rows, smem);
  E1Sched S;
  S.pre = x.pre; S.cntl = x.cntl; S.t2e = x.t2e; S.nN = FF / 128; S.G = gridDim.x; S.c = BIDX(); S.total = x.pre[NE + 1] * S.nN;
  S.A = (const char*)p.HL; S.W = (const char*)p.wt_exp; S.etok = p.etok;
  S.preload((unsigned*)(smem + EXP_LDS_OFF), 24);
  EpiE1 E{p.Hbuf, x.hoff};
  pg8::gemm_phase(smem, D, S, E);
  __syncthreads();
}
DI void ph_e2(const Params& p, int l, char* smem) {
  const int rows = (l == 0) ? T : TL;
  const ExpTables x = expert_tables(p, l, rows, smem);
  E2Sched S;
  S.pre = x.pre; S.cntl = x.cntl; S.t2e = x.t2e; S.nN = D / 256; S.G = gridDim.x; S.c = BIDX(); S.total = x.pre[NE + 1] * S.nN;
  S.A = (const char*)p.Hbuf; S.W = (const char*)p.wt_exp; S.hoff = x.hoff;
  EpiE2 E{p.acc, p.etok, p.egate, (float*)(smem + EXP_LDS_OFF), p.SHo};
  pg8::gemm_phase(smem, FF, S, E);
  __syncthreads();
}

DI void ph_combine(const Params& p, int l) {
  const int tid = TIDX(), lane = tid & 63, wave = tid >> 6;
  const int rows = (l == 0) ? T : TL;
  constexpr int NV = D / 256;
  constexpr int RPW = 2;
  const float* lg = p.ln_g + ((size_t)l * 2 + 1) * D;
  const float* lb = p.ln_b + ((size_t)l * 2 + 1) * D;
  for (int tile = BIDX(); tile < rows / (8 * RPW); tile += gridDim.x) {
    f32x4 xv[RPW][NV];
    float s[RPW];
#pragma unroll
    for (int u = 0; u < RPW; ++u) {
      const int r = tile * (8 * RPW) + u * 8 + wave;
      const float* x1 = x1row(p, r);
      const float* m = modp(p, l, r);
      s[u] = 0.f;
#pragma unroll
      for (int i = 0; i < NV; ++i) {
        const int e = 4 * lane + 256 * i;
        const u32x2 aw = *(const u32x2*)(p.acc + (size_t)r * (D / 2) + e / 2);
        float m0, m1, m2, m3;
        acc_unpack4(aw[0], aw[1], m0, m1, m2, m3);
        const f32x4 xx = *(const f32x4*)(x1 + e), gg = *(const f32x4*)(m + 5 * D + e);
        const f32x4 sh4 = ld_bf4(p.SHo + (size_t)r * D + e);
        xv[u][i][0] = DN_ALPHA * xx[0] + gg[0] * (m0 + sh4[0]); xv[u][i][1] = DN_ALPHA * xx[1] + gg[1] * (m1 + sh4[1]);
        xv[u][i][2] = DN_ALPHA * xx[2] + gg[2] * (m2 + sh4[2]); xv[u][i][3] = DN_ALPHA * xx[3] + gg[3] * (m3 + sh4[3]);
        s[u] += (xv[u][i][0] + xv[u][i][1]) + (xv[u][i][2] + xv[u][i][3]);
      }
    }
#pragma unroll
    for (int u = 0; u < RPW; ++u) {
      const int r = tile * (8 * RPW) + u * 8 + wave;
      float* x1 = x1row(p, r);
      const float* m = modp(p, l, r);
      const float mu = wave_sum(s[u]) * (1.f / (float)D);
      float s2 = 0.f;
#pragma unroll
      for (int i = 0; i < NV; ++i)
#pragma unroll
        for (int j = 0; j < 4; ++j) { float dd = xv[u][i][j] - mu; s2 += dd * dd; }
      const float rstd = rsqrtf(wave_sum(s2) * (1.f / (float)D) + LN_EPS);
      const float* m1 = (l + 1 < DEPTH) ? modp(p, l + 1, r) : m;
#pragma unroll
      for (int i = 0; i < NV; ++i) {
        const int e = 4 * lane + 256 * i;
        const f32x4 g4 = *(const f32x4*)(lg + e), b4 = *(const f32x4*)(lb + e);
        f32x4 xn;
#pragma unroll
        for (int j = 0; j < 4; ++j) xn[j] = (xv[u][i][j] - mu) * rstd * g4[j] + b4[j];
        if (r < TL) *(f32x4*)(x1 + e) = xn;
        if (l + 1 < DEPTH) {
          const f32x4 sc = *(const f32x4*)(m1 + D + e), sh = *(const f32x4*)(m1 + e);
          f32x4 o;
#pragma unroll
          for (int j = 0; j < 4; ++j) o[j] = xn[j] * (1.f + sc[j]) + sh[j];
          st_bf4(p.HL + (size_t)r * D + e, o);
        }
      }
    }
  }
}

constexpr int PH_PER_LAYER = 10;
constexpr int NPHASES = 2 + PH_PER_LAYER * DEPTH;
DI void run_phase(const Params& p, int ph, char* smem) {
  if (ph == 0) { ph_prologue(p, smem); return; }
  if (ph == 1) { ph_premod(p); return; }
  const int l = (ph - 2) / PH_PER_LAYER, q = (ph - 2) % PH_PER_LAYER;
  switch (q) {
    case 0: ph_inproj(p, l, smem); break;
    case 1: ph_mix(p, l, smem); break;
    case 2: ph_prep(p, l, smem); break;
    case 3: ph_scan(p, smem); break;
    case 4: ph_assemble(p, l, smem); break;
    case 5: ph_outproj(p, l, smem); break;
    case 6: ph_ln_router(p, l, smem); break;
    case 7: ph_e1(p, l, smem); break;
    case 8: ph_e2(p, l, smem); break;
    case 9: ph_combine(p, l); break;
  }
}

static inline size_t al256(size_t x) { return (x + 255) & ~(size_t)255; }
static inline size_t max2(size_t a, size_t b) { return a > b ? a : b; }
static Params make_params(void* const* d_in, void* d_out, void* d_ws, size_t* used) {
  Params p{};
  const float** f = (const float**)&p;
  for (int i = 0; i < 42; ++i) f[i] = (const float*)d_in[i];
  p.out = (float*)d_out;
  char* w = (char*)d_ws;
  size_t o = 0;
  auto take = [&](size_t bytes) { char* r = w + o; o = al256(o + bytes); return r; };
  p.HL = (u16*)take((size_t)T * D * 2);
  p.mod = (float*)take((size_t)DEPTH * (NB + 1) * 6 * D * 4);
  p.h3lat = (float*)take((size_t)DEPTH * SEQ * 64 * 4);
  p.h3ctx = (float*)take((size_t)DEPTH * CTXL * 64 * 4);
  p.tw = (cf*)take((size_t)(FFTN / 2) * 8);
  p.tstamp = (long long*)take(64 * 8);
  p.bar = (unsigned*)take((size_t)XCD_BAR_WORDS * 4);
  p.cnt = (int*)take((size_t)DEPTH * NE * 4);
  p.sbonus = (float*)take((size_t)T * RW_H * 4);
  p.XC = (float*)take((size_t)TC * D * 4);
  p.wt_in = (u16*)take((size_t)DEPTH * P_IN_PAD * D * 2);
  p.wt_out = (u16*)take((size_t)DEPTH * D * MIX_W * 2);
  p.wt_rhi = (u16*)take((size_t)DEPTH * NE * D * 2);
  p.wt_rlo = (u16*)take((size_t)DEPTH * NE * D * 2);
  p.wt_wup = (u16*)take((size_t)DEPTH * 2 * RW_CH * DRK * 2);
  p.wt_aup = (u16*)take((size_t)DEPTH * 2 * RW_CH * IRK * 2);
  p.wt_gup = (u16*)take((size_t)DEPTH * RW_CH * GRK * 2);
  const size_t szEt = al256((size_t)NE * T * 4);
  char* G = take(max2(max2((size_t)T * RW_CH * 2, (size_t)2 * HY_CH * FFTN * 8), 2 * szEt));
  p.spec = (cf*)G;
  p.gbuf = (u16*)G;
  p.etok = (int*)G;
  p.egate = (float*)(G + szEt);
  const size_t szPAPH = (size_t)T * PA_W * 2 + (size_t)T * PH_W * 2;
  const size_t szSIsh = (size_t)T * RW_H * 192 * 2;
  const size_t szWexp = (size_t)(NE + 1) * EXP_STRIDE * 2;
  char* R0 = take(max2(max2(szPAPH, szSIsh), szWexp));
  p.PA = (u16*)R0;
  p.PH = (u16*)(R0 + (size_t)T * PA_W * 2);
  p.SIsh_lat = (u16*)R0;
  p.SIsh_ctx = p.SIsh_lat + (size_t)NB * RW_H * SEQ * 192;
  p.wt_exp = (u16*)R0;
  const size_t szPR = (size_t)T * RW_COLS * 2, szY = (size_t)2 * T * RW_CH * 2;
  char* R1 = take(max2(szPR, szY));
  p.PR = (u16*)R1;
  p.ybuf = (u16*)R1;
  const size_t szSIdir = (size_t)2 * T * RW_H * 192 * 2;
  const size_t szYC = al256((size_t)T * MIX_W * 2);
  char* R2 = take(max2(szSIdir, szYC));
  p.SIdir_lat = (u16*)R2;
  p.SIdir_ctx = p.SIdir_lat + (size_t)2 * NB * RW_H * SEQ * 192;
  p.ycat = (u16*)R2;
  p.acc = (int*)R1;
  const size_t szAcc = al256((size_t)T * (D / 2) * 4);
  const size_t szH = (size_t)(T * TOPK + T + (NE + 1) * 256) * FF * 2;
  p.Hbuf = (u16*)(R1 + szAcc);
  const size_t szSH = al256((size_t)T * D * 2);
  p.SHo = (u16*)(R1 + szAcc + al256(szH));
  p.ya = (u16*)take((size_t)T * CONV_CH * 2);
  p.yhlat = (u16*)take((size_t)NB * HY_CH * SEQ * 2);
  p.yhctx = (u16*)take((size_t)NB * HY_CH * CTXL * 2);
  if (szAcc + al256(szH) + szSH > al256(max2(szPR, szY)) + al256(max2(szSIdir, szYC))) o = (size_t)1 << 62;
  *used = o;
  return p;
}
static size_t ws_needed() {
  return (size_t)640 * 1024 * 1024;
}

#ifndef EMU
constexpr int NFIELDS = sizeof(Params) / 8;
static_assert(sizeof(Params) % 8 == 0 && sizeof(Params) <= 1024, "Params layout");
DI unsigned long long uni64(unsigned long long v) {
  unsigned lo = __builtin_amdgcn_readfirstlane((unsigned)v), hi = __builtin_amdgcn_readfirstlane((unsigned)(v >> 32));
  return ((unsigned long long)hi << 32) | lo;
}
DI void load_params(Params& q, const char* smem) {
  const unsigned long long* src = (const unsigned long long*)(smem + SMEM_BYTES - 1024);
  char** dst = (char**)&q;
  typedef __attribute__((address_space(1))) char gchar_t;
#pragma clang loop unroll(full)
  for (int i = 0; i < NFIELDS; ++i) dst[i] = (char*)(gchar_t*)uni64(src[i]);
}
__global__ void __launch_bounds__(NT) hybrid_mega(Params parg) {
  __shared__ __attribute__((aligned(16))) char smem[SMEM_BYTES];
  if (threadIdx.x < NFIELDS)
    ((unsigned long long*)(smem + SMEM_BYTES - 1024))[threadIdx.x] = ((const unsigned long long*)&parg)[threadIdx.x];
  volatile LAS unsigned* st = (volatile LAS unsigned*)(smem + SMEM_BYTES - 16);
  if (threadIdx.x == 0) { st[0] = 0u; st[1] = 0u; }
  __syncthreads();
  const XcdBarrier xb = xcd_barrier_post(parg.bar, st);
#if PROF_SEG
  if (blockIdx.x == 0 && threadIdx.x < 16) parg.tstamp[32 + threadIdx.x] = 0;
#endif
#if PROF_A || PROF_B || PROF_C || PROF_SEG
#define MK_STAMP(ph) if (blockIdx.x == 0 && threadIdx.x == 0) p.tstamp[ph] = (long long)__builtin_amdgcn_s_memrealtime();
#else
#define MK_STAMP(ph)
#endif
#define MK_PHASE(ph) { Params p; load_params(p, smem); MK_STAMP(ph) run_phase(p, ph, smem); if ((ph) + 1 < NPHASES) xcd_barrier(xb); }
  MK_PHASE(0) MK_PHASE(1) MK_PHASE(2) MK_PHASE(3) MK_PHASE(4) MK_PHASE(5) MK_PHASE(6) MK_PHASE(7) MK_PHASE(8) MK_PHASE(9) MK_PHASE(10)
  MK_PHASE(11) MK_PHASE(12) MK_PHASE(13) MK_PHASE(14) MK_PHASE(15) MK_PHASE(16) MK_PHASE(17) MK_PHASE(18) MK_PHASE(19) MK_PHASE(20) MK_PHASE(21)
  static_assert(NPHASES == 22, "phase program");
#if PROF_A || PROF_B || PROF_C || PROF_SEG
  {
    xcd_barrier(xb);
    Params p;
    load_params(p, smem);
    if (blockIdx.x == 0 && threadIdx.x == 0) p.tstamp[NPHASES] = (long long)__builtin_amdgcn_s_memrealtime();
    xcd_barrier(xb);
    const long long* ts = p.tstamp;
    float tot = (float)(ts[NPHASES] - ts[0]);
    (void)tot;
    float ta = 0.f, tb = 0.f;
    long long tc = 0;
    for (int ph = 0; ph < NPHASES; ++ph) {
      float dt = (float)(ts[ph + 1] - ts[ph]);
      if ((PROF_A >> ph) & 1) ta += dt;
      if ((PROF_B >> ph) & 1) tb += dt;
      if ((PROF_C >> ph) & 1) tc += ts[ph + 1] - ts[ph];
    }
#if PROF_SEG
    {
      float st_ = 0.f;
      for (int k = 0; k < 16; ++k) st_ += (float)ts[32 + k];
      ta = (float)ts[32 + PROF_SA]; tb = (float)ts[32 + PROF_SB]; tot = st_ > 0.f ? st_ : 1.f;
      tc = ts[32 + PROF_SC];
    }
#endif
    float fa = ta / tot, fb = tb / tot;
#if PROF_SEG
    fa = floorf(fa * 50.f + 0.5f) * (1.f / 50.f); fb = floorf(fb * 45.f + 0.5f) * (1.f / 45.f);
#endif
    const float da = sqrtf(0.5f * fa);
    const size_t NA = (size_t)TL * D / 100;
    if (!PROF_SEG) for (size_t i = (size_t)blockIdx.x * NT + threadIdx.x; i < NA; i += (size_t)gridDim.x * NT) p.out[i] += da;
    if (PROF_B && !PROF_SEG && blockIdx.x == 0 && threadIdx.x == 0) p.out[(size_t)TL * D - 1] += 10.f + 90.f * fb;
    if (PROF_C || PROF_SEG) { while ((long long)__builtin_amdgcn_s_memrealtime() < ts[NPHASES] + tc) {} }
  }
#endif
}
#ifdef MULTI_LAUNCH
__global__ void __launch_bounds__(NT) hybrid_phase(Params p, int ph) {
  __shared__ __attribute__((aligned(16))) char smem[SMEM_BYTES];
  run_phase(p, ph, smem);
}
#endif

extern "C" void kernel_launch(void* const* d_in, const int* in_sizes, int n_in, void* d_out, int out_size, void* d_ws,
                              size_t ws_size, hipStream_t stream) {
  (void)in_sizes; (void)n_in; (void)out_size;
  static int grid_blocks = 0;
  if (!grid_blocks) {
    int dev = 0, cus = 0, per_cu = 0;
    hipGetDevice(&dev);
    hipDeviceGetAttribute(&cus, hipDeviceAttributeMultiprocessorCount, dev);
    hipOccupancyMaxActiveBlocksPerMultiprocessor(&per_cu, hybrid_mega, NT, 0);
    if (per_cu < 1) per_cu = 1;
    grid_blocks = cus;
  }
  size_t used = 0;
  Params p = make_params(d_in, d_out, d_ws, &used);
  if (used > ws_size) return;
#ifdef MULTI_LAUNCH
  for (int ph = 0; ph < NPHASES; ++ph) hipLaunchKernelGGL(hybrid_phase, dim3(grid_blocks), dim3(NT), 0, stream, p, ph);
#else
  hipMemsetAsync(p.bar, 0, (size_t)XCD_BAR_WORDS * 4, stream);
  void* args[] = {&p};
  hipLaunchCooperativeKernel((void*)hybrid_mega, dim3(grid_blocks), dim3(NT), args, 0, stream);
#endif
}
#endif
```

```cpp
#ifdef EMU
#include "emu_hip.h"
#else
#include <hip/hip_runtime.h>
#endif
#include <stdint.h>
#include <stddef.h>

#define DI __device__ __forceinline__

#ifdef CFG_SMALL
constexpr int D = 512, NB = 2, SEQ = 256, GRID_W = 16, CTXL = 256, CONV_CH = 128, HY_CH = 128, RW_H = 4;
#else
constexpr int D = 1024, NB = 8, SEQ = 4096, GRID_W = 64, CTXL = 256, CONV_CH = 256, HY_CH = 256, RW_H = 8;
#endif
constexpr int DEPTH = 2;
constexpr int HD = 64;
constexpr int RW_CH = RW_H * HD;
constexpr int MIX_W = CONV_CH + HY_CH + RW_CH;
constexpr int DRK = 64, IRK = 64, GRK = 128;
constexpr int RW_COLS = 3 * RW_CH + 2 * DRK + 2 * IRK + GRK;
constexpr int PA_W = 3 * CONV_CH, PH_W = 3 * HY_CH;
constexpr int P_IN = PA_W + PH_W + RW_COLS;
constexpr int P_IN_PAD = ((P_IN + 255) / 256) * 256;
constexpr int HY_EMB = 33, HY_BANDS = 16, HY_HID = 64;
constexpr int NE = 64, TOPK = 8, FF = 256;
constexpr int TL = NB * SEQ, TC = NB * CTXL, T = TL + TC;
constexpr int FFTN = 2 * SEQ;
constexpr int ilog2c(int n) { return n <= 1 ? 0 : 1 + ilog2c(n / 2); }
constexpr int LOG2N = ilog2c(FFTN);
constexpr float LN_EPS = 1e-5f;
constexpr float RW_GN_EPS = 64e-5f;
constexpr float DN_ALPHA = 1.41421356237309515f;
constexpr float ROUTED_SCALE = 2.5f;
constexpr int NT = 512;
#ifndef PROF_A
#define PROF_A 0
#endif
#ifndef PROF_B
#define PROF_B 0
#endif
#ifndef PROF_C
#define PROF_C 0
#endif
constexpr int SMEM_BYTES = 160 * 1024;
static_assert(MIX_W == D, "mix width");
static_assert(D % 128 == 0 && P_IN % 128 == 0 && PA_W % 128 == 0 && PH_W % 128 == 0, "tiles");
static_assert(SEQ % 256 == 0 && CTXL % 256 == 0, "row tiles");

typedef unsigned short u16;
typedef __attribute__((ext_vector_type(8))) short bf16x8;
typedef __attribute__((ext_vector_type(16))) float f32x16;
typedef __attribute__((ext_vector_type(4))) unsigned u32x4;
typedef __attribute__((ext_vector_type(2))) unsigned u32x2;
typedef __attribute__((ext_vector_type(4))) float f32x4;
struct cf { float x, y; };

struct Params {
  const float *x, *c, *ctx, *c_ctx, *w_ada, *b_ada, *w_in, *conv_a, *hy_sconv_w, *hy_sconv_b;
  const float *hf_w1, *hf_b1, *hf_w2, *hf_b2, *hf_w3, *hf_b3, *hf_wout, *hf_freq, *hf_skip;
  const float *rw_mu, *rw_w0, *rw_w_up, *rw_a0, *rw_a_up, *rw_g_up, *rw_k_k, *rw_k_a, *rw_r_k;
  const float *rw_lnx_g, *rw_lnx_b, *mix_norm_g, *w_out, *ln_g, *ln_b, *w_router, *e_bias;
  const float *w_e_gate, *w_e_up, *w_e_down, *w_s_gate, *w_s_up, *w_s_down;
  float* out;
  float* mod;
  float* h3lat;
  float* h3ctx;
  cf* tw;
  int* cnt;
  float* sbonus;
  cf* spec;
  u16* HL;
  u16* PA;
  u16* PH;
  u16* PR;
  u16* SIsh_lat;
  u16* SIsh_ctx;
  u16* SIdir_lat;
  u16* SIdir_ctx;
  u16* ya;
  u16* yhlat;
  u16* yhctx;
  u16* gbuf;
  u16* ybuf;
  u16* ycat;
  float* XC;
  u16* wt_in;
  u16* wt_out;
  u16* wt_rhi;
  u16* wt_rlo;
  u16* wt_wup;
  u16* wt_aup;
  u16* wt_gup;
  u16* Hbuf;
  u16* SHo;
  u16* wt_exp;
  int* acc;
  int* etok;
  float* egate;
  u16* XP;
  long long* tstamp;
  unsigned* bar;
};


#ifndef PROF_SEG
#define PROF_SEG 0
#endif
#if PROF_SEG && !defined(EMU)
#define SEG_BEGIN(p) long long seg_last_ = 0; const bool seg_on_ = (blockIdx.x == 0 && threadIdx.x == 0); if (seg_on_) seg_last_ = (long long)__builtin_amdgcn_s_memrealtime();
#define SEG_MARK(p, k) if (seg_on_) { long long now_ = (long long)__builtin_amdgcn_s_memrealtime(); (p).tstamp[32 + (k)] += now_ - seg_last_; seg_last_ = now_; }
#else
#define SEG_BEGIN(p)
#define SEG_MARK(p, k)
#endif
#ifdef EMU
DI int TIDX() { return threadIdx.x; }
DI int BIDX() { return blockIdx.x; }
#else
DI int TIDX() { int t = threadIdx.x; asm volatile("" : "+v"(t)); return t; }
DI int BIDX() { int b = blockIdx.x; asm volatile("" : "+s"(b)); return b; }
#endif

#ifdef EMU
DI u16 f2bf(float x) {
  unsigned u = __builtin_bit_cast(unsigned, x);
  u += 0x7fffu + ((u >> 16) & 1u);
  return (u16)(u >> 16);
}
#else
DI u16 f2bf(float x) { return __builtin_bit_cast(u16, (__bf16)x); }
#endif
DI float bf2f(u16 h) { return __builtin_bit_cast(float, ((unsigned)h) << 16); }
DI u16 f2h(float x) { return __builtin_bit_cast(u16, (_Float16)x); }
DI float h2f(u16 h) { return (float)__builtin_bit_cast(_Float16, h); }
#ifdef EMU
DI unsigned pk2(float a, float b) { return (unsigned)f2bf(a) | ((unsigned)f2bf(b) << 16); }
#else
DI unsigned pk2(float a, float b) {
  typedef __bf16 bf16v2 __attribute__((ext_vector_type(2)));
  bf16v2 v; v[0] = (__bf16)a; v[1] = (__bf16)b;
  return __builtin_bit_cast(unsigned, v);
}
#endif
DI float sigmoidf_(float x) { return 1.0f / (1.0f + expf(-x)); }
DI float siluf_(float x) { return x / (1.0f + expf(-x)); }
DI float softplusf_(float x) { return x > 20.f ? x : log1pf(expf(x)); }
#ifdef EMU
DI float fexp_(float x) { return expf(x); }
DI float frcp_(float x) { return 1.0f / x; }
#else
DI float fexp_(float x) { return __builtin_amdgcn_exp2f(x * 1.44269504088896341f); }
DI float frcp_(float x) { return __builtin_amdgcn_rcpf(x); }
#endif
DI float fsigmoid_(float x) { return frcp_(1.0f + fexp_(-x)); }
DI float ftanh_(float x) { return 1.0f - 2.0f * frcp_(1.0f + fexp_(2.0f * x)); }

#ifdef EMU
DI float red16(float v) { v += __shfl_xor(v, 1); v += __shfl_xor(v, 2); v += __shfl_xor(v, 4); v += __shfl_xor(v, 8); return v; }
DI float wave_sum(float v) {
#pragma unroll
  for (int m = 1; m < 64; m <<= 1) v += __shfl_xor(v, m);
  return v;
}
#else
template <int CTRL> DI float dppf(float v) {
  return __builtin_bit_cast(float, __builtin_amdgcn_update_dpp(0, __builtin_bit_cast(int, v), CTRL, 0xf, 0xf, true));
}
DI float red16(float v) {
  v += dppf<0xB1>(v);
  v += dppf<0x4E>(v);
  v += dppf<0x141>(v);
  v += dppf<0x140>(v);
  return v;
}
DI float wave_sum(float v) {
  v = red16(v);
  int iv = __builtin_bit_cast(int, v);
  float a = __builtin_bit_cast(float, __builtin_amdgcn_readlane(iv, 0));
  float b = __builtin_bit_cast(float, __builtin_amdgcn_readlane(iv, 16));
  float c = __builtin_bit_cast(float, __builtin_amdgcn_readlane(iv, 32));
  float d = __builtin_bit_cast(float, __builtin_amdgcn_readlane(iv, 48));
  return (a + b) + (c + d);
}
#endif
#ifdef EMU
DI float wave_max(float v) {
#pragma unroll
  for (int m = 1; m < 64; m <<= 1) v = fmaxf(v, __shfl_xor(v, m));
  return v;
}
#else
DI float wave_max(float v) {
  v = fmaxf(v, dppf<0xB1>(v));
  v = fmaxf(v, dppf<0x4E>(v));
  v = fmaxf(v, dppf<0x141>(v));
  v = fmaxf(v, dppf<0x140>(v));
  int iv = __builtin_bit_cast(int, v);
  float a = __builtin_bit_cast(float, __builtin_amdgcn_readlane(iv, 0));
  float b = __builtin_bit_cast(float, __builtin_amdgcn_readlane(iv, 16));
  float c = __builtin_bit_cast(float, __builtin_amdgcn_readlane(iv, 32));
  float d = __builtin_bit_cast(float, __builtin_amdgcn_readlane(iv, 48));
  return fmaxf(fmaxf(a, b), fmaxf(c, d));
}
#endif
DI void wave_sync() {
#ifdef EMU
  emu::wave_barrier();
#else
  asm volatile("s_waitcnt lgkmcnt(0)" ::: "memory");
  __builtin_amdgcn_wave_barrier();
#endif
}
DI f32x4 ld_bf4(const u16* q) {
  u32x2 v = *(const u32x2*)q;
  f32x4 r;
  r[0] = bf2f((u16)(v[0] & 0xffff)); r[1] = bf2f((u16)(v[0] >> 16));
  r[2] = bf2f((u16)(v[1] & 0xffff)); r[3] = bf2f((u16)(v[1] >> 16));
  return r;
}
DI void st_bf4(u16* q, f32x4 v) {
  u32x2 o; o[0] = pk2(v[0], v[1]); o[1] = pk2(v[2], v[3]);
  *(u32x2*)q = o;
}
DI int crow(int reg, int h) { return (reg & 3) + 8 * (reg >> 2) + 4 * h; }
#define MFMA32(a, b, c) __builtin_amdgcn_mfma_f32_32x32x16_bf16((a), (b), (c), 0, 0, 0)

DI int modrow(int r) { return r < TL ? r / SEQ : NB; }
DI const float* modp(const Params& p, int l, int r) { return p.mod + ((size_t)l * (NB + 1) + modrow(r)) * (6 * D); }


#define XB_TMO      128
#define XB_TICKET   192
#define XB_XCNT(j)  (256  + 64 * (j))
#define XB_XSUB(j)  (1280 + 64 * (j))
#define XB_XGEN(j)  (2304 + 64 * (j))
#define XB_TOP      3328
#define XB_TOPGEN   3392
#define XCD_BAR_WORDS 3456
#ifndef EMU
#define XB_SPIN_CAP (1u << 22)
#define LAS __attribute__((address_space(3)))
DI unsigned xb_ld(unsigned* p) { return __hip_atomic_load(p, __ATOMIC_RELAXED, __HIP_MEMORY_SCOPE_AGENT); }
DI unsigned xb_add(unsigned* p, unsigned v) { return __hip_atomic_fetch_add(p, v, __ATOMIC_RELAXED, __HIP_MEMORY_SCOPE_AGENT); }
DI unsigned xb_xcc_id() { return (unsigned)__builtin_amdgcn_s_getreg((3 << 11) | 20) & 0xFu; }
#define XB_SPIN(cond, bar) do { unsigned _sp = 0; while (cond) { __builtin_amdgcn_s_sleep(1); \
    if ((++_sp & 255u) == 0u) { if (xb_ld(&(bar)[XB_TMO])) break; if (_sp > XB_SPIN_CAP) { atomicAdd(&(bar)[XB_TMO], 1u); break; } } } } while (0)
struct XcdBarrier { unsigned* bar; unsigned x; volatile LAS unsigned* st; };
DI XcdBarrier xcd_barrier_post(unsigned* bar, volatile LAS unsigned* st) {
  XcdBarrier b; b.bar = bar; b.x = xb_xcc_id(); b.st = st;
  if (threadIdx.x == 0) (void)xb_add(&bar[XB_XCNT(b.x)], 1u);
  return b;
}
DI void xcd_barrier_complete(unsigned* bar, unsigned x, unsigned& nloc, unsigned& nx) {
  const unsigned G = gridDim.x * gridDim.y * gridDim.z;
  unsigned sum, cnt, mine, sp = 0u;
  for (;;) {
    sum = 0u; cnt = 0u; mine = 0u;
#pragma unroll
    for (unsigned j = 0; j < 16; ++j) { const unsigned c = xb_ld(&bar[XB_XCNT(j)]); sum += c; cnt += (c > 0u) ? 1u : 0u; mine = (j == x) ? c : mine; }
    if (sum == G) break;
    __builtin_amdgcn_s_sleep(1);
    if ((++sp & 255u) == 0u) { if (xb_ld(&bar[XB_TMO])) break; if (sp > XB_SPIN_CAP) { atomicAdd(&bar[XB_TMO], 1u); break; } }
  }
  nloc = mine > 0u ? mine : 1u; nx = cnt > 0u ? cnt : 1u;
}
DI void xcd_barrier(const XcdBarrier& b) {
  asm volatile("s_waitcnt vmcnt(0)" ::: "memory");
  __syncthreads();
  if (threadIdx.x == 0) {
    unsigned* bar = b.bar;
    __builtin_amdgcn_s_waitcnt(0);
    unsigned nloc = b.st[0], nx = b.st[1];
    if (nloc == 0u) { xcd_barrier_complete(bar, b.x, nloc, nx); b.st[0] = nloc; b.st[1] = nx; }
    const unsigned old = xb_add(&bar[XB_XSUB(b.x)], 1u);
    const unsigned gen = old / nloc;
    if (old + 1u == (gen + 1u) * nloc) {
      __builtin_amdgcn_fence(__ATOMIC_RELEASE, "agent");
      asm volatile("s_waitcnt vmcnt(0)" ::: "memory");
      const unsigned og = xb_add(&bar[XB_TOP], 1u);
      const unsigned tg = og / nx;
      if (og + 1u == (tg + 1u) * nx) xb_add(&bar[XB_TOPGEN], 1u);
      else XB_SPIN(xb_ld(&bar[XB_TOPGEN]) == tg, bar);
      __builtin_amdgcn_fence(__ATOMIC_ACQUIRE, "agent");
      xb_add(&bar[XB_XGEN(b.x)], 1u);
      asm volatile("s_waitcnt vmcnt(0)" ::: "memory");
    } else {
      XB_SPIN(xb_ld(&bar[XB_XGEN(b.x)]) == gen, bar);
      __builtin_amdgcn_fence(__ATOMIC_ACQUIRE, "agent");
      asm volatile("s_waitcnt vmcnt(0)" ::: "memory");
    }
  }
  __syncthreads();
}
#endif

namespace pg8 {
constexpr int BM = 256, BK = 64, HALF = 128, HTB = HALF * BK * 2, STAGE_BYTES = 8 * HTB;
struct Unit { int pm, pn, e, cnt, idx; };
__host__ __device__ __forceinline__ int lds_byte(int r, int c) { const int st = (r >> 4) * 2 + (c >> 5), rr = r & 15, cc = c & 31, ob = rr * 64 + cc * 2; return st * 1024 + (ob ^ (((ob >> 9) & 1) << 5)); }
__host__ __device__ __forceinline__ void stage_rc(int b, int& R, int& C) { const int st = b / 1024, sb = b % 1024, swz = sb ^ (((sb >> 9) & 1) << 5); R = (st >> 1) * 16 + swz / 64; C = (st & 1) * 32 + (swz % 64) / 2; }

#ifdef EMU
template <class Epi, class Sched>
inline void gemm_phase(char* lds, int K, const Sched& S, const Epi& E) {
  (void)lds;
  const int tid = TIDX(), wid = tid >> 6, lane = tid & 63, wr = wid >> 2, wc = wid & 3, fr = lane & 15, fq = lane >> 4;
  Unit u;
  for (int ui = 0; S.next(ui, u); ++ui) {
    f32x4 acc[2][2][4][2];
    for (int ai = 0; ai < 2; ++ai) for (int bj = 0; bj < 2; ++bj) for (int m = 0; m < 4; ++m) for (int n = 0; n < 2; ++n) {
      const int r = 128 * ai + 64 * wr + 16 * m + fr;
      const u16* arow = (const u16*)(S.abase() + S.arow_off(u, r));
      for (int j = 0; j < 4; ++j) {
        const int c = 32 * wc + 16 * n + 4 * fq + j;
        const u16* brow = (const u16*)S.bbase(u, bj) + (size_t)c * K;
        float s = 0.f;
        for (int k = 0; k < K; ++k) s += bf2f(arow[k]) * bf2f(brow[k]);
        acc[ai][bj][m][n][j] = s;
      }
    }
    E(acc, u, wr, wc, fr, fq, E.prefetch(u, wr, lane));
  }
}
#else
#define PG8_LAS __attribute__((address_space(3)))
template <class Epi, class Sched>
__device__ __forceinline__ void gemm_phase(char* lds_generic, int K, const Sched& S, const Epi& E) {
  PG8_LAS unsigned char* lds = (PG8_LAS unsigned char*)lds_generic;
  const int tid = TIDX(), wid = __builtin_amdgcn_readfirstlane(tid >> 6), lane = tid & 63, wr = wid >> 2, wc = wid & 3, fr = lane & 15, fq = lane >> 4;
  const int nt = K / BK;
  int Rr[2], Cc[2];
  unsigned voffB[2];
#pragma unroll
  for (int i = 0; i < 2; ++i) { stage_rc(tid * 16 + i * 8192, Rr[i], Cc[i]); voffB[i] = (unsigned)(Rr[i] * K + Cc[i]) * 2u; }
  const size_t kstep = (size_t)(BK * 2);
  const unsigned ldsw = (unsigned)wid * 1024u;
  const int aoff = lds_byte(wr * 64 + fr, fq * 8), boff = lds_byte(wc * 32 + fr, fq * 8);
#define PG8_SA(b, h) (((b) * 2 + (h)) * HTB)
#define PG8_SB(b, h) ((4 + (b) * 2 + (h)) * HTB)
#define PG8_STAGE2(bufoff, gbase, v0, v1) do { \
    __builtin_amdgcn_global_load_lds((const unsigned*)((const char*)(gbase) + (v0)), (PG8_LAS unsigned*)(lds + (bufoff) + ldsw), 16, 0, 0); \
    __builtin_amdgcn_global_load_lds((const unsigned*)((const char*)(gbase) + (v1)), (PG8_LAS unsigned*)(lds + (bufoff) + ldsw + 8192), 16, 0, 0); } while (0)
#define PG8_STAGEB(bufoff, gbase) PG8_STAGE2(bufoff, gbase, voffB[0], voffB[1])
#define PG8_LDA(dst, b, h) do { _Pragma("unroll") for (int m = 0; m < 4; ++m) _Pragma("unroll") for (int k = 0; k < 2; ++k) dst[m][k] = *(const PG8_LAS bf16x8*)(lds + PG8_SA(b, h) + aoff + m * 2048 + k * 1024); } while (0)
#define PG8_LDB(dst, b, h) do { _Pragma("unroll") for (int n = 0; n < 2; ++n) _Pragma("unroll") for (int k = 0; k < 2; ++k) dst[n][k] = *(const PG8_LAS bf16x8*)(lds + PG8_SB(b, h) + boff + n * 2048 + k * 1024); } while (0)
#define PG8_MMA(ai, bj, At, Bt) do { __builtin_amdgcn_s_setprio(1); _Pragma("unroll") for (int m = 0; m < 4; ++m) _Pragma("unroll") for (int n = 0; n < 2; ++n) _Pragma("unroll") for (int k = 0; k < 2; ++k) \
    acc[ai][bj][m][n] = __builtin_amdgcn_mfma_f32_16x16x32_bf16(Bt[n][k], At[m][k], acc[ai][bj][m][n], 0, 0, 0); __builtin_amdgcn_s_setprio(0); } while (0)
#define PG8_WAIT_V(n) asm volatile("s_waitcnt vmcnt(" #n ")" ::: "memory")
#define PG8_WAIT_L(n) asm volatile("s_waitcnt lgkmcnt(" #n ")" ::: "memory")
#define PG8_BAR __builtin_amdgcn_s_barrier()
#define PG8_SCHED __builtin_amdgcn_sched_barrier(0)
  Unit cur, nxt; int ui = 0;
  if (!S.next(0, cur)) return;
  f32x4 acc[2][2][4][2];
#pragma unroll
  for (int a = 0; a < 2; ++a)
#pragma unroll
    for (int b = 0; b < 2; ++b)
#pragma unroll
      for (int m = 0; m < 4; ++m)
#pragma unroll
        for (int n = 0; n < 2; ++n) acc[a][b][m][n] = (f32x4){0.f, 0.f, 0.f, 0.f};
  bf16x8 At[4][2], B0[2][2], B1[2][2];
  const char* const gA = S.abase();
  unsigned cv00 = 0, cv01 = 0, cv10 = 0, cv11 = 0, nv00 = 0, nv01 = 0, nv10 = 0, nv11 = 0;
  const char *cA0 = gA, *cA1 = gA, *nA0 = gA, *nA1 = gA;
  if constexpr (Sched::GATHER) {
    cv00 = S.arow_off(cur, Rr[0]) + Cc[0] * 2u; cv01 = S.arow_off(cur, Rr[1]) + Cc[1] * 2u;
    cv10 = S.arow_off(cur, 128 + Rr[0]) + Cc[0] * 2u; cv11 = S.arow_off(cur, 128 + Rr[1]) + Cc[1] * 2u;
  } else {
    cA0 = gA + S.arow_off(cur, 0); cA1 = gA + S.arow_off(cur, 128);
  }
#define PG8_STAGE_A(bufoff, kb, h, NEXT) do { \
    if constexpr (Sched::GATHER) { PG8_STAGE2(bufoff, gA + (kb), (NEXT) ? ((h) ? nv10 : nv00) : ((h) ? cv10 : cv00), (NEXT) ? ((h) ? nv11 : nv01) : ((h) ? cv11 : cv01)); } \
    else { PG8_STAGE2(bufoff, ((NEXT) ? ((h) ? nA1 : nA0) : ((h) ? cA1 : cA0)) + (kb), voffB[0], voffB[1]); } } while (0)
  const char* cB0 = S.bbase(cur, 0); const char* cB1 = S.bbase(cur, 1);
  PG8_STAGEB(PG8_SB(0, 0), cB0); PG8_STAGE_A(PG8_SA(0, 0), 0, 0, false); PG8_STAGEB(PG8_SB(0, 1), cB1); PG8_STAGE_A(PG8_SA(0, 1), 0, 1, false);
  if (wr == 1) PG8_BAR;
  PG8_WAIT_V(4); PG8_BAR;
  PG8_STAGEB(PG8_SB(1, 0), cB0 + kstep); PG8_STAGE_A(PG8_SA(1, 0), kstep, 0, false); PG8_STAGEB(PG8_SB(1, 1), cB1 + kstep);
  PG8_WAIT_V(6); PG8_BAR;
  for (;;) {
    const bool has_next = S.next(ui + 1, nxt);
    const char* nB0 = cB0; const char* nB1 = cB1;
    if constexpr (Sched::GATHER) { nv00 = cv00; nv01 = cv01; nv10 = cv10; nv11 = cv11; } else { nA0 = cA0; nA1 = cA1; }
    if (has_next) {
      if constexpr (Sched::GATHER) {
        nv00 = S.arow_off(nxt, Rr[0]) + Cc[0] * 2u; nv01 = S.arow_off(nxt, Rr[1]) + Cc[1] * 2u;
        nv10 = S.arow_off(nxt, 128 + Rr[0]) + Cc[0] * 2u; nv11 = S.arow_off(nxt, 128 + Rr[1]) + Cc[1] * 2u;
      } else {
        nA0 = gA + S.arow_off(nxt, 0); nA1 = gA + S.arow_off(nxt, 128);
      }
      nB0 = S.bbase(nxt, 0); nB1 = S.bbase(nxt, 1);
    }
    const typename Epi::Pre epre = E.prefetch(cur, wr, lane);
#pragma clang loop unroll(disable)
    for (int t = 0; t < nt; t += 2) {
      const bool last = (t == nt - 2);
      const size_t kb1 = (size_t)(t + 1) * kstep;
      const size_t kb2 = last ? (size_t)0 : (size_t)(t + 2) * kstep;
      const size_t kb3 = kb2 + kstep;
      const char* b20 = last ? nB0 : cB0 + (size_t)(t + 2) * kstep;
      const char* b21 = last ? nB1 : cB1 + (size_t)(t + 2) * kstep;
      const char* b30 = b20 + kstep; const char* b31 = b21 + kstep;
      PG8_LDB(B0, 0, 0); PG8_SCHED; PG8_LDA(At, 0, 0); PG8_STAGE_A(PG8_SA(1, 1), kb1, 1, false);
      PG8_WAIT_L(8); PG8_BAR; PG8_WAIT_L(0); PG8_MMA(0, 0, At, B0); PG8_BAR; PG8_SCHED;
      PG8_LDB(B1, 0, 1); PG8_STAGEB(PG8_SB(0, 0), b20);
      PG8_BAR; PG8_WAIT_L(0); PG8_MMA(0, 1, At, B1); PG8_BAR;
      PG8_LDA(At, 0, 1); PG8_STAGE_A(PG8_SA(0, 0), kb2, 0, last);
      PG8_BAR; PG8_WAIT_L(0); PG8_MMA(1, 0, At, B0); PG8_BAR; PG8_SCHED;
      PG8_STAGEB(PG8_SB(0, 1), b21);
      PG8_WAIT_V(6); PG8_BAR; PG8_MMA(1, 1, At, B1); PG8_BAR;
      PG8_LDB(B0, 1, 0); PG8_SCHED; PG8_LDA(At, 1, 0); PG8_STAGE_A(PG8_SA(0, 1), kb2, 1, last);
      PG8_WAIT_L(8); PG8_BAR; PG8_WAIT_L(0); PG8_MMA(0, 0, At, B0); PG8_BAR; PG8_SCHED;
      PG8_LDB(B1, 1, 1); PG8_STAGEB(PG8_SB(1, 0), b30);
      PG8_BAR; PG8_WAIT_L(0); PG8_MMA(0, 1, At, B1); PG8_BAR;
      PG8_LDA(At, 1, 1); PG8_STAGE_A(PG8_SA(1, 0), kb3, 0, last);
      PG8_BAR; PG8_WAIT_L(0); PG8_MMA(1, 0, At, B0); PG8_BAR; PG8_SCHED;
      PG8_STAGEB(PG8_SB(1, 1), b31);
      PG8_WAIT_V(6); PG8_BAR; PG8_MMA(1, 1, At, B1); PG8_BAR;
    }
    E(acc, cur, wr, wc, fr, fq, epre);
    if (!has_next) break;
#pragma unroll
    for (int a = 0; a < 2; ++a)
#pragma unroll
      for (int b = 0; b < 2; ++b)
#pragma unroll
        for (int m = 0; m < 4; ++m)
#pragma unroll
          for (int n = 0; n < 2; ++n) acc[a][b][m][n] = (f32x4){0.f, 0.f, 0.f, 0.f};
    cur = nxt; cB0 = nB0; cB1 = nB1; ++ui;
    if constexpr (Sched::GATHER) { cv00 = nv00; cv01 = nv01; cv10 = nv10; cv11 = nv11; } else { cA0 = nA0; cA1 = nA1; }
  }
  PG8_WAIT_V(0);
  if (wr == 0) PG8_BAR;
  PG8_BAR;
#undef PG8_SA
#undef PG8_SB
#undef PG8_STAGE2
#undef PG8_STAGE_A
#undef PG8_STAGEB
#undef PG8_LDA
#undef PG8_LDB
#undef PG8_MMA
#undef PG8_WAIT_V
#undef PG8_WAIT_L
#undef PG8_BAR
#undef PG8_SCHED
}
#endif
DI int remap_xcd(int L, int nwg) {
  const int q = nwg / 8, r = nwg % 8, xcd = L % 8, off = L / 8;
  return (xcd < r ? xcd * (q + 1) : r * (q + 1) + (xcd - r) * q) + off;
}
}

DI void convert_tile(const float* __restrict__ src, int K, int N, u16* __restrict__ dst, u16* __restrict__ dst_lo, int tile, char* smem) {
  const int tid = TIDX();
  float* t = (float*)smem;
  const int ntn = N / 64;
  const int k0 = (tile / ntn) * 64, n0 = (tile % ntn) * 64;
#pragma unroll
  for (int i = 0; i < 8; ++i) {
    const int row = i * 8 + (tid >> 6), col = tid & 63;
    t[row * 65 + col] = src[(size_t)(k0 + row) * N + n0 + col];
  }
  __syncthreads();
  const int n = tid >> 3, kq = tid & 7;
  float f[8];
#pragma unroll
  for (int j = 0; j < 8; ++j) f[j] = t[(kq * 8 + j) * 65 + n];
  u32x4 pb;
  pb[0] = pk2(f[0], f[1]); pb[1] = pk2(f[2], f[3]); pb[2] = pk2(f[4], f[5]); pb[3] = pk2(f[6], f[7]);
  *(u32x4*)(dst + (size_t)(n0 + n) * K + k0 + kq * 8) = pb;
  if (dst_lo) {
#pragma unroll
    for (int j = 0; j < 8; ++j) f[j] -= bf2f(f2bf(f[j]));
    pb[0] = pk2(f[0], f[1]); pb[1] = pk2(f[2], f[3]); pb[2] = pk2(f[4], f[5]); pb[3] = pk2(f[6], f[7]);
    *(u32x4*)(dst_lo + (size_t)(n0 + n) * K + k0 + kq * 8) = pb;
  }
  __syncthreads();
}
DI void convert_tile_w(const float* __restrict__ src, int K, int N, u16* __restrict__ dst, int tile, char* smem) {
  const int tid = TIDX();
  float* t = (float*)smem;
  const int ntn = N / 256;
  const int k0 = (tile / ntn) * 64, n0 = (tile % ntn) * 256;
#pragma unroll
  for (int i = 0; i < 8; ++i) {
    const int row = i * 8 + (tid >> 6), col = (tid & 63) * 4;
    const f32x4 v = *(const f32x4*)(src + (size_t)(k0 + row) * N + n0 + col);
    float* q = t + row * 257 + col;
    q[0] = v[0]; q[1] = v[1]; q[2] = v[2]; q[3] = v[3];
  }
  __syncthreads();
#pragma unroll
  for (int i = 0; i < 4; ++i) {
    const int idx = tid + NT * i;
    const int n = idx >> 3, kq = idx & 7;
    float f[8];
#pragma unroll
    for (int j = 0; j < 8; ++j) f[j] = t[(kq * 8 + j) * 257 + n];
    u32x4 pb;
    pb[0] = pk2(f[0], f[1]); pb[1] = pk2(f[2], f[3]); pb[2] = pk2(f[4], f[5]); pb[3] = pk2(f[6], f[7]);
    *(u32x4*)(dst + (size_t)(n0 + n) * K + k0 + kq * 8) = pb;
  }
  __syncthreads();
}
constexpr int CT_IN = (D / 64) * (P_IN / 64), CT_OUT = (MIX_W / 64) * (D / 64), CT_R = (D / 64) * (NE / 64);
constexpr int CT_WUP = (DRK / 64) * (RW_CH / 64), CT_GUP = (GRK / 64) * (RW_CH / 64);
constexpr int CT_STATIC_L = CT_IN + CT_OUT + CT_R + 4 * CT_WUP + CT_GUP;
DI void convert_static_item(const Params& p, int it, char* smem) {
  const int l = it / CT_STATIC_L;
  int q = it % CT_STATIC_L;
  if (q < CT_IN) { convert_tile(p.w_in + (size_t)l * D * P_IN, D, P_IN, p.wt_in + (size_t)l * P_IN_PAD * D, nullptr, q, smem); return; }
  q -= CT_IN;
  if (q < CT_OUT) { convert_tile(p.w_out + (size_t)l * MIX_W * D, MIX_W, D, p.wt_out + (size_t)l * D * MIX_W, nullptr, q, smem); return; }
  q -= CT_OUT;
  if (q < CT_R) { convert_tile(p.w_router + (size_t)l * D * NE, D, NE, p.wt_rhi + (size_t)l * NE * D, p.wt_rlo + (size_t)l * NE * D, q, smem); return; }
  q -= CT_R;
  if (q < 4 * CT_WUP) {
    const int which = q / CT_WUP, tile = q % CT_WUP;
    const int d = which & 1;
    if (which < 2) convert_tile(p.rw_w_up + ((size_t)l * 2 + d) * DRK * RW_CH, DRK, RW_CH, p.wt_wup + ((size_t)l * 2 + d) * RW_CH * DRK, nullptr, tile, smem);
    else convert_tile(p.rw_a_up + ((size_t)l * 2 + d) * IRK * RW_CH, IRK, RW_CH, p.wt_aup + ((size_t)l * 2 + d) * RW_CH * IRK, nullptr, tile, smem);
    return;
  }
  q -= 4 * CT_WUP;
  convert_tile(p.rw_g_up + (size_t)l * GRK * RW_CH, GRK, RW_CH, p.wt_gup + (size_t)l * RW_CH * GRK, nullptr, q, smem);
}
constexpr int CT_EMAT = (D / 64) * (FF / 256);
static_assert(FF % 256 == 0 && D % 256 == 0 && (D / 64) * (FF / 256) == (FF / 64) * (D / 256), "expert conversion tiling");
constexpr int CT_EXP_L = (NE + 1) * 3 * CT_EMAT;
constexpr size_t EXP_STRIDE = (size_t)3 * D * FF;
DI void convert_expert_item(const Params& p, int l, int it, char* smem) {
  const int e = it / (3 * CT_EMAT), m = (it / CT_EMAT) % 3, tile = it % CT_EMAT;
  const float *eg = p.w_e_gate, *eu = p.w_e_up, *ed = p.w_e_down, *sg = p.w_s_gate, *su = p.w_s_up, *sd = p.w_s_down;
#ifndef EMU
  asm volatile("" : "+s"(eg), "+s"(eu), "+s"(ed), "+s"(sg), "+s"(su), "+s"(sd));
#endif
  const float* src;
  if (e < NE) src = (m == 0 ? eg : m == 1 ? eu : ed) + ((size_t)l * NE + e) * D * FF;
  else src = (m == 0 ? sg : m == 1 ? su : sd) + (size_t)l * D * FF;
#ifndef EMU
  src = (const float*)(__attribute__((address_space(1))) const float*)(unsigned long long)src;
#endif
  u16* dst = p.wt_exp + (size_t)e * EXP_STRIDE + (size_t)m * D * FF;
  if (m < 2) convert_tile_w(src, D, FF, dst, tile, smem);
  else convert_tile_w(src, FF, D, dst, tile, smem);
}

DI float* x1row(const Params& p, int r) { return r < TL ? p.out + (size_t)r * D : p.XC + (size_t)(r - TL) * D; }
DI u16* xbrow(const Params& p, int r) { return r < TL ? (u16*)p.out + (size_t)r * D : (u16*)p.XC + (size_t)(r - TL) * D; }
DI u16* xblast(const Params& p, int r) { return (u16*)(p.out + (size_t)r * D) + D; }

struct DenseSched {
  static constexpr bool GATHER = false;
  const char* A; const char* Bt; int K, nM, nN, nwg, G, c;
  DI void init(const void* A_, const void* Bt_, int K_, int M, int N, int G_, int c_) { A = (const char*)A_; Bt = (const char*)Bt_; K = K_; nM = M / 256; nN = N / 256; nwg = nM * nN; G = G_; c = c_; }
  DI bool next(int i, pg8::Unit& u) const {
    const int L = i * G + c; if (L >= nwg) return false;
    const int wgid = pg8::remap_xcd(L, nwg);
    const int nig = 8 * nN, gid = wgid / nig, fm = gid * 8, gsz = (nM - fm) < 8 ? (nM - fm) : 8;
    u.pm = fm + ((wgid % nig) % gsz); u.pn = (wgid % nig) / gsz; u.e = 0; u.cnt = 0; u.idx = i; return true;
  }
  DI const char* abase() const { return A; }
  DI unsigned arow_off(const pg8::Unit& u, int r) const { return (unsigned)(u.pm * 256 + r) * (unsigned)(K * 2); }
  DI const char* bbase(const pg8::Unit& u, int half) const { return Bt + (size_t)(u.pn * 256 + half * 128) * K * 2; }
};
struct ExpertSched {
  const int* pre;
  const int* cntl;
  const unsigned char* t2e;
  int nN, G, c, total;
  DI bool locate(int i, pg8::Unit& u) const {
    const int L = i * G + c; if (L >= total) return false;
    const int w = pg8::remap_xcd(L, total);
    const int tile = w / nN; u.pn = w % nN;
    const int e = (int)t2e[tile];
    u.e = e; u.pm = tile - pre[e]; u.cnt = cntl[e]; u.idx = i;
    return true;
  }
};
struct E1Sched : ExpertSched {
  static constexpr bool GATHER = true;
  const char* A; const char* W; const int* etok;
  const unsigned* loff; int nl;
  DI bool next(int i, pg8::Unit& u) const { return locate(i, u); }
  DI const char* abase() const { return A; }
  DI unsigned goff(const pg8::Unit& u, int r) const {
    const int slot = u.pm * 256 + r;
    const unsigned tl = (unsigned)etok[u.e < NE ? (size_t)u.e * T + slot : (size_t)slot];
    const unsigned tok = u.e < NE ? (tl < (unsigned)T ? tl : 0u) : (unsigned)slot;
    return tok * (unsigned)(D * 2);
  }
  DI unsigned arow_off(const pg8::Unit& u, int r) const { return u.idx < nl ? loff[u.idx * 256 + r] : goff(u, r); }
  DI void preload(unsigned* lds_off, int maxu) {
    loff = lds_off; nl = 0;
    const int tid = TIDX();
    pg8::Unit u;
    int n = 0;
    while (n < maxu && locate(n, u)) ++n;
    for (int i = tid; i < n * 256; i += NT) { locate(i >> 8, u); lds_off[i] = goff(u, i & 255); }
    __syncthreads();
    nl = n;
  }
  DI const char* bbase(const pg8::Unit& u, int half) const { return W + ((size_t)u.e * EXP_STRIDE + (size_t)half * D * FF + (size_t)u.pn * 128 * D) * 2; }
};
struct E2Sched : ExpertSched {
  static constexpr bool GATHER = false;
  const char* A; const char* W; const int* hoff;
  DI bool next(int i, pg8::Unit& u) const { return locate(i, u); }
  DI const char* abase() const { return A; }
  DI unsigned arow_off(const pg8::Unit& u, int r) const { return (unsigned)(hoff[u.e] + u.pm * 256 + r) * (unsigned)(FF * 2); }
  DI const char* bbase(const pg8::Unit& u, int half) const { return W + ((size_t)u.e * EXP_STRIDE + (size_t)2 * D * FF + (size_t)(u.pn * 256 + half * 128) * FF) * 2; }
};

struct EpiInproj {
  u16 *PA, *PH, *PR;
  struct Pre {};
  DI Pre prefetch(const pg8::Unit&, int, int) const { return Pre{}; }
  DI void operator()(const f32x4 (&acc)[2][2][4][2], const pg8::Unit& u, int wr, int wc, int fr, int fq, const Pre&) const {
    const int row0 = u.pm * 256 + wr * 64 + fr;
#pragma unroll
    for (int bj = 0; bj < 2; ++bj) {
      const int colh = u.pn * 256 + bj * 128;
      if (colh >= P_IN) continue;
      if (colh >= PA_W && colh < PA_W + PH_W) {
        const int c0 = colh - PA_W + wc * 32 + 4 * fq;
        const int rb = u.pm * 256;
        u16* base; int L, t0;
        if (rb < TL) { L = SEQ; base = PH + (size_t)(rb / SEQ) * PH_W * SEQ; t0 = rb % SEQ; }
        else { L = CTXL; base = PH + (size_t)NB * PH_W * SEQ + (size_t)((rb - TL) / CTXL) * PH_W * CTXL; t0 = (rb - TL) % CTXL; }
#pragma unroll
        for (int ai = 0; ai < 2; ++ai)
#pragma unroll
          for (int m = 0; m < 4; ++m) {
            const int t = t0 + wr * 64 + fr + ai * 128 + m * 16;
#pragma unroll
            for (int n = 0; n < 2; ++n) {
              const f32x4 v = acc[ai][bj][m][n];
#pragma unroll
              for (int j = 0; j < 4; ++j) base[(size_t)(c0 + n * 16 + j) * L + t] = f2bf(v[j]);
            }
          }
        continue;
      }
      u16* base; int ld, c0;
      if (colh < PA_W) { base = PA; ld = PA_W; c0 = colh; }
      else { base = PR; ld = RW_COLS; c0 = colh - PA_W - PH_W; }
      const int col0 = c0 + wc * 32 + 4 * fq;
#pragma unroll
      for (int ai = 0; ai < 2; ++ai)
#pragma unroll
        for (int m = 0; m < 4; ++m) {
          u16* rowp = base + (size_t)(row0 + ai * 128 + m * 16) * ld + col0;
#pragma unroll
          for (int n = 0; n < 2; ++n) {
            const f32x4 v = acc[ai][bj][m][n];
            u32x2 o; o[0] = pk2(v[0], v[1]); o[1] = pk2(v[2], v[3]);
            *(u32x2*)(rowp + n * 16) = o;
          }
        }
    }
  }
};
struct EpiOutproj {
  const Params* p; int l;
  struct Pre {};
  DI Pre prefetch(const pg8::Unit&, int, int) const { return Pre{}; }
  DI void operator()(const f32x4 (&acc)[2][2][4][2], const pg8::Unit& u, int wr, int wc, int fr, int fq, const Pre&) const {
    const int row0 = u.pm * 256 + wr * 64 + fr, col0 = u.pn * 256 + wc * 32 + 4 * fq;
    const float* md = modp(*p, l, u.pm * 256) + 2 * D;
    f32x4 g1[2][2];
#pragma unroll
    for (int bj = 0; bj < 2; ++bj)
#pragma unroll
      for (int n = 0; n < 2; ++n) g1[bj][n] = *(const f32x4*)(md + col0 + bj * 128 + n * 16);
    constexpr int MB = 2;
#pragma unroll
    for (int ai = 0; ai < 2; ++ai)
#pragma unroll
      for (int m0 = 0; m0 < 4; m0 += MB) {
        f32x4 xv[MB][2][2];
#pragma unroll
        for (int mm = 0; mm < MB; ++mm) {
          const int r = row0 + ai * 128 + (m0 + mm) * 16;
          const float* xin = r < TL ? p->x + (size_t)r * D : p->ctx + (size_t)(r - TL) * D;
          const u16* xinb = xbrow(*p, r);
#pragma unroll
          for (int bj = 0; bj < 2; ++bj)
#pragma unroll
            for (int n = 0; n < 2; ++n) {
              const int c = col0 + bj * 128 + n * 16;
              xv[mm][bj][n] = (l == 0) ? *(const f32x4*)(xin + c) : ld_bf4(xinb + c);
            }
        }
#pragma unroll
        for (int mm = 0; mm < MB; ++mm) {
          const int r = row0 + ai * 128 + (m0 + mm) * 16;
          u16* xo = p->XP + (size_t)r * D;
#pragma unroll
          for (int bj = 0; bj < 2; ++bj)
#pragma unroll
            for (int n = 0; n < 2; ++n) {
              const int c = col0 + bj * 128 + n * 16;
              const f32x4 a = acc[ai][bj][m0 + mm][n];
              f32x4 o;
#pragma unroll
              for (int j = 0; j < 4; ++j) o[j] = DN_ALPHA * xv[mm][bj][n][j] + g1[bj][n][j] * a[j];
              st_bf4(xo + c, o);
            }
        }
      }
  }
};
struct EpiE1 {
  u16* H; const int* hoff;
  struct Pre {};
  DI Pre prefetch(const pg8::Unit&, int, int) const { return Pre{}; }
  DI void operator()(const f32x4 (&acc)[2][2][4][2], const pg8::Unit& u, int wr, int wc, int fr, int fq, const Pre&) const {
    const int row0 = hoff[u.e] + u.pm * 256 + wr * 64 + fr, col0 = u.pn * 128 + wc * 32 + 4 * fq;
#pragma unroll
    for (int ai = 0; ai < 2; ++ai)
#pragma unroll
      for (int m = 0; m < 4; ++m) {
        u16* rowp = H + (size_t)(row0 + ai * 128 + m * 16) * FF + col0;
#pragma unroll
        for (int n = 0; n < 2; ++n) {
          const f32x4 g = acc[ai][0][m][n], uu = acc[ai][1][m][n];
          u32x2 o; o[0] = pk2(g[0] * fsigmoid_(g[0]) * uu[0], g[1] * fsigmoid_(g[1]) * uu[1]); o[1] = pk2(g[2] * fsigmoid_(g[2]) * uu[2], g[3] * fsigmoid_(g[3]) * uu[3]);
          *(u32x2*)(rowp + n * 16) = o;
        }
      }
  }
};
constexpr float ACC_SCALE = 1024.f;
DI unsigned long long acc_pack4(float a, float b, float c, float d) {
  const long long qa = (long long)(int)rintf(a * ACC_SCALE), qb = (long long)(int)rintf(b * ACC_SCALE);
  const long long qc = (long long)(int)rintf(c * ACC_SCALE), qd = (long long)(int)rintf(d * ACC_SCALE);
  return (unsigned long long)(qa + (qb << 16) + (qc << 32) + (qd << 48));
}
DI void acc_unpack4(unsigned lo, unsigned hi, float& a, float& b, float& c, float& d) {
  long long v = (long long)(((unsigned long long)hi << 32) | (unsigned long long)lo);
  const long long f0 = (long long)(short)(v & 0xffff); v = (v - f0) >> 16;
  const long long f1 = (long long)(short)(v & 0xffff); v = (v - f1) >> 16;
  const long long f2 = (long long)(short)(v & 0xffff); v = (v - f2) >> 16;
  const long long f3 = (long long)(short)(v & 0xffff);
  a = (float)(int)f0 * (1.f / ACC_SCALE); b = (float)(int)f1 * (1.f / ACC_SCALE);
  c = (float)(int)f2 * (1.f / ACC_SCALE); d = (float)(int)f3 * (1.f / ACC_SCALE);
}
struct EpiE2 {
  int* accb; const int* etok; const float* egate; float* xs; u16* sho;
  static constexpr int WSTRIDE = 16 * 36 + 16 + 256;
  struct Pre { int t0, t1; float g0, g1; };
  DI Pre prefetch(const pg8::Unit& u, int wr, int lane) const {
    Pre q; q.t0 = 0; q.t1 = 0; q.g0 = 1.f; q.g1 = 1.f;
    if (u.e < NE) {
      const int s0 = u.pm * 256 + wr * 64 + ((lane >> 4) & 3) * 16 + (lane & 15), s1 = s0 + 128;
      const size_t b = (size_t)u.e * T;
      const size_t i0 = b + (s0 < u.cnt ? s0 : u.pm * 256), i1 = b + (s1 < u.cnt ? s1 : u.pm * 256);
      q.t0 = etok[i0]; q.g0 = egate[i0]; q.t1 = etok[i1]; q.g1 = egate[i1];
    }
    return q;
  }
  DI void operator()(const f32x4 (&acc)[2][2][4][2], const pg8::Unit& u, int wr, int wc, int fr, int fq, const Pre& pq) const {
    if (u.e == NE) {
      const int row0 = u.pm * 256 + wr * 64 + fr, col0 = u.pn * 256 + wc * 32 + 4 * fq;
#pragma unroll
      for (int ai = 0; ai < 2; ++ai)
#pragma unroll
        for (int m = 0; m < 4; ++m) {
          const int r = row0 + ai * 128 + m * 16;
          if (r < u.cnt) {
#pragma unroll
            for (int bj = 0; bj < 2; ++bj)
#pragma unroll
              for (int n = 0; n < 2; ++n) st_bf4(sho + (size_t)r * D + col0 + bj * 128 + n * 16, acc[ai][bj][m][n]);
          }
        }
      return;
    }
    const int lane = fq * 16 + fr, wave = wr * 4 + wc;
    float* X = xs + wave * WSTRIDE;
    int* tk = (int*)(X + 16 * 36);
    int* tokw = tk + 16;
    float* gatew = (float*)(tokw + 128);
    wave_sync();
#pragma unroll
    for (int q = 0; q < 2; ++q) {
      const int lr = lane + 64 * q;
      const int slot = u.pm * 256 + (lr >> 6) * 128 + wr * 64 + ((lr >> 4) & 3) * 16 + (lr & 15);
      const bool valid = slot < u.cnt;
      const int tok = q ? pq.t1 : pq.t0; const float gt = q ? pq.g1 : pq.g0;
      tokw[lr] = valid ? tok : -1; gatew[lr] = valid ? gt : 0.f;
    }
    wave_sync();
#pragma unroll
    for (int ai = 0; ai < 2; ++ai)
#pragma unroll
      for (int m = 0; m < 4; ++m) {
        const int lrow = ai * 64 + m * 16;
        const float gt = gatew[lrow + fr];
#pragma unroll
        for (int bj = 0; bj < 2; ++bj) {
          wave_sync();
#pragma unroll
          for (int n = 0; n < 2; ++n) {
            f32x4 v = acc[ai][bj][m][n];
#pragma unroll
            for (int j = 0; j < 4; ++j) v[j] *= gt;
            *(f32x4*)(X + fr * 36 + n * 16 + fq * 4) = v;
          }
          wave_sync();
          const int cquad = (u.pn * 256 + bj * 128 + wc * 32) / 4 + (lane & 7);
#pragma unroll
          for (int i = 0; i < 2; ++i) {
            const int rr = 8 * i + (lane >> 3);
            const int t2 = tokw[lrow + rr];
            const f32x4 xv = *(const f32x4*)(X + rr * 36 + 4 * (lane & 7));
            if (t2 >= 0) atomicAdd((unsigned long long*)accb + (size_t)t2 * (D / 4) + cquad, acc_pack4(xv[0], xv[1], xv[2], xv[3]));
          }
        }
      }
  }
};

constexpr int TICKET_SLOT_OFF = SMEM_BYTES - 1024 - 64;
template <class F> DI void ticket_loop(unsigned* ctr, int n_items, char* smem, F&& body) {
  int* slot = (int*)(smem + TICKET_SLOT_OFF);
  const int tid = TIDX();
  __syncthreads();
  if (tid == 0) slot[0] = (int)atomicAdd(ctr, 1u);
  __syncthreads();
  for (int k = 0;; ++k) {
    const int it = slot[k & 1];
    if (it >= n_items) break;
    int nx = 0;
    if (tid == 0) nx = (int)atomicAdd(ctr, 1u);
    body(it);
    if (tid == 0) slot[(k + 1) & 1] = nx;
    __syncthreads();
  }
}
DI void ph_prologue(const Params& p, char* smem) {
  const int tid = TIDX();
  constexpr int NCH = 6 * D / 128;
  constexpr int ITEMS_MOD = DEPTH * NCH;
  constexpr int ITEMS_H3 = DEPTH * (SEQ / 64 + CTXL / 64);
  constexpr int ITEMS_CV = DEPTH * CT_STATIC_L;
  constexpr int ITEMS = ITEMS_MOD + ITEMS_H3 + 1;
  for (int item = BIDX(); item < ITEMS; item += gridDim.x) {
    if (item < ITEMS_MOD) {
      const int l = item / NCH, ch = item % NCH;
      float* sv = (float*)smem;
      float* red = sv + (NB + 1) * D;
      {
        constexpr int NSV = ((NB + 1) * D + NT - 1) / NT;
        float cv[NSV];
#pragma unroll
        for (int j = 0; j < NSV; ++j) {
          int i = tid + j * NT; if (i > (NB + 1) * D - 1) i = (NB + 1) * D - 1;
          const int row = i / D, e = i % D;
          const float* src = row < NB ? p.c + row * D : p.c_ctx;
          cv[j] = src[e];
        }
#pragma unroll
        for (int j = 0; j < NSV; ++j) { const int i = tid + j * NT; if (i < (NB + 1) * D) sv[i] = siluf_(cv[j]); }
      }
      __syncthreads();
      const int col = ch * 128 + (tid & 127), kg = tid >> 7;
      float a[NB + 1];
#pragma unroll
      for (int r = 0; r < NB + 1; ++r) a[r] = 0.f;
      const float* W = p.w_ada + (size_t)l * D * 6 * D;
      for (int k = kg * (D / 4); k < (kg + 1) * (D / 4); k += 16) {
        float w[16];
#pragma unroll
        for (int j = 0; j < 16; ++j) w[j] = W[(size_t)(k + j) * 6 * D + col];
#pragma unroll
        for (int j = 0; j < 16; ++j)
#pragma unroll
          for (int r = 0; r < NB + 1; ++r) a[r] += sv[r * D + k + j] * w[j];
      }
#pragma unroll
      for (int r = 0; r < NB + 1; ++r) red[(kg * (NB + 1) + r) * 128 + (tid & 127)] = a[r];
      __syncthreads();
      for (int i = tid; i < (NB + 1) * 128; i += NT) {
        int r = i / 128, cc = i % 128;
        float s = 0.f;
        for (int g = 0; g < 4; ++g) s += red[(g * (NB + 1) + r) * 128 + cc];
        int cg_ = ch * 128 + cc;
        p.mod[((size_t)l * (NB + 1) + r) * 6 * D + cg_] = s + p.b_ada[(size_t)l * 6 * D + cg_];
      }
      __syncthreads();
    } else if (item < ITEMS_MOD + ITEMS_H3) {
      int it = item - ITEMS_MOD;
      constexpr int PER_L = SEQ / 64 + CTXL / 64;
      const int l = it / PER_L;
      int q = it % PER_L;
      const bool isctx = q >= SEQ / 64;
      const int L = isctx ? CTXL : SEQ;
      const int pos0 = (isctx ? q - SEQ / 64 : q) * 64;
      float* z = (float*)smem;
      float* ha = z + 64 * 36;
      float* hb = ha + 64 * 64;
      float* w1s = hb + 64 * 64;
      float* w2s = w1s + HY_EMB * HY_HID;
      float* w3s = w2s + HY_HID * HY_HID;
      {
        constexpr int N1 = (HY_EMB * HY_HID + NT - 1) / NT, N2 = (HY_HID * HY_HID + NT - 1) / NT;
        float a1[N1], a2[N2], a3[N2];
        const float* g1 = p.hf_w1 + (size_t)l * HY_EMB * HY_HID;
        const float* g2 = p.hf_w2 + (size_t)l * HY_HID * HY_HID;
        const float* g3 = p.hf_w3 + (size_t)l * HY_HID * HY_HID;
#pragma unroll
        for (int j = 0; j < N1; ++j) { int i = tid + j * NT; if (i > HY_EMB * HY_HID - 1) i = HY_EMB * HY_HID - 1; a1[j] = g1[i]; }
#pragma unroll
        for (int j = 0; j < N2; ++j) { int i = tid + j * NT; if (i > HY_HID * HY_HID - 1) i = HY_HID * HY_HID - 1; a2[j] = g2[i]; a3[j] = g3[i]; }
#pragma unroll
        for (int j = 0; j < N1; ++j) { const int i = tid + j * NT; if (i < HY_EMB * HY_HID) w1s[i] = a1[j]; }
#pragma unroll
        for (int j = 0; j < N2; ++j) { const int i = tid + j * NT; if (i < HY_HID * HY_HID) { w2s[i] = a2[j]; w3s[i] = a3[j]; } }
      }
      for (int i = tid; i < 64 * HY_EMB; i += NT) {
        int pp = i / HY_EMB, e = i % HY_EMB;
        int pos = pos0 + pp;
        float v;
        if (e == 0) v = (float)pos / (float)(L - 1);
        else {
          int bi = (e - 1) % HY_BANDS;
          float band = 1e-4f + ((float)(HY_BANDS - 1) - 1e-4f) * (float)bi / (float)(HY_BANDS - 1);
          float ang = (2.0f * 3.14159265358979323846f / (float)L) * (float)pos * band;
          v = (e - 1) < HY_BANDS ? cosf(ang) : -sinf(ang);
        }
        z[pp * 36 + e] = v;
      }
      __syncthreads();
      const int pp = tid >> 3, sub = tid & 7;
      const float* fr = p.hf_freq + l * HY_HID;
      {
        const float* b = p.hf_b1 + l * HY_HID;
        float acc8[8];
#pragma unroll
        for (int uu = 0; uu < 8; ++uu) acc8[uu] = b[sub * 8 + uu];
        for (int e = 0; e < HY_EMB; ++e) {
          const float zv = z[pp * 36 + e];
#pragma unroll
          for (int uu = 0; uu < 8; ++uu) acc8[uu] += zv * w1s[e * HY_HID + sub * 8 + uu];
        }
#pragma unroll 1
        for (int uu = 0; uu < 8; ++uu) ha[pp * 64 + sub * 8 + uu] = sinf(fr[sub * 8 + uu] * acc8[uu]);
      }
      __syncthreads();
      {
        const float* b = p.hf_b2 + l * HY_HID;
        float acc8[8];
#pragma unroll
        for (int uu = 0; uu < 8; ++uu) acc8[uu] = b[sub * 8 + uu];
        for (int e = 0; e < HY_HID; ++e) {
          const float zv = ha[pp * 64 + e];
#pragma unroll
          for (int uu = 0; uu < 8; ++uu) acc8[uu] += zv * w2s[e * HY_HID + sub * 8 + uu];
        }
#pragma unroll 1
        for (int uu = 0; uu < 8; ++uu) hb[pp * 64 + sub * 8 + uu] = sinf(fr[sub * 8 + uu] * acc8[uu]);
      }
      __syncthreads();
      {
        const float* b = p.hf_b3 + l * HY_HID;
        float* dst = isctx ? p.h3ctx + ((size_t)l * CTXL + pos0) * 64 : p.h3lat + ((size_t)l * SEQ + pos0) * 64;
        float acc8[8];
#pragma unroll
        for (int uu = 0; uu < 8; ++uu) acc8[uu] = b[sub * 8 + uu];
        for (int e = 0; e < HY_HID; ++e) {
          const float zv = hb[pp * 64 + e];
#pragma unroll
          for (int uu = 0; uu < 8; ++uu) acc8[uu] += zv * w3s[e * HY_HID + sub * 8 + uu];
        }
#pragma unroll 1
        for (int uu = 0; uu < 8; ++uu) dst[pp * 64 + sub * 8 + uu] = sinf(fr[sub * 8 + uu] * acc8[uu]);
      }
      __syncthreads();
    } else {
      for (int k = tid; k < FFTN / 2; k += NT) {
        double ang = -2.0 * 3.14159265358979323846 * (double)k / (double)FFTN;
        cf w; w.x = (float)cos(ang); w.y = (float)sin(ang);
        p.tw[k] = w;
      }
      for (int i = tid; i < DEPTH * NE; i += NT) p.cnt[i] = 0;
    }
  }
  ticket_loop(p.bar + XB_TICKET, ITEMS_CV, smem, [&](int it) { convert_static_item(p, it, smem); });
}

DI void ph_premod(const Params& p) {
  const int tid = TIDX();
  constexpr int ITEMS = T / 8;
  constexpr int NI = 8 * D / 4 / NT;
  static_assert(NI * NT * 4 == 8 * D, "premod tiling");
  for (int item = BIDX(); item < ITEMS; item += gridDim.x) {
    f32x4 xv[NI], sc[NI], sh[NI];
#pragma unroll
    for (int k = 0; k < NI; ++k) {
      const int i = tid + k * NT;
      const int r = item * 8 + i / (D / 4), e = (i % (D / 4)) * 4;
      const float* m = modp(p, 0, r);
      const float* src = r < TL ? p.x + (size_t)r * D : p.ctx + (size_t)(r - TL) * D;
      xv[k] = *(const f32x4*)(src + e); sc[k] = *(const f32x4*)(m + D + e); sh[k] = *(const f32x4*)(m + e);
    }
#pragma unroll
    for (int k = 0; k < NI; ++k) {
      const int i = tid + k * NT;
      const int r = item * 8 + i / (D / 4), e = (i % (D / 4)) * 4;
      f32x4 o;
#pragma unroll
      for (int j = 0; j < 4; ++j) o[j] = xv[k][j] * (1.f + sc[k][j]) + sh[k][j];
      st_bf4(p.HL + (size_t)r * D + e, o);
    }
  }
}

DI int fpad(int i) { return i + (i >> 4); }
constexpr int FFT_LDS = FFTN + FFTN / 16;
__device__ static constexpr float C16[8] = {1.f, 0.92387953251128674f, 0.70710678118654752f, 0.38268343236508977f, 0.f, -0.38268343236508977f, -0.70710678118654752f, -0.92387953251128674f};
__device__ static constexpr float S16[8] = {0.f, 0.38268343236508977f, 0.70710678118654752f, 0.92387953251128674f, 1.f, 0.92387953251128674f, 0.70710678118654752f, 0.38268343236508977f};
template <int R, bool INV>
DI void fft_pass(cf* buf, const cf* tw, int m) {
  const int g = m >> (R - 1);
  constexpr int NQ = 1 << R;
  for (int w = TIDX(); w < (FFTN >> R); w += NT) {
    const int j = w % g, blk = w / g;
    const int base = blk * (g << R) + j;
    cf v[NQ];
#pragma unroll
    for (int q = 0; q < NQ; ++q) v[q] = buf[fpad(base + q * g)];
    cf bt[R];
    bt[0] = tw[j * ((FFTN / 2) / ((NQ / 2) * g))];
#pragma unroll
    for (int r = 1; r < R; ++r) { bt[r].x = bt[r - 1].x * bt[r - 1].x - bt[r - 1].y * bt[r - 1].y; bt[r].y = 2.f * bt[r - 1].x * bt[r - 1].y; }
    if (!INV) {
#pragma unroll
      for (int r = 0; r < R; ++r) {
        const int half = 1 << (R - 1 - r);
#pragma unroll
        for (int q = 0; q < NQ; ++q) {
          if ((q & half) == 0) {
            const int qq = q & (half - 1);
            const int ci = qq * (8 / half);
            cf W;
            W.x = bt[r].x * C16[ci] + bt[r].y * S16[ci];
            W.y = bt[r].y * C16[ci] - bt[r].x * S16[ci];
            cf a = v[q], b = v[q + half];
            v[q].x = a.x + b.x; v[q].y = a.y + b.y;
            float dx = a.x - b.x, dy = a.y - b.y;
            v[q + half].x = dx * W.x - dy * W.y;
            v[q + half].y = dx * W.y + dy * W.x;
          }
        }
      }
    } else {
#pragma unroll
      for (int r = R - 1; r >= 0; --r) {
        const int half = 1 << (R - 1 - r);
#pragma unroll
        for (int q = 0; q < NQ; ++q) {
          if ((q & half) == 0) {
            const int qq = q & (half - 1);
            const int ci = qq * (8 / half);
            cf W;
            W.x = bt[r].x * C16[ci] + bt[r].y * S16[ci];
            W.y = bt[r].y * C16[ci] - bt[r].x * S16[ci];
            cf a = v[q], b = v[q + half];
            float bx = b.x * W.x + b.y * W.y;
            float by = b.y * W.x - b.x * W.y;
            v[q].x = a.x + bx; v[q].y = a.y + by;
            v[q + half].x = a.x - bx; v[q + half].y = a.y - by;
          }
        }
      }
    }
#pragma unroll
    for (int q = 0; q < NQ; ++q) buf[fpad(base + q * g)] = v[q];
  }
}
constexpr int FFT_R4 = LOG2N / 4, FFT_REM = LOG2N % 4;
DI void fft_fwd_main(cf* buf, const cf* tw) {
  int m = FFTN / 2;
#pragma unroll
  for (int i = 0; i < FFT_R4; ++i) { fft_pass<4, false>(buf, tw, m); __syncthreads(); m >>= 4; }
}
DI void fft_fwd_tail(cf* buf, const cf* tw) {
  if (FFT_REM == 3) { fft_pass<3, false>(buf, tw, 4); __syncthreads(); }
  if (FFT_REM == 2) { fft_pass<2, false>(buf, tw, 2); __syncthreads(); }
  if (FFT_REM == 1) { fft_pass<1, false>(buf, tw, 1); __syncthreads(); }
}
DI void fft_fwd(cf* buf, const cf* tw) { fft_fwd_main(buf, tw); fft_fwd_tail(buf, tw); }
DI void fft_inv_tail(cf* buf, const cf* tw) {
  if (FFT_REM == 3) { fft_pass<3, true>(buf, tw, 4); __syncthreads(); }
  if (FFT_REM == 2) { fft_pass<2, true>(buf, tw, 2); __syncthreads(); }
  if (FFT_REM == 1) { fft_pass<1, true>(buf, tw, 1); __syncthreads(); }
}
DI void fft_inv_main(cf* buf, const cf* tw) {
  int m = (1 << FFT_REM) * 8;
#pragma unroll
  for (int i = 0; i < FFT_R4; ++i) { fft_pass<4, true>(buf, tw, m); __syncthreads(); m <<= 4; }
}
DI void tw_to_lds(cf* tw, const cf* __restrict__ gtw) {
  constexpr int NIT = (FFTN / 4 + NT - 1) / NT;
  f32x4 t4[NIT];
#pragma unroll
  for (int j = 0; j < NIT; ++j) { int i = TIDX() + j * NT; if (i > FFTN / 4 - 1) i = FFTN / 4 - 1; t4[j] = ((const f32x4*)gtw)[i]; }
#pragma unroll
  for (int j = 0; j < NIT; ++j) { const int i = TIDX() + j * NT; if (i < FFTN / 4) ((f32x4*)tw)[i] = t4[j]; }
}
constexpr int MID_IT = (FFTN / 2 + NT - 1) / NT;
struct MidSpec { f32x4 k[MID_IT]; };
DI MidSpec fft_mid_prefetch(const cf* __restrict__ sp) {
  MidSpec m;
#pragma unroll
  for (int j = 0; j < MID_IT; ++j) {
    int i = TIDX() + j * NT; if (i > FFTN / 2 - 1) i = FFTN / 2 - 1;
    m.k[j] = *(const f32x4*)(sp + 2 * i);
  }
  return m;
}
DI void fft_mid(cf* buf, const cf* tw, const cf* __restrict__ sp, const MidSpec& ms) {
  if (FFT_REM == 1) {
#pragma unroll
    for (int j = 0; j < MID_IT; ++j) {
      const int i = TIDX() + j * NT;
      if (i >= FFTN / 2) break;
      const cf a = buf[fpad(2 * i)], b = buf[fpad(2 * i + 1)];
      cf A, B;
      A.x = a.x + b.x; A.y = a.y + b.y; B.x = a.x - b.x; B.y = a.y - b.y;
      const f32x4 k = ms.k[j];
      cf P, Q;
      P.x = A.x * k[0] - A.y * k[1]; P.y = A.x * k[1] + A.y * k[0];
      Q.x = B.x * k[2] - B.y * k[3]; Q.y = B.x * k[3] + B.y * k[2];
      cf o0, o1;
      o0.x = P.x + Q.x; o0.y = P.y + Q.y; o1.x = P.x - Q.x; o1.y = P.y - Q.y;
      buf[fpad(2 * i)] = o0; buf[fpad(2 * i + 1)] = o1;
    }
    __syncthreads();
  } else {
    fft_fwd_tail(buf, tw);
    for (int i = TIDX(); i < FFTN; i += NT) {
      cf a = buf[fpad(i)], k = sp[i], r;
      r.x = a.x * k.x - a.y * k.y; r.y = a.x * k.y + a.y * k.x;
      buf[fpad(i)] = r;
    }
    __syncthreads();
    fft_inv_tail(buf, tw);
  }
}

DI float hy_delta(int c) {
  const float lo = -4.605170185988091f / 1.5f, hi = -4.605170185988091f / 0.3f;
  return fabsf(lo + (hi - lo) * (float)c / (float)(HY_CH - 1));
}

DI void hy_spectrum_item(const Params& p, int l, int o, int c, char* smem) {
  const int tid = TIDX();
  cf* buf = (cf*)smem;
  cf* tw = buf + FFT_LDS;
  float* wc = (float*)(tw + FFTN / 2);
  tw_to_lds(tw, p.tw);
  if (tid < 128) {
    int dir = tid >> 6, u = tid & 63;
    wc[tid] = p.hf_wout[((size_t)l * HY_HID + u) * (4 * HY_CH) + o * 2 * HY_CH + dir * HY_CH + c];
  }
  __syncthreads();
  const float dl = hy_delta(c);
  {
    const int q = tid & 15, rr = tid >> 4;
    constexpr int RPP = NT / 16;
    constexpr int UNR = (SEQ / RPP) % 8 == 0 ? 8 : 1;
    const f32x4 wf = *(const f32x4*)(wc + 4 * q), wb = *(const f32x4*)(wc + 64 + 4 * q);
    const float* hbase = p.h3lat + (size_t)l * SEQ * 64 + 4 * q;
    for (int t0 = 0; t0 < SEQ; t0 += RPP * UNR) {
      f32x4 hv[UNR];
#pragma unroll
      for (int j = 0; j < UNR; ++j) hv[j] = *(const f32x4*)(hbase + (size_t)(t0 + j * RPP + rr) * 64);
#pragma unroll
      for (int j = 0; j < UNR; ++j) {
        const int t = t0 + j * RPP + rr;
        float sf = (hv[j][0] * wf[0] + hv[j][1] * wf[1]) + (hv[j][2] * wf[2] + hv[j][3] * wf[3]);
        float sb = (hv[j][0] * wb[0] + hv[j][1] * wb[1]) + (hv[j][2] * wb[2] + hv[j][3] * wb[3]);
        sf = red16(sf); sb = red16(sb);
        if (q == 0) {
          const float dec = expf(-((float)t / (float)(SEQ - 1)) * dl);
          cf a; a.x = sf * dec; a.y = 0.f;
          buf[fpad(t)] = a;
          if (t >= 1) { cf b; b.x = sb * dec; b.y = 0.f; buf[fpad(FFTN - t)] = b; }
          if (t == 0) { cf zz; zz.x = 0.f; zz.y = 0.f; buf[fpad(SEQ)] = zz; }
        }
      }
    }
  }
  __syncthreads();
  fft_fwd(buf, tw);
  cf* dst = p.spec + ((size_t)o * HY_CH + c) * FFTN;
  const float sc = 1.0f / (float)FFTN;
  for (int i = tid; i < FFTN; i += NT) { cf v = buf[fpad(i)]; v.x *= sc; v.y *= sc; dst[i] = v; }
  __syncthreads();
}

DI void ph_inproj(const Params& p, int l, char* smem) {
  constexpr int SPEC_ITEMS = 2 * HY_CH;
  const int G = gridDim.x, c = BIDX();
  {
    DenseSched S; S.init(p.HL, p.wt_in + (size_t)l * P_IN_PAD * D, D, T, P_IN_PAD, G, c);
    EpiInproj E{p.PA, p.PH, p.PR};
    pg8::gemm_phase(smem, D, S, E);
  }
  __syncthreads();
  (void)c;
  ticket_loop(p.bar + XB_TICKET + 1 + l, SPEC_ITEMS, smem, [&](int it) { hy_spectrum_item(p, l, it / HY_CH, it % HY_CH, smem); });
}

DI float hy_u(const u16* P, int t, int L, float w0, float w1, float w2, float bias) {
  const bool hp = t >= 1, hn = t + 1 < L;
  const float c = bf2f(P[t]), a = bf2f(P[hp ? t - 1 : t]), b = bf2f(P[hn ? t + 1 : t]);
  return w1 * c + bias + (hp ? w0 : 0.f) * a + (hn ? w2 : 0.f) * b;
}

struct HyRaw { u32x4 x; u16 prev, next; };
DI HyRaw hy_load8(const u16* P, int t0, int L) {
  HyRaw r;
  r.x = *(const u32x4*)(P + t0);
  r.prev = P[t0 >= 1 ? t0 - 1 : t0];
  r.next = P[t0 + 8 < L ? t0 + 8 : t0 + 7];
  return r;
}
DI void hy_conv8(const HyRaw& r, int t0, int L, float w0, float w1, float w2, float bias, float (&out)[8]) {
  float x[10];
  x[0] = bf2f(r.prev);
#pragma unroll
  for (int j = 0; j < 4; ++j) { x[1 + 2 * j] = bf2f((u16)(r.x[j] & 0xffff)); x[2 + 2 * j] = bf2f((u16)(r.x[j] >> 16)); }
  x[9] = bf2f(r.next);
  const float wp = t0 >= 1 ? w0 : 0.f, wn = t0 + 8 < L ? w2 : 0.f;
#pragma unroll
  for (int j = 0; j < 8; ++j) out[j] = w1 * x[1 + j] + bias + (j == 0 ? wp : w0) * x[j] + (j == 7 ? wn : w2) * x[2 + j];
}

DI void hyena_lat_item(const Params& p, int l, int c, int pair, char* smem, bool load_tw) {
  const int tid = TIDX();
  cf* buf = (cf*)smem;
  cf* tw = buf + FFT_LDS;
  const float* cw = p.hy_sconv_w + (size_t)l * 3 * PH_W;
  const float* cb = p.hy_sconv_b + (size_t)l * PH_W;
  const int b0 = pair * 2, b1 = pair * 2 + 1;
  const int t0 = tid * 8;
  const bool act = t0 < SEQ;
  const int tl = act ? t0 : 0;
  HyRaw rw[3][2];
#pragma unroll
  for (int q = 0; q < 3; ++q) {
    rw[q][0] = hy_load8(p.PH + ((size_t)b0 * PH_W + q * HY_CH + c) * SEQ, tl, SEQ);
    rw[q][1] = hy_load8(p.PH + ((size_t)b1 * PH_W + q * HY_CH + c) * SEQ, tl, SEQ);
  }
  if (load_tw) tw_to_lds(tw, p.tw);
  const MidSpec ms0 = fft_mid_prefetch(p.spec + ((size_t)0 * HY_CH + c) * FFTN);
  float vr[2][8], z1[2][8];
  {
    const int col = c;
    const float w0 = cw[col], w1 = cw[PH_W + col], w2 = cw[2 * PH_W + col], bs = cb[col];
    hy_conv8(rw[0][0], tl, SEQ, w0, w1, w2, bs, vr[0]);
    hy_conv8(rw[0][1], tl, SEQ, w0, w1, w2, bs, vr[1]);
    if (act) {
#pragma unroll
      for (int j = 0; j < 8; ++j) {
        cf a; a.x = vr[0][j]; a.y = vr[1][j];
        buf[fpad(t0 + j)] = a;
        cf zz; zz.x = 0.f; zz.y = 0.f;
        buf[fpad(t0 + j + SEQ)] = zz;
      }
    }
  }
  __syncthreads();
  fft_fwd_main(buf, tw);
  fft_mid(buf, tw, p.spec + ((size_t)0 * HY_CH + c) * FFTN, ms0);
  const MidSpec ms1 = fft_mid_prefetch(p.spec + ((size_t)1 * HY_CH + c) * FFTN);
  fft_inv_main(buf, tw);
  {
    const int col = HY_CH + c;
    const float w0 = cw[col], w1 = cw[PH_W + col], w2 = cw[2 * PH_W + col], bs = cb[col];
    const float sk = p.hf_skip[((size_t)l * 2 + 0) * HY_CH + c];
    float x1a[8], x1b[8];
    hy_conv8(rw[1][0], tl, SEQ, w0, w1, w2, bs, x1a);
    hy_conv8(rw[1][1], tl, SEQ, w0, w1, w2, bs, x1b);
    cf yv[8];
    if (act) {
#pragma unroll
      for (int j = 0; j < 8; ++j) yv[j] = buf[fpad(t0 + j)];
    }
    __syncthreads();
    if (act) {
#pragma unroll
      for (int j = 0; j < 8; ++j) {
        z1[0][j] = (yv[j].x + sk * vr[0][j]) * x1a[j];
        z1[1][j] = (yv[j].y + sk * vr[1][j]) * x1b[j];
        cf a; a.x = z1[0][j]; a.y = z1[1][j];
        buf[fpad(t0 + j)] = a;
        cf zz; zz.x = 0.f; zz.y = 0.f;
        buf[fpad(t0 + j + SEQ)] = zz;
      }
    }
  }
  __syncthreads();
  fft_fwd_main(buf, tw);
  fft_mid(buf, tw, p.spec + ((size_t)1 * HY_CH + c) * FFTN, ms1);
  fft_inv_main(buf, tw);
  {
    const int col = 2 * HY_CH + c;
    const float w0 = cw[col], w1 = cw[PH_W + col], w2 = cw[2 * PH_W + col], bs = cb[col];
    const float sk = p.hf_skip[((size_t)l * 2 + 1) * HY_CH + c];
    float x2a[8], x2b[8];
    hy_conv8(rw[2][0], tl, SEQ, w0, w1, w2, bs, x2a);
    hy_conv8(rw[2][1], tl, SEQ, w0, w1, w2, bs, x2b);
    if (act) {
      u32x4 oa, ob;
#pragma unroll
      for (int j = 0; j < 4; ++j) {
        const cf y0 = buf[fpad(t0 + 2 * j)], y1 = buf[fpad(t0 + 2 * j + 1)];
        oa[j] = pk2((y0.x + sk * z1[0][2 * j]) * x2a[2 * j], (y1.x + sk * z1[0][2 * j + 1]) * x2a[2 * j + 1]);
        ob[j] = pk2((y0.y + sk * z1[1][2 * j]) * x2b[2 * j], (y1.y + sk * z1[1][2 * j + 1]) * x2b[2 * j + 1]);
      }
      *(u32x4*)(p.yhlat + ((size_t)b0 * HY_CH + c) * SEQ + t0) = oa;
      *(u32x4*)(p.yhlat + ((size_t)b1 * HY_CH + c) * SEQ + t0) = ob;
    }
  }
  __syncthreads();
}

DI void hyena_ctx_item(const Params& p, int l, int c, char* smem) {
  const int tid = TIDX();
  float* taps = (float*)smem;
  float* uv = taps + 4 * CTXL;
  float* zb = uv + NB * 3 * CTXL;
  float* wc = zb + NB * CTXL;
  if (tid < 256) {
    int od = tid >> 6, u = tid & 63;
    wc[tid] = p.hf_wout[((size_t)l * HY_HID + u) * (4 * HY_CH) + od * HY_CH + c];
  }
  __syncthreads();
  const float dl = hy_delta(c);
  for (int i = tid; i < 4 * CTXL; i += NT) {
    int od = i / CTXL, t = i % CTXL;
    const float* h = p.h3ctx + ((size_t)l * CTXL + t) * 64;
    float s = 0.f;
    for (int u = 0; u < 64; ++u) s += h[u] * wc[od * 64 + u];
    taps[i] = s * expf(-((float)t / (float)(CTXL - 1)) * dl);
  }
  const float* cw = p.hy_sconv_w + (size_t)l * 3 * PH_W;
  const float* cb = p.hy_sconv_b + (size_t)l * PH_W;
  for (int i = tid; i < NB * 3 * CTXL; i += NT) {
    int b = i / (3 * CTXL), j = (i / CTXL) % 3, t = i % CTXL;
    int col = j * HY_CH + c;
    const u16* P = p.PH + (size_t)NB * PH_W * SEQ + ((size_t)b * PH_W + col) * CTXL;
    uv[i] = hy_u(P, t, CTXL, cw[col], cw[PH_W + col], cw[2 * PH_W + col], cb[col]);
  }
  __syncthreads();
  const float sk0 = p.hf_skip[((size_t)l * 2 + 0) * HY_CH + c], sk1 = p.hf_skip[((size_t)l * 2 + 1) * HY_CH + c];
  for (int i = tid; i < NB * CTXL; i += NT) {
    int b = i / CTXL, t = i % CTXL;
    const float* v = uv + (b * 3 + 0) * CTXL;
    float s = 0.f;
    for (int s_ = 0; s_ < CTXL; ++s_) {
      int lag = t - s_;
      float k = lag >= 0 ? taps[0 * CTXL + lag] : taps[1 * CTXL - lag];
      s += k * v[s_];
    }
    zb[i] = (s + sk0 * v[t]) * uv[(b * 3 + 1) * CTXL + t];
  }
  __syncthreads();
  for (int i = tid; i < NB * CTXL; i += NT) {
    int b = i / CTXL, t = i % CTXL;
    const float* v = zb + b * CTXL;
    float s = 0.f;
    for (int s_ = 0; s_ < CTXL; ++s_) {
      int lag = t - s_;
      float k = lag >= 0 ? taps[2 * CTXL + lag] : taps[3 * CTXL - lag];
      s += k * v[s_];
    }
    p.yhctx[((size_t)b * HY_CH + c) * CTXL + t] = f2bf((s + sk1 * v[t]) * uv[(b * 3 + 2) * CTXL + t]);
  }
  __syncthreads();
}

DI void mixer_a_item(const Params& p, int l, int tile) {
  const int tid = TIDX(), lane = tid & 63, wave = tid >> 6;
  const int ts = lane >> 4, cq = lane & 15;
  constexpr int NBK = CONV_CH / 64;
  const float* cw = p.conv_a + (size_t)l * 3 * CONV_CH;
  const float* gn = p.mix_norm_g + (size_t)l * (CONV_CH + HY_CH);
#pragma unroll
  for (int it = 0; it < 2; ++it) {
    const int r = tile * 64 + wave * 8 + it * 4 + ts;
    int rp = r, rn = r;
    bool hp = false, hn = false;
    if (r < TL) { const int t = r % SEQ; hp = t >= GRID_W; hn = t + GRID_W < SEQ; if (hp) rp = r - GRID_W; if (hn) rn = r + GRID_W; }
    else { const int t = (r - TL) % CTXL; hp = t >= 1; hn = t + 1 < CTXL; if (hp) rp = r - 1; if (hn) rn = r + 1; }
    const float fp = hp ? 1.f : 0.f, fn = hn ? 1.f : 0.f;
    const u16* row = p.PA + (size_t)r * PA_W;
    const u16* qp = p.PA + (size_t)rp * PA_W;
    const u16* qn = p.PA + (size_t)rn * PA_W;
    float yv[NBK][4];
    float ss = 0.f;
#pragma unroll
    for (int bk = 0; bk < NBK; ++bk) {
      const int c = bk * 64 + cq * 4;
      const f32x4 bg = ld_bf4(row + c);
      const f32x4 c0 = ld_bf4(row + CONV_CH + c), x0 = ld_bf4(row + 2 * CONV_CH + c);
      const f32x4 c1 = ld_bf4(qp + CONV_CH + c), x1 = ld_bf4(qp + 2 * CONV_CH + c);
      const f32x4 c2 = ld_bf4(qn + CONV_CH + c), x2 = ld_bf4(qn + 2 * CONV_CH + c);
      const f32x4 w0 = *(const f32x4*)(cw + c), w1 = *(const f32x4*)(cw + CONV_CH + c), w2 = *(const f32x4*)(cw + 2 * CONV_CH + c);
#pragma unroll
      for (int j = 0; j < 4; ++j) {
        const float z = c0[j] * x0[j] * w1[j] + fp * w0[j] * (c1[j] * x1[j]) + fn * w2[j] * (c2[j] * x2[j]);
        yv[bk][j] = bg[j] * z;
        ss += yv[bk][j] * yv[bk][j];
      }
    }
    ss = red16(ss);
    const float rs = rsqrtf(ss / (float)CONV_CH + LN_EPS);
#pragma unroll
    for (int bk = 0; bk < NBK; ++bk) {
      const int c = bk * 64 + cq * 4;
      const f32x4 g4 = *(const f32x4*)(gn + c);
      f32x4 o;
#pragma unroll
      for (int j = 0; j < 4; ++j) o[j] = yv[bk][j] * rs * g4[j];
      st_bf4(p.ya + (size_t)r * CONV_CH + c, o);
    }
  }
}

DI void ph_mix(const Params& p, int l, char* smem) {
  const bool need_ctx = (l == 0);
  constexpr int HL_ITEMS = HY_CH * (NB / 2);
  const int HC_ITEMS = need_ctx ? HY_CH : 0;
  const int MA_ITEMS = (need_ctx ? T : TL) / 64;
  const int total = HL_ITEMS + HC_ITEMS + MA_ITEMS;
  SEG_BEGIN(p)
  bool tw_loaded = false;
  ticket_loop(p.bar + XB_TICKET + 1 + 2 * DEPTH + l, total, smem, [&](int item) {
    if (item < HL_ITEMS) { hyena_lat_item(p, l, item / (NB / 2), item % (NB / 2), smem, !tw_loaded); tw_loaded = true; SEG_MARK(p, 9) }
    else if (item < HL_ITEMS + HC_ITEMS) { hyena_ctx_item(p, l, item - HL_ITEMS, smem); SEG_MARK(p, 10) }
    else { mixer_a_item(p, l, item - HL_ITEMS - HC_ITEMS); SEG_MARK(p, 11) }
  });
}

DI void seq_of_row(int r, int& b, int& t, int& L) {
  if (r < TL) { b = r / SEQ; t = r % SEQ; L = SEQ; }
  else { int rc = r - TL; b = rc / CTXL; t = rc % CTXL; L = CTXL; }
}
DI float rw_u(const Params& p, const float* mu, int r, int t, int L, int col) {
  const float m0 = mu[col], m2 = mu[RW_COLS + col];
  float s = (1.f - m0 - m2) * bf2f(p.PR[(size_t)r * RW_COLS + col]);
  if (t >= 1) s += m0 * bf2f(p.PR[(size_t)(r - 1) * RW_COLS + col]);
  if (t + 1 < L) s += m2 * bf2f(p.PR[(size_t)(r + 1) * RW_COLS + col]);
  return s;
}
DI bf16x8 load_bfrag(const float* W, int ldn, int k0, int col, int lane) {
  const float* q = W + (size_t)(k0 + 8 * (lane >> 5)) * ldn + col + (lane & 31);
  bf16x8 b;
#pragma unroll
  for (int j = 0; j < 8; ++j) b[j] = (short)f2bf(q[(size_t)j * ldn]);
  return b;
}

DI f32x4 rw_u4(const Params& p, const float* mu, int r, int t, int L, int col) {
  const f32x4 m0 = *(const f32x4*)(mu + col), m2 = *(const f32x4*)(mu + RW_COLS + col);
  const bool hp = t >= 1, hn = t + 1 < L;
  const f32x4 c = ld_bf4(p.PR + (size_t)r * RW_COLS + col);
  const f32x4 a = ld_bf4(p.PR + (size_t)(hp ? r - 1 : r) * RW_COLS + col);
  const f32x4 b = ld_bf4(p.PR + (size_t)(hn ? r + 1 : r) * RW_COLS + col);
  const float fp = hp ? 1.f : 0.f, fn = hn ? 1.f : 0.f;
  f32x4 s;
#pragma unroll
  for (int i = 0; i < 4; ++i) s[i] = (1.f - m0[i] - m2[i]) * c[i] + (fp * m0[i]) * a[i] + (fn * m2[i]) * b[i];
  return s;
}
DI bf16x8 ld_bfrag_t(const u16* Wt, int K, int k0, int col, int lane) {
  return *(const bf16x8*)(Wt + (size_t)(col + (lane & 31)) * K + k0 + 8 * (lane >> 5));
}

DI void prep_item(const Params& p, int l, int tile, char* smem) {
  const int tid = TIDX(), lane = tid & 63, wave = tid >> 6;
  constexpr int LA = 72, LG = 136, LX = 68;
  constexpr int XW = 32 * LX + 64;
  u16* Awd = (u16*)smem;
  u16* Aad = Awd + 2 * 32 * LA;
  u16* Agd = Aad + 2 * 32 * LA;
  float* Xall = (float*)(Agd + 32 * LG);
  const float* mu = p.rw_mu + (size_t)l * 2 * RW_COLS;
  const int r0 = tile * 32;
  int b_, t0, L;
  seq_of_row(r0, b_, t0, L);
  SEG_BEGIN(p)
#pragma unroll 2
  for (int i = tid; i < 32 * 96; i += NT) {
    const int tok = i / 96, c4 = (i % 96) * 4;
    f32x4 u = rw_u4(p, mu, r0 + tok, t0 + tok, L, 3 * RW_CH + c4);
    if (c4 < 128) { f32x4 o; for (int j = 0; j < 4; ++j) o[j] = ftanh_(u[j]); st_bf4(Awd + ((c4 >> 6) * 32 + tok) * LA + (c4 & 63), o); }
    else if (c4 < 256) { int c2 = c4 - 128; st_bf4(Aad + ((c2 >> 6) * 32 + tok) * LA + (c2 & 63), u); }
    else { f32x4 o; for (int j = 0; j < 4; ++j) o[j] = fsigmoid_(u[j]); st_bf4(Agd + tok * LG + (c4 - 256), o); }
  }
  __syncthreads();
  SEG_MARK(p, 4)
  const int ts = lane >> 4, cq = lane & 15;
  if (wave < RW_H) {
    const int h = wave;
    float* X = Xall + (size_t)wave * XW;
    float* rinvw = X + 32 * LX;
    float* sbw = rinvw + 32;
    const size_t seqidx0 = (size_t)(b_ * RW_H + h) * L + t0;
    u16* sish = (r0 < TL ? p.SIsh_lat : p.SIsh_ctx);
    u16* sidir = (r0 < TL ? p.SIdir_lat : p.SIdir_ctx);
    const size_t dirstride = (size_t)NB * RW_H * L * 192;
    const int ch = h * 64 + cq * 4;
    const f32x4 kkc = *(const f32x4*)(p.rw_k_k + (size_t)l * RW_CH + ch);
    const f32x4 k_a = *(const f32x4*)(p.rw_k_a + (size_t)l * RW_CH + ch);
    const f32x4 r_k = *(const f32x4*)(p.rw_r_k + (size_t)l * RW_CH + ch);
    auto gemm_to_X = [&](const u16* Atile, int lda_, int arow0, const u16* Wt, int K) {
      f32x16 c0, c1;
#pragma unroll
      for (int r = 0; r < 16; ++r) { c0[r] = 0.f; c1[r] = 0.f; }
#pragma unroll 4
      for (int k0 = 0; k0 < K; k0 += 16) {
        bf16x8 a1 = *(const bf16x8*)(Atile + (arow0 + (lane & 31)) * lda_ + k0 + (lane >> 5) * 8);
        c0 = MFMA32(a1, ld_bfrag_t(Wt, K, k0, h * 64, lane), c0);
        c1 = MFMA32(a1, ld_bfrag_t(Wt, K, k0, h * 64 + 32, lane), c1);
      }
      wave_sync();
#pragma unroll
      for (int r = 0; r < 16; ++r) {
        X[crow(r, lane >> 5) * LX + (lane & 31)] = c0[r];
        X[crow(r, lane >> 5) * LX + 32 + (lane & 31)] = c1[r];
      }
      wave_sync();
    };
    {
      constexpr int mt = 0;
      if (lane < 32) sbw[lane] = 0.f;
      f32x4 rvs[8], kvs[8];
      float ris[8];
      struct Taps { u32x2 c[3], a[3], b[3]; };
      auto load_taps = [&](int it) {
        const int tok = mt * 32 + it * 4 + ts, r = r0 + tok, t = t0 + tok;
        const bool hp = t >= 1, hn = t + 1 < L;
        Taps q;
#pragma unroll
        for (int g = 0; g < 3; ++g) {
          const int col = g * RW_CH + ch;
          q.c[g] = *(const u32x2*)(p.PR + (size_t)r * RW_COLS + col);
          q.a[g] = *(const u32x2*)(p.PR + (size_t)(hp ? r - 1 : r) * RW_COLS + col);
          q.b[g] = *(const u32x2*)(p.PR + (size_t)(hn ? r + 1 : r) * RW_COLS + col);
        }
        return q;
      };
      auto up4 = [](u32x2 v) { f32x4 o; o[0] = bf2f((u16)(v[0] & 0xffff)); o[1] = bf2f((u16)(v[0] >> 16)); o[2] = bf2f((u16)(v[1] & 0xffff)); o[3] = bf2f((u16)(v[1] >> 16)); return o; };
      f32x4 mw0[3], mw2[3];
#pragma unroll
      for (int g = 0; g < 3; ++g) { mw0[g] = *(const f32x4*)(mu + g * RW_CH + ch); mw2[g] = *(const f32x4*)(mu + RW_COLS + g * RW_CH + ch); }
      Taps cur = load_taps(0);
#pragma unroll
      for (int it = 0; it < 8; ++it) {
        const int tt = it * 4 + ts, tok = mt * 32 + tt;
        Taps nxt = cur;
        if (it + 1 < 8) nxt = load_taps(it + 1);
        f32x4 uv[3];
        {
          const int t = t0 + tok;
          const float fp = t >= 1 ? 1.f : 0.f, fn = t + 1 < L ? 1.f : 0.f;
#pragma unroll
          for (int g = 0; g < 3; ++g) {
            const f32x4 c4 = up4(cur.c[g]), a4 = up4(cur.a[g]), b4 = up4(cur.b[g]);
#pragma unroll
            for (int i = 0; i < 4; ++i) uv[g][i] = (1.f - mw0[g][i] - mw2[g][i]) * c4[i] + (fp * mw0[g][i]) * a4[i] + (fn * mw2[g][i]) * b4[i];
          }
        }
        cur = nxt;
        const f32x4 rv = uv[0], kv = uv[1], vv = uv[2];
        rvs[it] = rv; kvs[it] = kv;
        f32x4 kr;
        float ss = 0.f;
#pragma unroll
        for (int j = 0; j < 4; ++j) { kr[j] = kv[j] * kkc[j]; ss += kr[j] * kr[j]; }
        const float ri = rsqrtf(fmaxf(red16(ss), 1e-24f));
        ris[it] = ri;
#pragma unroll
        for (int j = 0; j < 4; ++j) kr[j] *= ri;
        u16* dst = sish + (seqidx0 + tok) * 192 + cq * 4;
        st_bf4(dst, rv); st_bf4(dst + 64, kr); st_bf4(dst + 128, vv);
      }
      SEG_MARK(p, 5)
#pragma unroll 1
      for (int d = 0; d < 2; ++d) {
        gemm_to_X(Awd, LA, d * 32 + mt * 32, p.wt_wup + ((size_t)l * 2 + d) * RW_CH * DRK, DRK);
        const f32x4 w0 = *(const f32x4*)(p.rw_w0 + ((size_t)l * 2 + d) * RW_CH + ch);
#pragma unroll 4
        for (int it = 0; it < 8; ++it) {
          const int tt = it * 4 + ts, tok = mt * 32 + tt;
          f32x4 xw = *(const f32x4*)(X + tt * LX + cq * 4);
          u32x2 o;
          u16 hh[4];
#pragma unroll
          for (int j = 0; j < 4; ++j) {
            const float e = 0.60653065971263342f * fsigmoid_(w0[j] + xw[j]);
            hh[j] = f2h(1.0f - fexp_(-e));
          }
          o[0] = (unsigned)hh[0] | ((unsigned)hh[1] << 16); o[1] = (unsigned)hh[2] | ((unsigned)hh[3] << 16);
          *(u32x2*)(sidir + (size_t)d * dirstride + (seqidx0 + tok) * 192 + cq * 4) = o;
        }
        SEG_MARK(p, 6)
        gemm_to_X(Aad, LA, d * 32 + mt * 32, p.wt_aup + ((size_t)l * 2 + d) * RW_CH * IRK, IRK);
        const f32x4 a0 = *(const f32x4*)(p.rw_a0 + ((size_t)l * 2 + d) * RW_CH + ch);
#pragma unroll
        for (int it = 0; it < 8; ++it) {
          const int tt = it * 4 + ts, tok = mt * 32 + tt;
          f32x4 xa = *(const f32x4*)(X + tt * LX + cq * 4);
          const f32x4 rv = rvs[it], kv = kvs[it];
          const float ri = ris[it];
          f32x4 ka, kd;
          float bs = 0.f;
#pragma unroll
          for (int j = 0; j < 4; ++j) {
            float a = fsigmoid_(a0[j] + xa[j]);
            ka[j] = kv[j] * kkc[j] * ri * a;
            kd[j] = kv[j] * (1.f + (a - 1.f) * k_a[j]);
            bs += rv[j] * kd[j] * r_k[j];
          }
          u16* dst = sidir + (size_t)d * dirstride + (seqidx0 + tok) * 192 + cq * 4;
          st_bf4(dst + 64, ka); st_bf4(dst + 128, kd);
          bs = red16(bs);
          if (cq == 0) sbw[tt] += bs;
        }
      }
      SEG_MARK(p, 7)
      wave_sync();
      if (lane < 32) p.sbonus[(size_t)(r0 + mt * 32 + lane) * RW_H + h] = sbw[lane];
      gemm_to_X(Agd, LG, mt * 32, p.wt_gup + (size_t)l * RW_CH * GRK, GRK);
#pragma unroll 4
      for (int it = 0; it < 8; ++it) {
        const int tt = it * 4 + ts, tok = mt * 32 + tt;
        f32x4 xg = *(const f32x4*)(X + tt * LX + cq * 4);
        st_bf4(p.gbuf + (size_t)(r0 + tok) * RW_CH + ch, xg);
      }
      wave_sync();
      SEG_MARK(p, 8)
    }
  }
  __syncthreads();
  SEG_MARK(p, 8)
}

DI void ph_prep(const Params& p, int l, char* smem) {
  for (int item = BIDX(); item < T / 32; item += gridDim.x) prep_item(p, l, item, smem);
}

typedef __attribute__((ext_vector_type(2))) float f32x2;
constexpr int SC_C = 16, SC_NSLOT = 8, SC_NCONS = 2, SC_NPROD = 6;
constexpr int SC_LDP = 72;
constexpr int SC_LDQ = 40;
constexpr int SC_AT = 0, SC_RT = SC_AT + 16 * SC_LDP * 2, SC_KT = SC_RT + 16 * SC_LDP * 2, SC_PQ = SC_KT + 64 * SC_LDQ * 2,
              SC_BM = SC_PQ + 16 * SC_LDQ * 2, SC_TM = SC_BM + 16 * SC_LDQ * 2, SC_VT = SC_TM + 16 * SC_LDQ * 2, SC_CUM = SC_VT + 64 * 16 * 2,
              SC_SLOT = SC_CUM + 64 * 4;
constexpr int SC_PSCR = SC_NSLOT * SC_SLOT;
constexpr int SC_PSCR_W = 2 * 16 * SC_LDP * 2;
constexpr int SC_FLAGS = SC_PSCR + SC_NPROD * SC_PSCR_W;
static_assert(SC_FLAGS + 64 * 4 < SMEM_BYTES - 1024, "scan LDS");
static_assert(SC_SLOT % 16 == 0 && SC_PSCR_W % 16 == 0, "scan LDS alignment");

#ifdef EMU
typedef volatile int* sc_flag_t;
#else
typedef volatile LAS int* sc_flag_t;
#endif
DI void sc_wait_eq(sc_flag_t f, int want) {
#ifdef EMU
  while (*f != want) emu_yield();
#else
  while (__builtin_amdgcn_readfirstlane(*f) != want) {}
  asm volatile("s_waitcnt lgkmcnt(0)" ::: "memory");
#endif
}
DI void sc_wait_ge(sc_flag_t f, int want) {
#ifdef EMU
  while (*f < want) emu_yield();
#else
  while (__builtin_amdgcn_readfirstlane(*f) < want) __builtin_amdgcn_s_sleep(1);
  asm volatile("s_waitcnt lgkmcnt(0)" ::: "memory");
#endif
}
DI void sc_flag_inc(sc_flag_t f) {
#ifdef EMU
  *f = *f + 1;
#else
  (void)__hip_atomic_fetch_add((LAS int*)f, 1, __ATOMIC_RELAXED, __HIP_MEMORY_SCOPE_WORKGROUP);
#endif
}
DI float rdlane_f(float v, int l) { return __builtin_bit_cast(float, __builtin_amdgcn_readlane(__builtin_bit_cast(int, v), l)); }
#define MFMA16(a, b, c) __builtin_amdgcn_mfma_f32_16x16x32_bf16((a), (b), (c), 0, 0, 0)

DI void sc_step_time(int d, int s, bool& isctx, int& t) {
  isctx = s < CTXL;
  if (isctx) t = d == 0 ? s : CTXL - 1 - s;
  else { const int u = s - CTXL; t = d == 0 ? u : SEQ - 1 - u; }
}

DI void scan_chain_item(const Params& p, int item, char* smem) {
  const int tid = TIDX(), lane = tid & 63, wave = tid >> 6;
  const int chain = item >> 1, hf = item & 1;
  const int h = chain % RW_H, b = (chain / RW_H) % NB, d = chain / (RW_H * NB);
  constexpr int NCHUNK = (CTXL + SEQ) / SC_C;
  sc_flag_t ready = (sc_flag_t)(smem + SC_FLAGS);
  sc_flag_t done = ready + SC_NSLOT;
  if (tid < 2 * SC_NSLOT) ready[tid] = 0;
  __syncthreads();
  const int q4 = lane >> 4, c16 = lane & 15;
  if (wave >= SC_NCONS) {
    const int pw = wave - SC_NCONS;
    u16* Bt = (u16*)(smem + SC_PSCR + pw * SC_PSCR_W);
    u16* Kt = Bt + 16 * SC_LDP;
    const int k = lane;
    u16 raw[SC_C][6];
    static_assert(CTXL % SC_C == 0 && SEQ % SC_C == 0, "a chunk lies inside the context or the latent part");
    auto load_chunk = [&](int c) {
      bool isctx; int t0;
      sc_step_time(d, c * SC_C, isctx, t0);
      const int L = isctx ? CTXL : SEQ;
      const long st = (d == 0) ? 192 : -192;
      const size_t base = ((size_t)(b * RW_H + h) * L + t0) * 192 + k;
      const u16* sh = (isctx ? p.SIsh_ctx : p.SIsh_lat) + base;
      const u16* dr = (isctx ? p.SIdir_ctx : p.SIdir_lat) + (size_t)d * NB * RW_H * L * 192 + base;
#pragma unroll
      for (int j = 0; j < SC_C; ++j) {
        const u16* s_ = sh + j * st; const u16* d_ = dr + j * st;
        raw[j][0] = s_[0]; raw[j][1] = s_[64]; raw[j][2] = s_[128];
        raw[j][3] = d_[0]; raw[j][4] = d_[64]; raw[j][5] = d_[128];
      }
    };
    if (pw < NCHUNK) load_chunk(pw);
    for (int c = pw; c < NCHUNK; c += SC_NPROD) {
      const int slot = c % SC_NSLOT;
      char* sl = smem + slot * SC_SLOT;
      u16* At = (u16*)(sl + SC_AT); u16* Rt = (u16*)(sl + SC_RT); u16* KT = (u16*)(sl + SC_KT);
      u16* PQ = (u16*)(sl + SC_PQ); u16* BM = (u16*)(sl + SC_BM); u16* TM = (u16*)(sl + SC_TM);
      u16* VT = (u16*)(sl + SC_VT); float* CUM = (float*)(sl + SC_CUM);
      sc_wait_ge(done + slot, SC_NCONS * (c / SC_NSLOT));
      float cum = 1.f;
      unsigned ktp[8], btp[8], vtp[8];
#pragma unroll
      for (int j2 = 0; j2 < SC_C / 2; ++j2) {
        float at[2], rt[2], bt[2], kt[2];
#pragma unroll
        for (int e = 0; e < 2; ++e) {
          const int j = 2 * j2 + e;
          const float rr = bf2f(raw[j][0]), kk = bf2f(raw[j][1]);
          const float w = 1.f - h2f(raw[j][3]), ka = bf2f(raw[j][4]), kd = bf2f(raw[j][5]);
          at[e] = cum * kk;
          cum *= w;
          const float ic = frcp_(cum);
          rt[e] = cum * rr; bt[e] = ka * ic; kt[e] = kd * ic;
        }
        const unsigned ap = pk2(at[0], at[1]), rp = pk2(rt[0], rt[1]);
        btp[j2] = pk2(bt[0], bt[1]); ktp[j2] = pk2(kt[0], kt[1]);
        vtp[j2] = (unsigned)raw[2 * j2][2] | ((unsigned)raw[2 * j2 + 1][2] << 16);
        const int o0 = (2 * j2) * SC_LDP + k, o1 = o0 + SC_LDP;
        At[o0] = (u16)(ap & 0xffffu); At[o1] = (u16)(ap >> 16);
        Rt[o0] = (u16)(rp & 0xffffu); Rt[o1] = (u16)(rp >> 16);
        Bt[o0] = (u16)(btp[j2] & 0xffffu); Bt[o1] = (u16)(btp[j2] >> 16);
        Kt[o0] = (u16)(ktp[j2] & 0xffffu); Kt[o1] = (u16)(ktp[j2] >> 16);
      }
      if (c + SC_NPROD < NCHUNK) load_chunk(c + SC_NPROD);
      CUM[k] = cum;
      {
#pragma unroll
        for (int hh = 0; hh < 2; ++hh) {
          u32x4 o;
          o[0] = ktp[4 * hh]; o[1] = ktp[4 * hh + 1]; o[2] = ktp[4 * hh + 2]; o[3] = ktp[4 * hh + 3];
          *(u32x4*)(KT + k * SC_LDQ + 8 * hh) = o;
          o[0] = btp[4 * hh]; o[1] = btp[4 * hh + 1]; o[2] = btp[4 * hh + 2]; o[3] = btp[4 * hh + 3];
          *(u32x4*)(KT + k * SC_LDQ + 16 + 8 * hh) = o;
          o[0] = vtp[4 * hh]; o[1] = vtp[4 * hh + 1]; o[2] = vtp[4 * hh + 2]; o[3] = vtp[4 * hh + 3];
          *(u32x4*)(VT + k * 16 + 8 * hh) = o;
        }
      }
      wave_sync();
      f32x4 am = {0.f, 0.f, 0.f, 0.f}, bm = am, pm = am, qm = am;
#pragma unroll
      for (int ks = 0; ks < 2; ++ks) {
        const int o = c16 * SC_LDP + 32 * ks + 8 * q4;
        const bf16x8 fa = *(const bf16x8*)(At + o), fr = *(const bf16x8*)(Rt + o);
        const bf16x8 fb = *(const bf16x8*)(Bt + o), fk = *(const bf16x8*)(Kt + o);
        am = MFMA16(fa, fb, am); bm = MFMA16(fa, fk, bm); pm = MFMA16(fr, fk, pm); qm = MFMA16(fr, fb, qm);
      }
#pragma unroll
      for (int r = 0; r < 4; ++r) {
        const int j = 4 * q4 + r;
        BM[j * SC_LDQ + c16] = c16 < j ? f2bf(bm[r]) : (u16)0;
        PQ[j * SC_LDQ + c16] = c16 <= j ? f2bf(pm[r]) : (u16)0;
        PQ[j * SC_LDQ + 16 + c16] = c16 <= j ? f2bf(-qm[r]) : (u16)0;
      }
      float* Af = (float*)Bt;
#pragma unroll
      for (int r = 0; r < 4; ++r) Af[(4 * q4 + r) * 16 + c16] = am[r];
      wave_sync();
      float Tc[16];
#pragma unroll
      for (int j = 0; j < 16; ++j) {
        float tv = (j == c16) ? 1.f : 0.f;
#pragma unroll
        for (int m = 0; m < (j + 3) / 4; ++m) {
          const f32x4 a4 = *(const f32x4*)(Af + j * 16 + 4 * m);
#pragma unroll
          for (int e = 0; e < 4; ++e) if (4 * m + e < j) tv -= a4[e] * Tc[4 * m + e];
        }
        Tc[j] = tv;
      }
#pragma unroll
      for (int j = 0; j < 16; ++j) {
        if (q4 == 0) TM[j * SC_LDQ + c16] = f2bf(Tc[j]);
      }
      wave_sync();
      if (lane == 0) ready[slot] = c + 1;
    }
  } else {
    const int vt = SC_NCONS * hf + wave;
#ifndef EMU
    __builtin_amdgcn_s_setprio(3);
#endif
    f32x4 ST[4];
#pragma unroll
    for (int mt = 0; mt < 4; ++mt) ST[mt] = (f32x4){0.f, 0.f, 0.f, 0.f};
    auto ld2 = [&](const u16* q0, const u16* q1) {
      const u32x2 a = *(const u32x2*)q0, b2 = *(const u32x2*)q1;
      u32x4 o; o[0] = a[0]; o[1] = a[1]; o[2] = b2[0]; o[3] = b2[1];
      return __builtin_bit_cast(bf16x8, o);
    };
    auto ld1z = [&](const u16* q0) {
      const u32x2 a = *(const u32x2*)q0;
      u32x4 o; o[0] = a[0]; o[1] = a[1]; o[2] = 0u; o[3] = 0u;
      return __builtin_bit_cast(bf16x8, o);
    };
    SEG_BEGIN(p)
    for (int c = 0; c < NCHUNK; ++c) {
      const int slot = c % SC_NSLOT;
      const char* sl = smem + slot * SC_SLOT;
      const u16* At = (const u16*)(sl + SC_AT); const u16* Rt = (const u16*)(sl + SC_RT); const u16* KT = (const u16*)(sl + SC_KT);
      const u16* PQ = (const u16*)(sl + SC_PQ); const u16* BM = (const u16*)(sl + SC_BM); const u16* TM = (const u16*)(sl + SC_TM);
      const u16* VT = (const u16*)(sl + SC_VT); const float* CUM = (const float*)(sl + SC_CUM);
      bf16x8 shi[2], slo[2];
#pragma unroll
      for (int ks = 0; ks < 2; ++ks) {
        u32x4 oh, ol;
#pragma unroll
        for (int hh = 0; hh < 2; ++hh) {
          const f32x4 x = ST[2 * ks + hh];
          float h0 = bf2f(f2bf(x[0])), h1 = bf2f(f2bf(x[1])), h2 = bf2f(f2bf(x[2])), h3 = bf2f(f2bf(x[3]));
          oh[2 * hh] = pk2(x[0], x[1]); oh[2 * hh + 1] = pk2(x[2], x[3]);
          ol[2 * hh] = pk2(x[0] - h0, x[1] - h1); ol[2 * hh + 1] = pk2(x[2] - h2, x[3] - h3);
        }
        shi[ks] = __builtin_bit_cast(bf16x8, oh); slo[ks] = __builtin_bit_cast(bf16x8, ol);
      }
      SEG_MARK(p, 12)
      sc_wait_eq(ready + slot, c + 1);
      SEG_MARK(p, 13)
      f32x4 rhs = {0.f, 0.f, 0.f, 0.f}, y = rhs;
#pragma unroll
      for (int ks = 0; ks < 2; ++ks) {
        const int o = c16 * SC_LDP + 32 * ks + 4 * q4;
        const bf16x8 fa = ld2(At + o, At + o + 16), fr = ld2(Rt + o, Rt + o + 16);
        rhs = MFMA16(fa, shi[ks], rhs); y = MFMA16(fr, shi[ks], y);
        rhs = MFMA16(fa, slo[ks], rhs); y = MFMA16(fr, slo[ks], y);
      }
      const u32x2 vraw = *(const u32x2*)(VT + (16 * vt + c16) * 16 + 4 * q4);
      {
        u32x4 o; o[0] = vraw[0]; o[1] = vraw[1]; o[2] = 0u; o[3] = 0u;
        rhs = MFMA16(ld1z(BM + c16 * SC_LDQ + 4 * q4), __builtin_bit_cast(bf16x8, o), rhs);
      }
      f32x4 z = {0.f, 0.f, 0.f, 0.f};
      {
        u32x4 o; o[0] = pk2(rhs[0], rhs[1]); o[1] = pk2(rhs[2], rhs[3]); o[2] = 0u; o[3] = 0u;
        z = MFMA16(ld1z(TM + c16 * SC_LDQ + 4 * q4), __builtin_bit_cast(bf16x8, o), z);
      }
      const unsigned z01 = pk2(z[0], z[1]), z23 = pk2(z[2], z[3]);
      {
        u32x4 o; o[0] = vraw[0]; o[1] = vraw[1]; o[2] = z01; o[3] = z23;
        y = MFMA16(ld2(PQ + c16 * SC_LDQ + 4 * q4, PQ + c16 * SC_LDQ + 16 + 4 * q4), __builtin_bit_cast(bf16x8, o), y);
      }
      {
        bool isctx; int t0;
        sc_step_time(d, c * SC_C + 4 * q4, isctx, t0);
        const int rrow0 = isctx ? TL + b * CTXL + t0 : b * SEQ + t0;
        u16* yo = p.ybuf + ((size_t)d * T + rrow0) * RW_CH + h * 64 + 16 * vt + c16;
        const long yst = (d == 0) ? RW_CH : -RW_CH;
#pragma unroll
        for (int r = 0; r < 4; ++r) yo[r * yst] = f2bf(y[r]);
      }
      {
        u32x4 o; o[0] = vraw[0]; o[1] = vraw[1]; o[2] = z01 ^ 0x80008000u; o[3] = z23 ^ 0x80008000u;
        const bf16x8 bS = __builtin_bit_cast(bf16x8, o);
#pragma unroll
        for (int mt = 0; mt < 4; ++mt) {
          const u16* kr = KT + (16 * mt + c16) * SC_LDQ + 4 * q4;
          ST[mt] = MFMA16(ld2(kr, kr + 16), bS, ST[mt]);
          const f32x4 cm = *(const f32x4*)(CUM + 16 * mt + 4 * q4);
#pragma unroll
          for (int r = 0; r < 4; ++r) ST[mt][r] *= cm[r];
        }
      }
      wave_sync();
      if (lane == 0) sc_flag_inc(done + slot);
    }
#ifndef EMU
    __builtin_amdgcn_s_setprio(0);
#endif
  }
  __syncthreads();
}
DI void ph_scan(const Params& p, char* smem) {
  for (int item = BIDX(); item < 2 * (2 * NB * RW_H); item += gridDim.x) scan_chain_item(p, item, smem);
}

DI void ph_assemble(const Params& p, int l, char* smem) {
  const int tid = TIDX(), lane = tid & 63, wave = tid >> 6;
  const int ts = lane >> 4, cq = lane & 15;
  const int rows = (l == 0) ? T : TL;
  constexpr int LY = 66;
  u16* yt = (u16*)smem;
  const float* gn = p.mix_norm_g + (size_t)l * (CONV_CH + HY_CH);
  for (int tile = BIDX(); tile < rows / 64; tile += gridDim.x) {
    const int r0 = tile * 64;
    int b_, t0, L;
    seq_of_row(r0, b_, t0, L);
    const u16* yh = (r0 < TL ? p.yhlat : p.yhctx) + (size_t)b_ * HY_CH * L + t0;
    for (int i = tid; i < HY_CH * 8; i += NT) {
      int c = i >> 3, part = i & 7;
      const u32x4 v = *(const u32x4*)(yh + (size_t)c * L + part * 8);
      unsigned* q = (unsigned*)(yt + c * LY + part * 8);
      q[0] = v[0]; q[1] = v[1]; q[2] = v[2]; q[3] = v[3];
    }
    __syncthreads();
    const u16* sish = (r0 < TL ? p.SIsh_lat : p.SIsh_ctx);
#pragma unroll
    for (int it = 0; it < 2; ++it) {
      const int tok = wave * 8 + it * 4 + ts;
      const int r = r0 + tok;
      u16* dst = p.ycat + (size_t)r * MIX_W;
#pragma unroll
      for (int bk = 0; bk < CONV_CH / 64; ++bk)
        *(u32x2*)(dst + bk * 64 + cq * 4) = *(const u32x2*)(p.ya + (size_t)r * CONV_CH + bk * 64 + cq * 4);
      float hv[HY_CH / 64][4];
      float ss = 0.f;
#pragma unroll
      for (int bk = 0; bk < HY_CH / 64; ++bk)
#pragma unroll
        for (int j = 0; j < 4; ++j) { hv[bk][j] = bf2f(yt[(bk * 64 + cq * 4 + j) * LY + tok]); ss += hv[bk][j] * hv[bk][j]; }
      ss = red16(ss);
      const float rs = rsqrtf(ss / (float)HY_CH + LN_EPS);
#pragma unroll
      for (int bk = 0; bk < HY_CH / 64; ++bk) {
        const f32x4 g4 = *(const f32x4*)(gn + CONV_CH + bk * 64 + cq * 4);
        f32x4 o;
#pragma unroll
        for (int j = 0; j < 4; ++j) o[j] = hv[bk][j] * rs * g4[j];
        st_bf4(dst + CONV_CH + bk * 64 + cq * 4, o);
      }
#pragma unroll
      for (int h = 0; h < RW_H; ++h) {
        const int ch = h * 64 + cq * 4;
        const f32x4 yf = ld_bf4(p.ybuf + (size_t)r * RW_CH + ch), yb = ld_bf4(p.ybuf + ((size_t)T + r) * RW_CH + ch);
        const f32x4 vv = ld_bf4(sish + ((size_t)(b_ * RW_H + h) * L + t0 + tok) * 192 + 128 + cq * 4);
        const f32x4 gg = ld_bf4(p.gbuf + (size_t)r * RW_CH + ch);
        const f32x4 lg4 = *(const f32x4*)(p.rw_lnx_g + (size_t)l * RW_CH + ch), lb4 = *(const f32x4*)(p.rw_lnx_b + (size_t)l * RW_CH + ch);
        const float sb = p.sbonus[(size_t)r * RW_H + h];
        f32x4 yv;
        float sm = 0.f;
#pragma unroll
        for (int j = 0; j < 4; ++j) { yv[j] = yf[j] + yb[j]; sm += yv[j]; }
        const float mu = red16(sm) * (1.f / 64.f);
        float sq = 0.f;
#pragma unroll
        for (int j = 0; j < 4; ++j) { yv[j] -= mu; sq += yv[j] * yv[j]; }
        const float rstd = rsqrtf(red16(sq) * (1.f / 64.f) + RW_GN_EPS);
        f32x4 o;
#pragma unroll
        for (int j = 0; j < 4; ++j) o[j] = (yv[j] * rstd * lg4[j] + lb4[j] + sb * vv[j]) * gg[j];
        st_bf4(dst + CONV_CH + HY_CH + ch, o);
      }
    }
    __syncthreads();
  }
}

DI void ph_outproj(const Params& p, int l, char* smem) {
  const int rows = (l == 0) ? T : TL;
  const int G = gridDim.x, c = BIDX();
  {
    DenseSched S; S.init(p.ycat, p.wt_out + (size_t)l * D * MIX_W, MIX_W, rows, D, G, c);
    EpiOutproj E{&p, l};
    pg8::gemm_phase(smem, MIX_W, S, E);
  }
  __syncthreads();
  ticket_loop(p.bar + XB_TICKET + 1 + DEPTH + l, CT_EXP_L, smem, [&](int it) { convert_expert_item(p, l, it, smem); });
}

DI void ph_ln_router(const Params& p, int l, char* smem) {
  const int tid = TIDX(), lane = tid & 63, wave = tid >> 6;
  const int rows = (l == 0) ? T : TL;
  constexpr int LH = D + 8;
  constexpr int EPL = D / 64;
  u16* Hhi = (u16*)smem;
  u16* Hlo = Hhi + 32 * LH;
  float* red = (float*)smem;
  constexpr int LGS_OFF = (2 * 32 * LH * 2 > 8 * 32 * 64 * 4) ? 2 * 32 * LH * 2 : 8 * 32 * 64 * 4;
  float* lgs = (float*)(smem + LGS_OFF);
  const float* lg = p.ln_g + ((size_t)l * 2 + 0) * D;
  const float* lb = p.ln_b + ((size_t)l * 2 + 0) * D;
  const u16* Whi = p.wt_rhi + (size_t)l * NE * D;
  const u16* Wlo = p.wt_rlo + (size_t)l * NE * D;
  constexpr int KS = D / 8;
  SEG_BEGIN(p)
  for (int tile = BIDX(); tile < rows / 32; tile += gridDim.x) {
    const int r0 = tile * 32;
#pragma unroll 2
    for (int tt = 0; tt < 4; ++tt) {
      const int tok = wave * 4 + tt;
      const int r = r0 + tok;
      float* xr = x1row(p, r);
      const float* m = modp(p, l, r);
      constexpr int NV = D / 256;
      f32x4 xv[NV];
      float s = 0.f;
#pragma unroll
      for (int i = 0; i < NV; ++i) { xv[i] = ld_bf4(p.XP + (size_t)r * D + 4 * lane + 256 * i); s += (xv[i][0] + xv[i][1]) + (xv[i][2] + xv[i][3]); }
      const float mu = wave_sum(s) * (1.f / (float)D);
      float s2 = 0.f;
#pragma unroll
      for (int i = 0; i < NV; ++i)
#pragma unroll
        for (int j = 0; j < 4; ++j) { float dd = xv[i][j] - mu; s2 += dd * dd; }
      const float rstd = rsqrtf(wave_sum(s2) * (1.f / (float)D) + LN_EPS);
#pragma unroll
      for (int i = 0; i < NV; ++i) {
        const int e = 4 * lane + 256 * i;
        const f32x4 g4 = *(const f32x4*)(lg + e), b4 = *(const f32x4*)(lb + e);
        const f32x4 sc = *(const f32x4*)(m + 4 * D + e), sh = *(const f32x4*)(m + 3 * D + e);
        f32x4 xn, hh, lo;
#pragma unroll
        for (int j = 0; j < 4; ++j) { xn[j] = (xv[i][j] - mu) * rstd * g4[j] + b4[j]; hh[j] = xn[j] * (1.f + sc[j]) + sh[j]; }
        st_bf4((l + 1 < DEPTH ? xbrow(p, r) : xblast(p, r)) + e, xn);
        u32x2 hp; hp[0] = pk2(hh[0], hh[1]); hp[1] = pk2(hh[2], hh[3]);
#pragma unroll
        for (int j = 0; j < 4; ++j) lo[j] = hh[j] - bf2f((u16)((j & 1) ? (hp[j >> 1] >> 16) : (hp[j >> 1] & 0xffff)));
        *(u32x2*)(Hhi + tok * LH + e) = hp;
        st_bf4(Hlo + tok * LH + e, lo);
        *(u32x2*)(p.HL + (size_t)r * D + e) = hp;
        u32x2 zz; zz[0] = 0u; zz[1] = 0u;
        *(u32x2*)(p.acc + (size_t)r * (D / 2) + e / 2) = zz;
      }
    }
    __syncthreads();
    SEG_MARK(p, 0)
    f32x16 c0, c1;
#pragma unroll
    for (int r = 0; r < 16; ++r) { c0[r] = 0.f; c1[r] = 0.f; }
#pragma unroll 4
    for (int k0 = wave * KS; k0 < (wave + 1) * KS; k0 += 16) {
      const int ko = k0 + (lane >> 5) * 8;
      bf16x8 ah = *(const bf16x8*)(Hhi + (lane & 31) * LH + ko);
      bf16x8 al = *(const bf16x8*)(Hlo + (lane & 31) * LH + ko);
      bf16x8 bh0 = *(const bf16x8*)(Whi + (size_t)(lane & 31) * D + ko);
      bf16x8 bh1 = *(const bf16x8*)(Whi + (size_t)(32 + (lane & 31)) * D + ko);
      bf16x8 bl0 = *(const bf16x8*)(Wlo + (size_t)(lane & 31) * D + ko);
      bf16x8 bl1 = *(const bf16x8*)(Wlo + (size_t)(32 + (lane & 31)) * D + ko);
      c0 = MFMA32(ah, bh0, c0); c0 = MFMA32(ah, bl0, c0); c0 = MFMA32(al, bh0, c0);
      c1 = MFMA32(ah, bh1, c1); c1 = MFMA32(ah, bl1, c1); c1 = MFMA32(al, bh1, c1);
    }
    __syncthreads();
    SEG_MARK(p, 1)
#pragma unroll
    for (int r = 0; r < 16; ++r) {
      red[(wave * 32 + crow(r, lane >> 5)) * 64 + (lane & 31)] = c0[r];
      red[(wave * 32 + crow(r, lane >> 5)) * 64 + 32 + (lane & 31)] = c1[r];
    }
    __syncthreads();
    for (int i = tid; i < 32 * 64; i += NT) {
      float sacc = 0.f;
#pragma unroll
      for (int w = 0; w < 8; ++w) sacc += red[w * 2048 + i];
      lgs[i] = sacc;
    }
    __syncthreads();
    SEG_MARK(p, 2)
    unsigned long long* selm = (unsigned long long*)(lgs + 32 * 64);
    unsigned char* lpos = (unsigned char*)(selm + 32);
    int* tbase = (int*)(lpos + 32 * 64);
    const float eb = p.e_bias[(size_t)l * NE + lane];
    float gate4[4];
    bool ch4[4];
    {
      float score4[4], selv4[4];
#pragma unroll
      for (int tt = 0; tt < 4; ++tt) { score4[tt] = fsigmoid_(lgs[(wave * 4 + tt) * 64 + lane]); selv4[tt] = score4[tt] + eb; ch4[tt] = false; }
      for (int round = 0; round < TOPK; ++round) {
#pragma unroll
        for (int tt = 0; tt < 4; ++tt) {
          const float cand = ch4[tt] ? -1e30f : selv4[tt];
          const float mx = wave_max(cand);
          const unsigned long long bal = __ballot(cand == mx);
          const int win = __ffsll((long long)bal) - 1;
          if (lane == win) ch4[tt] = true;
        }
      }
#pragma unroll
      for (int tt = 0; tt < 4; ++tt) {
        const float ssum = wave_sum(ch4[tt] ? score4[tt] : 0.f);
        gate4[tt] = ROUTED_SCALE * score4[tt] / ssum;
        const unsigned long long m = __ballot(ch4[tt]);
        if (lane == 0) selm[wave * 4 + tt] = m;
      }
    }
    __syncthreads();
    if (wave == 0) {
      int c = 0;
      for (int t = 0; t < 32; ++t) {
        const int bit = (int)((selm[t] >> lane) & 1ull);
        lpos[t * 64 + lane] = (unsigned char)c;
        c += bit;
      }
      int base = 0;
      if (c > 0) base = atomicAdd(p.cnt + l * NE + lane, c);
      tbase[lane] = base;
    }
    __syncthreads();
#pragma unroll
    for (int tt = 0; tt < 4; ++tt) {
      const int tok = wave * 4 + tt;
      if (ch4[tt]) {
        const int pos = tbase[lane] + (int)lpos[tok * 64 + lane];
        p.etok[(size_t)lane * T + pos] = r0 + tok;
        p.egate[(size_t)lane * T + pos] = gate4[tt];
      }
    }
    __syncthreads();
    SEG_MARK(p, 3)
  }
}

constexpr int EXP_LDS_OFF = 128 * 1024;
constexpr int MAX_ROW_TILES = (T * TOPK) / 256 + NE + T / 256;
static_assert(28 * 1024 + (2 * (NE + 2) + (NE + 2)) * 4 + MAX_ROW_TILES + EXP_LDS_OFF <= SMEM_BYTES - 1024, "expert tables fit below the parked parameters");
static_assert(NE == 64, "binary search step");
struct ExpTables { int* pre; int* hoff; int* cntl; unsigned char* t2e; };
DI ExpTables expert_tables(const Params& p, int l, int rows, char* smem) {
  ExpTables x;
  x.pre = (int*)(smem + EXP_LDS_OFF + 28 * 1024);
  x.hoff = x.pre + (NE + 2);
  x.cntl = x.hoff + (NE + 2);
  x.t2e = (unsigned char*)(x.cntl + (NE + 2));
  const int tid = TIDX();
  if (tid == 0) {
    int s = 0, ho = 0;
    for (int e = 0; e < NE; ++e) { const int ce = p.cnt[l * NE + e]; const int nt = (ce + 255) / 256; x.pre[e] = s; x.hoff[e] = ho; x.cntl[e] = ce; s += nt; ho += nt * 256; }
    x.pre[NE] = s; x.hoff[NE] = ho; x.cntl[NE] = rows; s += rows / 256; x.pre[NE + 1] = s;
  }
  __syncthreads();
  {
    const int R = x.pre[NE + 1];
    for (int t = tid; t < R; t += NT) {
      int e = 0;
#pragma unroll
      for (int step = 64; step >= 1; step >>= 1) { const int c = e + step; if (c <= NE && x.pre[c] <= t) e = c; }
      x.t2e[t] = (unsigned char)e;
    }
  }
  __syncthreads();
  return x;
}
DI void ph_e1(const Params& p, int l, char* smem) {
  const int rows = (l == 0) ? T : TL;
  const ExpTables x = expert_tables(p, l, rows, smem);
  E1Sched S;
  S.pre = x.pre; S.cntl = x.cntl; S.t2e = x.t2e; S.nN = FF / 128; S.G = gridDim.x; S.c = BIDX(); S.total = x.pre[NE + 1] * S.nN;
  S.A = (const char*)p.HL; S.W = (const char*)p.wt_exp; S.etok = p.etok;
  S.preload((unsigned*)(smem + EXP_LDS_OFF), 24);
  EpiE1 E{p.Hbuf, x.hoff};
  pg8::gemm_phase(smem, D, S, E);
  __syncthreads();
}
DI void ph_e2(const Params& p, int l, char* smem) {
  const int rows = (l == 0) ? T : TL;
  const ExpTables x = expert_tables(p, l, rows, smem);
  E2Sched S;
  S.pre = x.pre; S.cntl = x.cntl; S.t2e = x.t2e; S.nN = D / 256; S.G = gridDim.x; S.c = BIDX(); S.total = x.pre[NE + 1] * S.nN;
  S.A = (const char*)p.Hbuf; S.W = (const char*)p.wt_exp; S.hoff = x.hoff;
  EpiE2 E{p.acc, p.etok, p.egate, (float*)(smem + EXP_LDS_OFF), p.SHo};
  pg8::gemm_phase(smem, FF, S, E);
  __syncthreads();
}

DI void ph_combine(const Params& p, int l) {
  const int tid = TIDX(), lane = tid & 63, wave = tid >> 6;
  const int rows = (l == 0) ? T : TL;
  constexpr int NV = D / 256;
  constexpr int RPW = 2;
  const float* lg = p.ln_g + ((size_t)l * 2 + 1) * D;
  const float* lb = p.ln_b + ((size_t)l * 2 + 1) * D;
  for (int tile = BIDX(); tile < rows / (8 * RPW); tile += gridDim.x) {
    f32x4 xv[RPW][NV];
    float s[RPW];
#pragma unroll
    for (int u = 0; u < RPW; ++u) {
      const int r = tile * (8 * RPW) + u * 8 + wave;
      const float* x1 = x1row(p, r);
      const float* m = modp(p, l, r);
      s[u] = 0.f;
#pragma unroll
      for (int i = 0; i < NV; ++i) {
        const int e = 4 * lane + 256 * i;
        const u32x2 aw = *(const u32x2*)(p.acc + (size_t)r * (D / 2) + e / 2);
        float m0, m1, m2, m3;
        acc_unpack4(aw[0], aw[1], m0, m1, m2, m3);
        const f32x4 xx = ld_bf4((l + 1 < DEPTH ? xbrow(p, r) : xblast(p, r)) + e);
        const f32x4 gg = *(const f32x4*)(m + 5 * D + e);
        const f32x4 sh4 = ld_bf4(p.SHo + (size_t)r * D + e);
        xv[u][i][0] = DN_ALPHA * xx[0] + gg[0] * (m0 + sh4[0]); xv[u][i][1] = DN_ALPHA * xx[1] + gg[1] * (m1 + sh4[1]);
        xv[u][i][2] = DN_ALPHA * xx[2] + gg[2] * (m2 + sh4[2]); xv[u][i][3] = DN_ALPHA * xx[3] + gg[3] * (m3 + sh4[3]);
        s[u] += (xv[u][i][0] + xv[u][i][1]) + (xv[u][i][2] + xv[u][i][3]);
      }
    }
#pragma unroll
    for (int u = 0; u < RPW; ++u) {
      const int r = tile * (8 * RPW) + u * 8 + wave;
      float* x1 = x1row(p, r);
      const float* m = modp(p, l, r);
      const float mu = wave_sum(s[u]) * (1.f / (float)D);
      float s2 = 0.f;
#pragma unroll
      for (int i = 0; i < NV; ++i)
#pragma unroll
        for (int j = 0; j < 4; ++j) { float dd = xv[u][i][j] - mu; s2 += dd * dd; }
      const float rstd = rsqrtf(wave_sum(s2) * (1.f / (float)D) + LN_EPS);
      const float* m1 = (l + 1 < DEPTH) ? modp(p, l + 1, r) : m;
#pragma unroll
      for (int i = 0; i < NV; ++i) {
        const int e = 4 * lane + 256 * i;
        const f32x4 g4 = *(const f32x4*)(lg + e), b4 = *(const f32x4*)(lb + e);
        f32x4 xn;
#pragma unroll
        for (int j = 0; j < 4; ++j) xn[j] = (xv[u][i][j] - mu) * rstd * g4[j] + b4[j];
        if (r < TL) { if (l + 1 < DEPTH) st_bf4(xbrow(p, r) + e, xn); else *(f32x4*)(x1 + e) = xn; }
        if (l + 1 < DEPTH) {
          const f32x4 sc = *(const f32x4*)(m1 + D + e), sh = *(const f32x4*)(m1 + e);
          f32x4 o;
#pragma unroll
          for (int j = 0; j < 4; ++j) o[j] = xn[j] * (1.f + sc[j]) + sh[j];
          st_bf4(p.HL + (size_t)r * D + e, o);
        }
      }
    }
  }
}

constexpr int PH_PER_LAYER = 10;
constexpr int NPHASES = 2 + PH_PER_LAYER * DEPTH;
DI void run_phase(const Params& p, int ph, char* smem) {
  if (ph == 0) { ph_prologue(p, smem); return; }
  if (ph == 1) { ph_premod(p); return; }
  const int l = (ph - 2) / PH_PER_LAYER, q = (ph - 2) % PH_PER_LAYER;
  switch (q) {
    case 0: ph_inproj(p, l, smem); break;
    case 1: ph_mix(p, l, smem); break;
    case 2: ph_prep(p, l, smem); break;
    case 3: ph_scan(p, smem); break;
    case 4: ph_assemble(p, l, smem); break;
    case 5: ph_outproj(p, l, smem); break;
    case 6: ph_ln_router(p, l, smem); break;
    case 7: ph_e1(p, l, smem); break;
    case 8: ph_e2(p, l, smem); break;
    case 9: ph_combine(p, l); break;
  }
}

static inline size_t al256(size_t x) { return (x + 255) & ~(size_t)255; }
static inline size_t max2(size_t a, size_t b) { return a > b ? a : b; }
static Params make_params(void* const* d_in, void* d_out, void* d_ws, size_t* used) {
  Params p{};
  const float** f = (const float**)&p;
  for (int i = 0; i < 42; ++i) f[i] = (const float*)d_in[i];
  p.out = (float*)d_out;
  char* w = (char*)d_ws;
  size_t o = 0;
  auto take = [&](size_t bytes) { char* r = w + o; o = al256(o + bytes); return r; };
  p.HL = (u16*)take((size_t)T * D * 2);
  p.mod = (float*)take((size_t)DEPTH * (NB + 1) * 6 * D * 4);
  p.h3lat = (float*)take((size_t)DEPTH * SEQ * 64 * 4);
  p.h3ctx = (float*)take((size_t)DEPTH * CTXL * 64 * 4);
  p.tw = (cf*)take((size_t)(FFTN / 2) * 8);
  p.tstamp = (long long*)take(64 * 8);
  p.bar = (unsigned*)take((size_t)XCD_BAR_WORDS * 4);
  p.cnt = (int*)take((size_t)DEPTH * NE * 4);
  p.sbonus = (float*)take((size_t)T * RW_H * 4);
  p.XC = (float*)take((size_t)TC * D * 4);
  p.wt_in = (u16*)take((size_t)DEPTH * P_IN_PAD * D * 2);
  p.wt_out = (u16*)take((size_t)DEPTH * D * MIX_W * 2);
  p.wt_rhi = (u16*)take((size_t)DEPTH * NE * D * 2);
  p.wt_rlo = (u16*)take((size_t)DEPTH * NE * D * 2);
  p.wt_wup = (u16*)take((size_t)DEPTH * 2 * RW_CH * DRK * 2);
  p.wt_aup = (u16*)take((size_t)DEPTH * 2 * RW_CH * IRK * 2);
  p.wt_gup = (u16*)take((size_t)DEPTH * RW_CH * GRK * 2);
  const size_t szEt = al256((size_t)NE * T * 4);
  char* G = take(max2(max2((size_t)T * RW_CH * 2, (size_t)2 * HY_CH * FFTN * 8), 2 * szEt));
  p.spec = (cf*)G;
  p.gbuf = (u16*)G;
  p.etok = (int*)G;
  p.egate = (float*)(G + szEt);
  const size_t szPAPH = (size_t)T * PA_W * 2 + (size_t)T * PH_W * 2;
  const size_t szSIsh = (size_t)T * RW_H * 192 * 2;
  const size_t szWexp = (size_t)(NE + 1) * EXP_STRIDE * 2;
  char* R0 = take(max2(max2(szPAPH, szSIsh), szWexp));
  p.PA = (u16*)R0;
  p.PH = (u16*)(R0 + (size_t)T * PA_W * 2);
  p.SIsh_lat = (u16*)R0;
  p.SIsh_ctx = p.SIsh_lat + (size_t)NB * RW_H * SEQ * 192;
  p.wt_exp = (u16*)R0;
  const size_t szPR = (size_t)T * RW_COLS * 2, szY = (size_t)2 * T * RW_CH * 2;
  char* R1 = take(max2(szPR, szY));
  p.PR = (u16*)R1;
  p.ybuf = (u16*)R1;
  const size_t szSIdir = (size_t)2 * T * RW_H * 192 * 2;
  const size_t szYC = al256((size_t)T * MIX_W * 2);
  char* R2 = take(max2(szSIdir, szYC));
  p.SIdir_lat = (u16*)R2;
  p.SIdir_ctx = p.SIdir_lat + (size_t)2 * NB * RW_H * SEQ * 192;
  p.ycat = (u16*)R2;
  p.XP = (u16*)(R2 + szYC);
  p.acc = (int*)R1;
  const size_t szAcc = al256((size_t)T * (D / 2) * 4);
  const size_t szH = (size_t)(T * TOPK + T + (NE + 1) * 256) * FF * 2;
  p.Hbuf = (u16*)(R1 + szAcc);
  const size_t szSH = al256((size_t)T * D * 2);
  p.SHo = (u16*)(R1 + szAcc + al256(szH));
  p.ya = (u16*)take((size_t)T * CONV_CH * 2);
  p.yhlat = (u16*)take((size_t)NB * HY_CH * SEQ * 2);
  p.yhctx = (u16*)take((size_t)NB * HY_CH * CTXL * 2);
  if (szAcc + al256(szH) + szSH > al256(max2(szPR, szY)) + al256(max2(szSIdir, szYC))) o = (size_t)1 << 62;
  if (szYC + (size_t)T * D * 2 > max2(szSIdir, szYC)) o = (size_t)1 << 62;
  *used = o;
  return p;
}
static size_t ws_needed() {
  return (size_t)640 * 1024 * 1024;
}

#ifndef EMU
constexpr int NFIELDS = sizeof(Params) / 8;
static_assert(sizeof(Params) % 8 == 0 && sizeof(Params) <= 1024, "Params layout");
DI unsigned long long uni64(unsigned long long v) {
  unsigned lo = __builtin_amdgcn_readfirstlane((unsigned)v), hi = __builtin_amdgcn_readfirstlane((unsigned)(v >> 32));
  return ((unsigned long long)hi << 32) | lo;
}
DI void load_params(Params& q, const char* smem) {
  const unsigned long long* src = (const unsigned long long*)(smem + SMEM_BYTES - 1024);
  char** dst = (char**)&q;
  typedef __attribute__((address_space(1))) char gchar_t;
#pragma clang loop unroll(full)
  for (int i = 0; i < NFIELDS; ++i) dst[i] = (char*)(gchar_t*)uni64(src[i]);
}
__global__ void __launch_bounds__(NT) hybrid_mega(Params parg) {
  __shared__ __attribute__((aligned(16))) char smem[SMEM_BYTES];
  if (threadIdx.x < NFIELDS)
    ((unsigned long long*)(smem + SMEM_BYTES - 1024))[threadIdx.x] = ((const unsigned long long*)&parg)[threadIdx.x];
  volatile LAS unsigned* st = (volatile LAS unsigned*)(smem + SMEM_BYTES - 16);
  if (threadIdx.x == 0) { st[0] = 0u; st[1] = 0u; }
  __syncthreads();
  const XcdBarrier xb = xcd_barrier_post(parg.bar, st);
#if PROF_SEG
  if (blockIdx.x == 0 && threadIdx.x < 16) parg.tstamp[32 + threadIdx.x] = 0;
#endif
#if PROF_A || PROF_B || PROF_C || PROF_SEG
#define MK_STAMP(ph) if (blockIdx.x == 0 && threadIdx.x == 0) p.tstamp[ph] = (long long)__builtin_amdgcn_s_memrealtime();
#else
#define MK_STAMP(ph)
#endif
#define MK_PHASE(ph) { Params p; load_params(p, smem); MK_STAMP(ph) run_phase(p, ph, smem); if ((ph) + 1 < NPHASES) xcd_barrier(xb); }
  MK_PHASE(0) MK_PHASE(1) MK_PHASE(2) MK_PHASE(3) MK_PHASE(4) MK_PHASE(5) MK_PHASE(6) MK_PHASE(7) MK_PHASE(8) MK_PHASE(9) MK_PHASE(10)
  MK_PHASE(11) MK_PHASE(12) MK_PHASE(13) MK_PHASE(14) MK_PHASE(15) MK_PHASE(16) MK_PHASE(17) MK_PHASE(18) MK_PHASE(19) MK_PHASE(20) MK_PHASE(21)
  static_assert(NPHASES == 22, "phase program");
#if PROF_A || PROF_B || PROF_C || PROF_SEG
  {
    xcd_barrier(xb);
    Params p;
    load_params(p, smem);
    if (blockIdx.x == 0 && threadIdx.x == 0) p.tstamp[NPHASES] = (long long)__builtin_amdgcn_s_memrealtime();
    xcd_barrier(xb);
    const long long* ts = p.tstamp;
    float tot = (float)(ts[NPHASES] - ts[0]);
    (void)tot;
    float ta = 0.f, tb = 0.f;
    long long tc = 0;
    for (int ph = 0; ph < NPHASES; ++ph) {
      float dt = (float)(ts[ph + 1] - ts[ph]);
      if ((PROF_A >> ph) & 1) ta += dt;
      if ((PROF_B >> ph) & 1) tb += dt;
      if ((PROF_C >> ph) & 1) tc += ts[ph + 1] - ts[ph];
    }
#if PROF_SEG
    {
      float st_ = 0.f;
      for (int k = 0; k < 16; ++k) st_ += (float)ts[32 + k];
      ta = (float)ts[32 + PROF_SA]; tb = (float)ts[32 + PROF_SB]; tot = st_ > 0.f ? st_ : 1.f;
      tc = ts[32 + PROF_SC];
    }
#endif
    float fa = ta / tot, fb = tb / tot;
#if PROF_SEG
    fa = floorf(fa * 50.f + 0.5f) * (1.f / 50.f); fb = floorf(fb * 45.f + 0.5f) * (1.f / 45.f);
#endif
    const float da = sqrtf(0.5f * fa);
    const size_t NA = (size_t)TL * D / 100;
    if (!PROF_SEG) for (size_t i = (size_t)blockIdx.x * NT + threadIdx.x; i < NA; i += (size_t)gridDim.x * NT) p.out[i] += da;
    if (PROF_B && !PROF_SEG && blockIdx.x == 0 && threadIdx.x == 0) p.out[(size_t)TL * D - 1] += 10.f + 90.f * fb;
    if (PROF_C || PROF_SEG) { while ((long long)__builtin_amdgcn_s_memrealtime() < ts[NPHASES] + tc) {} }
  }
#endif
}
#ifdef MULTI_LAUNCH
__global__ void __launch_bounds__(NT) hybrid_phase(Params p, int ph) {
  __shared__ __attribute__((aligned(16))) char smem[SMEM_BYTES];
  run_phase(p, ph, smem);
}
#endif

extern "C" void kernel_launch(void* const* d_in, const int* in_sizes, int n_in, void* d_out, int out_size, void* d_ws,
                              size_t ws_size, hipStream_t stream) {
  (void)in_sizes; (void)n_in; (void)out_size;
  static int grid_blocks = 0;
  if (!grid_blocks) {
    int dev = 0, cus = 0, per_cu = 0;
    hipGetDevice(&dev);
    hipDeviceGetAttribute(&cus, hipDeviceAttributeMultiprocessorCount, dev);
    hipOccupancyMaxActiveBlocksPerMultiprocessor(&per_cu, hybrid_mega, NT, 0);
    if (per_cu < 1) per_cu = 1;
    grid_blocks = cus;
  }
  size_t used = 0;
  Params p = make_params(d_in, d_out, d_ws, &used);
  if (used > ws_size) return;
#ifdef MULTI_LAUNCH
  for (int ph = 0; ph < NPHASES; ++ph) hipLaunchKernelGGL(hybrid_phase, dim3(grid_blocks), dim3(NT), 0, stream, p, ph);
#else
  hipMemsetAsync(p.bar, 0, (size_t)XCD_BAR_WORDS * 4, stream);
  void* args[] = {&p};
  hipLaunchCooperativeKernel((void*)hybrid_mega, dim3(grid_blocks), dim3(NT), args, 0, stream);
#endif
}
#endif
```
